# Optimizing an MI355X kernel written in HIP

```python
import jax
import jax.numpy as jnp
from jax import lax
import numpy as np

D_MODEL = 1024
BATCH = 8
SEQ = 2048
DEPTH = 1
DEC_BATCH = 32
DEC_SEQ = 1
PAST_LEN = 16384
PAGE_SIZE = 128

EPS = 1e-6
GDN_HEADS = 8
GDN_DK = 128
GDN_DV = 128
CONV_W = 4
GDN_CHUNK = 64
MLA_HEADS = 8
Q_LORA = 512
KV_LORA = 512
NOPE_DIM = 128
ROPE_DIM = 64
V_DIM = 128
ROPE_THETA = 10000.0
Q_BLOCK = 128
MLA_SCALE = (NOPE_DIM + ROPE_DIM) ** -0.5
D_FF = 4 * D_MODEL
QKV_WIDTH = GDN_HEADS * (2 * GDN_DK + GDN_DV)
Z_WIDTH = GDN_HEADS * GDN_DV
LATENT_WIDTH = KV_LORA + ROPE_DIM
GATE_WIDTH = 2 * D_MODEL
OFF_Z = QKV_WIDTH
OFF_BETA = OFF_Z + Z_WIDTH
OFF_DECAY = OFF_BETA + GDN_HEADS
OFF_QDOWN = OFF_DECAY + GDN_HEADS
OFF_KVDOWN = OFF_QDOWN + Q_LORA
OFF_GATES = OFF_KVDOWN + LATENT_WIDTH
IN_WIDTH = OFF_GATES + GATE_WIDTH
IN_SPLITS = (OFF_Z, OFF_BETA, OFF_DECAY, OFF_QDOWN, OFF_KVDOWN, OFF_GATES)

kernel_name = 'hybrid_gdn_mla_gated_decoder_step'


def rms_norm(x, g):
    xf = x.astype(jnp.float32)
    y = xf * lax.rsqrt(jnp.mean(jnp.square(xf), axis=-1, keepdims=True) + EPS)
    return (y * g.astype(jnp.float32)).astype(x.dtype)


def l2_normalize(x):
    xf = x.astype(jnp.float32)
    return xf * lax.rsqrt(jnp.sum(jnp.square(xf), axis=-1, keepdims=True) + EPS)


def apply_rope(x, pos):
    inv = jnp.power(ROPE_THETA, -jnp.arange(0, ROPE_DIM, 2, dtype=jnp.float32) / ROPE_DIM)
    ang = pos.astype(jnp.float32)[:, None] * inv[None, :]
    cos, sin = jnp.cos(ang), jnp.sin(ang)
    if x.ndim == 4:
        cos, sin = cos[:, None, :], sin[:, None, :]
    xf = x.astype(jnp.float32)
    x1, x2 = xf[..., :ROPE_DIM // 2], xf[..., ROPE_DIM // 2:]
    return jnp.concatenate([x1 * cos - x2 * sin, x1 * sin + x2 * cos], axis=-1).astype(x.dtype)


def causal_conv(buf, x, w):
    xpad = jnp.concatenate([buf.astype(x.dtype), x], axis=1)
    t = x.shape[1]
    y = xpad[:, 0:t] * w[0]
    for i in range(1, CONV_W):
        y = y + xpad[:, i:i + t] * w[i]
    return jax.nn.silu(y), xpad[:, -(CONV_W - 1):]


def gdn_inputs(qkv_raw, b, a, conv_buf, conv_w, a_log, dt_bias):
    bsz, t = qkv_raw.shape[:2]
    qkv, new_buf = causal_conv(conv_buf, qkv_raw, conv_w)
    q, k, v = jnp.split(qkv, [GDN_HEADS * GDN_DK, 2 * GDN_HEADS * GDN_DK], axis=-1)
    q = l2_normalize(q.reshape(bsz, t, GDN_HEADS, GDN_DK)) * (GDN_DK ** -0.5)
    k = l2_normalize(k.reshape(bsz, t, GDN_HEADS, GDN_DK))
    v = v.reshape(bsz, t, GDN_HEADS, GDN_DV).astype(jnp.float32)
    beta = jax.nn.sigmoid(b.astype(jnp.float32))
    g = -jnp.exp(a_log.astype(jnp.float32)) * jax.nn.softplus(
        a.astype(jnp.float32) + dt_bias.astype(jnp.float32))
    return q, k, v, g, beta, new_buf


def gdn_chunked(q, k, v, g, beta, s0):
    bsz, t, h, dk = q.shape
    dv = v.shape[-1]
    n = t // GDN_CHUNK

    def to_chunks(arr):
        return jnp.moveaxis(arr, 1, 2).reshape(bsz, h, n, GDN_CHUNK, *arr.shape[3:])

    q, k, v, g, beta = (to_chunks(arr) for arr in (q, k, v, g, beta))
    G = jnp.cumsum(g, axis=-1)
    idx = jnp.arange(GDN_CHUNK)
    incl = idx[:, None] >= idx[None, :]
    strict = idx[:, None] > idx[None, :]
    diff = G[..., :, None] - G[..., None, :]
    decay = jnp.where(incl, jnp.exp(jnp.where(incl, diff, 0.0)), 0.0)
    kb = k * beta[..., None]
    vb = v * beta[..., None]
    L = jnp.where(strict, jnp.einsum('bhnid,bhnjd->bhnij', kb, k) * decay, 0.0)
    rhs = jnp.concatenate([vb, kb * jnp.exp(G)[..., None]], axis=-1)
    sol = lax.linalg.triangular_solve(L, rhs, left_side=True, lower=True, unit_diagonal=True)
    u0, w = sol[..., :dv], sol[..., dv:]
    aqk = jnp.einsum('bhnid,bhnjd->bhnij', q, k) * decay
    qg = q * jnp.exp(G)[..., None]
    kd = k * jnp.exp(G[..., -1:] - G)[..., None]
    g_end = jnp.exp(G[..., -1])
    xs = tuple(jnp.moveaxis(arr, 2, 0) for arr in (u0, w, qg, aqk, kd, g_end))

    def step(s, inp):
        u0_n, w_n, qg_n, aqk_n, kd_n, g_end_n = inp
        u = u0_n - jnp.einsum('bhik,bhkv->bhiv', w_n, s)
        o = jnp.einsum('bhik,bhkv->bhiv', qg_n, s) + jnp.einsum('bhij,bhjv->bhiv', aqk_n, u)
        s = g_end_n[..., None, None] * s + jnp.einsum('bhik,bhiv->bhkv', kd_n, u)
        return s, o

    s, o = lax.scan(step, s0.astype(jnp.float32), xs)
    o = jnp.moveaxis(o, 0, 2).reshape(bsz, h, t, dv)
    return jnp.moveaxis(o, 1, 2), s


def gdn_recurrent(q, k, v, g, beta, s0):
    xs = tuple(jnp.moveaxis(arr, 1, 0) for arr in (q, k, v, g, beta))

    def step(s, inp):
        q_t, k_t, v_t, g_t, b_t = inp
        s = jnp.exp(g_t)[..., None, None] * s
        u = b_t[..., None] * (v_t - jnp.einsum('bhk,bhkv->bhv', k_t, s))
        s = s + jnp.einsum('bhk,bhv->bhkv', k_t, u)
        return s, jnp.einsum('bhk,bhkv->bhv', q_t, s)

    s, o = lax.scan(step, s0.astype(jnp.float32), xs)
    return jnp.moveaxis(o, 0, 1), s


def gdn_output(o, z, gdn_norm):
    bsz, t = o.shape[:2]
    zf = z.reshape(bsz, t, GDN_HEADS, GDN_DV).astype(jnp.float32)
    y = rms_norm(o, gdn_norm) * jax.nn.silu(zf)
    return y.reshape(bsz, t, Z_WIDTH).astype(z.dtype)


def mla_queries_and_latent(q_down, kv_down, pos, q_a_norm, w_uq, kv_a_norm,
                           q_norm_nope, q_norm_rope, k_norm_rope):
    bsz, t = q_down.shape[:2]
    q = (rms_norm(q_down, q_a_norm) @ w_uq).reshape(bsz, t, MLA_HEADS, NOPE_DIM + ROPE_DIM)
    qn = rms_norm(q[..., :NOPE_DIM], q_norm_nope)
    qr = apply_rope(rms_norm(q[..., NOPE_DIM:], q_norm_rope), pos)
    c = rms_norm(kv_down[..., :KV_LORA], kv_a_norm)
    kr = apply_rope(rms_norm(kv_down[..., KV_LORA:], k_norm_rope), pos)
    return qn, qr, jnp.concatenate([c, kr], axis=-1)


def mla_keys(latent, w_uk, w_uv, k_norm_nope):
    bsz, s = latent.shape[:2]
    c = latent[..., :KV_LORA].astype(w_uk.dtype)
    kr = latent[..., KV_LORA:].astype(w_uk.dtype)
    kn = rms_norm((c @ w_uk).reshape(bsz, s, MLA_HEADS, NOPE_DIM), k_norm_nope)
    v = (c @ w_uv).reshape(bsz, s, MLA_HEADS, V_DIM)
    return kn, kr, v


def mla_scores(qn, qr, kn, kr):
    s = jnp.einsum('bqhd,bkhd->bhqk', qn, kn) + jnp.einsum('bqhr,bkr->bhqk', qr, kr)
    return s.astype(jnp.float32) * MLA_SCALE


def mla_prompt_attention(qn, qr, kn, kr, v):
    bsz, t = qn.shape[:2]
    nb = t // Q_BLOCK
    kpos = jnp.arange(t)

    def blocks(arr):
        return jnp.moveaxis(arr.reshape(bsz, nb, Q_BLOCK, *arr.shape[2:]), 1, 0)

    def attend(inp):
        qn_b, qr_b, i = inp
        s = mla_scores(qn_b, qr_b, kn, kr)
        qpos = i * Q_BLOCK + jnp.arange(Q_BLOCK)
        s = jnp.where(kpos[None, :] <= qpos[:, None], s, -jnp.inf)
        p = jax.nn.softmax(s, axis=-1).astype(v.dtype)
        return jnp.einsum('bhqk,bkhd->bqhd', p, v)

    o = lax.map(attend, (blocks(qn), blocks(qr), jnp.arange(nb)))
    return jnp.moveaxis(o, 0, 1).reshape(bsz, t, MLA_HEADS * V_DIM)


def partial_softmax(s, v):
    m = jnp.max(s, axis=-1)
    p = jnp.exp(s - m[..., None])
    acc = jnp.einsum('bhqk,bkhd->bhqd', p.astype(v.dtype), v).astype(jnp.float32)
    return m, jnp.sum(p, axis=-1), acc


def mla_sample_attention(qn, qr, new_latent, cache_l, page_table, w_uk, w_uv, k_norm_nope):
    bsz, t = qn.shape[:2]

    def page_block(phys):
        kn, kr, v = mla_keys(cache_l[phys], w_uk, w_uv, k_norm_nope)
        return partial_softmax(mla_scores(qn, qr, kn, kr), v)

    m_p, l_p, a_p = lax.map(page_block, page_table.T)
    kn, kr, v = mla_keys(new_latent, w_uk, w_uv, k_norm_nope)
    causal = jnp.tril(jnp.ones((t, t), dtype=bool))
    s = jnp.where(causal, mla_scores(qn, qr, kn, kr), -jnp.inf)
    m_s, l_s, a_s = partial_softmax(s, v)
    m = jnp.concatenate([m_p, m_s[None]], axis=0)
    l = jnp.concatenate([l_p, l_s[None]], axis=0)
    a = jnp.concatenate([a_p, a_s[None]], axis=0)
    wgt = jnp.exp(m - jnp.max(m, axis=0))
    o = jnp.sum(wgt[..., None] * a, axis=0) / jnp.sum(wgt * l, axis=0)[..., None]
    return jnp.moveaxis(o, 1, 2).reshape(bsz, t, MLA_HEADS * V_DIM).astype(qn.dtype)


def merge_and_mlp(x, y_a, y_b, gates, w_ya, w_yb, w_o, norm_mlp, w_up, w_down):
    g_a, g_b = jnp.split(jax.nn.sigmoid(gates), 2, axis=-1)
    x = x + (g_a * (y_a @ w_ya) + g_b * (y_b @ w_yb)) @ w_o
    h = jnp.square(jax.nn.relu(rms_norm(x, norm_mlp) @ w_up))
    return x + h @ w_down


def decoder_layer(x_p, x_s, cache_l, gdn_state_l, conv_state_l, page_table,
                  norm_mix, w_in, conv_w, a_log, dt_bias, gdn_norm,
                  q_a_norm, w_uq, kv_a_norm, w_uk, w_uv,
                  q_norm_nope, q_norm_rope, k_norm_nope, k_norm_rope,
                  w_ya, w_yb, w_o, norm_mlp, w_up, w_down):
    def run_group(x, pos, conv_buf, s0, gdn_core, mla_attend):
        qkv_raw, z, b, a, q_down, kv_down, gates = jnp.split(
            rms_norm(x, norm_mix) @ w_in, IN_SPLITS, axis=-1)
        q, k, v, g, beta, new_buf = gdn_inputs(qkv_raw, b, a, conv_buf, conv_w, a_log, dt_bias)
        o_a, s_new = gdn_core(q, k, v, g, beta, s0)
        y_a = gdn_output(o_a, z, gdn_norm)
        qn, qr, latent = mla_queries_and_latent(q_down, kv_down, pos, q_a_norm, w_uq, kv_a_norm,
                                                q_norm_nope, q_norm_rope, k_norm_rope)
        y_b = mla_attend(qn, qr, latent)
        y = merge_and_mlp(x, y_a, y_b, gates, w_ya, w_yb, w_o, norm_mlp, w_up, w_down)
        return y, latent, s_new, new_buf

    bp, tp = x_p.shape[:2]
    y_p, rows_p, s_p, buf_p = run_group(
        x_p, jnp.arange(tp),
        jnp.zeros((bp, CONV_W - 1, QKV_WIDTH), x_p.dtype),
        jnp.zeros((bp, GDN_HEADS, GDN_DK, GDN_DV), jnp.float32),
        gdn_chunked,
        lambda qn, qr, lat: mla_prompt_attention(qn, qr, *mla_keys(lat, w_uk, w_uv, k_norm_nope)))
    past_len = page_table.shape[1] * PAGE_SIZE
    y_s, rows_s, s_s, buf_s = run_group(
        x_s, past_len + jnp.arange(x_s.shape[1]),
        conv_state_l, gdn_state_l,
        gdn_recurrent,
        lambda qn, qr, lat: mla_sample_attention(qn, qr, lat, cache_l, page_table, w_uk, w_uv, k_norm_nope))
    return y_p, y_s, rows_p, s_p, buf_p, rows_s, s_s, buf_s


def setup_inputs(seed: int = 0) -> dict:
    key = jax.random.key(seed)
    k = jax.random.split(key, 32)
    f32 = jnp.float32
    n_pages = PAST_LEN // PAGE_SIZE
    n_used = DEC_BATCH * n_pages
    n_phys = n_used + n_used // 4

    def dense(kk, fan_in, fan_out):
        return jax.random.normal(kk, (DEPTH, fan_in, fan_out), f32) * fan_in ** -0.5

    def gain(kk, n):
        return 1.0 + 0.02 * jax.random.normal(kk, (DEPTH, n), f32)

    dt = jax.random.uniform(k[8], (DEPTH, GDN_HEADS), f32, 0.001, 0.1)
    return {
        'x_prompt': jax.random.normal(k[0], (BATCH, SEQ, D_MODEL), f32),
        'x_sample': jax.random.normal(k[1], (DEC_BATCH, DEC_SEQ, D_MODEL), f32),
        'cache_mla': jax.random.normal(k[2], (DEPTH, n_phys, PAGE_SIZE, LATENT_WIDTH), f32),
        'state_gdn': jax.random.normal(k[3], (DEPTH, DEC_BATCH, GDN_HEADS, GDN_DK, GDN_DV), f32) * GDN_DK ** -0.5,
        'state_conv': jax.random.normal(k[4], (DEPTH, DEC_BATCH, CONV_W - 1, QKV_WIDTH), f32),
        'page_table': jax.random.permutation(k[5], n_phys)[:n_used].reshape(DEC_BATCH, n_pages).astype(jnp.int32),
        'norm_mix': gain(k[6], D_MODEL),
        'w_in': dense(k[7], D_MODEL, IN_WIDTH),
        'conv_w': jax.random.normal(k[9], (DEPTH, CONV_W, QKV_WIDTH), f32) * CONV_W ** -0.5,
        'a_log': jnp.log(jax.random.uniform(k[10], (DEPTH, GDN_HEADS), f32, 1.0, 16.0)),
        'dt_bias': dt + jnp.log(-jnp.expm1(-dt)),
        'gdn_norm': gain(k[11], GDN_DV),
        'q_a_norm': gain(k[12], Q_LORA),
        'w_uq': dense(k[13], Q_LORA, MLA_HEADS * (NOPE_DIM + ROPE_DIM)),
        'kv_a_norm': gain(k[14], KV_LORA),
        'w_uk': dense(k[15], KV_LORA, MLA_HEADS * NOPE_DIM),
        'w_uv': dense(k[16], KV_LORA, MLA_HEADS * V_DIM),
        'q_norm_nope': gain(k[17], NOPE_DIM),
        'q_norm_rope': gain(k[18], ROPE_DIM),
        'k_norm_nope': gain(k[19], NOPE_DIM),
        'k_norm_rope': gain(k[20], ROPE_DIM),
        'w_ya': dense(k[21], Z_WIDTH, D_MODEL),
        'w_yb': dense(k[22], MLA_HEADS * V_DIM, D_MODEL),
        'w_o': dense(k[23], D_MODEL, D_MODEL),
        'norm_mlp': gain(k[24], D_MODEL),
        'w_up': dense(k[25], D_MODEL, D_FF),
        'w_down': dense(k[26], D_FF, D_MODEL),
    }


def reference(x_prompt, x_sample, cache_mla, state_gdn, state_conv, page_table,
              norm_mix, w_in, conv_w, a_log, dt_bias, gdn_norm,
              q_a_norm, w_uq, kv_a_norm, w_uk, w_uv,
              q_norm_nope, q_norm_rope, k_norm_nope, k_norm_rope,
              w_ya, w_yb, w_o, norm_mlp, w_up, w_down):
    x_p, x_s = x_prompt, x_sample
    rows_p, gdn_p, conv_p, rows_s, gdn_s, conv_s = [], [], [], [], [], []
    for l in range(DEPTH):
        x_p, x_s, rp, sp, bp, rs, ss, bs = decoder_layer(
            x_p, x_s, cache_mla[l], state_gdn[l], state_conv[l], page_table,
            norm_mix[l], w_in[l], conv_w[l], a_log[l], dt_bias[l], gdn_norm[l],
            q_a_norm[l], w_uq[l], kv_a_norm[l], w_uk[l], w_uv[l],
            q_norm_nope[l], q_norm_rope[l], k_norm_nope[l], k_norm_rope[l],
            w_ya[l], w_yb[l], w_o[l], norm_mlp[l], w_up[l], w_down[l])
        rows_p.append(rp)
        gdn_p.append(sp)
        conv_p.append(bp)
        rows_s.append(rs)
        gdn_s.append(ss)
        conv_s.append(bs)
    return (x_p, x_s, jnp.stack(rows_p), jnp.stack(gdn_p), jnp.stack(conv_p),
            jnp.stack(rows_s), jnp.stack(gdn_s), jnp.stack(conv_s))
```

```cpp
#include <hip/hip_runtime.h>
#include <cstdio>
#include <cstdint>
namespace pg8 {
#define PG8_LAS __attribute__((address_space(3)))
typedef unsigned short bf16_t;
typedef short bf16x8 __attribute__((ext_vector_type(8)));
typedef float f32x4 __attribute__((ext_vector_type(4)));
typedef unsigned u32x4 __attribute__((ext_vector_type(4)));
constexpr int BM = 256, BK = 64, HALF = 128, HTB = HALF * BK * 2  , STAGE_BYTES = 8 * HTB, NXCD = 8, WGM = 8;

__host__ __device__ __forceinline__ int lds_byte(int r, int c) { const int st = (r >> 4) * 2 + (c >> 5), rr = r & 15, cc = c & 31, ob = rr * 64 + cc * 2; return st * 1024 + (ob ^ (((ob >> 9) & 1) << 5)); }
__host__ __device__ __forceinline__ void stage_rc(int b, int& R, int& C) { const int st = b / 1024, sb = b % 1024, swz = sb ^ (((sb >> 9) & 1) << 5); R = (st >> 1) * 16 + swz / 64; C = (st & 1) * 32 + (swz % 64) / 2; }
__host__ __device__ __forceinline__ int perm32(int rho) { const int n = rho >> 4, i = rho & 15; return 8 * (i >> 2) + 4 * n + (i & 3); }

struct Unit { int pm, pn; };
struct Gemm { const bf16_t* A; const bf16_t* Bt; int M, N, K; };

struct StaticOrder {
    int nM, nN, nwg, G, c;
    __host__ __device__ void init(int M, int N, int G_, int c_) { nM = M / BM; nN = N / BM; nwg = nM * nN; G = G_; c = c_; }
    __host__ __device__ bool next(int i, Unit& u) const {
        const long L = (long)i * G + c; if (L >= nwg) return false;
        int wgid = (int)L; { const int q = nwg / NXCD, r = nwg % NXCD, xcd = wgid % NXCD, off = wgid / NXCD; wgid = (xcd < r ? xcd * (q + 1) : r * (q + 1) + (xcd - r) * q) + off; }
        const int nig = WGM * nN, gid = wgid / nig, fm = gid * WGM, gsz = (nM - fm) < WGM ? (nM - fm) : WGM;
        u.pm = fm + ((wgid % nig) % gsz); u.pn = (wgid % nig) / gsz; return true;
    }
    __device__ __forceinline__ void a_ready(const Unit&) const {}
    __device__ __forceinline__ void done(const Unit&) const {}
};

__device__ __forceinline__ unsigned cvt_pk_bf16(float lo, float hi) { unsigned r; asm volatile("v_cvt_pk_bf16_f32 %0, %1, %2" : "=v"(r) : "v"(lo), "v"(hi)); return r; }
template <class Epi, class Sched, bool ALIGN_EPI = false, bool SP2 = false>
__device__ __forceinline__ void gemm_phase(PG8_LAS unsigned char* lds, const Gemm g, const Sched& S, const Epi& E) {
    const int tid = threadIdx.x, wid = __builtin_amdgcn_readfirstlane(tid >> 6), lane = tid & 63, wr = wid >> 2, wc = wid & 3, fr = lane & 15, fq = lane >> 4;
    const int K = g.K, nt = K / BK;
    unsigned voffA[2], voffB[2];
#pragma unroll
    for (int i = 0; i < 2; ++i) { int R, C; stage_rc(tid * 16 + i * 8192, R, C); const int Rb = Epi::PERM ? ((R & ~31) + perm32(R & 31)) : R;
        voffA[i] = (unsigned)(R * K + C) * 2u; voffB[i] = (unsigned)(Rb * K + C) * 2u; }
    const size_t kstep = (size_t)(BK * 2);
    const size_t hstep = (size_t)HALF * K * 2;
    const size_t tstep = 2 * hstep;
    const unsigned ldsw = (unsigned)wid * 1024u;
    const int aoff = lds_byte(wr * 64 + fr, fq * 8), boff = lds_byte(wc * 32 + fr, fq * 8);
#define PG8_SA(b, h) (((b) * 2 + (h)) * HTB)
#define PG8_SB(b, h) ((4 + (b) * 2 + (h)) * HTB)
#define PG8_STAGE(bufoff, gbase, voff) do { _Pragma("unroll") for (int _i = 0; _i < 2; ++_i) \
        __builtin_amdgcn_global_load_lds((const unsigned*)((const char*)(gbase) + (voff)[_i]), (PG8_LAS unsigned*)(lds + (bufoff) + ldsw + _i * 8192), 16, 0, 0); } while (0)
#define PG8_LDA(dst, b, h) do { _Pragma("unroll") for (int m = 0; m < 4; ++m) _Pragma("unroll") for (int k = 0; k < 2; ++k) dst[m][k] = *(const PG8_LAS bf16x8*)(lds + PG8_SA(b, h) + aoff + m * 2048 + k * 1024); } while (0)
#define PG8_LDB(dst, b, h) do { _Pragma("unroll") for (int n = 0; n < 2; ++n) _Pragma("unroll") for (int k = 0; k < 2; ++k) dst[n][k] = *(const PG8_LAS bf16x8*)(lds + PG8_SB(b, h) + boff + n * 2048 + k * 1024); } while (0)
#define PG8_MMA(ai, bj, At, Bt) do { __builtin_amdgcn_s_setprio(1); _Pragma("unroll") for (int m = 0; m < 4; ++m) _Pragma("unroll") for (int n = 0; n < 2; ++n) _Pragma("unroll") for (int k = 0; k < 2; ++k) \
        acc[ai][bj][m][n] = __builtin_amdgcn_mfma_f32_16x16x32_bf16(Bt[n][k], At[m][k], acc[ai][bj][m][n], 0, 0, 0); __builtin_amdgcn_s_setprio(0); } while (0)
#define PG8_WAIT_V(n) asm volatile("s_waitcnt vmcnt(" #n ")" ::: "memory")
#define PG8_WAIT_L(n) asm volatile("s_waitcnt lgkmcnt(" #n ")" ::: "memory")
#define PG8_BAR __builtin_amdgcn_s_barrier()
#define PG8_SCHED __builtin_amdgcn_sched_barrier(0)
    Unit cur, nxt; int ui = 0;
    if (!S.next(0, cur)) return;
    f32x4 acc[2][2][4][2];
#pragma unroll
    for (int a = 0; a < 2; ++a)
#pragma unroll
        for (int b = 0; b < 2; ++b)
#pragma unroll
            for (int m = 0; m < 4; ++m)
#pragma unroll
                for (int n = 0; n < 2; ++n) acc[a][b][m][n] = (f32x4){0.f, 0.f, 0.f, 0.f};
    bf16x8 At[4][2], B0[2][2], B1[2][2];
    const char* cA = (const char*)g.A + (size_t)cur.pm * tstep; const char* cB = (const char*)g.Bt + (size_t)cur.pn * tstep;
    S.a_ready(cur);
    if constexpr (SP2) {
        PG8_STAGE(PG8_SB(0, 0), cB, voffB); PG8_STAGE(PG8_SB(0, 1), cB + hstep, voffB); PG8_STAGE(PG8_SA(0, 0), cA, voffA); PG8_STAGE(PG8_SA(0, 1), cA + hstep, voffA);
        if (wr == 1) PG8_BAR;
        PG8_WAIT_V(2); PG8_BAR;
        PG8_STAGE(PG8_SB(1, 0), cB + kstep, voffB); PG8_STAGE(PG8_SA(1, 0), cA + kstep, voffA); PG8_STAGE(PG8_SB(1, 1), cB + hstep + kstep, voffB);
        PG8_WAIT_V(6); PG8_BAR;
    } else {
        PG8_STAGE(PG8_SB(0, 0), cB, voffB); PG8_STAGE(PG8_SA(0, 0), cA, voffA); PG8_STAGE(PG8_SB(0, 1), cB + hstep, voffB); PG8_STAGE(PG8_SA(0, 1), cA + hstep, voffA);
        if (wr == 1) PG8_BAR;
        PG8_WAIT_V(4); PG8_BAR;
        PG8_STAGE(PG8_SB(1, 0), cB + kstep, voffB); PG8_STAGE(PG8_SA(1, 0), cA + kstep, voffA); PG8_STAGE(PG8_SB(1, 1), cB + hstep + kstep, voffB);
        PG8_WAIT_V(6); PG8_BAR;
    }
    for (;;) {
        const bool has_next = S.next(ui + 1, nxt);
        const char* nA = has_next ? (const char*)g.A + (size_t)nxt.pm * tstep : cA; const char* nB = has_next ? (const char*)g.Bt + (size_t)nxt.pn * tstep : cB;
        for (int t = 0; t < nt; t += 2) {
            const bool last = (t == nt - 2);
            const char* a1 = cA + (size_t)(t + 1) * kstep;
            const char* a2 = last ? nA : cA + (size_t)(t + 2) * kstep; const char* b2 = last ? nB : cB + (size_t)(t + 2) * kstep;
            const char* a3 = a2 + kstep; const char* b3 = b2 + kstep;
            if (last && has_next) S.a_ready(nxt);
            if constexpr (SP2) {
            PG8_LDB(B0, 0, 0); PG8_LDB(B1, 0, 1); PG8_SCHED; PG8_LDA(At, 0, 0); PG8_STAGE(PG8_SA(1, 1), a1 + hstep, voffA);
            PG8_WAIT_V(8); PG8_WAIT_L(0); PG8_BAR; PG8_MMA(0, 0, At, B0); PG8_MMA(0, 1, At, B1); PG8_BAR; PG8_SCHED;
            PG8_LDA(At, 0, 1); PG8_STAGE(PG8_SB(0, 0), b2, voffB); PG8_STAGE(PG8_SB(0, 1), b2 + hstep, voffB); PG8_STAGE(PG8_SA(0, 0), a2, voffA);
            PG8_WAIT_V(8); PG8_WAIT_L(0); PG8_BAR; PG8_MMA(1, 0, At, B0); PG8_MMA(1, 1, At, B1); PG8_BAR; PG8_SCHED;
            PG8_LDB(B0, 1, 0); PG8_LDB(B1, 1, 1); PG8_SCHED; PG8_LDA(At, 1, 0); PG8_STAGE(PG8_SA(0, 1), a2 + hstep, voffA);
            PG8_WAIT_V(8); PG8_WAIT_L(0); PG8_BAR; PG8_MMA(0, 0, At, B0); PG8_MMA(0, 1, At, B1); PG8_BAR; PG8_SCHED;
            PG8_LDA(At, 1, 1); PG8_STAGE(PG8_SB(1, 0), b3, voffB); PG8_STAGE(PG8_SB(1, 1), b3 + hstep, voffB); PG8_STAGE(PG8_SA(1, 0), a3, voffA);
            PG8_WAIT_V(8); PG8_WAIT_L(0); PG8_BAR; PG8_MMA(1, 0, At, B0); PG8_MMA(1, 1, At, B1); PG8_BAR; PG8_SCHED;
            } else {
            PG8_LDB(B0, 0, 0); PG8_SCHED; PG8_LDA(At, 0, 0); PG8_STAGE(PG8_SA(1, 1), a1 + hstep, voffA);
            PG8_WAIT_L(8); PG8_BAR; PG8_WAIT_L(0); PG8_MMA(0, 0, At, B0); PG8_BAR; PG8_SCHED;
            PG8_LDB(B1, 0, 1); PG8_STAGE(PG8_SB(0, 0), b2, voffB);
            PG8_BAR; PG8_WAIT_L(0); PG8_MMA(0, 1, At, B1); PG8_BAR;
            PG8_LDA(At, 0, 1); PG8_STAGE(PG8_SA(0, 0), a2, voffA);
            PG8_BAR; PG8_WAIT_L(0); PG8_MMA(1, 0, At, B0); PG8_BAR; PG8_SCHED;
            PG8_STAGE(PG8_SB(0, 1), b2 + hstep, voffB);
            PG8_WAIT_V(6); PG8_BAR; PG8_MMA(1, 1, At, B1); PG8_BAR;
            PG8_LDB(B0, 1, 0); PG8_SCHED; PG8_LDA(At, 1, 0); PG8_STAGE(PG8_SA(0, 1), a2 + hstep, voffA);
            PG8_WAIT_L(8); PG8_BAR; PG8_WAIT_L(0); PG8_MMA(0, 0, At, B0); PG8_BAR; PG8_SCHED;
            PG8_LDB(B1, 1, 1); PG8_STAGE(PG8_SB(1, 0), b3, voffB);
            PG8_BAR; PG8_WAIT_L(0); PG8_MMA(0, 1, At, B1); PG8_BAR;
            PG8_LDA(At, 1, 1); PG8_STAGE(PG8_SA(1, 0), a3, voffA);
            PG8_BAR; PG8_WAIT_L(0); PG8_MMA(1, 0, At, B0); PG8_BAR; PG8_SCHED;
            PG8_STAGE(PG8_SB(1, 1), b3 + hstep, voffB);
            PG8_WAIT_V(6); PG8_BAR; PG8_MMA(1, 1, At, B1); PG8_BAR;
            }
        }
        if constexpr (ALIGN_EPI) { if (wr == 0) PG8_BAR; }
        if constexpr (!Epi::AFTER_DRAIN) { E(acc, cur, wr, wc, fr, fq); S.done(cur); }
        if (!has_next) break;
#pragma unroll
        for (int a = 0; a < 2; ++a)
#pragma unroll
            for (int b = 0; b < 2; ++b)
#pragma unroll
                for (int m = 0; m < 4; ++m)
#pragma unroll
                    for (int n = 0; n < 2; ++n) acc[a][b][m][n] = (f32x4){0.f, 0.f, 0.f, 0.f};
        cur = nxt; cA = nA; cB = nB; ++ui;
        if constexpr (ALIGN_EPI) { if (wr == 1) PG8_BAR; }
    }
    PG8_WAIT_V(0);
    if constexpr (!ALIGN_EPI) { if (wr == 0) PG8_BAR; }
    PG8_BAR;
    if constexpr (Epi::AFTER_DRAIN) { E.fused(acc, cur, wr, wc, fr, fq, lds, wid, lane); S.done(cur); }
#undef PG8_SA
#undef PG8_SB
#undef PG8_STAGE
#undef PG8_LDA
#undef PG8_LDB
#undef PG8_MMA
#undef PG8_WAIT_V
#undef PG8_WAIT_L
#undef PG8_BAR
#undef PG8_SCHED
}
}
#define XB_TMO      128
#define XB_XCNT(j)  (256  + 64 * (j))
#define XB_XSUB(j)  (1280 + 64 * (j))
#define XB_XGEN(j)  (2304 + 64 * (j))
#define XB_TOP      3328
#define XB_TOPGEN   3392
#define XCD_BAR_WORDS 3456
#define XB_SPIN_CAP (1u << 18)
#define LAS __attribute__((address_space(3)))

__device__ __forceinline__ unsigned xb_ld(unsigned* p)              { return __hip_atomic_load(p, __ATOMIC_RELAXED, __HIP_MEMORY_SCOPE_AGENT); }
__device__ __forceinline__ unsigned xb_add(unsigned* p, unsigned v) { return __hip_atomic_fetch_add(p, v, __ATOMIC_RELAXED, __HIP_MEMORY_SCOPE_AGENT); }
__device__ __forceinline__ unsigned xb_xcc_id() { return (unsigned)__builtin_amdgcn_s_getreg((3 << 11) | 20) & 0xFu; }
#define XB_SPIN(cond, bar) do { unsigned _sp = 0; while (cond) { __builtin_amdgcn_s_sleep(1); \
    if ((++_sp & 255u) == 0u) { if (xb_ld(&(bar)[XB_TMO])) break; if (_sp > XB_SPIN_CAP) { atomicAdd(&(bar)[XB_TMO], 1u); break; } } } } while (0)

struct XcdBarrier {
    unsigned* bar; unsigned x;
    volatile LAS unsigned* st;
};

__device__ __forceinline__ XcdBarrier xcd_barrier_post(unsigned* bar, volatile LAS unsigned* st) {
    XcdBarrier b; b.bar = bar; b.x = xb_xcc_id(); b.st = st;
    if (threadIdx.x == 0) (void)xb_add(&bar[XB_XCNT(b.x)], 1u);
    return b;
}
__device__ __forceinline__ void xcd_barrier_complete(unsigned* bar, unsigned x, unsigned& nloc, unsigned& nx) {
    const unsigned G = gridDim.x * gridDim.y * gridDim.z;
    unsigned sum, cnt, mine, sp = 0u;
    for (;;) {
        sum = 0u; cnt = 0u; mine = 0u;
#pragma unroll
        for (unsigned j = 0; j < 16; ++j) { const unsigned c = xb_ld(&bar[XB_XCNT(j)]); sum += c; cnt += (c > 0u) ? 1u : 0u; mine = (j == x) ? c : mine; }
        if (sum == G) break;
        __builtin_amdgcn_s_sleep(1);
        if ((++sp & 255u) == 0u) { if (xb_ld(&bar[XB_TMO])) break; if (sp > XB_SPIN_CAP) { atomicAdd(&bar[XB_TMO], 1u); break; } }
    }
    nloc = mine > 0u ? mine : 1u; nx = cnt > 0u ? cnt : 1u;
}

__device__ __forceinline__ void xcd_barrier(const XcdBarrier& b) {
    asm volatile("s_waitcnt vmcnt(0)" ::: "memory");
    __syncthreads();
    if (threadIdx.x == 0) {
        unsigned* bar = b.bar;
        __builtin_amdgcn_s_waitcnt(0);
        unsigned nloc = b.st[0], nx = b.st[1];
        if (nloc == 0u) { xcd_barrier_complete(bar, b.x, nloc, nx); b.st[0] = nloc; b.st[1] = nx; }
        const unsigned old = xb_add(&bar[XB_XSUB(b.x)], 1u);
        const unsigned gen = old / nloc;
        if (old + 1u == (gen + 1u) * nloc) {
            __builtin_amdgcn_fence(__ATOMIC_RELEASE, "agent");
            asm volatile("s_waitcnt vmcnt(0)" ::: "memory");
            const unsigned og = xb_add(&bar[XB_TOP], 1u);
            const unsigned tg = og / nx;
            if (og + 1u == (tg + 1u) * nx) xb_add(&bar[XB_TOPGEN], 1u);
            else XB_SPIN(xb_ld(&bar[XB_TOPGEN]) == tg, bar);
            __builtin_amdgcn_fence(__ATOMIC_ACQUIRE, "agent");
            xb_add(&bar[XB_XGEN(b.x)], 1u);
            asm volatile("s_waitcnt vmcnt(0)" ::: "memory");
        } else {
            XB_SPIN(xb_ld(&bar[XB_XGEN(b.x)]) == gen, bar);
            __builtin_amdgcn_fence(__ATOMIC_ACQUIRE, "agent");
            asm volatile("s_waitcnt vmcnt(0)" ::: "memory");
        }
    }
    __syncthreads();
}
constexpr int MP = 16384, MS = 32, MR = MP + MS, MPAD = 16640;
constexpr int SEQ = 2048, NB = 8, NH = 8, DM = 1024;
constexpr int QKVW = 3072, NIN = 7424;
constexpr int PAST = 16384, NPAGE = 128, PAGE = 128, LATW = 576;
constexpr float EPS = 1e-6f;
constexpr float MLA_SCALE = 0.07216878364870322f;

constexpr size_t O_YP = 0, O_YS = O_YP + (size_t)MP * 1024, O_ROWSP = O_YS + 32 * 1024, O_GSP = O_ROWSP + (size_t)MP * 576,
                 O_CSP = O_GSP + 8 * 8 * 128 * 128, O_ROWSS = O_CSP + 8 * 3 * 3072, O_GSS = O_ROWSS + 32 * 576, O_CSS = O_GSS + (size_t)32 * 8 * 128 * 128;

constexpr size_t WS_CTL = 0, CTL_BYTES = 1u << 20;
constexpr size_t WS_WIN = CTL_BYTES;
constexpr size_t WS_WQ  = WS_WIN + (size_t)NIN * 1024 * 2;
constexpr size_t WS_WKV = WS_WQ + (size_t)1536 * 512 * 2;
constexpr size_t WS_WYA = WS_WKV + (size_t)2048 * 512 * 2;
constexpr size_t WS_WYB = WS_WYA + (size_t)1024 * 1024 * 2;
constexpr size_t WS_WO  = WS_WYB + (size_t)1024 * 1024 * 2;
constexpr size_t WS_WUP = WS_WO + (size_t)1024 * 1024 * 2;
constexpr size_t WS_WDN = WS_WUP + (size_t)4096 * 1024 * 2;
constexpr size_t WS_XN  = WS_WDN + (size_t)4096 * 1024 * 2;
constexpr size_t WS_QKV = WS_XN + (size_t)MPAD * 1024 * 2;
constexpr size_t WS_Z   = WS_QKV + (size_t)MPAD * 3072 * 2;
constexpr size_t WS_QD  = WS_Z + (size_t)MPAD * 1024 * 2;
constexpr size_t WS_KVD = WS_QD + (size_t)MPAD * 512 * 2;
constexpr size_t WS_SM  = WS_KVD + (size_t)MPAD * 512 * 2;
constexpr size_t WS_GATES = WS_SM + (size_t)MPAD * 128 * 4;
constexpr size_t WS_C   = WS_GATES + (size_t)MPAD * 2048 * 2;
constexpr size_t WS_KR  = WS_C + (size_t)MPAD * 512 * 2;
constexpr size_t WS_BETA = WS_KR + (size_t)MPAD * 64 * 2;
constexpr size_t WS_GLOG = WS_BETA + (size_t)MPAD * 8 * 4;
constexpr size_t WS_QP  = WS_GLOG + (size_t)MPAD * 8 * 4;
constexpr size_t WS_QP2 = WS_QP + (size_t)MPAD * 1536 * 2;
constexpr size_t WS_KN  = WS_QP2 + (size_t)MPAD * 1536 * 2;
constexpr size_t WS_V   = WS_KN + (size_t)MPAD * 1024 * 2;
constexpr size_t WS_YA  = WS_V + (size_t)MPAD * 1024 * 2;
constexpr size_t WS_YB  = WS_YA + (size_t)MPAD * 1024 * 2;
constexpr size_t WS_TF  = WS_YB + (size_t)MPAD * 1024 * 2;
constexpr size_t WS_T   = WS_TF + (size_t)MPAD * 1024 * 4;
constexpr size_t WS_X1  = WS_T + (size_t)MPAD * 1024 * 2;
constexpr size_t WS_XN2 = WS_X1 + (size_t)MPAD * 1024 * 4;
constexpr size_t WS_H   = WS_XN2 + (size_t)MPAD * 1024 * 2;
constexpr size_t WS_GU0 = WS_H + (size_t)MPAD * 4096 * 2;
constexpr size_t WS_GW  = WS_GU0 + (size_t)2048 * 64 * 128 * 4;
constexpr size_t WS_GQG = WS_GW + (size_t)2048 * 64 * 128 * 2;
constexpr size_t WS_GKD = WS_GQG + (size_t)2048 * 64 * 128 * 2;
constexpr size_t WS_GAQK = WS_GKD + (size_t)2048 * 64 * 128 * 2;
constexpr size_t WS_GEND = WS_GAQK + (size_t)2048 * 64 * 64 * 2;
constexpr size_t WS_DML = WS_GEND + (size_t)2048 * 4 * 64;
constexpr size_t WS_DACC = WS_DML + (size_t)4096 * 8 * 2 * 4;
constexpr size_t WS_END = WS_DACC + (size_t)4096 * 8 * 512 * 4;

constexpr int LDS_BYTES = 163840;
constexpr int MISC_OFF = LDS_BYTES - 128;

#define GAS __attribute__((address_space(1)))
typedef unsigned short bf16;
typedef unsigned v4u __attribute__((ext_vector_type(4)));
typedef unsigned v2u __attribute__((ext_vector_type(2)));
typedef float f32x4 __attribute__((ext_vector_type(4)));
typedef float f32x16 __attribute__((ext_vector_type(16)));
typedef short bf16x8 __attribute__((ext_vector_type(8)));
#define LDS_WAIT() asm volatile("s_waitcnt lgkmcnt(0)" ::: "memory")
#define VM_WAIT() asm volatile("s_waitcnt vmcnt(0)" ::: "memory")
__device__ __forceinline__ float bf2f(unsigned b) { return __builtin_bit_cast(float, b << 16); }
__device__ __forceinline__ unsigned f2bf(float f) { unsigned u = __builtin_bit_cast(unsigned, f); return (u + 0x7fffu + ((u >> 16) & 1u)) >> 16; }
__device__ __forceinline__ unsigned pk2(float lo, float hi) { return f2bf(lo) | (f2bf(hi) << 16); }
__device__ __forceinline__ float lo16(unsigned w) { return __builtin_bit_cast(float, w << 16); }
__device__ __forceinline__ float hi16(unsigned w) { return __builtin_bit_cast(float, w & 0xffff0000u); }
__device__ __forceinline__ float wave_sum(float v) {
#pragma unroll
    for (int o = 1; o < 64; o <<= 1) v += __shfl_xor(v, o);
    return v;
}
__device__ __forceinline__ float wave_max(float v) {
#pragma unroll
    for (int o = 1; o < 64; o <<= 1) v = fmaxf(v, __shfl_xor(v, o));
    return v;
}
__device__ __forceinline__ float sigmoidf_(float x) { return 1.f / (1.f + __expf(-x)); }
__device__ __forceinline__ float siluf_(float x) { return x / (1.f + __expf(-x)); }

__constant__ float ROPE_INV[32] = {1.000000000e+00f,7.498942614e-01f,5.623413324e-01f,4.216965139e-01f,3.162277639e-01f,2.371373773e-01f,1.778279394e-01f,1.333521307e-01f,
    1.000000015e-01f,7.498941571e-02f,5.623413250e-02f,4.216965288e-02f,3.162277490e-02f,2.371373773e-02f,1.778279431e-02f,1.333521493e-02f,
    9.999999776e-03f,7.498941850e-03f,5.623413250e-03f,4.216964822e-03f,3.162277630e-03f,2.371373586e-03f,1.778279431e-03f,1.333521446e-03f,
    1.000000047e-03f,7.498942432e-04f,5.623413017e-04f,4.216965172e-04f,3.162277571e-04f,2.371373703e-04f,1.778279402e-04f,1.333521504e-04f};

struct Args { const float* in[27]; float* out; unsigned char* ws; int ph_lo, ph_hi; };
enum { I_XP = 0, I_XS, I_CACHE, I_SGDN, I_SCONV, I_PT, I_NMIX, I_WIN, I_CONVW, I_ALOG, I_DTB, I_GDNN, I_QAN, I_WUQ, I_KVAN, I_WUK, I_WUV,
       I_QNN, I_QNR, I_KNN, I_KNR, I_WYA, I_WYB, I_WO, I_NMLP, I_WUP, I_WDN };

__device__ __forceinline__ int src_col(int mode, int n) {
    if (mode == 0) {
        if (n < 4096) return n;
        if (n < 5184) return n + 16;
        if (n < 5200) return n - 5184 + 4096;
        if (n < 5376) return -1;
        return n - 5376 + 5200;
    }
    if (mode == 1) {
        if (n < 1024) return (n >> 7) * 192 + (n & 127);
        const int m = n - 1024; return (m >> 6) * 192 + 128 + (m & 63);
    }
    return n;
}
__device__ __forceinline__ void cvt_item(const float* W, int N, int K, bf16* WT, int row_off, int mode, LAS float* scr, int item, int nblk, int lane) {
    const int kb = item / nblk, nb = item % nblk, k0 = 64 * kb, n0 = 32 * nb;
    const int sc = src_col(mode, n0 + (lane & 31));
#pragma unroll 8
    for (int i = 0; i < 32; ++i) { const int kk = 2 * i + (lane >> 5); scr[kk * 33 + (lane & 31)] = sc >= 0 ? W[(size_t)(k0 + kk) * N + sc] : 0.f; }
    LDS_WAIT(); asm volatile("" ::: "memory");
    const int c = lane & 7;
#pragma unroll
    for (int j = 0; j < 4; ++j) { const int n = (lane >> 3) + 8 * j; const LAS float* s = scr + (8 * c) * 33 + n;
        v4u o; o.x = pk2(s[0 * 33], s[1 * 33]); o.y = pk2(s[2 * 33], s[3 * 33]); o.z = pk2(s[4 * 33], s[5 * 33]); o.w = pk2(s[6 * 33], s[7 * 33]);
        *(v4u*)(WT + (size_t)(row_off + n0 + n) * K + k0 + 8 * c) = o; }
    LDS_WAIT(); asm volatile("" ::: "memory");
}
__device__ __forceinline__ void rms_row_to_bf16(const float* xrow, const float* gain, bf16* orow, int lane) {
    const f32x4* xr = (const f32x4*)xrow + lane; const f32x4* gr = (const f32x4*)gain + lane;
    f32x4 v[4]; float s = 0.f;
#pragma unroll
    for (int j = 0; j < 4; ++j) { v[j] = xr[64 * j]; s += (v[j].x * v[j].x + v[j].y * v[j].y) + (v[j].z * v[j].z + v[j].w * v[j].w); }
    const float r = 1.f / sqrtf(wave_sum(s) * (1.f / 1024.f) + EPS);
    unsigned long long* o8 = (unsigned long long*)orow + lane;
#pragma unroll
    for (int j = 0; j < 4; ++j) { const f32x4 g = gr[64 * j];
        o8[64 * j] = (unsigned long long)pk2(v[j].x * r * g.x, v[j].y * r * g.y) | ((unsigned long long)pk2(v[j].z * r * g.z, v[j].w * r * g.w) << 32); }
}
__device__ __forceinline__ void p0_prologue(const Args& A, LAS unsigned char* lds, int gw, int NGW, int wave, int lane) {
    LAS float* scr = (LAS float*)(lds + wave * 16384);
    unsigned char* ws = A.ws;
    constexpr int I0 = 16 * (NIN / 32), I1 = 8 * (1536 / 32), I2 = 8 * 32, I3 = 8 * 32, I4 = 16 * 32, I5 = I4, I6 = I4, I7 = 16 * 128, I8 = 64 * 32;
    constexpr int NITEMS = I0 + I1 + I2 + I3 + I4 + I5 + I6 + I7 + I8;
    for (int it = gw; it < NITEMS; it += NGW) {
        int r = it;
        if (r < I0) { cvt_item(A.in[I_WIN], 7248, 1024, (bf16*)(ws + WS_WIN), 0, 0, scr, r, NIN / 32, lane); continue; } r -= I0;
        if (r < I1) { cvt_item(A.in[I_WUQ], 1536, 512, (bf16*)(ws + WS_WQ), 0, 1, scr, r, 1536 / 32, lane); continue; } r -= I1;
        if (r < I2) { cvt_item(A.in[I_WUK], 1024, 512, (bf16*)(ws + WS_WKV), 0, 2, scr, r, 32, lane); continue; } r -= I2;
        if (r < I3) { cvt_item(A.in[I_WUV], 1024, 512, (bf16*)(ws + WS_WKV), 1024, 2, scr, r, 32, lane); continue; } r -= I3;
        if (r < I4) { cvt_item(A.in[I_WYA], 1024, 1024, (bf16*)(ws + WS_WYA), 0, 2, scr, r, 32, lane); continue; } r -= I4;
        if (r < I5) { cvt_item(A.in[I_WYB], 1024, 1024, (bf16*)(ws + WS_WYB), 0, 2, scr, r, 32, lane); continue; } r -= I5;
        if (r < I6) { cvt_item(A.in[I_WO], 1024, 1024, (bf16*)(ws + WS_WO), 0, 2, scr, r, 32, lane); continue; } r -= I6;
        if (r < I7) { cvt_item(A.in[I_WUP], 4096, 1024, (bf16*)(ws + WS_WUP), 0, 2, scr, r, 128, lane); continue; } r -= I7;
        cvt_item(A.in[I_WDN], 1024, 4096, (bf16*)(ws + WS_WDN), 0, 2, scr, r, 32, lane);
    }
    bf16* XN = (bf16*)(ws + WS_XN);
    for (int m = gw; m < MPAD; m += NGW) {
        if (m < MR) rms_row_to_bf16(m < MP ? A.in[I_XP] + (size_t)m * 1024 : A.in[I_XS] + (size_t)(m - MP) * 1024, A.in[I_NMIX], XN + (size_t)m * 1024, lane);
        else { v4u z = {0u, 0u, 0u, 0u}; *((v4u*)(XN + (size_t)m * 1024) + lane) = z; *((v4u*)(XN + (size_t)m * 1024) + 64 + lane) = z; }
    }
}

struct EpiG1 {
    static constexpr bool PERM = true, AFTER_DRAIN = false;
    bf16 *QKV, *Z, *QD, *KVD, *GATES; float* SM;
    __device__ __forceinline__ void operator()(const pg8::f32x4 (&acc)[2][2][4][2], const pg8::Unit& u, int wr, int wc, int fr, int fq) const {
        const int row0 = u.pm * 256 + wr * 64 + fr, pn = u.pn, cl = wc * 32 + 8 * fq;
        if (pn == 20) {
#pragma unroll
            for (int ai = 0; ai < 2; ++ai)
#pragma unroll
                for (int m = 0; m < 4; ++m) { float* rowp = SM + (size_t)(row0 + ai * 128 + m * 16) * 128 + cl;
                    *(pg8::f32x4*)rowp = acc[ai][0][m][0]; *(pg8::f32x4*)(rowp + 4) = acc[ai][0][m][1]; }
            return;
        }
        bf16* base; int ld; bool sg = false;
        if (pn < 12) { base = QKV + pn * 256; ld = 3072; }
        else if (pn < 16) { base = Z + (pn - 12) * 256; ld = 1024; }
        else if (pn < 18) { base = QD + (pn - 16) * 256; ld = 512; }
        else if (pn < 20) { base = KVD + (pn - 18) * 256; ld = 512; }
        else { base = GATES + (pn - 21) * 256; ld = 2048; sg = true; }
#pragma unroll
        for (int ai = 0; ai < 2; ++ai)
#pragma unroll
            for (int m = 0; m < 4; ++m) { bf16* rowp = base + (size_t)(row0 + ai * 128 + m * 16) * ld + cl;
#pragma unroll
                for (int bj = 0; bj < 2; ++bj) { pg8::f32x4 v0 = acc[ai][bj][m][0], v1 = acc[ai][bj][m][1];
                    if (sg) { v0 = (pg8::f32x4){sigmoidf_(v0[0]), sigmoidf_(v0[1]), sigmoidf_(v0[2]), sigmoidf_(v0[3])}; v1 = (pg8::f32x4){sigmoidf_(v1[0]), sigmoidf_(v1[1]), sigmoidf_(v1[2]), sigmoidf_(v1[3])}; }
                    pg8::u32x4 w; w.x = pg8::cvt_pk_bf16(v0[0], v0[1]); w.y = pg8::cvt_pk_bf16(v0[2], v0[3]); w.z = pg8::cvt_pk_bf16(v1[0], v1[1]); w.w = pg8::cvt_pk_bf16(v1[2], v1[3]);
                    *(pg8::u32x4*)(rowp + bj * 128) = w; } }
    }
};

__device__ __forceinline__ void p2_rows(const Args& A, int gw, int NGW, int lane) {
    unsigned char* ws = A.ws;
    bf16* QD = (bf16*)(ws + WS_QD); const bf16* KVD = (const bf16*)(ws + WS_KVD); const float* SM = (const float*)(ws + WS_SM);
    bf16* C = (bf16*)(ws + WS_C); bf16* KR = (bf16*)(ws + WS_KR); float* BETA = (float*)(ws + WS_BETA); float* GLOG = (float*)(ws + WS_GLOG);
    for (int m = gw; m < MR; m += NGW) {
        const int pos = m < MP ? (m & (SEQ - 1)) : PAST;
        float* lat = m < MP ? A.out + O_ROWSP + (size_t)m * LATW : A.out + O_ROWSS + (size_t)(m - MP) * LATW;
        {
            v4u w = *((const v4u*)(QD + (size_t)m * 512) + lane);
            float v[8] = {lo16(w.x), hi16(w.x), lo16(w.y), hi16(w.y), lo16(w.z), hi16(w.z), lo16(w.w), hi16(w.w)};
            float s = 0.f;
#pragma unroll
            for (int i = 0; i < 8; ++i) s += v[i] * v[i];
            const float r = 1.f / sqrtf(wave_sum(s) * (1.f / 512.f) + EPS);
            const f32x4 g0 = *((const f32x4*)A.in[I_QAN] + 2 * lane), g1 = *((const f32x4*)A.in[I_QAN] + 2 * lane + 1);
            v4u o; o.x = pk2(v[0] * r * g0.x, v[1] * r * g0.y); o.y = pk2(v[2] * r * g0.z, v[3] * r * g0.w); o.z = pk2(v[4] * r * g1.x, v[5] * r * g1.y); o.w = pk2(v[6] * r * g1.z, v[7] * r * g1.w);
            *((v4u*)(QD + (size_t)m * 512) + lane) = o;
        }
        {
            v4u w = *((const v4u*)(KVD + (size_t)m * 512) + lane);
            float v[8] = {lo16(w.x), hi16(w.x), lo16(w.y), hi16(w.y), lo16(w.z), hi16(w.z), lo16(w.w), hi16(w.w)};
            float s = 0.f;
#pragma unroll
            for (int i = 0; i < 8; ++i) s += v[i] * v[i];
            const float r = 1.f / sqrtf(wave_sum(s) * (1.f / 512.f) + EPS);
            const f32x4 g0 = *((const f32x4*)A.in[I_KVAN] + 2 * lane), g1 = *((const f32x4*)A.in[I_KVAN] + 2 * lane + 1);
            f32x4 c0 = {v[0] * r * g0.x, v[1] * r * g0.y, v[2] * r * g0.z, v[3] * r * g0.w}, c1 = {v[4] * r * g1.x, v[5] * r * g1.y, v[6] * r * g1.z, v[7] * r * g1.w};
            *((f32x4*)lat + 2 * lane) = c0; *((f32x4*)lat + 2 * lane + 1) = c1;
            v4u o; o.x = pk2(c0.x, c0.y); o.y = pk2(c0.z, c0.w); o.z = pk2(c1.x, c1.y); o.w = pk2(c1.z, c1.w);
            *((v4u*)(C + (size_t)m * 512) + lane) = o;
        }
        {
            const float x = SM[(size_t)m * 128 + lane];
            const float r = 1.f / sqrtf(wave_sum(x * x) * (1.f / 64.f) + EPS);
            const float xr = x * r * A.in[I_KNR][lane];
            const float other = __shfl_xor(xr, 32);
            const float ang = (float)pos * ROPE_INV[lane & 31];
            const float cs = cosf(ang), sn = sinf(ang);
            const float o = lane < 32 ? xr * cs - other * sn : other * sn + xr * cs;
            lat[512 + lane] = o;
            KR[(size_t)m * 64 + lane] = (bf16)f2bf(o);
        }
        if (lane < 8) {
            const float b = SM[(size_t)m * 128 + 64 + lane], a = SM[(size_t)m * 128 + 72 + lane];
            BETA[(size_t)m * 8 + lane] = 1.f / (1.f + expf(-b));
            const float xx = a + A.in[I_DTB][lane];
            const float sp = fmaxf(xx, 0.f) + log1pf(expf(-fabsf(xx)));
            GLOG[(size_t)m * 8 + lane] = -expf(A.in[I_ALOG][lane]) * sp;
        }
    }
}
__device__ __forceinline__ void p2_conv_state(const Args& A, int gtid, int NGT) {
    const bf16* QKV = (const bf16*)(A.ws + WS_QKV);
    for (int i = gtid; i < 8 * 3 * 3072; i += NGT) { const int c = i % 3072, r = (i / 3072) % 3, b = i / (3 * 3072);
        A.out[O_CSP + i] = bf2f(QKV[(size_t)(b * SEQ + SEQ - 3 + r) * 3072 + c]); }
    for (int i = gtid; i < 32 * 3 * 3072; i += NGT) { const int c = i % 3072, r = (i / 3072) % 3, j = i / (3 * 3072);
        A.out[O_CSS + i] = r < 2 ? A.in[I_SCONV][(size_t)(j * 3 + r + 1) * 3072 + c] : bf2f(QKV[(size_t)(MP + j) * 3072 + c]); }
}
__device__ __forceinline__ pg8::u32x4 pack8(const pg8::f32x4& v0, const pg8::f32x4& v1) {
    pg8::u32x4 w; w.x = pg8::cvt_pk_bf16(v0[0], v0[1]); w.y = pg8::cvt_pk_bf16(v0[2], v0[3]); w.z = pg8::cvt_pk_bf16(v1[0], v1[1]); w.w = pg8::cvt_pk_bf16(v1[2], v1[3]); return w;
}
template <int ACT> struct EpiStore {
    static constexpr bool PERM = true, AFTER_DRAIN = false;
    bf16* O0; int ld0; int split; bf16* O1; int ld1;
    __device__ __forceinline__ void operator()(const pg8::f32x4 (&acc)[2][2][4][2], const pg8::Unit& u, int wr, int wc, int fr, int fq) const {
        const int row0 = u.pm * 256 + wr * 64 + fr, cl = wc * 32 + 8 * fq;
        bf16* base; int ld;
        if (u.pn < split) { base = O0 + u.pn * 256; ld = ld0; } else { base = O1 + (u.pn - split) * 256; ld = ld1; }
#pragma unroll
        for (int ai = 0; ai < 2; ++ai)
#pragma unroll
            for (int m = 0; m < 4; ++m) { bf16* rowp = base + (size_t)(row0 + ai * 128 + m * 16) * ld + cl;
#pragma unroll
                for (int bj = 0; bj < 2; ++bj) { pg8::f32x4 v0 = acc[ai][bj][m][0], v1 = acc[ai][bj][m][1];
                    if (ACT == 1) {
#pragma unroll
                        for (int e = 0; e < 4; ++e) { const float a = fmaxf(v0[e], 0.f), b = fmaxf(v1[e], 0.f); v0[e] = a * a; v1[e] = b * b; } }
                    *(pg8::u32x4*)(rowp + bj * 128) = pack8(v0, v1); } }
    }
};
template <int STEP> struct EpiMerge {
    static constexpr bool PERM = true, AFTER_DRAIN = false;
    const bf16* GATES; float* TF; bf16* T;
    __device__ __forceinline__ void operator()(const pg8::f32x4 (&acc)[2][2][4][2], const pg8::Unit& u, int wr, int wc, int fr, int fq) const {
        const int row0 = u.pm * 256 + wr * 64 + fr, c0 = u.pn * 256 + wc * 32 + 8 * fq;
#pragma unroll
        for (int ai = 0; ai < 2; ++ai)
#pragma unroll
            for (int m = 0; m < 4; ++m) { const size_t row = (size_t)(row0 + ai * 128 + m * 16);
#pragma unroll
                for (int bj = 0; bj < 2; ++bj) { const int col = c0 + bj * 128;
                    const v4u gw = *(const v4u*)(GATES + row * 2048 + (STEP == 1 ? 0 : 1024) + col);
                    const float g[8] = {lo16(gw.x), hi16(gw.x), lo16(gw.y), hi16(gw.y), lo16(gw.z), hi16(gw.z), lo16(gw.w), hi16(gw.w)};
                    pg8::f32x4 v0 = acc[ai][bj][m][0], v1 = acc[ai][bj][m][1];
#pragma unroll
                    for (int e = 0; e < 4; ++e) { v0[e] *= g[e]; v1[e] *= g[4 + e]; }
                    float* tp = TF + row * 1024 + col;
                    if (STEP == 1) { *(pg8::f32x4*)tp = v0; *(pg8::f32x4*)(tp + 4) = v1; }
                    else { v0 += *(const pg8::f32x4*)tp; v1 += *(const pg8::f32x4*)(tp + 4); *(pg8::u32x4*)(T + row * 1024 + col) = pack8(v0, v1); } } }
    }
};
template <int MODE> struct EpiRes {
    static constexpr bool PERM = true, AFTER_DRAIN = false;
    const float *XPp, *XSp; float* X1; float* out;
    __device__ __forceinline__ void operator()(const pg8::f32x4 (&acc)[2][2][4][2], const pg8::Unit& u, int wr, int wc, int fr, int fq) const {
        const int row0 = u.pm * 256 + wr * 64 + fr, c0 = u.pn * 256 + wc * 32 + 8 * fq;
#pragma unroll
        for (int ai = 0; ai < 2; ++ai)
#pragma unroll
            for (int m = 0; m < 4; ++m) { const int row = row0 + ai * 128 + m * 16;
                if (row >= MR) continue;
#pragma unroll
                for (int bj = 0; bj < 2; ++bj) { const int col = c0 + bj * 128;
                    const float* src; float* dst;
                    if (MODE == 0) { src = row < MP ? XPp + (size_t)row * 1024 + col : XSp + (size_t)(row - MP) * 1024 + col; dst = X1 + (size_t)row * 1024 + col; }
                    else { src = X1 + (size_t)row * 1024 + col; dst = row < MP ? out + O_YP + (size_t)row * 1024 + col : out + O_YS + (size_t)(row - MP) * 1024 + col; }
                    *(pg8::f32x4*)dst = acc[ai][bj][m][0] + *(const pg8::f32x4*)src; *(pg8::f32x4*)(dst + 4) = acc[ai][bj][m][1] + *(const pg8::f32x4*)(src + 4); } }
    }
};

#define MFMA32(a, b, c) __builtin_amdgcn_mfma_f32_32x32x16_bf16((a), (b), (c), 0, 0, 0)
__device__ __forceinline__ int crow(int r, int hi) { return (r & 3) + 8 * (r >> 2) + 4 * hi; }
__device__ __forceinline__ bf16x8 lds_ld8(LAS const unsigned char* p) { return *(LAS const bf16x8*)p; }
__device__ __forceinline__ bf16x8 gl_ld8(const bf16* p) { return *(const bf16x8*)p; }

constexpr int GA_QH = 0, GA_KH = 17408, GA_KBH = 34816, GA_VBT = 52224, GA_KBGT = 70656, GA_KDT = 89088, GA_LF = 107520, GA_TB = 123904, GA_GS = 133120, GA_BS = 133376;
__device__ __forceinline__ void gdn_a_unit(const Args& A, LAS unsigned char* lds, int unit, int tid, int lane, int wave) {
    unsigned char* ws = A.ws;
    const int b = unit >> 8, h = (unit >> 5) & 7, n = unit & 31;
    const int row0 = b * SEQ + n * 64;
    const bf16* QKV = (const bf16*)(ws + WS_QKV);
    LAS float* Gs = (LAS float*)(lds + GA_GS); LAS float* Bs = (LAS float*)(lds + GA_BS);
    if (wave == 0) {
        float x = ((const float*)(ws + WS_GLOG))[(size_t)(row0 + lane) * 8 + h];
#pragma unroll
        for (int o = 1; o < 64; o <<= 1) { const float y = __shfl_up(x, o); if (lane >= o) x += y; }
        Gs[lane] = x; Bs[lane] = ((const float*)(ws + WS_BETA))[(size_t)(row0 + lane) * 8 + h];
    }
    __syncthreads();
    const float Gend = Gs[63];
    {
        const int cg = tid & 15, rr = tid >> 4;
        bf16* GQG = (bf16*)(ws + WS_GQG) + (size_t)unit * 8192;
#pragma unroll 1
        for (int part = 0; part < 3; ++part) {
            const int colb = part * 1024 + h * 128 + 8 * cg;
            float wgt[4][8];
#pragma unroll
            for (int tap = 0; tap < 4; ++tap) { const f32x4 w0 = *(const f32x4*)(A.in[I_CONVW] + tap * 3072 + colb), w1 = *(const f32x4*)(A.in[I_CONVW] + tap * 3072 + colb + 4);
                wgt[tap][0] = w0.x; wgt[tap][1] = w0.y; wgt[tap][2] = w0.z; wgt[tap][3] = w0.w; wgt[tap][4] = w1.x; wgt[tap][5] = w1.y; wgt[tap][6] = w1.z; wgt[tap][7] = w1.w; }
#pragma unroll
            for (int ri = 0; ri < 2; ++ri) {
                const int i = rr + 32 * ri, tl = n * 64 + i;
                float y[8];
#pragma unroll
                for (int e = 0; e < 8; ++e) y[e] = 0.f;
#pragma unroll
                for (int tap = 0; tap < 4; ++tap) { const int tt = tl - 3 + tap;
                    if (tt >= 0) { const v4u w = *(const v4u*)(QKV + (size_t)(b * SEQ + tt) * 3072 + colb);
                        const float x[8] = {lo16(w.x), hi16(w.x), lo16(w.y), hi16(w.y), lo16(w.z), hi16(w.z), lo16(w.w), hi16(w.w)};
#pragma unroll
                        for (int e = 0; e < 8; ++e) y[e] += wgt[tap][e] * x[e]; } }
                float ss = 0.f;
#pragma unroll
                for (int e = 0; e < 8; ++e) { y[e] = siluf_(y[e]); ss += y[e] * y[e]; }
                ss += __shfl_xor(ss, 1); ss += __shfl_xor(ss, 2); ss += __shfl_xor(ss, 4); ss += __shfl_xor(ss, 8);
                const float rs = 1.f / sqrtf(ss + EPS), beta = Bs[i], eg = __expf(Gs[i]), ed = __expf(Gend - Gs[i]);
                if (part == 0) {
                    float q[8];
#pragma unroll
                    for (int e = 0; e < 8; ++e) q[e] = y[e] * rs * 0.08838834764831845f;
                    v4u o; o.x = pk2(q[0], q[1]); o.y = pk2(q[2], q[3]); o.z = pk2(q[4], q[5]); o.w = pk2(q[6], q[7]);
                    *(LAS v4u*)(lds + GA_QH + i * 272 + cg * 16) = o;
                    v4u g; g.x = pk2(q[0] * eg, q[1] * eg); g.y = pk2(q[2] * eg, q[3] * eg); g.z = pk2(q[4] * eg, q[5] * eg); g.w = pk2(q[6] * eg, q[7] * eg);
                    *(v4u*)(GQG + i * 128 + 8 * cg) = g;
                } else if (part == 1) {
                    float k[8];
#pragma unroll
                    for (int e = 0; e < 8; ++e) k[e] = y[e] * rs;
                    v4u o; o.x = pk2(k[0], k[1]); o.y = pk2(k[2], k[3]); o.z = pk2(k[4], k[5]); o.w = pk2(k[6], k[7]);
                    *(LAS v4u*)(lds + GA_KH + i * 272 + cg * 16) = o;
                    v4u kb; kb.x = pk2(k[0] * beta, k[1] * beta); kb.y = pk2(k[2] * beta, k[3] * beta); kb.z = pk2(k[4] * beta, k[5] * beta); kb.w = pk2(k[6] * beta, k[7] * beta);
                    *(LAS v4u*)(lds + GA_KBH + i * 272 + cg * 16) = kb;
#pragma unroll
                    for (int e = 0; e < 8; ++e) { *(LAS bf16*)(lds + GA_KBGT + (8 * cg + e) * 144 + i * 2) = (bf16)f2bf(k[e] * beta * eg);
                        *(LAS bf16*)(lds + GA_KDT + (8 * cg + e) * 144 + i * 2) = (bf16)f2bf(k[e] * ed); }
                } else {
#pragma unroll
                    for (int e = 0; e < 8; ++e) *(LAS bf16*)(lds + GA_VBT + (8 * cg + e) * 144 + i * 2) = (bf16)f2bf(y[e] * beta);
                }
            }
        }
    }
    __syncthreads();
    const int l31 = lane & 31, hi = lane >> 5;
    {
        const int it = (wave >> 1) & 1, jt = wave & 1; const bool isL = wave < 4;
        f32x16 acc = {};
        if (it >= jt) {
            LAS const unsigned char* Ab = lds + (isL ? GA_KBH : GA_QH) + (32 * it + l31) * 272 + hi * 16;
            LAS const unsigned char* Bb = lds + GA_KH + (32 * jt + l31) * 272 + hi * 16;
#pragma unroll
            for (int ks = 0; ks < 8; ++ks) acc = MFMA32(lds_ld8(Ab + ks * 32), lds_ld8(Bb + ks * 32), acc);
        }
        const int j = 32 * jt + l31; const float Gj = Gs[j];
        bf16* AQ = (bf16*)(ws + WS_GAQK) + (size_t)unit * 4096;
#pragma unroll
        for (int r = 0; r < 16; ++r) { const int i = 32 * it + crow(r, hi);
            const float d = __expf(fminf(Gs[i] - Gj, 0.f));
            if (isL) ((LAS float*)(lds + GA_LF))[i * 64 + j] = (i > j) ? acc[r] * d : 0.f;
            else AQ[i * 64 + j] = (bf16)f2bf((i >= j) ? acc[r] * d : 0.f); }
    }
    __syncthreads();
    if (wave == 0) {
        float T[64];
        LAS const float* Lf = (LAS const float*)(lds + GA_LF);
#pragma unroll
        for (int i = 0; i < 64; ++i) {
            float a = (i == lane) ? 1.f : 0.f;
#pragma unroll
            for (int j4 = 0; j4 < (i + 3) / 4; ++j4) { const f32x4 l4 = *(LAS const f32x4*)(Lf + i * 64 + 4 * j4);
                if (4 * j4 + 0 < i) a -= l4.x * T[4 * j4 + 0];
                if (4 * j4 + 1 < i) a -= l4.y * T[4 * j4 + 1];
                if (4 * j4 + 2 < i) a -= l4.z * T[4 * j4 + 2];
                if (4 * j4 + 3 < i) a -= l4.w * T[4 * j4 + 3]; }
            T[i] = a;
            *(LAS bf16*)(lds + GA_TB + i * 144 + lane * 2) = (bf16)f2bf(a);
        }
    } else {
        bf16* GKD = (bf16*)(ws + WS_GKD) + (size_t)unit * 8192;
        for (int id = tid - 64; id < 1024; id += 448) { const int row = id >> 3, ch = id & 7;
            *(v4u*)(GKD + row * 64 + ch * 8) = *(LAS const v4u*)(lds + GA_KDT + row * 144 + ch * 16); }
    }
    __syncthreads();
    {
        const int nt = wave; LAS const unsigned char* Bb = lds + (nt < 4 ? GA_VBT : GA_KBGT) + (32 * (nt & 3) + l31) * 144 + hi * 16;
        float* GU0 = (float*)(ws + WS_GU0) + (size_t)unit * 8192; bf16* GW = (bf16*)(ws + WS_GW) + (size_t)unit * 8192;
#pragma unroll
        for (int it = 0; it < 2; ++it) {
            f32x16 acc = {};
            LAS const unsigned char* Ab = lds + GA_TB + (32 * it + l31) * 144 + hi * 16;
#pragma unroll
            for (int ks = 0; ks < 4; ++ks) if (ks < 2 * (it + 1)) acc = MFMA32(lds_ld8(Ab + ks * 32), lds_ld8(Bb + ks * 32), acc);
            const int col = 32 * (nt & 3) + l31;
#pragma unroll
            for (int r = 0; r < 16; ++r) { const int i = 32 * it + crow(r, hi);
                if (nt < 4) GU0[i * 128 + col] = acc[r]; else GW[i * 128 + col] = (bf16)f2bf(acc[r]); }
        }
        if (tid == 0) ((float*)(ws + WS_GEND))[unit] = __expf(Gend);
    }
    __syncthreads();
}

constexpr int GB_ST = 0, GB_UT = 34816, GB_OF = 53248;
__device__ __forceinline__ void gdn_b_unit(const Args& A, LAS unsigned char* lds, int bh, int tid, int lane, int wave) {
    unsigned char* ws = A.ws;
    const int b = bh >> 3, h = bh & 7, l31 = lane & 31, hi = lane >> 5;
    const int it = wave >> 2, vt = wave & 3;
    for (int i = tid; i < 34816 / 16; i += 512) *(LAS v4u*)(lds + GB_ST + i * 16) = (v4u){0u, 0u, 0u, 0u};
    f32x16 Sacc[2] = {};
    __syncthreads();
    const bf16* Zb = (const bf16*)(ws + WS_Z); bf16* YA = (bf16*)(ws + WS_YA);
    LAS const unsigned char* Sb = lds + GB_ST + (32 * vt + l31) * 272 + hi * 16;
    LAS const unsigned char* Ub = lds + GB_UT + (32 * vt + l31) * 144 + hi * 16;
#pragma unroll 1
    for (int n = 0; n < 32; ++n) {
        const int cu = bh * 32 + n, r0 = b * SEQ + 64 * n;
        const bf16* GW = (const bf16*)(ws + WS_GW) + (size_t)cu * 8192; const bf16* GQG = (const bf16*)(ws + WS_GQG) + (size_t)cu * 8192;
        const bf16* GKD = (const bf16*)(ws + WS_GKD) + (size_t)cu * 8192; const bf16* GAQ = (const bf16*)(ws + WS_GAQK) + (size_t)cu * 4096;
        const float* GU0 = (const float*)(ws + WS_GU0) + (size_t)cu * 8192; const float gend = ((const float*)(ws + WS_GEND))[cu];
        {
            f32x16 acc = {};
            const bf16* Ab = GW + (32 * it + l31) * 128 + 8 * hi;
#pragma unroll
            for (int ks = 0; ks < 8; ++ks) acc = MFMA32(gl_ld8(Ab + 16 * ks), lds_ld8(Sb + ks * 32), acc);
            float u[16];
#pragma unroll
            for (int r = 0; r < 16; ++r) u[r] = GU0[(32 * it + crow(r, hi)) * 128 + 32 * vt + l31] - acc[r];
#pragma unroll
            for (int g = 0; g < 4; ++g) { v2u w; w.x = pk2(u[4 * g], u[4 * g + 1]); w.y = pk2(u[4 * g + 2], u[4 * g + 3]);
                *(LAS v2u*)(lds + GB_UT + (32 * vt + l31) * 144 + (32 * it + 8 * g + 4 * hi) * 2) = w; }
        }
        __syncthreads();
        {
            f32x16 acc = {};
            const bf16* Ab = GQG + (32 * it + l31) * 128 + 8 * hi;
#pragma unroll
            for (int ks = 0; ks < 8; ++ks) acc = MFMA32(gl_ld8(Ab + 16 * ks), lds_ld8(Sb + ks * 32), acc);
            const bf16* Cb = GAQ + (32 * it + l31) * 64 + 8 * hi;
#pragma unroll
            for (int ks = 0; ks < 4; ++ks) if (ks < 2 * (it + 1)) acc = MFMA32(gl_ld8(Cb + 16 * ks), lds_ld8(Ub + ks * 32), acc);
#pragma unroll
            for (int r = 0; r < 16; ++r) ((LAS float*)(lds + GB_OF))[(32 * it + crow(r, hi)) * 132 + 32 * vt + l31] = acc[r];
        }
        __syncthreads();
        {
#pragma unroll
            for (int t = 0; t < 2; ++t) { const int kt = 2 * (wave >> 2) + t;
                Sacc[t] = Sacc[t] * gend;
                const bf16* Ab = GKD + (32 * kt + l31) * 64 + 8 * hi;
#pragma unroll
                for (int ks = 0; ks < 4; ++ks) Sacc[t] = MFMA32(gl_ld8(Ab + 16 * ks), lds_ld8(Ub + ks * 32), Sacc[t]);
#pragma unroll
                for (int g = 0; g < 4; ++g) { v2u w; w.x = pk2(Sacc[t][4 * g], Sacc[t][4 * g + 1]); w.y = pk2(Sacc[t][4 * g + 2], Sacc[t][4 * g + 3]);
                    *(LAS v2u*)(lds + GB_ST + (32 * vt + l31) * 272 + (32 * kt + 8 * g + 4 * hi) * 2) = w; }
            }
        }
        {
            const int i = tid >> 3, c0 = (tid & 7) * 16;
            LAS const float* orow = (LAS const float*)(lds + GB_OF) + i * 132 + c0;
            float o[16]; float ss = 0.f;
#pragma unroll
            for (int q = 0; q < 4; ++q) { const f32x4 v = *(LAS const f32x4*)(orow + 4 * q); o[4 * q] = v.x; o[4 * q + 1] = v.y; o[4 * q + 2] = v.z; o[4 * q + 3] = v.w; }
#pragma unroll
            for (int e = 0; e < 16; ++e) ss += o[e] * o[e];
            ss += __shfl_xor(ss, 1); ss += __shfl_xor(ss, 2); ss += __shfl_xor(ss, 4);
            const float r = 1.f / sqrtf(ss * (1.f / 128.f) + EPS);
            const size_t off = (size_t)(r0 + i) * 1024 + h * 128 + c0;
            const v4u z0 = *(const v4u*)(Zb + off), z1 = *(const v4u*)(Zb + off + 8);
            const float z[16] = {lo16(z0.x), hi16(z0.x), lo16(z0.y), hi16(z0.y), lo16(z0.z), hi16(z0.z), lo16(z0.w), hi16(z0.w),
                                 lo16(z1.x), hi16(z1.x), lo16(z1.y), hi16(z1.y), lo16(z1.z), hi16(z1.z), lo16(z1.w), hi16(z1.w)};
            float y[16];
#pragma unroll
            for (int e = 0; e < 16; ++e) y[e] = o[e] * r * A.in[I_GDNN][c0 + e] * siluf_(z[e]);
            v4u o0, o1; o0.x = pk2(y[0], y[1]); o0.y = pk2(y[2], y[3]); o0.z = pk2(y[4], y[5]); o0.w = pk2(y[6], y[7]);
            o1.x = pk2(y[8], y[9]); o1.y = pk2(y[10], y[11]); o1.z = pk2(y[12], y[13]); o1.w = pk2(y[14], y[15]);
            *(v4u*)(YA + off) = o0; *(v4u*)(YA + off + 8) = o1;
        }
        __syncthreads();
    }
    float* So = A.out + O_GSP + (size_t)bh * 16384;
#pragma unroll
    for (int t = 0; t < 2; ++t) { const int kt = 2 * (wave >> 2) + t;
#pragma unroll
        for (int r = 0; r < 16; ++r) So[(32 * kt + crow(r, hi)) * 128 + 32 * vt + l31] = Sacc[t][r]; }
    __syncthreads();
}

__device__ __forceinline__ void gdn_r_unit(const Args& A, LAS unsigned char* lds, int unit, int tid, int lane, int wave) {
    unsigned char* ws = A.ws;
    const int j = unit >> 3, h = unit & 7, row = MP + j;
    LAS float* qs = (LAS float*)lds; LAS float* ks = qs + 128; LAS float* vs = qs + 256; LAS float* red = qs + 384;
    LAS float* os = qs + 896;
    if (tid < 384) {
        const int part = tid >> 7, d = tid & 127, col = part * 1024 + h * 128 + d;
        const float* cw = A.in[I_CONVW]; const float* sc = A.in[I_SCONV] + (size_t)j * 3 * 3072;
        const float xn = bf2f(((const bf16*)(ws + WS_QKV))[(size_t)row * 3072 + col]);
        const float y = cw[col] * sc[col] + cw[3072 + col] * sc[3072 + col] + cw[2 * 3072 + col] * sc[2 * 3072 + col] + cw[3 * 3072 + col] * xn;
        qs[tid] = siluf_(y);
    }
    __syncthreads();
    const float rq = 1.f / sqrtf(wave_sum(qs[lane] * qs[lane] + qs[lane + 64] * qs[lane + 64]) + EPS) * 0.08838834764831845f;
    const float rk = 1.f / sqrtf(wave_sum(ks[lane] * ks[lane] + ks[lane + 64] * ks[lane + 64]) + EPS);
    const float beta = ((const float*)(ws + WS_BETA))[(size_t)row * 8 + h], eg = __expf(((const float*)(ws + WS_GLOG))[(size_t)row * 8 + h]);
    const int v = tid & 127, kq = tid >> 7;
    const float* S0 = A.in[I_SGDN] + (size_t)unit * 16384;
    float s[32]; float kv = 0.f;
#pragma unroll
    for (int i = 0; i < 32; ++i) { const int k = 32 * kq + i; s[i] = eg * S0[k * 128 + v]; kv += ks[k] * rk * s[i]; }
    red[kq * 128 + v] = kv;
    __syncthreads();
    const float u = beta * (vs[v] - (red[v] + red[128 + v] + red[256 + v] + red[384 + v]));
    __syncthreads();
    float* So = A.out + O_GSS + (size_t)unit * 16384; float po = 0.f;
#pragma unroll
    for (int i = 0; i < 32; ++i) { const int k = 32 * kq + i; s[i] += ks[k] * rk * u; So[k * 128 + v] = s[i]; po += qs[k] * rq * s[i]; }
    red[kq * 128 + v] = po;
    __syncthreads();
    if (tid < 128) os[tid] = red[tid] + red[128 + tid] + red[256 + tid] + red[384 + tid];
    __syncthreads();
    const float rn = 1.f / sqrtf(wave_sum(os[lane] * os[lane] + os[lane + 64] * os[lane + 64]) * (1.f / 128.f) + EPS);
    if (tid < 128) { const size_t off = (size_t)row * 1024 + h * 128 + tid;
        ((bf16*)(ws + WS_YA))[off] = (bf16)f2bf(os[tid] * rn * A.in[I_GDNN][tid] * siluf_(bf2f(((const bf16*)(ws + WS_Z))[off]))); }
    __syncthreads();
}

__device__ __forceinline__ void p4_rows(const Args& A, int gw, int NGW, int lane) {
    unsigned char* ws = A.ws;
    const bf16* QP = (const bf16*)(ws + WS_QP); bf16* QP2 = (bf16*)(ws + WS_QP2); bf16* KN = (bf16*)(ws + WS_KN);
    const int hh = lane >> 3, l7 = lane & 7;
    for (int m = gw; m < MR; m += NGW) {
        const int pos = m < MP ? (m & (SEQ - 1)) : PAST;
#pragma unroll
        for (int which = 0; which < 2; ++which) {
            const bf16* src = which == 0 ? QP + (size_t)m * 1536 + 16 * lane : KN + (size_t)m * 1024 + 16 * lane;
            const float* gain = (which == 0 ? A.in[I_QNN] : A.in[I_KNN]) + 16 * l7;
            const v4u w0 = *(const v4u*)src, w1 = *(const v4u*)(src + 8);
            float v[16] = {lo16(w0.x), hi16(w0.x), lo16(w0.y), hi16(w0.y), lo16(w0.z), hi16(w0.z), lo16(w0.w), hi16(w0.w),
                           lo16(w1.x), hi16(w1.x), lo16(w1.y), hi16(w1.y), lo16(w1.z), hi16(w1.z), lo16(w1.w), hi16(w1.w)};
            float ss = 0.f;
#pragma unroll
            for (int e = 0; e < 16; ++e) ss += v[e] * v[e];
            ss += __shfl_xor(ss, 1); ss += __shfl_xor(ss, 2); ss += __shfl_xor(ss, 4);
            const float r = 1.f / sqrtf(ss * (1.f / 128.f) + EPS);
#pragma unroll
            for (int e = 0; e < 16; ++e) v[e] = v[e] * r * gain[e];
            v4u o0, o1; o0.x = pk2(v[0], v[1]); o0.y = pk2(v[2], v[3]); o0.z = pk2(v[4], v[5]); o0.w = pk2(v[6], v[7]);
            o1.x = pk2(v[8], v[9]); o1.y = pk2(v[10], v[11]); o1.z = pk2(v[12], v[13]); o1.w = pk2(v[14], v[15]);
            bf16* dst = which == 0 ? QP2 + (size_t)m * 1536 + hh * 192 + 16 * l7 : KN + (size_t)m * 1024 + 16 * lane;
            *(v4u*)dst = o0; *(v4u*)(dst + 8) = o1;
        }
        {
            const v4u w = *(const v4u*)(QP + (size_t)m * 1536 + 1024 + 8 * lane);
            float v[8] = {lo16(w.x), hi16(w.x), lo16(w.y), hi16(w.y), lo16(w.z), hi16(w.z), lo16(w.w), hi16(w.w)};
            float ss = 0.f;
#pragma unroll
            for (int e = 0; e < 8; ++e) ss += v[e] * v[e];
            ss += __shfl_xor(ss, 1); ss += __shfl_xor(ss, 2); ss += __shfl_xor(ss, 4);
            const float r = 1.f / sqrtf(ss * (1.f / 64.f) + EPS);
            float o[8];
#pragma unroll
            for (int e = 0; e < 8; ++e) { const float xn = v[e] * r * A.in[I_QNR][8 * l7 + e]; const float other = __shfl_xor(xn, 4);
                const float ang = (float)pos * ROPE_INV[8 * (l7 & 3) + e]; const float cs = cosf(ang), sn = sinf(ang);
                o[e] = (l7 < 4) ? xn * cs - other * sn : other * sn + xn * cs; }
            v4u ow; ow.x = pk2(o[0], o[1]); ow.y = pk2(o[2], o[3]); ow.z = pk2(o[4], o[5]); ow.w = pk2(o[6], o[7]);
            *(v4u*)(QP2 + (size_t)m * 1536 + hh * 192 + 128 + 8 * l7) = ow;
        }
    }
}
namespace att {
using s16x4 = __attribute__((ext_vector_type(4))) short;
using u32x4 = __attribute__((ext_vector_type(4))) unsigned;
constexpr int SHM_V = 16384, SHM_K = 16384, SHM_KR = 8192;
constexpr int OFF_V = 0, OFF_K = 2 * SHM_V, OFF_KR = OFF_K + 2 * SHM_K, OFF_WS = OFF_KR + 2 * SHM_KR, OFF_QR = OFF_WS + 2048;
constexpr float THR = 8.f;
#define KSWZ(row, colB) ((row) * 256 + ((colB) ^ (((row) & 7) << 4)))
#define KRSWZ(row, colB) ((row) * 128 + ((colB) ^ (((row) & 7) << 4)))
#define SBAR() __builtin_amdgcn_sched_barrier(0)
__device__ __forceinline__ unsigned cvtpk(float lo, float hi) { unsigned r; asm volatile("v_cvt_pk_bf16_f32 %0, %1, %2" : "=v"(r) : "v"(lo), "v"(hi)); return r; }
__device__ __forceinline__ void partialSM(f32x16& p0, f32x16& p1, float& m_reg, float& mn, float& alpha) {
    constexpr float C = MLA_SCALE * 1.4426950408889634f;
    float pmax = p0[0];
#pragma unroll
    for (int r = 1; r < 16; ++r) pmax = fmaxf(pmax, p0[r]);
#pragma unroll
    for (int r = 0; r < 16; ++r) pmax = fmaxf(pmax, p1[r]);
    { auto rr = __builtin_amdgcn_permlane32_swap(__float_as_uint(pmax), __float_as_uint(pmax), false, false);
      pmax = fmaxf(__uint_as_float(rr[0]), __uint_as_float(rr[1])); }
    if (__builtin_expect(__all(pmax - m_reg <= THR / MLA_SCALE), 1)) { mn = m_reg; alpha = 1.f; }
    else { mn = fmaxf(m_reg, pmax); alpha = __builtin_amdgcn_exp2f((m_reg - mn) * C); m_reg = mn; }
    const float mnC = -mn * C;
#pragma unroll
    for (int r = 0; r < 16; ++r) p0[r] = fmaf(p0[r], C, mnC);
#pragma unroll
    for (int r = 0; r < 16; ++r) p1[r] = fmaf(p1[r], C, mnC);
#pragma unroll
    for (int r = 0; r < 16; ++r) p0[r] = __builtin_amdgcn_exp2f(p0[r]);
}
__device__ __forceinline__ void finishSM(f32x16& p0, f32x16& p1, float alpha, float& l_reg, bf16x8& pa0, bf16x8& pa1, bf16x8& pa2, bf16x8& pa3) {
#pragma unroll
    for (int r = 0; r < 16; ++r) p1[r] = __builtin_amdgcn_exp2f(p1[r]);
    float ps = 0;
#pragma unroll
    for (int r = 0; r < 16; ++r) ps += p0[r];
#pragma unroll
    for (int r = 0; r < 16; ++r) ps += p1[r];
    { auto rr = __builtin_amdgcn_permlane32_swap(__float_as_uint(ps), __float_as_uint(ps), false, false);
      ps = __uint_as_float(rr[0]) + __uint_as_float(rr[1]); }
    l_reg = l_reg * alpha + ps;
#define PK4(P, BASE, OUT) do { unsigned a0 = cvtpk(P[BASE + 0], P[BASE + 1]), a1 = cvtpk(P[BASE + 2], P[BASE + 3]);   \
    unsigned b0 = cvtpk(P[BASE + 4], P[BASE + 5]), b1 = cvtpk(P[BASE + 6], P[BASE + 7]);                              \
    auto r0 = __builtin_amdgcn_permlane32_swap(a0, b0, false, false); auto r1 = __builtin_amdgcn_permlane32_swap(a1, b1, false, false); \
    u32x4 w = {r0[0], r1[0], r0[1], r1[1]}; OUT = *reinterpret_cast<bf16x8*>(&w); } while (0)
    PK4(p0, 0, pa0); PK4(p0, 8, pa1); PK4(p1, 0, pa2); PK4(p1, 8, pa3);
#undef PK4
}
__device__ __forceinline__ void qkt(f32x16& p0, f32x16& p1, LAS const unsigned char* Ks, LAS const unsigned char* KRs, const bf16x8* qr, LAS const unsigned char* qrl, int r32, int hi) {
    p0 = f32x16{}; p1 = f32x16{};
#pragma unroll
    for (int d0 = 0; d0 < 8; ++d0) { const int cb = (d0 * 16 + hi * 8) * 2;
        const bf16x8 b0 = *(LAS const bf16x8*)(Ks + KSWZ(r32, cb)), b1 = *(LAS const bf16x8*)(Ks + KSWZ(32 + r32, cb));
        p0 = MFMA32(b0, qr[d0], p0); p1 = MFMA32(b1, qr[d0], p1); if (d0 == 3 || d0 == 7) SBAR(); }
#pragma unroll
    for (int d0 = 0; d0 < 4; ++d0) { const int cb = (d0 * 16 + hi * 8) * 2;
        const bf16x8 b0 = *(LAS const bf16x8*)(KRs + KRSWZ(r32, cb)), b1 = *(LAS const bf16x8*)(KRs + KRSWZ(32 + r32, cb));
        const bf16x8 qq = *(LAS const bf16x8*)(qrl + d0 * 1024);
        p0 = MFMA32(b0, qq, p0); p1 = MFMA32(b1, qq, p1); }
}
__device__ __forceinline__ void cmask(f32x16& p0, f32x16& p1, int key0, int qpos, int hi) {
#pragma unroll
    for (int r = 0; r < 16; ++r) { const int k = key0 + crow(r, hi); if (k > qpos) p0[r] = -1e30f; if (k + 32 > qpos) p1[r] = -1e30f; }
}
__device__ __forceinline__ int v_st(int k, int c) { const int kk = (k & ~0xC) | ((k & 4) << 1) | ((k & 8) >> 1); return ((kk >> 3) * 4 + (c >> 5)) * 512 + ((kk & 7) * 32 + (c & 31)) * 2; }
__device__ __forceinline__ int v_rd_base(int lane) { return ((lane & 3) << 3) | (((lane >> 2) & 3) << 6) | (((lane >> 4) & 1) << 5) | (((lane >> 5) & 1) << 8); }
constexpr int v_rd_off(int d0, int ks, int half) { return d0 * 512 + ks * 4096 + half * 2048; }
template <int OFF> __device__ __forceinline__ s16x4 tr_read(int vb) {
    s16x4 r; asm volatile("ds_read_b64_tr_b16 %0, %1 offset:%2" : "=&v"(r) : "v"(vb), "i"(OFF) : "memory"); return r;
}
template <int D0> __device__ __forceinline__ void pv_one(f32x16& od, int vb, bf16x8 pa0, bf16x8 pa1, bf16x8 pa2, bf16x8 pa3) {
    const s16x4 l0 = tr_read<v_rd_off(D0, 0, 0)>(vb), h0 = tr_read<v_rd_off(D0, 0, 1)>(vb), l1 = tr_read<v_rd_off(D0, 1, 0)>(vb), h1 = tr_read<v_rd_off(D0, 1, 1)>(vb);
    const s16x4 l2 = tr_read<v_rd_off(D0, 2, 0)>(vb), h2 = tr_read<v_rd_off(D0, 2, 1)>(vb), l3 = tr_read<v_rd_off(D0, 3, 0)>(vb), h3 = tr_read<v_rd_off(D0, 3, 1)>(vb);
    asm volatile("s_waitcnt lgkmcnt(0)" ::: "memory"); SBAR();
#define PKV(L, H) (bf16x8){L[0], L[1], L[2], L[3], H[0], H[1], H[2], H[3]}
    od = MFMA32(pa0, PKV(l0, h0), od); od = MFMA32(pa1, PKV(l1, h1), od); od = MFMA32(pa2, PKV(l2, h2), od); od = MFMA32(pa3, PKV(l3, h3), od);
#undef PKV
}
__device__ __forceinline__ void pv_d0(f32x16* o, int vb, bf16x8 pa0, bf16x8 pa1, bf16x8 pa2, bf16x8 pa3) {
    pv_one<0>(o[0], vb, pa0, pa1, pa2, pa3); pv_one<1>(o[1], vb, pa0, pa1, pa2, pa3); pv_one<2>(o[2], vb, pa0, pa1, pa2, pa3); pv_one<3>(o[3], vb, pa0, pa1, pa2, pa3);
}
__device__ __forceinline__ void attn_block(const bf16* __restrict__ Qb, const bf16* __restrict__ Kh, const bf16* __restrict__ KRb, const bf16* __restrict__ Vh,
                                           bf16* __restrict__ Ob, int q0, LAS unsigned char* lds) {
    const int tid = threadIdx.x, wid = __builtin_amdgcn_readfirstlane(tid >> 6), lane = tid & 63, r32 = lane & 31, hi = lane >> 5;
    LAS unsigned char* V_lds = lds + OFF_V; LAS unsigned char* K_lds = lds + OFF_K; LAS unsigned char* KR_lds = lds + OFF_KR;
    LAS float* wsf = (LAS float*)(lds + OFF_WS) + wid * 64; LAS float* li_l = wsf; LAS float* al_l = wsf + 32;
    float m_reg = -1e30f, l_reg = 0; f32x16 o[4] = {}; bf16x8 qr[8];
    LAS unsigned char* qrl = lds + OFF_QR + wid * 4096 + lane * 16;
    { const char* Qw = (const char*)Qb + (size_t)wid * (32 * 1536 * 2); const unsigned qoff = (unsigned)(r32 * 1536 + hi * 8) * 2u;
#pragma unroll
      for (int d0 = 0; d0 < 8; ++d0) qr[d0] = *(const bf16x8*)(Qw + qoff + d0 * 32);
#pragma unroll
      for (int d0 = 0; d0 < 4; ++d0) *(LAS bf16x8*)(qrl + d0 * 1024) = *(const bf16x8*)(Qw + qoff + (8 + d0) * 32); }
    const int qpos = q0 + wid * 32 + r32;
    const int sr = tid >> 4, sc = (tid & 15) * 8, vst0 = v_st(sr, sc), vst1 = v_st(32 + sr, sc);
    const int krr = tid >> 3, krc = (tid & 7) * 8;
    const unsigned voff = (unsigned)(sr * 1024 + sc) * 2u, voffr = (unsigned)(krr * 64 + krc) * 2u;
    const int vb0 = (int)(uintptr_t)V_lds + v_rd_base(lane);
    bf16x8 vs0, vs1, ks0, ks1, krs;
#define SLOAD(k0) do { const char* kb_ = (const char*)Kh + (size_t)(k0) * 2048; const char* vb_ = (const char*)Vh + (size_t)(k0) * 2048; const char* rb_ = (const char*)KRb + (size_t)(k0) * 128; \
    vs0 = *(const bf16x8*)(vb_ + voff); vs1 = *(const bf16x8*)(vb_ + 65536 + voff); ks0 = *(const bf16x8*)(kb_ + voff); ks1 = *(const bf16x8*)(kb_ + 65536 + voff); \
    krs = *(const bf16x8*)(rb_ + voffr); } while (0)
#define SWRITE(b) do { *(LAS bf16x8*)(V_lds + (b) * SHM_V + vst0) = vs0; *(LAS bf16x8*)(V_lds + (b) * SHM_V + vst1) = vs1; const int kc = sc * 2; \
    *(LAS bf16x8*)(K_lds + (b) * SHM_K + KSWZ(sr, kc)) = ks0; *(LAS bf16x8*)(K_lds + (b) * SHM_K + KSWZ(32 + sr, kc)) = ks1; \
    *(LAS bf16x8*)(KR_lds + (b) * SHM_KR + KRSWZ(krr, krc * 2)) = krs; } while (0)
#define SWAIT() asm volatile("s_waitcnt vmcnt(0)" ::: "memory")
#define RESC(a) do { if (__any((a) < 1.f)) { if (hi == 0) al_l[r32] = (a); asm volatile("s_waitcnt lgkmcnt(0)" ::: "memory"); \
    _Pragma("unroll") for (int d = 0; d < 4; ++d) _Pragma("unroll") for (int r = 0; r < 16; ++r) o[d][r] *= al_l[crow(r, hi)]; } } while (0)
    f32x16 p0, p1; float mn, al; bf16x8 pa0, pa1, pa2, pa3;
    const int NT = (q0 + 256) / 64, NM = q0 / 64;
    SLOAD(0); SWAIT(); SWRITE(0); SLOAD(64); __syncthreads();
#pragma unroll 1
    for (int j = 0; j < NT; ++j) {
        const int bf = j & 1;
        SBAR(); qkt(p0, p1, K_lds + bf * SHM_K, KR_lds + bf * SHM_KR, qr, qrl, r32, hi); if (j >= NM) cmask(p0, p1, 64 * j, qpos, hi);
        partialSM(p0, p1, m_reg, mn, al); RESC(al);
        finishSM(p0, p1, al, l_reg, pa0, pa1, pa2, pa3); SBAR();
        if (j + 1 < NT) { SWAIT(); SWRITE(bf ^ 1); }
        if (j + 2 < NT) SLOAD((j + 2) * 64);
        SBAR();
        pv_d0(o, vb0 + bf * SHM_V, pa0, pa1, pa2, pa3);
        __syncthreads();
    }
    if (hi == 0) li_l[r32] = l_reg; asm volatile("s_waitcnt lgkmcnt(0)" ::: "memory");
    char* Ow = (char*)Ob + (size_t)wid * (32 * 1024 * 2);
    unsigned lofs = (unsigned)(4 * hi * 1024 + r32) * 2u; asm volatile("" : "+v"(lofs));
#pragma unroll
    for (int r = 0; r < 16; ++r) { const float rl = __builtin_amdgcn_rcpf(li_l[crow(r, hi)]);
#pragma unroll
        for (int d0 = 0; d0 < 4; ++d0) *(bf16*)(Ow + lofs + (unsigned)(((r & 3) + 8 * (r >> 2)) * 1024 + d0 * 32) * 2u) = (bf16)f2bf(o[d0][r] * rl); }
    __syncthreads();
#undef SLOAD
#undef SWRITE
#undef SWAIT
#undef RESC
}
}

constexpr int DP_CT = 0, DP_KR = 133120, DP_PT = 151552, DP_QK = 153728, DP_QR = 157824;
__device__ __forceinline__ void dec_tables(const Args& A, LAS unsigned char* lds, int j, int tid) {
    const bf16* Qrow = (const bf16*)(A.ws + WS_QP2) + (size_t)(MP + j) * 1536;
#pragma unroll
    for (int q = 0; q < 2; ++q) { const int idx = tid + 512 * q, h = idx >> 7, d = idx & 127; ((LAS float*)(lds + DP_QK))[idx] = bf2f(Qrow[h * 192 + d]) * A.in[I_KNN][d]; }
    { const int h = tid >> 6, e = tid & 63; ((LAS float*)(lds + DP_QR))[tid] = bf2f(Qrow[h * 192 + 128 + e]); }
}
__device__ __forceinline__ void dec_page(const Args& A, LAS unsigned char* lds, int unit, int tid, int lane, int wave) {
    unsigned char* ws = A.ws;
    const int phys = ((const int*)A.in[I_PT])[unit];
    const float* src = A.in[I_CACHE] + (size_t)phys * PAGE * LATW;
#pragma unroll 1
    for (int q0 = 0; q0 < 18; q0 += 6) {
        f32x4 va[6], vb[6];
#pragma unroll
        for (int q = 0; q < 6; ++q) { const int id = (q0 + q) * 512 + tid, row = id / 72, g = id % 72; const float* p = src + (size_t)row * LATW + 8 * g; va[q] = *(const f32x4*)p; vb[q] = *(const f32x4*)(p + 4); }
#pragma unroll
        for (int q = 0; q < 6; ++q) { const int id = (q0 + q) * 512 + tid, row = id / 72, g = id % 72;
            v4u o; o.x = pk2(va[q].x, va[q].y); o.y = pk2(va[q].z, va[q].w); o.z = pk2(vb[q].x, vb[q].y); o.w = pk2(vb[q].z, vb[q].w);
            if (g < 64) *(LAS v4u*)(lds + DP_CT + row * 1040 + g * 16) = o; else *(LAS v4u*)(lds + DP_KR + row * 144 + (g - 64) * 16) = o; }
    }
    __syncthreads();
    const int l31 = lane & 31, hi = lane >> 5, h = wave;
    float ssq[4] = {0.f, 0.f, 0.f, 0.f}, dot[4] = {0.f, 0.f, 0.f, 0.f};
    const bf16* WK = (const bf16*)(ws + WS_WKV);
    LAS const float* QK = (LAS const float*)(lds + DP_QK) + h * 128;
#pragma unroll 1
    for (int e = 0; e < 2; ++e) {
        f32x16 acc[2][4];
#pragma unroll
        for (int mt = 0; mt < 2; ++mt)
#pragma unroll
            for (int nt = 0; nt < 4; ++nt) acc[mt][nt] = f32x16{};
        const bf16* Ab = WK + (size_t)(h * 128 + 64 * e + l31) * 512 + 8 * hi;
        LAS const unsigned char* Bb = lds + DP_CT + l31 * 1040 + hi * 16;
#pragma unroll 2
        for (int ks = 0; ks < 32; ++ks) {
            const bf16x8 a0 = gl_ld8(Ab + 16 * ks), a1 = gl_ld8(Ab + 32 * 512 + 16 * ks);
            bf16x8 bq[4];
#pragma unroll
            for (int nt = 0; nt < 4; ++nt) bq[nt] = lds_ld8(Bb + nt * 32 * 1040 + ks * 32);
#pragma unroll
            for (int nt = 0; nt < 4; ++nt) { acc[0][nt] = MFMA32(a0, bq[nt], acc[0][nt]); acc[1][nt] = MFMA32(a1, bq[nt], acc[1][nt]); }
        }
#pragma unroll
        for (int mt = 0; mt < 2; ++mt)
#pragma unroll
            for (int g = 0; g < 4; ++g) { const f32x4 qv = *(LAS const f32x4*)(QK + 64 * e + 32 * mt + 8 * g + 4 * hi);
#pragma unroll
                for (int nt = 0; nt < 4; ++nt) {
                    const float x0 = acc[mt][nt][4 * g], x1 = acc[mt][nt][4 * g + 1], x2 = acc[mt][nt][4 * g + 2], x3 = acc[mt][nt][4 * g + 3];
                    ssq[nt] += x0 * x0 + x1 * x1 + x2 * x2 + x3 * x3; dot[nt] += x0 * qv.x + x1 * qv.y + x2 * qv.z + x3 * qv.w; } }
    }
#pragma unroll
    for (int nt = 0; nt < 4; ++nt) { ssq[nt] += __shfl_xor(ssq[nt], 32); dot[nt] += __shfl_xor(dot[nt], 32); }
    const float sn0 = dot[0] / sqrtf(ssq[0] * (1.f / 128.f) + EPS), sn1 = dot[1] / sqrtf(ssq[1] * (1.f / 128.f) + EPS);
    const float sn2 = dot[2] / sqrtf(ssq[2] * (1.f / 128.f) + EPS), sn3 = dot[3] / sqrtf(ssq[3] * (1.f / 128.f) + EPS);
    const float snA = hi ? sn2 : sn0, snB = hi ? sn3 : sn1;
    float s[2];
    LAS const float* QR = (LAS const float*)(lds + DP_QR) + h * 64;
#pragma unroll
    for (int u = 0; u < 2; ++u) { const int key = 32 * (2 * hi + u) + l31; float sr = 0.f;
#pragma unroll
        for (int c = 0; c < 8; ++c) { const v4u w = *(LAS const v4u*)(lds + DP_KR + key * 144 + c * 16); const f32x4 q0 = *(LAS const f32x4*)(QR + 8 * c), q1 = *(LAS const f32x4*)(QR + 8 * c + 4);
            sr += lo16(w.x) * q0.x + hi16(w.x) * q0.y + lo16(w.y) * q0.z + hi16(w.y) * q0.w + lo16(w.z) * q1.x + hi16(w.z) * q1.y + lo16(w.w) * q1.z + hi16(w.w) * q1.w; }
        s[u] = ((u ? snB : snA) + sr) * MLA_SCALE; }
    const float mx = wave_max(fmaxf(s[0], s[1]));
    const float p0 = __expf(s[0] - mx), p1 = __expf(s[1] - mx);
    const float lsum = wave_sum(p0 + p1);
    *(LAS bf16*)(lds + DP_PT + h * 272 + (32 * (2 * hi) + l31) * 2) = (bf16)f2bf(p0);
    *(LAS bf16*)(lds + DP_PT + h * 272 + (32 * (2 * hi + 1) + l31) * 2) = (bf16)f2bf(p1);
    if (lane == 0) { float* ml = (float*)(ws + WS_DML) + ((size_t)unit * 8 + h) * 2; ml[0] = mx; ml[1] = lsum; }
    __syncthreads();
    float* DA = (float*)(ws + WS_DACC) + (size_t)unit * 8 * 512;
#pragma unroll 1
    for (int t = 0; t < 2; ++t) { const int cb = 64 * wave + 32 * t + l31;
        f32x16 acc2 = {};
#pragma unroll 2
        for (int ks = 0; ks < 8; ++ks) {
            bf16x8 a = {0, 0, 0, 0, 0, 0, 0, 0};
            if (l31 < 8) a = lds_ld8(lds + DP_PT + l31 * 272 + (16 * ks + 8 * hi) * 2);
            bf16x8 bb;
#pragma unroll
            for (int jj = 0; jj < 8; ++jj) bb[jj] = (short)*(LAS const bf16*)(lds + DP_CT + (16 * ks + 8 * hi + jj) * 1040 + cb * 2);
            acc2 = MFMA32(a, bb, acc2);
        }
#pragma unroll
        for (int r = 0; r < 4; ++r) DA[(size_t)(r + 4 * hi) * 512 + cb] = acc2[r];
    }
    __syncthreads();
}
__device__ __forceinline__ void dec_combine(const Args& A, LAS unsigned char* lds, int unit, int tid, int lane, int wave) {
    unsigned char* ws = A.ws;
    const int j = unit >> 3, h = unit & 7, row = MP + j;
    const bf16* Qrow = (const bf16*)(ws + WS_QP2) + (size_t)row * 1536 + h * 192;
    const bf16* Krow = (const bf16*)(ws + WS_KN) + (size_t)row * 1024 + h * 128;
    const bf16* KRrow = (const bf16*)(ws + WS_KR) + (size_t)row * 64;
    const float snew = wave_sum(bf2f(Qrow[lane]) * bf2f(Krow[lane]) + bf2f(Qrow[lane + 64]) * bf2f(Krow[lane + 64]) + bf2f(Qrow[128 + lane]) * bf2f(KRrow[lane])) * MLA_SCALE;
    const float* ML = (const float*)(ws + WS_DML) + ((size_t)j * NPAGE * 8 + h) * 2;
    const float m0 = ML[(size_t)lane * 16], m1 = ML[(size_t)(lane + 64) * 16], l0 = ML[(size_t)lane * 16 + 1], l1 = ML[(size_t)(lane + 64) * 16 + 1];
    const float M = fmaxf(wave_max(fmaxf(m0, m1)), snew);
    const float wn = __expf(snew - M);
    const float den = wave_sum(__expf(m0 - M) * l0 + __expf(m1 - M) * l1) + wn;
    const float* DA = (const float*)(ws + WS_DACC) + ((size_t)j * NPAGE * 8 + h) * 512 + tid;
    float num = wn * bf2f(((const bf16*)(ws + WS_C))[(size_t)row * 512 + tid]);
#pragma unroll 4
    for (int p = 0; p < NPAGE; ++p) num += __expf(ML[(size_t)p * 16] - M) * DA[(size_t)p * 4096];
    LAS float* lat = (LAS float*)lds; LAS float* red = lat + 512;
    lat[tid] = num / den;
    __syncthreads();
    const int d = tid & 127, qt = tid >> 7;
    const float* Wv = A.in[I_WUV] + (size_t)(qt * 128) * 1024 + h * 128 + d;
    float part = 0.f;
#pragma unroll 8
    for (int c = 0; c < 128; ++c) part += lat[qt * 128 + c] * Wv[(size_t)c * 1024];
    red[tid] = part;
    __syncthreads();
    if (tid < 128) ((bf16*)(ws + WS_YB))[(size_t)row * 1024 + h * 128 + tid] = (bf16)f2bf(red[tid] + red[128 + tid] + red[256 + tid] + red[384 + tid]);
    __syncthreads();
}
#ifndef MK_SINGLE
#define MK_SINGLE 1
#endif
constexpr int N_PHASES = 12;
__global__ void __launch_bounds__(512, 2) mk_fwd(Args args) {
    extern __shared__ __attribute__((aligned(16))) unsigned char lds_raw[];
    LAS unsigned char* lds = (LAS unsigned char*)lds_raw;
    const int tid = threadIdx.x, lane = tid & 63, wave = __builtin_amdgcn_readfirstlane(tid >> 6);
    const int G = gridDim.x, bid = blockIdx.x;
    const int gw = bid * 8 + wave, NGW = G * 8, gtid = bid * 512 + tid, NGT = G * 512;
    volatile LAS unsigned* MISC = (volatile LAS unsigned*)(lds + MISC_OFF);
    if (tid < 32) MISC[tid] = 0u;
    __syncthreads();
    unsigned char* ws = args.ws;
#if MK_SINGLE
    XcdBarrier bar = xcd_barrier_post((unsigned*)(ws + WS_CTL) + 4096, MISC + 8);
#define GRID_BAR() xcd_barrier(bar)
#else
#define GRID_BAR() do {} while (0)
#endif
    const int lo = args.ph_lo, hi = args.ph_hi;
#ifndef PHASE_MASK
#define PHASE_MASK 0xFFFF
#endif
#define IN(k) (((PHASE_MASK >> (k)) & 1) && lo <= (k) && (k) < hi)
#define SEAM(k) do { if (IN(k) && IN((k) + 1)) GRID_BAR(); } while (0)

    if (IN(0)) {
        p0_prologue(args, lds, gw, NGW, wave, lane);
        for (int i = gtid; i < 32 * 2 * 3072; i += NGT) { const int c = i % 3072, r = (i / 3072) % 2, j = i / (2 * 3072);
            args.out[O_CSS + (size_t)(j * 3 + r) * 3072 + c] = args.in[I_SCONV][(size_t)(j * 3 + r + 1) * 3072 + c]; }
        __syncthreads();
    }
    SEAM(0);
    if (IN(1)) {
        pg8::Gemm g{(const pg8::bf16_t*)(ws + WS_XN), (const pg8::bf16_t*)(ws + WS_WIN), MPAD, NIN, 1024};
        pg8::StaticOrder S; S.init(MPAD, NIN, G, bid);
        EpiG1 E{(bf16*)(ws + WS_QKV), (bf16*)(ws + WS_Z), (bf16*)(ws + WS_QD), (bf16*)(ws + WS_KVD), (bf16*)(ws + WS_GATES), (float*)(ws + WS_SM)};
        pg8::gemm_phase<EpiG1, pg8::StaticOrder, true, true>(lds, g, S, E);
    }
    SEAM(1);
    if (IN(2)) {
        p2_rows(args, gw, NGW, lane);
        p2_conv_state(args, gtid, NGT);
    }
    SEAM(2);
    if (IN(3)) {
        { pg8::Gemm g{(const pg8::bf16_t*)(ws + WS_QD), (const pg8::bf16_t*)(ws + WS_WQ), MPAD, 1536, 512};
          pg8::StaticOrder S; S.init(MPAD, 1536, G, bid);
          EpiStore<0> E{(bf16*)(ws + WS_QP), 1536, 6, (bf16*)(ws + WS_QP), 1536};
          pg8::gemm_phase<EpiStore<0>, pg8::StaticOrder, true, true>(lds, g, S, E); }
        { pg8::Gemm g{(const pg8::bf16_t*)(ws + WS_C), (const pg8::bf16_t*)(ws + WS_WKV), MPAD, 2048, 512};
          pg8::StaticOrder S; S.init(MPAD, 2048, G, G - 1 - bid);
          EpiStore<0> E{(bf16*)(ws + WS_KN), 1024, 4, (bf16*)(ws + WS_V), 1024};
          pg8::gemm_phase<EpiStore<0>, pg8::StaticOrder, true, true>(lds, g, S, E); }
        for (int u = bid; u < 2048; u += G) gdn_a_unit(args, lds, u, tid, lane, wave);
        for (int u = bid; u < 256; u += G) gdn_r_unit(args, lds, u, tid, lane, wave);
    }
    SEAM(3);
    if (IN(4)) {
        p4_rows(args, gw, NGW, lane);
        for (int u = bid; u < 64; u += G) gdn_b_unit(args, lds, u, tid, lane, wave);
    }
    SEAM(4);
    if (IN(5)) {
#ifndef NO_ATT
        for (int u = bid; u < 256; u += G) {
            const int bh = u >> 2, pr = u & 3, b = bh >> 3, h = bh & 7;
#pragma unroll 1
            for (int s2 = 0; s2 < 2; ++s2) { const int qb = s2 ? 7 - pr : pr;
                att::attn_block((const bf16*)(ws + WS_QP2) + (size_t)(b * SEQ + 256 * qb) * 1536 + h * 192, (const bf16*)(ws + WS_KN) + (size_t)(b * SEQ) * 1024 + h * 128,
                                (const bf16*)(ws + WS_KR) + (size_t)(b * SEQ) * 64, (const bf16*)(ws + WS_V) + (size_t)(b * SEQ) * 1024 + h * 128,
                                (bf16*)(ws + WS_YB) + (size_t)(b * SEQ + 256 * qb) * 1024 + h * 128, 256 * qb, lds); }
        }
#endif
#ifndef NO_DEC
        for (int c = bid; c < 256; c += G) {
            __syncthreads();
            dec_tables(args, lds, c >> 3, tid);
            __syncthreads();
#pragma unroll 1
            for (int p = 0; p < 16; ++p) dec_page(args, lds, c * 16 + p, tid, lane, wave);
        }
#endif
    }
    SEAM(5);
    if (IN(6)) { for (int u = bid; u < 256; u += G) dec_combine(args, lds, u, tid, lane, wave); }
    SEAM(6);
    if (IN(7)) {
        pg8::StaticOrder S; S.init(MPAD, 1024, G, bid);
        { pg8::Gemm g{(const pg8::bf16_t*)(ws + WS_YA), (const pg8::bf16_t*)(ws + WS_WYA), MPAD, 1024, 1024};
          EpiMerge<1> E{(const bf16*)(ws + WS_GATES), (float*)(ws + WS_TF), (bf16*)(ws + WS_T)};
          pg8::gemm_phase<EpiMerge<1>, pg8::StaticOrder, true, true>(lds, g, S, E); }
        { pg8::Gemm g{(const pg8::bf16_t*)(ws + WS_YB), (const pg8::bf16_t*)(ws + WS_WYB), MPAD, 1024, 1024};
          EpiMerge<2> E{(const bf16*)(ws + WS_GATES), (float*)(ws + WS_TF), (bf16*)(ws + WS_T)};
          pg8::gemm_phase<EpiMerge<2>, pg8::StaticOrder, true, true>(lds, g, S, E); }
    }
    SEAM(7);
    if (IN(8)) {
        pg8::Gemm g{(const pg8::bf16_t*)(ws + WS_T), (const pg8::bf16_t*)(ws + WS_WO), MPAD, 1024, 1024};
        pg8::StaticOrder S; S.init(MPAD, 1024, G, bid);
        EpiRes<0> E{args.in[I_XP], args.in[I_XS], (float*)(ws + WS_X1), args.out};
        pg8::gemm_phase<EpiRes<0>, pg8::StaticOrder, true, true>(lds, g, S, E);
    }
    SEAM(8);
    if (IN(9)) {
        bf16* XN2 = (bf16*)(ws + WS_XN2); const float* X1 = (const float*)(ws + WS_X1);
        for (int m = gw; m < MPAD; m += NGW) {
            if (m < MR) rms_row_to_bf16(X1 + (size_t)m * 1024, args.in[I_NMLP], XN2 + (size_t)m * 1024, lane);
            else { v4u z = {0u, 0u, 0u, 0u}; *((v4u*)(XN2 + (size_t)m * 1024) + lane) = z; *((v4u*)(XN2 + (size_t)m * 1024) + 64 + lane) = z; }
        }
    }
    SEAM(9);
    if (IN(10)) {
        pg8::Gemm g{(const pg8::bf16_t*)(ws + WS_XN2), (const pg8::bf16_t*)(ws + WS_WUP), MPAD, 4096, 1024};
        pg8::StaticOrder S; S.init(MPAD, 4096, G, bid);
        EpiStore<1> E{(bf16*)(ws + WS_H), 4096, 16, (bf16*)(ws + WS_H), 4096};
        pg8::gemm_phase<EpiStore<1>, pg8::StaticOrder, true, true>(lds, g, S, E);
    }
    SEAM(10);
    if (IN(11)) {
        pg8::Gemm g{(const pg8::bf16_t*)(ws + WS_H), (const pg8::bf16_t*)(ws + WS_WDN), MPAD, 1024, 4096};
        pg8::StaticOrder S; S.init(MPAD, 1024, G, bid);
        EpiRes<1> E{args.in[I_XP], args.in[I_XS], (float*)(ws + WS_X1), args.out};
        pg8::gemm_phase<EpiRes<1>, pg8::StaticOrder, true, true>(lds, g, S, E);
    }
#undef IN
#undef SEAM
}

extern "C" void kernel_launch(void* const* d_in, const int* in_sizes, int n_in, void* d_out, int out_size, void* d_ws, size_t ws_size, hipStream_t stream) {
    static int grid = 0;
    if (grid == 0) {
        if (n_in != 27 || ws_size < WS_END) { fprintf(stderr, "kernel_launch: unexpected n_in %d or ws_size %zu (need %zu)\n", n_in, ws_size, (size_t)WS_END); grid = -1; return; }
        int dev = 0, cus = 0, per_cu = 0;
        if (hipGetDevice(&dev) != hipSuccess || hipDeviceGetAttribute(&cus, hipDeviceAttributeMultiprocessorCount, dev) != hipSuccess) { grid = -1; return; }
        if (hipFuncSetAttribute((const void*)mk_fwd, hipFuncAttributeMaxDynamicSharedMemorySize, LDS_BYTES) != hipSuccess) { fprintf(stderr, "kernel_launch: hipFuncSetAttribute failed\n"); grid = -1; return; }
        if (hipOccupancyMaxActiveBlocksPerMultiprocessor(&per_cu, (const void*)mk_fwd, 512, LDS_BYTES) != hipSuccess || per_cu < 1) fprintf(stderr, "kernel_launch: occupancy query says %d\n", per_cu);
        (void)hipGetLastError();
        grid = cus;
    }
    if (grid < 0) return;
    (void)hipMemsetAsync((char*)d_ws + WS_CTL, 0, CTL_BYTES, stream);
    Args a{};
    for (int i = 0; i < 27; ++i) a.in[i] = (const float*)d_in[i];
    a.out = (float*)d_out; a.ws = (unsigned char*)d_ws;
#if MK_SINGLE
    a.ph_lo = 0; a.ph_hi = N_PHASES;
    hipLaunchKernelGGL(mk_fwd, dim3(grid), dim3(512), LDS_BYTES, stream, a);
#else
    for (int p = 0; p < N_PHASES; ++p) { a.ph_lo = p; a.ph_hi = p + 1; hipLaunchKernelGGL(mk_fwd, dim3(grid), dim3(512), LDS_BYTES, stream, a); }
#endif
    const hipError_t le = hipPeekAtLastError();
    if (le != hipSuccess) fprintf(stderr, "kernel_launch: launch failed: %s\n", hipGetErrorName(le));
}
```

```cpp
#include <hip/hip_runtime.h>
#include <cstdio>
#include <cstdint>
namespace pg8 {
#define PG8_LAS __attribute__((address_space(3)))
typedef unsigned short bf16_t;
typedef short bf16x8 __attribute__((ext_vector_type(8)));
typedef float f32x4 __attribute__((ext_vector_type(4)));
typedef unsigned u32x4 __attribute__((ext_vector_type(4)));
constexpr int BM = 256, BK = 64, HALF = 128, HTB = HALF * BK * 2  , STAGE_BYTES = 8 * HTB, NXCD = 8, WGM = 8;

__host__ __device__ __forceinline__ int lds_byte(int r, int c) { const int st = (r >> 4) * 2 + (c >> 5), rr = r & 15, cc = c & 31, ob = rr * 64 + cc * 2; return st * 1024 + (ob ^ (((ob >> 9) & 1) << 5)); }
__host__ __device__ __forceinline__ void stage_rc(int b, int& R, int& C) { const int st = b / 1024, sb = b % 1024, swz = sb ^ (((sb >> 9) & 1) << 5); R = (st >> 1) * 16 + swz / 64; C = (st & 1) * 32 + (swz % 64) / 2; }
__host__ __device__ __forceinline__ int perm32(int rho) { const int n = rho >> 4, i = rho & 15; return 8 * (i >> 2) + 4 * n + (i & 3); }

struct Unit { int pm, pn; };
struct Gemm { const bf16_t* A; const bf16_t* Bt; int M, N, K; };

struct StaticOrder {
    int nM, nN, nwg, G, c;
    __host__ __device__ void init(int M, int N, int G_, int c_) { nM = M / BM; nN = N / BM; nwg = nM * nN; G = G_; c = c_; }
    __host__ __device__ bool next(int i, Unit& u) const {
        const long L = (long)i * G + c; if (L >= nwg) return false;
        int wgid = (int)L; { const int q = nwg / NXCD, r = nwg % NXCD, xcd = wgid % NXCD, off = wgid / NXCD; wgid = (xcd < r ? xcd * (q + 1) : r * (q + 1) + (xcd - r) * q) + off; }
        const int nig = WGM * nN, gid = wgid / nig, fm = gid * WGM, gsz = (nM - fm) < WGM ? (nM - fm) : WGM;
        u.pm = fm + ((wgid % nig) % gsz); u.pn = (wgid % nig) / gsz; return true;
    }
    __device__ __forceinline__ void a_ready(const Unit&) const {}
    __device__ __forceinline__ void done(const Unit&) const {}
};

__device__ __forceinline__ unsigned cvt_pk_bf16(float lo, float hi) { unsigned r; asm volatile("v_cvt_pk_bf16_f32 %0, %1, %2" : "=v"(r) : "v"(lo), "v"(hi)); return r; }
template <class Epi, class Sched, bool ALIGN_EPI = false, bool SP2 = false>
__device__ __forceinline__ void gemm_phase(PG8_LAS unsigned char* lds, const Gemm g, const Sched& S, const Epi& E) {
    const int tid = threadIdx.x, wid = __builtin_amdgcn_readfirstlane(tid >> 6), lane = tid & 63, wr = wid >> 2, wc = wid & 3, fr = lane & 15, fq = lane >> 4;
    const int K = g.K, nt = K / BK;
    unsigned voffA[2], voffB[2];
#pragma unroll
    for (int i = 0; i < 2; ++i) { int R, C; stage_rc(tid * 16 + i * 8192, R, C); const int Rb = Epi::PERM ? ((R & ~31) + perm32(R & 31)) : R;
        voffA[i] = (unsigned)(R * K + C) * 2u; voffB[i] = (unsigned)(Rb * K + C) * 2u; }
    const size_t kstep = (size_t)(BK * 2);
    const size_t hstep = (size_t)HALF * K * 2;
    const size_t tstep = 2 * hstep;
    const unsigned ldsw = (unsigned)wid * 1024u;
    const int aoff = lds_byte(wr * 64 + fr, fq * 8), boff = lds_byte(wc * 32 + fr, fq * 8);
#define PG8_SA(b, h) (((b) * 2 + (h)) * HTB)
#define PG8_SB(b, h) ((4 + (b) * 2 + (h)) * HTB)
#define PG8_STAGE(bufoff, gbase, voff) do { _Pragma("unroll") for (int _i = 0; _i < 2; ++_i) \
        __builtin_amdgcn_global_load_lds((const unsigned*)((const char*)(gbase) + (voff)[_i]), (PG8_LAS unsigned*)(lds + (bufoff) + ldsw + _i * 8192), 16, 0, 0); } while (0)
#define PG8_LDA(dst, b, h) do { _Pragma("unroll") for (int m = 0; m < 4; ++m) _Pragma("unroll") for (int k = 0; k < 2; ++k) dst[m][k] = *(const PG8_LAS bf16x8*)(lds + PG8_SA(b, h) + aoff + m * 2048 + k * 1024); } while (0)
#define PG8_LDB(dst, b, h) do { _Pragma("unroll") for (int n = 0; n < 2; ++n) _Pragma("unroll") for (int k = 0; k < 2; ++k) dst[n][k] = *(const PG8_LAS bf16x8*)(lds + PG8_SB(b, h) + boff + n * 2048 + k * 1024); } while (0)
#define PG8_MMA(ai, bj, At, Bt) do { __builtin_amdgcn_s_setprio(1); _Pragma("unroll") for (int m = 0; m < 4; ++m) _Pragma("unroll") for (int n = 0; n < 2; ++n) _Pragma("unroll") for (int k = 0; k < 2; ++k) \
        acc[ai][bj][m][n] = __builtin_amdgcn_mfma_f32_16x16x32_bf16(Bt[n][k], At[m][k], acc[ai][bj][m][n], 0, 0, 0); __builtin_amdgcn_s_setprio(0); } while (0)
#define PG8_WAIT_V(n) asm volatile("s_waitcnt vmcnt(" #n ")" ::: "memory")
#define PG8_WAIT_L(n) asm volatile("s_waitcnt lgkmcnt(" #n ")" ::: "memory")
#define PG8_BAR __builtin_amdgcn_s_barrier()
#define PG8_SCHED __builtin_amdgcn_sched_barrier(0)
    Unit cur, nxt; int ui = 0;
    if (!S.next(0, cur)) return;
    f32x4 acc[2][2][4][2];
#pragma unroll
    for (int a = 0; a < 2; ++a)
#pragma unroll
        for (int b = 0; b < 2; ++b)
#pragma unroll
            for (int m = 0; m < 4; ++m)
#pragma unroll
                for (int n = 0; n < 2; ++n) acc[a][b][m][n] = (f32x4){0.f, 0.f, 0.f, 0.f};
    bf16x8 At[4][2], B0[2][2], B1[2][2];
    const char* cA = (const char*)g.A + (size_t)cur.pm * tstep; const char* cB = (const char*)g.Bt + (size_t)cur.pn * tstep;
    S.a_ready(cur);
    if constexpr (SP2) {
        PG8_STAGE(PG8_SB(0, 0), cB, voffB); PG8_STAGE(PG8_SB(0, 1), cB + hstep, voffB); PG8_STAGE(PG8_SA(0, 0), cA, voffA); PG8_STAGE(PG8_SA(0, 1), cA + hstep, voffA);
        if (wr == 1) PG8_BAR;
        PG8_WAIT_V(2); PG8_BAR;
        PG8_STAGE(PG8_SB(1, 0), cB + kstep, voffB); PG8_STAGE(PG8_SA(1, 0), cA + kstep, voffA); PG8_STAGE(PG8_SB(1, 1), cB + hstep + kstep, voffB);
        PG8_WAIT_V(6); PG8_BAR;
    } else {
        PG8_STAGE(PG8_SB(0, 0), cB, voffB); PG8_STAGE(PG8_SA(0, 0), cA, voffA); PG8_STAGE(PG8_SB(0, 1), cB + hstep, voffB); PG8_STAGE(PG8_SA(0, 1), cA + hstep, voffA);
        if (wr == 1) PG8_BAR;
        PG8_WAIT_V(4); PG8_BAR;
        PG8_STAGE(PG8_SB(1, 0), cB + kstep, voffB); PG8_STAGE(PG8_SA(1, 0), cA + kstep, voffA); PG8_STAGE(PG8_SB(1, 1), cB + hstep + kstep, voffB);
        PG8_WAIT_V(6); PG8_BAR;
    }
    for (;;) {
        const bool has_next = S.next(ui + 1, nxt);
        const char* nA = has_next ? (const char*)g.A + (size_t)nxt.pm * tstep : cA; const char* nB = has_next ? (const char*)g.Bt + (size_t)nxt.pn * tstep : cB;
        for (int t = 0; t < nt; t += 2) {
            const bool last = (t == nt - 2);
            const char* a1 = cA + (size_t)(t + 1) * kstep;
            const char* a2 = last ? nA : cA + (size_t)(t + 2) * kstep; const char* b2 = last ? nB : cB + (size_t)(t + 2) * kstep;
            const char* a3 = a2 + kstep; const char* b3 = b2 + kstep;
            if (last && has_next) S.a_ready(nxt);
            if constexpr (SP2) {
            PG8_LDB(B0, 0, 0); PG8_LDB(B1, 0, 1); PG8_SCHED; PG8_LDA(At, 0, 0); PG8_STAGE(PG8_SA(1, 1), a1 + hstep, voffA);
            PG8_WAIT_V(8); PG8_WAIT_L(0); PG8_BAR; PG8_MMA(0, 0, At, B0); PG8_MMA(0, 1, At, B1); PG8_BAR; PG8_SCHED;
            PG8_LDA(At, 0, 1); PG8_STAGE(PG8_SB(0, 0), b2, voffB); PG8_STAGE(PG8_SB(0, 1), b2 + hstep, voffB); PG8_STAGE(PG8_SA(0, 0), a2, voffA);
            PG8_WAIT_V(8); PG8_WAIT_L(0); PG8_BAR; PG8_MMA(1, 0, At, B0); PG8_MMA(1, 1, At, B1); PG8_BAR; PG8_SCHED;
            PG8_LDB(B0, 1, 0); PG8_LDB(B1, 1, 1); PG8_SCHED; PG8_LDA(At, 1, 0); PG8_STAGE(PG8_SA(0, 1), a2 + hstep, voffA);
            PG8_WAIT_V(8); PG8_WAIT_L(0); PG8_BAR; PG8_MMA(0, 0, At, B0); PG8_MMA(0, 1, At, B1); PG8_BAR; PG8_SCHED;
            PG8_LDA(At, 1, 1); PG8_STAGE(PG8_SB(1, 0), b3, voffB); PG8_STAGE(PG8_SB(1, 1), b3 + hstep, voffB); PG8_STAGE(PG8_SA(1, 0), a3, voffA);
            PG8_WAIT_V(8); PG8_WAIT_L(0); PG8_BAR; PG8_MMA(1, 0, At, B0); PG8_MMA(1, 1, At, B1); PG8_BAR; PG8_SCHED;
            } else {
            PG8_LDB(B0, 0, 0); PG8_SCHED; PG8_LDA(At, 0, 0); PG8_STAGE(PG8_SA(1, 1), a1 + hstep, voffA);
            PG8_WAIT_L(8); PG8_BAR; PG8_WAIT_L(0); PG8_MMA(0, 0, At, B0); PG8_BAR; PG8_SCHED;
            PG8_LDB(B1, 0, 1); PG8_STAGE(PG8_SB(0, 0), b2, voffB);
            PG8_BAR; PG8_WAIT_L(0); PG8_MMA(0, 1, At, B1); PG8_BAR;
            PG8_LDA(At, 0, 1); PG8_STAGE(PG8_SA(0, 0), a2, voffA);
            PG8_BAR; PG8_WAIT_L(0); PG8_MMA(1, 0, At, B0); PG8_BAR; PG8_SCHED;
            PG8_STAGE(PG8_SB(0, 1), b2 + hstep, voffB);
            PG8_WAIT_V(6); PG8_BAR; PG8_MMA(1, 1, At, B1); PG8_BAR;
            PG8_LDB(B0, 1, 0); PG8_SCHED; PG8_LDA(At, 1, 0); PG8_STAGE(PG8_SA(0, 1), a2 + hstep, voffA);
            PG8_WAIT_L(8); PG8_BAR; PG8_WAIT_L(0); PG8_MMA(0, 0, At, B0); PG8_BAR; PG8_SCHED;
            PG8_LDB(B1, 1, 1); PG8_STAGE(PG8_SB(1, 0), b3, voffB);
            PG8_BAR; PG8_WAIT_L(0); PG8_MMA(0, 1, At, B1); PG8_BAR;
            PG8_LDA(At, 1, 1); PG8_STAGE(PG8_SA(1, 0), a3, voffA);
            PG8_BAR; PG8_WAIT_L(0); PG8_MMA(1, 0, At, B0); PG8_BAR; PG8_SCHED;
            PG8_STAGE(PG8_SB(1, 1), b3 + hstep, voffB);
            PG8_WAIT_V(6); PG8_BAR; PG8_MMA(1, 1, At, B1); PG8_BAR;
            }
        }
        if constexpr (ALIGN_EPI) { if (wr == 0) PG8_BAR; }
        if constexpr (!Epi::AFTER_DRAIN) { E(acc, cur, wr, wc, fr, fq); S.done(cur); }
        if (!has_next) break;
#pragma unroll
        for (int a = 0; a < 2; ++a)
#pragma unroll
            for (int b = 0; b < 2; ++b)
#pragma unroll
                for (int m = 0; m < 4; ++m)
#pragma unroll
                    for (int n = 0; n < 2; ++n) acc[a][b][m][n] = (f32x4){0.f, 0.f, 0.f, 0.f};
        cur = nxt; cA = nA; cB = nB; ++ui;
        if constexpr (ALIGN_EPI) { if (wr == 1) PG8_BAR; }
    }
    PG8_WAIT_V(0);
    if constexpr (!ALIGN_EPI) { if (wr == 0) PG8_BAR; }
    PG8_BAR;
    if constexpr (Epi::AFTER_DRAIN) { E.fused(acc, cur, wr, wc, fr, fq, lds, wid, lane); S.done(cur); }
#undef PG8_SA
#undef PG8_SB
#undef PG8_STAGE
#undef PG8_LDA
#undef PG8_LDB
#undef PG8_MMA
#undef PG8_WAIT_V
#undef PG8_WAIT_L
#undef PG8_BAR
#undef PG8_SCHED
}
}
#define XB_TMO      128
#define XB_XCNT(j)  (256  + 64 * (j))
#define XB_XSUB(j)  (1280 + 64 * (j))
#define XB_XGEN(j)  (2304 + 64 * (j))
#define XB_TOP      3328
#define XB_TOPGEN   3392
#define XCD_BAR_WORDS 3456
#define XB_SPIN_CAP (1u << 18)
#define LAS __attribute__((address_space(3)))

__device__ __forceinline__ unsigned xb_ld(unsigned* p)              { return __hip_atomic_load(p, __ATOMIC_RELAXED, __HIP_MEMORY_SCOPE_AGENT); }
__device__ __forceinline__ unsigned xb_add(unsigned* p, unsigned v) { return __hip_atomic_fetch_add(p, v, __ATOMIC_RELAXED, __HIP_MEMORY_SCOPE_AGENT); }
__device__ __forceinline__ unsigned xb_xcc_id() { return (unsigned)__builtin_amdgcn_s_getreg((3 << 11) | 20) & 0xFu; }
#define XB_SPIN(cond, bar) do { unsigned _sp = 0; while (cond) { __builtin_amdgcn_s_sleep(1); \
    if ((++_sp & 255u) == 0u) { if (xb_ld(&(bar)[XB_TMO])) break; if (_sp > XB_SPIN_CAP) { atomicAdd(&(bar)[XB_TMO], 1u); break; } } } } while (0)

struct XcdBarrier {
    unsigned* bar; unsigned x;
    volatile LAS unsigned* st;
};

__device__ __forceinline__ XcdBarrier xcd_barrier_post(unsigned* bar, volatile LAS unsigned* st) {
    XcdBarrier b; b.bar = bar; b.x = xb_xcc_id(); b.st = st;
    if (threadIdx.x == 0) (void)xb_add(&bar[XB_XCNT(b.x)], 1u);
    return b;
}
__device__ __forceinline__ void xcd_barrier_complete(unsigned* bar, unsigned x, unsigned& nloc, unsigned& nx) {
    const unsigned G = gridDim.x * gridDim.y * gridDim.z;
    unsigned sum, cnt, mine, sp = 0u;
    for (;;) {
        sum = 0u; cnt = 0u; mine = 0u;
#pragma unroll
        for (unsigned j = 0; j < 16; ++j) { const unsigned c = xb_ld(&bar[XB_XCNT(j)]); sum += c; cnt += (c > 0u) ? 1u : 0u; mine = (j == x) ? c : mine; }
        if (sum == G) break;
        __builtin_amdgcn_s_sleep(1);
        if ((++sp & 255u) == 0u) { if (xb_ld(&bar[XB_TMO])) break; if (sp > XB_SPIN_CAP) { atomicAdd(&bar[XB_TMO], 1u); break; } }
    }
    nloc = mine > 0u ? mine : 1u; nx = cnt > 0u ? cnt : 1u;
}

__device__ __forceinline__ void xcd_barrier(const XcdBarrier& b) {
    asm volatile("s_waitcnt vmcnt(0)" ::: "memory");
    __syncthreads();
    if (threadIdx.x == 0) {
        unsigned* bar = b.bar;
        __builtin_amdgcn_s_waitcnt(0);
        unsigned nloc = b.st[0], nx = b.st[1];
        if (nloc == 0u) { xcd_barrier_complete(bar, b.x, nloc, nx); b.st[0] = nloc; b.st[1] = nx; }
        const unsigned old = xb_add(&bar[XB_XSUB(b.x)], 1u);
        const unsigned gen = old / nloc;
        if (old + 1u == (gen + 1u) * nloc) {
            __builtin_amdgcn_fence(__ATOMIC_RELEASE, "agent");
            asm volatile("s_waitcnt vmcnt(0)" ::: "memory");
            const unsigned og = xb_add(&bar[XB_TOP], 1u);
            const unsigned tg = og / nx;
            if (og + 1u == (tg + 1u) * nx) xb_add(&bar[XB_TOPGEN], 1u);
            else XB_SPIN(xb_ld(&bar[XB_TOPGEN]) == tg, bar);
            __builtin_amdgcn_fence(__ATOMIC_ACQUIRE, "agent");
            xb_add(&bar[XB_XGEN(b.x)], 1u);
            asm volatile("s_waitcnt vmcnt(0)" ::: "memory");
        } else {
            XB_SPIN(xb_ld(&bar[XB_XGEN(b.x)]) == gen, bar);
            __builtin_amdgcn_fence(__ATOMIC_ACQUIRE, "agent");
            asm volatile("s_waitcnt vmcnt(0)" ::: "memory");
        }
    }
    __syncthreads();
}
constexpr int MP = 16384, MS = 32, MR = MP + MS, MPAD = 16640;
constexpr int SEQ = 2048, NB = 8, NH = 8, DM = 1024;
constexpr int QKVW = 3072, NIN = 7424;
constexpr int PAST = 16384, NPAGE = 128, PAGE = 128, LATW = 576;
constexpr float EPS = 1e-6f;
constexpr float MLA_SCALE = 0.07216878364870322f;

constexpr size_t O_YP = 0, O_YS = O_YP + (size_t)MP * 1024, O_ROWSP = O_YS + 32 * 1024, O_GSP = O_ROWSP + (size_t)MP * 576,
                 O_CSP = O_GSP + 8 * 8 * 128 * 128, O_ROWSS = O_CSP + 8 * 3 * 3072, O_GSS = O_ROWSS + 32 * 576, O_CSS = O_GSS + (size_t)32 * 8 * 128 * 128;

constexpr size_t WS_CTL = 0, CTL_BYTES = 1u << 20;
constexpr size_t WS_WIN = CTL_BYTES;
constexpr size_t WS_WQ  = WS_WIN + (size_t)NIN * 1024 * 2;
constexpr size_t WS_WKV = WS_WQ + (size_t)1536 * 512 * 2;
constexpr size_t WS_WYA = WS_WKV + (size_t)2048 * 512 * 2;
constexpr size_t WS_WYB = WS_WYA + (size_t)1024 * 1024 * 2;
constexpr size_t WS_WO  = WS_WYB + (size_t)1024 * 1024 * 2;
constexpr size_t WS_WUP = WS_WO + (size_t)1024 * 1024 * 2;
constexpr size_t WS_WDN = WS_WUP + (size_t)4096 * 1024 * 2;
constexpr size_t WS_XN  = WS_WDN + (size_t)4096 * 1024 * 2;
constexpr size_t WS_QKV = WS_XN + (size_t)MPAD * 1024 * 2;
constexpr size_t WS_Z   = WS_QKV + (size_t)MPAD * 3072 * 2;
constexpr size_t WS_QD  = WS_Z + (size_t)MPAD * 1024 * 2;
constexpr size_t WS_KVD = WS_QD + (size_t)MPAD * 512 * 2;
constexpr size_t WS_SM  = WS_KVD + (size_t)MPAD * 512 * 2;
constexpr size_t WS_GATES = WS_SM + (size_t)MPAD * 128 * 4;
constexpr size_t WS_C   = WS_GATES + (size_t)MPAD * 2048 * 2;
constexpr size_t WS_KR  = WS_C + (size_t)MPAD * 512 * 2;
constexpr size_t WS_BETA = WS_KR + (size_t)MPAD * 64 * 2;
constexpr size_t WS_GLOG = WS_BETA + (size_t)MPAD * 8 * 4;
constexpr size_t WS_QP  = WS_GLOG + (size_t)MPAD * 8 * 4;
constexpr size_t WS_QP2 = WS_QP + (size_t)MPAD * 1536 * 2;
constexpr size_t WS_KN  = WS_QP2 + (size_t)MPAD * 1536 * 2;
constexpr size_t WS_V   = WS_KN + (size_t)MPAD * 1024 * 2;
constexpr size_t WS_YA  = WS_V + (size_t)MPAD * 1024 * 2;
constexpr size_t WS_YB  = WS_YA + (size_t)MPAD * 1024 * 2;
constexpr size_t WS_TF  = WS_YB + (size_t)MPAD * 1024 * 2;
constexpr size_t WS_T   = WS_TF + (size_t)MPAD * 1024 * 4;
constexpr size_t WS_X1  = WS_T + (size_t)MPAD * 1024 * 2;
constexpr size_t WS_XN2 = WS_X1 + (size_t)MPAD * 1024 * 4;
constexpr size_t WS_H   = WS_XN2 + (size_t)MPAD * 1024 * 2;
constexpr size_t WS_GU0 = WS_H + (size_t)MPAD * 4096 * 2;
constexpr size_t WS_GW  = WS_GU0 + (size_t)2048 * 64 * 128 * 4;
constexpr size_t WS_GQG = WS_GW + (size_t)2048 * 64 * 128 * 2;
constexpr size_t WS_GKD = WS_GQG + (size_t)2048 * 64 * 128 * 2;
constexpr size_t WS_GAQK = WS_GKD + (size_t)2048 * 64 * 128 * 2;
constexpr size_t WS_GEND = WS_GAQK + (size_t)2048 * 64 * 64 * 2;
constexpr size_t WS_DML = WS_GEND + (size_t)2048 * 4 * 64;
constexpr size_t WS_DACC = WS_DML + (size_t)4096 * 8 * 2 * 4;
constexpr size_t WS_END = WS_DACC + (size_t)4096 * 8 * 512 * 4;

constexpr int LDS_BYTES = 163840;
constexpr int MISC_OFF = LDS_BYTES - 128;

#define GAS __attribute__((address_space(1)))
typedef unsigned short bf16;
typedef unsigned v4u __attribute__((ext_vector_type(4)));
typedef unsigned v2u __attribute__((ext_vector_type(2)));
typedef float f32x4 __attribute__((ext_vector_type(4)));
typedef float f32x16 __attribute__((ext_vector_type(16)));
typedef short bf16x8 __attribute__((ext_vector_type(8)));
#define LDS_WAIT() asm volatile("s_waitcnt lgkmcnt(0)" ::: "memory")
#define VM_WAIT() asm volatile("s_waitcnt vmcnt(0)" ::: "memory")
__device__ __forceinline__ float bf2f(unsigned b) { return __builtin_bit_cast(float, b << 16); }
__device__ __forceinline__ unsigned f2bf(float f) { unsigned u = __builtin_bit_cast(unsigned, f); return (u + 0x7fffu + ((u >> 16) & 1u)) >> 16; }
__device__ __forceinline__ unsigned pk2(float lo, float hi) { return f2bf(lo) | (f2bf(hi) << 16); }
__device__ __forceinline__ float lo16(unsigned w) { return __builtin_bit_cast(float, w << 16); }
__device__ __forceinline__ float hi16(unsigned w) { return __builtin_bit_cast(float, w & 0xffff0000u); }
__device__ __forceinline__ float wave_sum(float v) {
#pragma unroll
    for (int o = 1; o < 64; o <<= 1) v += __shfl_xor(v, o);
    return v;
}
__device__ __forceinline__ float wave_max(float v) {
#pragma unroll
    for (int o = 1; o < 64; o <<= 1) v = fmaxf(v, __shfl_xor(v, o));
    return v;
}
__device__ __forceinline__ float sigmoidf_(float x) { return 1.f / (1.f + __expf(-x)); }
__device__ __forceinline__ float siluf_(float x) { return x / (1.f + __expf(-x)); }

__constant__ float ROPE_INV[32] = {1.000000000e+00f,7.498942614e-01f,5.623413324e-01f,4.216965139e-01f,3.162277639e-01f,2.371373773e-01f,1.778279394e-01f,1.333521307e-01f,
    1.000000015e-01f,7.498941571e-02f,5.623413250e-02f,4.216965288e-02f,3.162277490e-02f,2.371373773e-02f,1.778279431e-02f,1.333521493e-02f,
    9.999999776e-03f,7.498941850e-03f,5.623413250e-03f,4.216964822e-03f,3.162277630e-03f,2.371373586e-03f,1.778279431e-03f,1.333521446e-03f,
    1.000000047e-03f,7.498942432e-04f,5.623413017e-04f,4.216965172e-04f,3.162277571e-04f,2.371373703e-04f,1.778279402e-04f,1.333521504e-04f};

struct Args { const float* in[27]; float* out; unsigned char* ws; int ph_lo, ph_hi; };
enum { I_XP = 0, I_XS, I_CACHE, I_SGDN, I_SCONV, I_PT, I_NMIX, I_WIN, I_CONVW, I_ALOG, I_DTB, I_GDNN, I_QAN, I_WUQ, I_KVAN, I_WUK, I_WUV,
       I_QNN, I_QNR, I_KNN, I_KNR, I_WYA, I_WYB, I_WO, I_NMLP, I_WUP, I_WDN };

__device__ __forceinline__ int src_col(int mode, int n) {
    if (mode == 0) {
        if (n < 4096) return n;
        if (n < 5184) return n + 16;
        if (n < 5200) return n - 5184 + 4096;
        if (n < 5376) return -1;
        return n - 5376 + 5200;
    }
    if (mode == 1) {
        if (n < 1024) return (n >> 7) * 192 + (n & 127);
        const int m = n - 1024; return (m >> 6) * 192 + 128 + (m & 63);
    }
    return n;
}
__device__ __forceinline__ void cvt_item(const float* W, int N, int K, bf16* WT, int row_off, int mode, LAS float* scr, int item, int nblk, int lane) {
    const int kb = item / nblk, nb = item % nblk, k0 = 64 * kb, n0 = 32 * nb;
    const int sc = src_col(mode, n0 + (lane & 31));
#pragma unroll 8
    for (int i = 0; i < 32; ++i) { const int kk = 2 * i + (lane >> 5); scr[kk * 33 + (lane & 31)] = sc >= 0 ? W[(size_t)(k0 + kk) * N + sc] : 0.f; }
    LDS_WAIT(); asm volatile("" ::: "memory");
    const int c = lane & 7;
#pragma unroll
    for (int j = 0; j < 4; ++j) { const int n = (lane >> 3) + 8 * j; const LAS float* s = scr + (8 * c) * 33 + n;
        v4u o; o.x = pk2(s[0 * 33], s[1 * 33]); o.y = pk2(s[2 * 33], s[3 * 33]); o.z = pk2(s[4 * 33], s[5 * 33]); o.w = pk2(s[6 * 33], s[7 * 33]);
        *(v4u*)(WT + (size_t)(row_off + n0 + n) * K + k0 + 8 * c) = o; }
    LDS_WAIT(); asm volatile("" ::: "memory");
}
__device__ __forceinline__ void rms_row_to_bf16(const float* xrow, const float* gain, bf16* orow, int lane) {
    const f32x4* xr = (const f32x4*)xrow + lane; const f32x4* gr = (const f32x4*)gain + lane;
    f32x4 v[4]; float s = 0.f;
#pragma unroll
    for (int j = 0; j < 4; ++j) { v[j] = xr[64 * j]; s += (v[j].x * v[j].x + v[j].y * v[j].y) + (v[j].z * v[j].z + v[j].w * v[j].w); }
    const float r = 1.f / sqrtf(wave_sum(s) * (1.f / 1024.f) + EPS);
    unsigned long long* o8 = (unsigned long long*)orow + lane;
#pragma unroll
    for (int j = 0; j < 4; ++j) { const f32x4 g = gr[64 * j];
        o8[64 * j] = (unsigned long long)pk2(v[j].x * r * g.x, v[j].y * r * g.y) | ((unsigned long long)pk2(v[j].z * r * g.z, v[j].w * r * g.w) << 32); }
}
__device__ __forceinline__ void p0_prologue(const Args& A, LAS unsigned char* lds, int gw, int NGW, int wave, int lane) {
    LAS float* scr = (LAS float*)(lds + wave * 16384);
    unsigned char* ws = A.ws;
    constexpr int I0 = 16 * (NIN / 32), I1 = 8 * (1536 / 32), I2 = 8 * 32, I3 = 8 * 32, I4 = 16 * 32, I5 = I4, I6 = I4, I7 = 16 * 128, I8 = 64 * 32;
    constexpr int NITEMS = I0 + I1 + I2 + I3 + I4 + I5 + I6 + I7 + I8;
    for (int it = gw; it < NITEMS; it += NGW) {
        int r = it;
        if (r < I0) { cvt_item(A.in[I_WIN], 7248, 1024, (bf16*)(ws + WS_WIN), 0, 0, scr, r, NIN / 32, lane); continue; } r -= I0;
        if (r < I1) { cvt_item(A.in[I_WUQ], 1536, 512, (bf16*)(ws + WS_WQ), 0, 1, scr, r, 1536 / 32, lane); continue; } r -= I1;
        if (r < I2) { cvt_item(A.in[I_WUK], 1024, 512, (bf16*)(ws + WS_WKV), 0, 2, scr, r, 32, lane); continue; } r -= I2;
        if (r < I3) { cvt_item(A.in[I_WUV], 1024, 512, (bf16*)(ws + WS_WKV), 1024, 2, scr, r, 32, lane); continue; } r -= I3;
        if (r < I4) { cvt_item(A.in[I_WYA], 1024, 1024, (bf16*)(ws + WS_WYA), 0, 2, scr, r, 32, lane); continue; } r -= I4;
        if (r < I5) { cvt_item(A.in[I_WYB], 1024, 1024, (bf16*)(ws + WS_WYB), 0, 2, scr, r, 32, lane); continue; } r -= I5;
        if (r < I6) { cvt_item(A.in[I_WO], 1024, 1024, (bf16*)(ws + WS_WO), 0, 2, scr, r, 32, lane); continue; } r -= I6;
        if (r < I7) { cvt_item(A.in[I_WUP], 4096, 1024, (bf16*)(ws + WS_WUP), 0, 2, scr, r, 128, lane); continue; } r -= I7;
        cvt_item(A.in[I_WDN], 1024, 4096, (bf16*)(ws + WS_WDN), 0, 2, scr, r, 32, lane);
    }
    bf16* XN = (bf16*)(ws + WS_XN);
    for (int m = gw; m < MPAD; m += NGW) {
        if (m < MR) rms_row_to_bf16(m < MP ? A.in[I_XP] + (size_t)m * 1024 : A.in[I_XS] + (size_t)(m - MP) * 1024, A.in[I_NMIX], XN + (size_t)m * 1024, lane);
        else { v4u z = {0u, 0u, 0u, 0u}; *((v4u*)(XN + (size_t)m * 1024) + lane) = z; *((v4u*)(XN + (size_t)m * 1024) + 64 + lane) = z; }
    }
}

struct EpiG1 {
    static constexpr bool PERM = true, AFTER_DRAIN = false;
    bf16 *QKV, *Z, *QD, *KVD, *GATES; float* SM;
    __device__ __forceinline__ void operator()(const pg8::f32x4 (&acc)[2][2][4][2], const pg8::Unit& u, int wr, int wc, int fr, int fq) const {
        const int row0 = u.pm * 256 + wr * 64 + fr, pn = u.pn, cl = wc * 32 + 8 * fq;
        if (pn == 20) {
#pragma unroll
            for (int ai = 0; ai < 2; ++ai)
#pragma unroll
                for (int m = 0; m < 4; ++m) { float* rowp = SM + (size_t)(row0 + ai * 128 + m * 16) * 128 + cl;
                    *(pg8::f32x4*)rowp = acc[ai][0][m][0]; *(pg8::f32x4*)(rowp + 4) = acc[ai][0][m][1]; }
            return;
        }
        bf16* base; int ld; bool sg = false;
        if (pn < 12) { base = QKV + pn * 256; ld = 3072; }
        else if (pn < 16) { base = Z + (pn - 12) * 256; ld = 1024; }
        else if (pn < 18) { base = QD + (pn - 16) * 256; ld = 512; }
        else if (pn < 20) { base = KVD + (pn - 18) * 256; ld = 512; }
        else { base = GATES + (pn - 21) * 256; ld = 2048; sg = true; }
#pragma unroll
        for (int ai = 0; ai < 2; ++ai)
#pragma unroll
            for (int m = 0; m < 4; ++m) { bf16* rowp = base + (size_t)(row0 + ai * 128 + m * 16) * ld + cl;
#pragma unroll
                for (int bj = 0; bj < 2; ++bj) { pg8::f32x4 v0 = acc[ai][bj][m][0], v1 = acc[ai][bj][m][1];
                    if (sg) { v0 = (pg8::f32x4){sigmoidf_(v0[0]), sigmoidf_(v0[1]), sigmoidf_(v0[2]), sigmoidf_(v0[3])}; v1 = (pg8::f32x4){sigmoidf_(v1[0]), sigmoidf_(v1[1]), sigmoidf_(v1[2]), sigmoidf_(v1[3])}; }
                    pg8::u32x4 w; w.x = pg8::cvt_pk_bf16(v0[0], v0[1]); w.y = pg8::cvt_pk_bf16(v0[2], v0[3]); w.z = pg8::cvt_pk_bf16(v1[0], v1[1]); w.w = pg8::cvt_pk_bf16(v1[2], v1[3]);
                    *(pg8::u32x4*)(rowp + bj * 128) = w; } }
    }
};

__device__ __forceinline__ void p2_rows(const Args& A, int gw, int NGW, int lane) {
    unsigned char* ws = A.ws;
    bf16* QD = (bf16*)(ws + WS_QD); const bf16* KVD = (const bf16*)(ws + WS_KVD); const float* SM = (const float*)(ws + WS_SM);
    bf16* C = (bf16*)(ws + WS_C); bf16* KR = (bf16*)(ws + WS_KR); float* BETA = (float*)(ws + WS_BETA); float* GLOG = (float*)(ws + WS_GLOG);
    for (int m = gw; m < MR; m += NGW) {
        const int pos = m < MP ? (m & (SEQ - 1)) : PAST;
        float* lat = m < MP ? A.out + O_ROWSP + (size_t)m * LATW : A.out + O_ROWSS + (size_t)(m - MP) * LATW;
        {
            v4u w = *((const v4u*)(QD + (size_t)m * 512) + lane);
            float v[8] = {lo16(w.x), hi16(w.x), lo16(w.y), hi16(w.y), lo16(w.z), hi16(w.z), lo16(w.w), hi16(w.w)};
            float s = 0.f;
#pragma unroll
            for (int i = 0; i < 8; ++i) s += v[i] * v[i];
            const float r = 1.f / sqrtf(wave_sum(s) * (1.f / 512.f) + EPS);
            const f32x4 g0 = *((const f32x4*)A.in[I_QAN] + 2 * lane), g1 = *((const f32x4*)A.in[I_QAN] + 2 * lane + 1);
            v4u o; o.x = pk2(v[0] * r * g0.x, v[1] * r * g0.y); o.y = pk2(v[2] * r * g0.z, v[3] * r * g0.w); o.z = pk2(v[4] * r * g1.x, v[5] * r * g1.y); o.w = pk2(v[6] * r * g1.z, v[7] * r * g1.w);
            *((v4u*)(QD + (size_t)m * 512) + lane) = o;
        }
        {
            v4u w = *((const v4u*)(KVD + (size_t)m * 512) + lane);
            float v[8] = {lo16(w.x), hi16(w.x), lo16(w.y), hi16(w.y), lo16(w.z), hi16(w.z), lo16(w.w), hi16(w.w)};
            float s = 0.f;
#pragma unroll
            for (int i = 0; i < 8; ++i) s += v[i] * v[i];
            const float r = 1.f / sqrtf(wave_sum(s) * (1.f / 512.f) + EPS);
            const f32x4 g0 = *((const f32x4*)A.in[I_KVAN] + 2 * lane), g1 = *((const f32x4*)A.in[I_KVAN] + 2 * lane + 1);
            f32x4 c0 = {v[0] * r * g0.x, v[1] * r * g0.y, v[2] * r * g0.z, v[3] * r * g0.w}, c1 = {v[4] * r * g1.x, v[5] * r * g1.y, v[6] * r * g1.z, v[7] * r * g1.w};
            *((f32x4*)lat + 2 * lane) = c0; *((f32x4*)lat + 2 * lane + 1) = c1;
            v4u o; o.x = pk2(c0.x, c0.y); o.y = pk2(c0.z, c0.w); o.z = pk2(c1.x, c1.y); o.w = pk2(c1.z, c1.w);
            *((v4u*)(C + (size_t)m * 512) + lane) = o;
        }
        {
            const float x = SM[(size_t)m * 128 + lane];
            const float r = 1.f / sqrtf(wave_sum(x * x) * (1.f / 64.f) + EPS);
            const float xr = x * r * A.in[I_KNR][lane];
            const float other = __shfl_xor(xr, 32);
            const float ang = (float)pos * ROPE_INV[lane & 31];
            const float cs = cosf(ang), sn = sinf(ang);
            const float o = lane < 32 ? xr * cs - other * sn : other * sn + xr * cs;
            lat[512 + lane] = o;
            KR[(size_t)m * 64 + lane] = (bf16)f2bf(o);
        }
        if (lane < 8) {
            const float b = SM[(size_t)m * 128 + 64 + lane], a = SM[(size_t)m * 128 + 72 + lane];
            BETA[(size_t)m * 8 + lane] = 1.f / (1.f + expf(-b));
            const float xx = a + A.in[I_DTB][lane];
            const float sp = fmaxf(xx, 0.f) + log1pf(expf(-fabsf(xx)));
            GLOG[(size_t)m * 8 + lane] = -expf(A.in[I_ALOG][lane]) * sp;
        }
    }
}
__device__ __forceinline__ void p2_conv_state(const Args& A, int gtid, int NGT) {
    const bf16* QKV = (const bf16*)(A.ws + WS_QKV);
    for (int i = gtid; i < 8 * 3 * 3072; i += NGT) { const int c = i % 3072, r = (i / 3072) % 3, b = i / (3 * 3072);
        A.out[O_CSP + i] = bf2f(QKV[(size_t)(b * SEQ + SEQ - 3 + r) * 3072 + c]); }
    for (int i = gtid; i < 32 * 3 * 3072; i += NGT) { const int c = i % 3072, r = (i / 3072) % 3, j = i / (3 * 3072);
        A.out[O_CSS + i] = r < 2 ? A.in[I_SCONV][(size_t)(j * 3 + r + 1) * 3072 + c] : bf2f(QKV[(size_t)(MP + j) * 3072 + c]); }
}
__device__ __forceinline__ pg8::u32x4 pack8(const pg8::f32x4& v0, const pg8::f32x4& v1) {
    pg8::u32x4 w; w.x = pg8::cvt_pk_bf16(v0[0], v0[1]); w.y = pg8::cvt_pk_bf16(v0[2], v0[3]); w.z = pg8::cvt_pk_bf16(v1[0], v1[1]); w.w = pg8::cvt_pk_bf16(v1[2], v1[3]); return w;
}
template <int ACT> struct EpiStore {
    static constexpr bool PERM = true, AFTER_DRAIN = false;
    bf16* O0; int ld0; int split; bf16* O1; int ld1;
    __device__ __forceinline__ void operator()(const pg8::f32x4 (&acc)[2][2][4][2], const pg8::Unit& u, int wr, int wc, int fr, int fq) const {
        const int row0 = u.pm * 256 + wr * 64 + fr, cl = wc * 32 + 8 * fq;
        bf16* base; int ld;
        if (u.pn < split) { base = O0 + u.pn * 256; ld = ld0; } else { base = O1 + (u.pn - split) * 256; ld = ld1; }
#pragma unroll
        for (int ai = 0; ai < 2; ++ai)
#pragma unroll
            for (int m = 0; m < 4; ++m) { bf16* rowp = base + (size_t)(row0 + ai * 128 + m * 16) * ld + cl;
#pragma unroll
                for (int bj = 0; bj < 2; ++bj) { pg8::f32x4 v0 = acc[ai][bj][m][0], v1 = acc[ai][bj][m][1];
                    if (ACT == 1) {
#pragma unroll
                        for (int e = 0; e < 4; ++e) { const float a = fmaxf(v0[e], 0.f), b = fmaxf(v1[e], 0.f); v0[e] = a * a; v1[e] = b * b; } }
                    *(pg8::u32x4*)(rowp + bj * 128) = pack8(v0, v1); } }
    }
};
template <int STEP> struct EpiMerge {
    static constexpr bool PERM = true, AFTER_DRAIN = false;
    const bf16* GATES; float* TF; bf16* T;
    __device__ __forceinline__ void operator()(const pg8::f32x4 (&acc)[2][2][4][2], const pg8::Unit& u, int wr, int wc, int fr, int fq) const {
        const int row0 = u.pm * 256 + wr * 64 + fr, c0 = u.pn * 256 + wc * 32 + 8 * fq;
#pragma unroll
        for (int ai = 0; ai < 2; ++ai)
#pragma unroll
            for (int m = 0; m < 4; ++m) { const size_t row = (size_t)(row0 + ai * 128 + m * 16);
#pragma unroll
                for (int bj = 0; bj < 2; ++bj) { const int col = c0 + bj * 128;
                    const v4u gw = *(const v4u*)(GATES + row * 2048 + (STEP == 1 ? 0 : 1024) + col);
                    const float g[8] = {lo16(gw.x), hi16(gw.x), lo16(gw.y), hi16(gw.y), lo16(gw.z), hi16(gw.z), lo16(gw.w), hi16(gw.w)};
                    pg8::f32x4 v0 = acc[ai][bj][m][0], v1 = acc[ai][bj][m][1];
#pragma unroll
                    for (int e = 0; e < 4; ++e) { v0[e] *= g[e]; v1[e] *= g[4 + e]; }
                    float* tp = TF + row * 1024 + col;
                    if (STEP == 1) { *(pg8::f32x4*)tp = v0; *(pg8::f32x4*)(tp + 4) = v1; }
                    else { v0 += *(const pg8::f32x4*)tp; v1 += *(const pg8::f32x4*)(tp + 4); *(pg8::u32x4*)(T + row * 1024 + col) = pack8(v0, v1); } } }
    }
};
template <int MODE> struct EpiRes {
    static constexpr bool PERM = true, AFTER_DRAIN = false;
    const float *XPp, *XSp; float* X1; float* out;
    __device__ __forceinline__ void operator()(const pg8::f32x4 (&acc)[2][2][4][2], const pg8::Unit& u, int wr, int wc, int fr, int fq) const {
        const int row0 = u.pm * 256 + wr * 64 + fr, c0 = u.pn * 256 + wc * 32 + 8 * fq;
#pragma unroll
        for (int ai = 0; ai < 2; ++ai)
#pragma unroll
            for (int m = 0; m < 4; ++m) { const int row = row0 + ai * 128 + m * 16;
                if (row >= MR) continue;
#pragma unroll
                for (int bj = 0; bj < 2; ++bj) { const int col = c0 + bj * 128;
                    const float* src; float* dst;
                    if (MODE == 0) { src = row < MP ? XPp + (size_t)row * 1024 + col : XSp + (size_t)(row - MP) * 1024 + col; dst = X1 + (size_t)row * 1024 + col; }
                    else { src = X1 + (size_t)row * 1024 + col; dst = row < MP ? out + O_YP + (size_t)row * 1024 + col : out + O_YS + (size_t)(row - MP) * 1024 + col; }
                    *(pg8::f32x4*)dst = acc[ai][bj][m][0] + *(const pg8::f32x4*)src; *(pg8::f32x4*)(dst + 4) = acc[ai][bj][m][1] + *(const pg8::f32x4*)(src + 4); } }
    }
};

#define MFMA32(a, b, c) __builtin_amdgcn_mfma_f32_32x32x16_bf16((a), (b), (c), 0, 0, 0)
__device__ __forceinline__ int crow(int r, int hi) { return (r & 3) + 8 * (r >> 2) + 4 * hi; }
__device__ __forceinline__ bf16x8 lds_ld8(LAS const unsigned char* p) { return *(LAS const bf16x8*)p; }
__device__ __forceinline__ bf16x8 gl_ld8(const bf16* p) { return *(const bf16x8*)p; }

constexpr int GA_QH = 0, GA_KH = 17408, GA_KBH = 34816, GA_VBT = 52224, GA_KBGT = 70656, GA_KDT = 89088, GA_LF = 107520, GA_TB = 123904, GA_GS = 133120, GA_BS = 133376;
__device__ __forceinline__ void gdn_a_unit(const Args& A, LAS unsigned char* lds, int unit, int tid, int lane, int wave) {
    unsigned char* ws = A.ws;
    const int b = unit >> 8, h = (unit >> 5) & 7, n = unit & 31;
    const int row0 = b * SEQ + n * 64;
    const bf16* QKV = (const bf16*)(ws + WS_QKV);
    LAS float* Gs = (LAS float*)(lds + GA_GS); LAS float* Bs = (LAS float*)(lds + GA_BS);
    if (wave == 0) {
        float x = ((const float*)(ws + WS_GLOG))[(size_t)(row0 + lane) * 8 + h];
#pragma unroll
        for (int o = 1; o < 64; o <<= 1) { const float y = __shfl_up(x, o); if (lane >= o) x += y; }
        Gs[lane] = x; Bs[lane] = ((const float*)(ws + WS_BETA))[(size_t)(row0 + lane) * 8 + h];
    }
    __syncthreads();
    const float Gend = Gs[63];
    {
        const int cg = tid & 15, rr = tid >> 4;
        bf16* GQG = (bf16*)(ws + WS_GQG) + (size_t)unit * 8192;
#pragma unroll 1
        for (int part = 0; part < 3; ++part) {
            const int colb = part * 1024 + h * 128 + 8 * cg;
            float wgt[4][8];
#pragma unroll
            for (int tap = 0; tap < 4; ++tap) { const f32x4 w0 = *(const f32x4*)(A.in[I_CONVW] + tap * 3072 + colb), w1 = *(const f32x4*)(A.in[I_CONVW] + tap * 3072 + colb + 4);
                wgt[tap][0] = w0.x; wgt[tap][1] = w0.y; wgt[tap][2] = w0.z; wgt[tap][3] = w0.w; wgt[tap][4] = w1.x; wgt[tap][5] = w1.y; wgt[tap][6] = w1.z; wgt[tap][7] = w1.w; }
#pragma unroll
            for (int ri = 0; ri < 2; ++ri) {
                const int i = rr + 32 * ri, tl = n * 64 + i;
                float y[8];
#pragma unroll
                for (int e = 0; e < 8; ++e) y[e] = 0.f;
#pragma unroll
                for (int tap = 0; tap < 4; ++tap) { const int tt = tl - 3 + tap;
                    if (tt >= 0) { const v4u w = *(const v4u*)(QKV + (size_t)(b * SEQ + tt) * 3072 + colb);
                        const float x[8] = {lo16(w.x), hi16(w.x), lo16(w.y), hi16(w.y), lo16(w.z), hi16(w.z), lo16(w.w), hi16(w.w)};
#pragma unroll
                        for (int e = 0; e < 8; ++e) y[e] += wgt[tap][e] * x[e]; } }
                float ss = 0.f;
#pragma unroll
                for (int e = 0; e < 8; ++e) { y[e] = siluf_(y[e]); ss += y[e] * y[e]; }
                ss += __shfl_xor(ss, 1); ss += __shfl_xor(ss, 2); ss += __shfl_xor(ss, 4); ss += __shfl_xor(ss, 8);
                const float rs = 1.f / sqrtf(ss + EPS), beta = Bs[i], eg = __expf(Gs[i]), ed = __expf(Gend - Gs[i]);
                if (part == 0) {
                    float q[8];
#pragma unroll
                    for (int e = 0; e < 8; ++e) q[e] = y[e] * rs * 0.08838834764831845f;
                    v4u o; o.x = pk2(q[0], q[1]); o.y = pk2(q[2], q[3]); o.z = pk2(q[4], q[5]); o.w = pk2(q[6], q[7]);
                    *(LAS v4u*)(lds + GA_QH + i * 272 + cg * 16) = o;
                    v4u g; g.x = pk2(q[0] * eg, q[1] * eg); g.y = pk2(q[2] * eg, q[3] * eg); g.z = pk2(q[4] * eg, q[5] * eg); g.w = pk2(q[6] * eg, q[7] * eg);
                    *(v4u*)(GQG + i * 128 + 8 * cg) = g;
                } else if (part == 1) {
                    float k[8];
#pragma unroll
                    for (int e = 0; e < 8; ++e) k[e] = y[e] * rs;
                    v4u o; o.x = pk2(k[0], k[1]); o.y = pk2(k[2], k[3]); o.z = pk2(k[4], k[5]); o.w = pk2(k[6], k[7]);
                    *(LAS v4u*)(lds + GA_KH + i * 272 + cg * 16) = o;
                    v4u kb; kb.x = pk2(k[0] * beta, k[1] * beta); kb.y = pk2(k[2] * beta, k[3] * beta); kb.z = pk2(k[4] * beta, k[5] * beta); kb.w = pk2(k[6] * beta, k[7] * beta);
                    *(LAS v4u*)(lds + GA_KBH + i * 272 + cg * 16) = kb;
#pragma unroll
                    for (int e = 0; e < 8; ++e) { *(LAS bf16*)(lds + GA_KBGT + (8 * cg + e) * 144 + i * 2) = (bf16)f2bf(k[e] * beta * eg);
                        *(LAS bf16*)(lds + GA_KDT + (8 * cg + e) * 144 + i * 2) = (bf16)f2bf(k[e] * ed); }
                } else {
#pragma unroll
                    for (int e = 0; e < 8; ++e) *(LAS bf16*)(lds + GA_VBT + (8 * cg + e) * 144 + i * 2) = (bf16)f2bf(y[e] * beta);
                }
            }
        }
    }
    __syncthreads();
    const int l31 = lane & 31, hi = lane >> 5;
    {
        const int it = (wave >> 1) & 1, jt = wave & 1; const bool isL = wave < 4;
        f32x16 acc = {};
        if (it >= jt) {
            LAS const unsigned char* Ab = lds + (isL ? GA_KBH : GA_QH) + (32 * it + l31) * 272 + hi * 16;
            LAS const unsigned char* Bb = lds + GA_KH + (32 * jt + l31) * 272 + hi * 16;
#pragma unroll
            for (int ks = 0; ks < 8; ++ks) acc = MFMA32(lds_ld8(Ab + ks * 32), lds_ld8(Bb + ks * 32), acc);
        }
        const int j = 32 * jt + l31; const float Gj = Gs[j];
        bf16* AQ = (bf16*)(ws + WS_GAQK) + (size_t)unit * 4096;
#pragma unroll
        for (int r = 0; r < 16; ++r) { const int i = 32 * it + crow(r, hi);
            const float d = __expf(fminf(Gs[i] - Gj, 0.f));
            if (isL) ((LAS float*)(lds + GA_LF))[i * 64 + j] = (i > j) ? acc[r] * d : 0.f;
            else AQ[i * 64 + j] = (bf16)f2bf((i >= j) ? acc[r] * d : 0.f); }
    }
    __syncthreads();
    if (wave == 0) {
        float T[64];
        LAS const float* Lf = (LAS const float*)(lds + GA_LF);
#pragma unroll
        for (int i = 0; i < 64; ++i) {
            float a = (i == lane) ? 1.f : 0.f;
#pragma unroll
            for (int j4 = 0; j4 < (i + 3) / 4; ++j4) { const f32x4 l4 = *(LAS const f32x4*)(Lf + i * 64 + 4 * j4);
                if (4 * j4 + 0 < i) a -= l4.x * T[4 * j4 + 0];
                if (4 * j4 + 1 < i) a -= l4.y * T[4 * j4 + 1];
                if (4 * j4 + 2 < i) a -= l4.z * T[4 * j4 + 2];
                if (4 * j4 + 3 < i) a -= l4.w * T[4 * j4 + 3]; }
            T[i] = a;
            *(LAS bf16*)(lds + GA_TB + i * 144 + lane * 2) = (bf16)f2bf(a);
        }
    } else {
        bf16* GKD = (bf16*)(ws + WS_GKD) + (size_t)unit * 8192;
        for (int id = tid - 64; id < 1024; id += 448) { const int row = id >> 3, ch = id & 7;
            *(v4u*)(GKD + row * 64 + ch * 8) = *(LAS const v4u*)(lds + GA_KDT + row * 144 + ch * 16); }
    }
    __syncthreads();
    {
        const int nt = wave; LAS const unsigned char* Bb = lds + (nt < 4 ? GA_VBT : GA_KBGT) + (32 * (nt & 3) + l31) * 144 + hi * 16;
        float* GU0 = (float*)(ws + WS_GU0) + (size_t)unit * 8192; bf16* GW = (bf16*)(ws + WS_GW) + (size_t)unit * 8192;
#pragma unroll
        for (int it = 0; it < 2; ++it) {
            f32x16 acc = {};
            LAS const unsigned char* Ab = lds + GA_TB + (32 * it + l31) * 144 + hi * 16;
#pragma unroll
            for (int ks = 0; ks < 4; ++ks) if (ks < 2 * (it + 1)) acc = MFMA32(lds_ld8(Ab + ks * 32), lds_ld8(Bb + ks * 32), acc);
            const int col = 32 * (nt & 3) + l31;
#pragma unroll
            for (int r = 0; r < 16; ++r) { const int i = 32 * it + crow(r, hi);
                if (nt < 4) GU0[i * 128 + col] = acc[r]; else GW[i * 128 + col] = (bf16)f2bf(acc[r]); }
        }
        if (tid == 0) ((float*)(ws + WS_GEND))[unit] = __expf(Gend);
    }
    __syncthreads();
}

constexpr int GB_ST = 0, GB_UT = 34816, GB_OF = 53248;
__device__ __forceinline__ void gdn_b_unit(const Args& A, LAS unsigned char* lds, int bh, int tid, int lane, int wave) {
    unsigned char* ws = A.ws;
    const int b = bh >> 3, h = bh & 7, l31 = lane & 31, hi = lane >> 5;
    const int it = wave >> 2, vt = wave & 3;
    for (int i = tid; i < 34816 / 16; i += 512) *(LAS v4u*)(lds + GB_ST + i * 16) = (v4u){0u, 0u, 0u, 0u};
    f32x16 Sacc[2] = {};
    __syncthreads();
    const bf16* Zb = (const bf16*)(ws + WS_Z); bf16* YA = (bf16*)(ws + WS_YA);
    LAS const unsigned char* Sb = lds + GB_ST + (32 * vt + l31) * 272 + hi * 16;
    LAS const unsigned char* Ub = lds + GB_UT + (32 * vt + l31) * 144 + hi * 16;
#pragma unroll 1
    for (int n = 0; n < 32; ++n) {
        const int cu = bh * 32 + n, r0 = b * SEQ + 64 * n;
        const bf16* GW = (const bf16*)(ws + WS_GW) + (size_t)cu * 8192; const bf16* GQG = (const bf16*)(ws + WS_GQG) + (size_t)cu * 8192;
        const bf16* GKD = (const bf16*)(ws + WS_GKD) + (size_t)cu * 8192; const bf16* GAQ = (const bf16*)(ws + WS_GAQK) + (size_t)cu * 4096;
        const float* GU0 = (const float*)(ws + WS_GU0) + (size_t)cu * 8192; const float gend = ((const float*)(ws + WS_GEND))[cu];
        {
            f32x16 acc = {};
            const bf16* Ab = GW + (32 * it + l31) * 128 + 8 * hi;
#pragma unroll
            for (int ks = 0; ks < 8; ++ks) acc = MFMA32(gl_ld8(Ab + 16 * ks), lds_ld8(Sb + ks * 32), acc);
            float u[16];
#pragma unroll
            for (int r = 0; r < 16; ++r) u[r] = GU0[(32 * it + crow(r, hi)) * 128 + 32 * vt + l31] - acc[r];
#pragma unroll
            for (int g = 0; g < 4; ++g) { v2u w; w.x = pk2(u[4 * g], u[4 * g + 1]); w.y = pk2(u[4 * g + 2], u[4 * g + 3]);
                *(LAS v2u*)(lds + GB_UT + (32 * vt + l31) * 144 + (32 * it + 8 * g + 4 * hi) * 2) = w; }
        }
        __syncthreads();
        {
            f32x16 acc = {};
            const bf16* Ab = GQG + (32 * it + l31) * 128 + 8 * hi;
#pragma unroll
            for (int ks = 0; ks < 8; ++ks) acc = MFMA32(gl_ld8(Ab + 16 * ks), lds_ld8(Sb + ks * 32), acc);
            const bf16* Cb = GAQ + (32 * it + l31) * 64 + 8 * hi;
#pragma unroll
            for (int ks = 0; ks < 4; ++ks) if (ks < 2 * (it + 1)) acc = MFMA32(gl_ld8(Cb + 16 * ks), lds_ld8(Ub + ks * 32), acc);
#pragma unroll
            for (int r = 0; r < 16; ++r) ((LAS float*)(lds + GB_OF))[(32 * it + crow(r, hi)) * 132 + 32 * vt + l31] = acc[r];
        }
        __syncthreads();
        {
#pragma unroll
            for (int t = 0; t < 2; ++t) { const int kt = 2 * (wave >> 2) + t;
                Sacc[t] = Sacc[t] * gend;
                const bf16* Ab = GKD + (32 * kt + l31) * 64 + 8 * hi;
#pragma unroll
                for (int ks = 0; ks < 4; ++ks) Sacc[t] = MFMA32(gl_ld8(Ab + 16 * ks), lds_ld8(Ub + ks * 32), Sacc[t]);
#pragma unroll
                for (int g = 0; g < 4; ++g) { v2u w; w.x = pk2(Sacc[t][4 * g], Sacc[t][4 * g + 1]); w.y = pk2(Sacc[t][4 * g + 2], Sacc[t][4 * g + 3]);
                    *(LAS v2u*)(lds + GB_ST + (32 * vt + l31) * 272 + (32 * kt + 8 * g + 4 * hi) * 2) = w; }
            }
        }
        {
            const int i = tid >> 3, c0 = (tid & 7) * 16;
            LAS const float* orow = (LAS const float*)(lds + GB_OF) + i * 132 + c0;
            float o[16]; float ss = 0.f;
#pragma unroll
            for (int q = 0; q < 4; ++q) { const f32x4 v = *(LAS const f32x4*)(orow + 4 * q); o[4 * q] = v.x; o[4 * q + 1] = v.y; o[4 * q + 2] = v.z; o[4 * q + 3] = v.w; }
#pragma unroll
            for (int e = 0; e < 16; ++e) ss += o[e] * o[e];
            ss += __shfl_xor(ss, 1); ss += __shfl_xor(ss, 2); ss += __shfl_xor(ss, 4);
            const float r = 1.f / sqrtf(ss * (1.f / 128.f) + EPS);
            const size_t off = (size_t)(r0 + i) * 1024 + h * 128 + c0;
            const v4u z0 = *(const v4u*)(Zb + off), z1 = *(const v4u*)(Zb + off + 8);
            const float z[16] = {lo16(z0.x), hi16(z0.x), lo16(z0.y), hi16(z0.y), lo16(z0.z), hi16(z0.z), lo16(z0.w), hi16(z0.w),
                                 lo16(z1.x), hi16(z1.x), lo16(z1.y), hi16(z1.y), lo16(z1.z), hi16(z1.z), lo16(z1.w), hi16(z1.w)};
            float y[16];
#pragma unroll
            for (int e = 0; e < 16; ++e) y[e] = o[e] * r * A.in[I_GDNN][c0 + e] * siluf_(z[e]);
            v4u o0, o1; o0.x = pk2(y[0], y[1]); o0.y = pk2(y[2], y[3]); o0.z = pk2(y[4], y[5]); o0.w = pk2(y[6], y[7]);
            o1.x = pk2(y[8], y[9]); o1.y = pk2(y[10], y[11]); o1.z = pk2(y[12], y[13]); o1.w = pk2(y[14], y[15]);
            *(v4u*)(YA + off) = o0; *(v4u*)(YA + off + 8) = o1;
        }
        __syncthreads();
    }
    float* So = A.out + O_GSP + (size_t)bh * 16384;
#pragma unroll
    for (int t = 0; t < 2; ++t) { const int kt = 2 * (wave >> 2) + t;
#pragma unroll
        for (int r = 0; r < 16; ++r) So[(32 * kt + crow(r, hi)) * 128 + 32 * vt + l31] = Sacc[t][r]; }
    __syncthreads();
}

__device__ __forceinline__ void gdn_r_unit(const Args& A, LAS unsigned char* lds, int unit, int tid, int lane, int wave) {
    unsigned char* ws = A.ws;
    const int j = unit >> 3, h = unit & 7, row = MP + j;
    LAS float* qs = (LAS float*)lds; LAS float* ks = qs + 128; LAS float* vs = qs + 256; LAS float* red = qs + 384;
    LAS float* os = qs + 896;
    if (tid < 384) {
        const int part = tid >> 7, d = tid & 127, col = part * 1024 + h * 128 + d;
        const float* cw = A.in[I_CONVW]; const float* sc = A.in[I_SCONV] + (size_t)j * 3 * 3072;
        const float xn = bf2f(((const bf16*)(ws + WS_QKV))[(size_t)row * 3072 + col]);
        const float y = cw[col] * sc[col] + cw[3072 + col] * sc[3072 + col] + cw[2 * 3072 + col] * sc[2 * 3072 + col] + cw[3 * 3072 + col] * xn;
        qs[tid] = siluf_(y);
    }
    __syncthreads();
    const float rq = 1.f / sqrtf(wave_sum(qs[lane] * qs[lane] + qs[lane + 64] * qs[lane + 64]) + EPS) * 0.08838834764831845f;
    const float rk = 1.f / sqrtf(wave_sum(ks[lane] * ks[lane] + ks[lane + 64] * ks[lane + 64]) + EPS);
    const float beta = ((const float*)(ws + WS_BETA))[(size_t)row * 8 + h], eg = __expf(((const float*)(ws + WS_GLOG))[(size_t)row * 8 + h]);
    const int v = tid & 127, kq = tid >> 7;
    const float* S0 = A.in[I_SGDN] + (size_t)unit * 16384;
    float s[32]; float kv = 0.f;
#pragma unroll
    for (int i = 0; i < 32; ++i) { const int k = 32 * kq + i; s[i] = eg * S0[k * 128 + v]; kv += ks[k] * rk * s[i]; }
    red[kq * 128 + v] = kv;
    __syncthreads();
    const float u = beta * (vs[v] - (red[v] + red[128 + v] + red[256 + v] + red[384 + v]));
    __syncthreads();
    float* So = A.out + O_GSS + (size_t)unit * 16384; float po = 0.f;
#pragma unroll
    for (int i = 0; i < 32; ++i) { const int k = 32 * kq + i; s[i] += ks[k] * rk * u; So[k * 128 + v] = s[i]; po += qs[k] * rq * s[i]; }
    red[kq * 128 + v] = po;
    __syncthreads();
    if (tid < 128) os[tid] = red[tid] + red[128 + tid] + red[256 + tid] + red[384 + tid];
    __syncthreads();
    const float rn = 1.f / sqrtf(wave_sum(os[lane] * os[lane] + os[lane + 64] * os[lane + 64]) * (1.f / 128.f) + EPS);
    if (tid < 128) { const size_t off = (size_t)row * 1024 + h * 128 + tid;
        ((bf16*)(ws + WS_YA))[off] = (bf16)f2bf(os[tid] * rn * A.in[I_GDNN][tid] * siluf_(bf2f(((const bf16*)(ws + WS_Z))[off]))); }
    __syncthreads();
}

__device__ __forceinline__ void p4_rows(const Args& A, int gw, int NGW, int lane) {
    unsigned char* ws = A.ws;
    const bf16* QP = (const bf16*)(ws + WS_QP); bf16* QP2 = (bf16*)(ws + WS_QP2); bf16* KN = (bf16*)(ws + WS_KN);
    const int hh = lane >> 3, l7 = lane & 7;
    for (int m = gw; m < MR; m += NGW) {
        const int pos = m < MP ? (m & (SEQ - 1)) : PAST;
#pragma unroll
        for (int which = 0; which < 2; ++which) {
            const bf16* src = which == 0 ? QP + (size_t)m * 1536 + 16 * lane : KN + (size_t)m * 1024 + 16 * lane;
            const float* gain = (which == 0 ? A.in[I_QNN] : A.in[I_KNN]) + 16 * l7;
            const v4u w0 = *(const v4u*)src, w1 = *(const v4u*)(src + 8);
            float v[16] = {lo16(w0.x), hi16(w0.x), lo16(w0.y), hi16(w0.y), lo16(w0.z), hi16(w0.z), lo16(w0.w), hi16(w0.w),
                           lo16(w1.x), hi16(w1.x), lo16(w1.y), hi16(w1.y), lo16(w1.z), hi16(w1.z), lo16(w1.w), hi16(w1.w)};
            float ss = 0.f;
#pragma unroll
            for (int e = 0; e < 16; ++e) ss += v[e] * v[e];
            ss += __shfl_xor(ss, 1); ss += __shfl_xor(ss, 2); ss += __shfl_xor(ss, 4);
            const float r = 1.f / sqrtf(ss * (1.f / 128.f) + EPS);
#pragma unroll
            for (int e = 0; e < 16; ++e) v[e] = v[e] * r * gain[e];
            v4u o0, o1; o0.x = pk2(v[0], v[1]); o0.y = pk2(v[2], v[3]); o0.z = pk2(v[4], v[5]); o0.w = pk2(v[6], v[7]);
            o1.x = pk2(v[8], v[9]); o1.y = pk2(v[10], v[11]); o1.z = pk2(v[12], v[13]); o1.w = pk2(v[14], v[15]);
            bf16* dst = which == 0 ? QP2 + (size_t)m * 1536 + hh * 192 + 16 * l7 : KN + (size_t)m * 1024 + 16 * lane;
            *(v4u*)dst = o0; *(v4u*)(dst + 8) = o1;
        }
        {
            const v4u w = *(const v4u*)(QP + (size_t)m * 1536 + 1024 + 8 * lane);
            float v[8] = {lo16(w.x), hi16(w.x), lo16(w.y), hi16(w.y), lo16(w.z), hi16(w.z), lo16(w.w), hi16(w.w)};
            float ss = 0.f;
#pragma unroll
            for (int e = 0; e < 8; ++e) ss += v[e] * v[e];
            ss += __shfl_xor(ss, 1); ss += __shfl_xor(ss, 2); ss += __shfl_xor(ss, 4);
            const float r = 1.f / sqrtf(ss * (1.f / 64.f) + EPS);
            float o[8];
#pragma unroll
            for (int e = 0; e < 8; ++e) { const float xn = v[e] * r * A.in[I_QNR][8 * l7 + e]; const float other = __shfl_xor(xn, 4);
                const float ang = (float)pos * ROPE_INV[8 * (l7 & 3) + e]; const float cs = cosf(ang), sn = sinf(ang);
                o[e] = (l7 < 4) ? xn * cs - other * sn : other * sn + xn * cs; }
            v4u ow; ow.x = pk2(o[0], o[1]); ow.y = pk2(o[2], o[3]); ow.z = pk2(o[4], o[5]); ow.w = pk2(o[6], o[7]);
            *(v4u*)(QP2 + (size_t)m * 1536 + hh * 192 + 128 + 8 * l7) = ow;
        }
    }
}
namespace att {
using s16x4 = __attribute__((ext_vector_type(4))) short;
using u32x4 = __attribute__((ext_vector_type(4))) unsigned;
constexpr int SHM_V = 16384, SHM_K = 16384, SHM_KR = 8192;
constexpr int OFF_V = 0, OFF_K = 2 * SHM_V, OFF_KR = OFF_K + 2 * SHM_K, OFF_WS = OFF_KR + 2 * SHM_KR, OFF_QR = OFF_WS + 2048;
constexpr float THR = 8.f;
#define KSWZ(row, colB) ((row) * 256 + ((colB) ^ (((row) & 7) << 4)))
#define KRSWZ(row, colB) ((row) * 128 + ((colB) ^ (((row) & 7) << 4)))
#define SBAR() __builtin_amdgcn_sched_barrier(0)
__device__ __forceinline__ unsigned cvtpk(float lo, float hi) { unsigned r; asm volatile("v_cvt_pk_bf16_f32 %0, %1, %2" : "=v"(r) : "v"(lo), "v"(hi)); return r; }
__device__ __forceinline__ void partialSM(f32x16& p0, f32x16& p1, float& m_reg, float& mn, float& alpha) {
    constexpr float C = MLA_SCALE * 1.4426950408889634f;
    float pmax = p0[0];
#pragma unroll
    for (int r = 1; r < 16; ++r) pmax = fmaxf(pmax, p0[r]);
#pragma unroll
    for (int r = 0; r < 16; ++r) pmax = fmaxf(pmax, p1[r]);
    { auto rr = __builtin_amdgcn_permlane32_swap(__float_as_uint(pmax), __float_as_uint(pmax), false, false);
      pmax = fmaxf(__uint_as_float(rr[0]), __uint_as_float(rr[1])); }
    if (__builtin_expect(__all(pmax - m_reg <= THR / MLA_SCALE), 1)) { mn = m_reg; alpha = 1.f; }
    else { mn = fmaxf(m_reg, pmax); alpha = __builtin_amdgcn_exp2f((m_reg - mn) * C); m_reg = mn; }
    const float mnC = -mn * C;
#pragma unroll
    for (int r = 0; r < 16; ++r) p0[r] = fmaf(p0[r], C, mnC);
#pragma unroll
    for (int r = 0; r < 16; ++r) p1[r] = fmaf(p1[r], C, mnC);
#pragma unroll
    for (int r = 0; r < 16; ++r) p0[r] = __builtin_amdgcn_exp2f(p0[r]);
}
__device__ __forceinline__ void finishSM(f32x16& p0, f32x16& p1, float alpha, float& l_reg, bf16x8& pa0, bf16x8& pa1, bf16x8& pa2, bf16x8& pa3) {
#pragma unroll
    for (int r = 0; r < 16; ++r) p1[r] = __builtin_amdgcn_exp2f(p1[r]);
    float ps = 0;
#pragma unroll
    for (int r = 0; r < 16; ++r) ps += p0[r];
#pragma unroll
    for (int r = 0; r < 16; ++r) ps += p1[r];
    { auto rr = __builtin_amdgcn_permlane32_swap(__float_as_uint(ps), __float_as_uint(ps), false, false);
      ps = __uint_as_float(rr[0]) + __uint_as_float(rr[1]); }
    l_reg = l_reg * alpha + ps;
#define PK4(P, BASE, OUT) do { unsigned a0 = cvtpk(P[BASE + 0], P[BASE + 1]), a1 = cvtpk(P[BASE + 2], P[BASE + 3]);   \
    unsigned b0 = cvtpk(P[BASE + 4], P[BASE + 5]), b1 = cvtpk(P[BASE + 6], P[BASE + 7]);                              \
    auto r0 = __builtin_amdgcn_permlane32_swap(a0, b0, false, false); auto r1 = __builtin_amdgcn_permlane32_swap(a1, b1, false, false); \
    u32x4 w = {r0[0], r1[0], r0[1], r1[1]}; OUT = *reinterpret_cast<bf16x8*>(&w); } while (0)
    PK4(p0, 0, pa0); PK4(p0, 8, pa1); PK4(p1, 0, pa2); PK4(p1, 8, pa3);
#undef PK4
}
__device__ __forceinline__ void qkt(f32x16& p0, f32x16& p1, LAS const unsigned char* Ks, LAS const unsigned char* KRs, const bf16x8* qr, LAS const unsigned char* qrl, int r32, int hi) {
    p0 = f32x16{}; p1 = f32x16{};
#pragma unroll
    for (int d0 = 0; d0 < 8; ++d0) { const int cb = (d0 * 16 + hi * 8) * 2;
        const bf16x8 b0 = *(LAS const bf16x8*)(Ks + KSWZ(r32, cb)), b1 = *(LAS const bf16x8*)(Ks + KSWZ(32 + r32, cb));
        p0 = MFMA32(b0, qr[d0], p0); p1 = MFMA32(b1, qr[d0], p1); if (d0 == 3 || d0 == 7) SBAR(); }
#pragma unroll
    for (int d0 = 0; d0 < 4; ++d0) { const int cb = (d0 * 16 + hi * 8) * 2;
        const bf16x8 b0 = *(LAS const bf16x8*)(KRs + KRSWZ(r32, cb)), b1 = *(LAS const bf16x8*)(KRs + KRSWZ(32 + r32, cb));
        const bf16x8 qq = *(LAS const bf16x8*)(qrl + d0 * 1024);
        p0 = MFMA32(b0, qq, p0); p1 = MFMA32(b1, qq, p1); }
}
__device__ __forceinline__ void cmask(f32x16& p0, f32x16& p1, int key0, int qpos, int hi) {
#pragma unroll
    for (int r = 0; r < 16; ++r) { const int k = key0 + crow(r, hi); if (k > qpos) p0[r] = -1e30f; if (k + 32 > qpos) p1[r] = -1e30f; }
}
__device__ __forceinline__ int v_st(int k, int c) { const int kk = (k & ~0xC) | ((k & 4) << 1) | ((k & 8) >> 1); return ((kk >> 3) * 4 + (c >> 5)) * 512 + ((kk & 7) * 32 + (c & 31)) * 2; }
__device__ __forceinline__ int v_rd_base(int lane) { return ((lane & 3) << 3) | (((lane >> 2) & 3) << 6) | (((lane >> 4) & 1) << 5) | (((lane >> 5) & 1) << 8); }
constexpr int v_rd_off(int d0, int ks, int half) { return d0 * 512 + ks * 4096 + half * 2048; }
template <int OFF> __device__ __forceinline__ s16x4 tr_read(int vb) {
    s16x4 r; asm volatile("ds_read_b64_tr_b16 %0, %1 offset:%2" : "=&v"(r) : "v"(vb), "i"(OFF) : "memory"); return r;
}
template <int D0> __device__ __forceinline__ void pv_one(f32x16& od, int vb, bf16x8 pa0, bf16x8 pa1, bf16x8 pa2, bf16x8 pa3) {
    const s16x4 l0 = tr_read<v_rd_off(D0, 0, 0)>(vb), h0 = tr_read<v_rd_off(D0, 0, 1)>(vb), l1 = tr_read<v_rd_off(D0, 1, 0)>(vb), h1 = tr_read<v_rd_off(D0, 1, 1)>(vb);
    const s16x4 l2 = tr_read<v_rd_off(D0, 2, 0)>(vb), h2 = tr_read<v_rd_off(D0, 2, 1)>(vb), l3 = tr_read<v_rd_off(D0, 3, 0)>(vb), h3 = tr_read<v_rd_off(D0, 3, 1)>(vb);
    asm volatile("s_waitcnt lgkmcnt(0)" ::: "memory"); SBAR();
#define PKV(L, H) (bf16x8){L[0], L[1], L[2], L[3], H[0], H[1], H[2], H[3]}
    od = MFMA32(pa0, PKV(l0, h0), od); od = MFMA32(pa1, PKV(l1, h1), od); od = MFMA32(pa2, PKV(l2, h2), od); od = MFMA32(pa3, PKV(l3, h3), od);
#undef PKV
}
__device__ __forceinline__ void pv_d0(f32x16* o, int vb, bf16x8 pa0, bf16x8 pa1, bf16x8 pa2, bf16x8 pa3) {
    pv_one<0>(o[0], vb, pa0, pa1, pa2, pa3); pv_one<1>(o[1], vb, pa0, pa1, pa2, pa3); pv_one<2>(o[2], vb, pa0, pa1, pa2, pa3); pv_one<3>(o[3], vb, pa0, pa1, pa2, pa3);
}
__device__ __forceinline__ void attn_block(const bf16* __restrict__ Qb, const bf16* __restrict__ Kh, const bf16* __restrict__ KRb, const bf16* __restrict__ Vh,
                                           bf16* __restrict__ Ob, int q0, LAS unsigned char* lds) {
    const int tid = threadIdx.x, wid = __builtin_amdgcn_readfirstlane(tid >> 6), lane = tid & 63, r32 = lane & 31, hi = lane >> 5;
    LAS unsigned char* V_lds = lds + OFF_V; LAS unsigned char* K_lds = lds + OFF_K; LAS unsigned char* KR_lds = lds + OFF_KR;
    LAS float* wsf = (LAS float*)(lds + OFF_WS) + wid * 64; LAS float* li_l = wsf; LAS float* al_l = wsf + 32;
    float m_reg = -1e30f, l_reg = 0; f32x16 o[4] = {}; bf16x8 qr[8];
    LAS unsigned char* qrl = lds + OFF_QR + wid * 4096 + lane * 16;
    { const char* Qw = (const char*)Qb + (size_t)wid * (32 * 1536 * 2); const unsigned qoff = (unsigned)(r32 * 1536 + hi * 8) * 2u;
#pragma unroll
      for (int d0 = 0; d0 < 8; ++d0) qr[d0] = *(const bf16x8*)(Qw + qoff + d0 * 32);
#pragma unroll
      for (int d0 = 0; d0 < 4; ++d0) *(LAS bf16x8*)(qrl + d0 * 1024) = *(const bf16x8*)(Qw + qoff + (8 + d0) * 32); }
    const int qpos = q0 + wid * 32 + r32;
    const int sr = tid >> 4, sc = (tid & 15) * 8, vst0 = v_st(sr, sc), vst1 = v_st(32 + sr, sc);
    const int krr = tid >> 3, krc = (tid & 7) * 8;
    const unsigned voff = (unsigned)(sr * 1024 + sc) * 2u, voffr = (unsigned)(krr * 64 + krc) * 2u;
    const int vb0 = (int)(uintptr_t)V_lds + v_rd_base(lane);
    bf16x8 vs0, vs1, ks0, ks1, krs;
#define SLOAD(k0) do { const char* kb_ = (const char*)Kh + (size_t)(k0) * 2048; const char* vb_ = (const char*)Vh + (size_t)(k0) * 2048; const char* rb_ = (const char*)KRb + (size_t)(k0) * 128; \
    vs0 = *(const bf16x8*)(vb_ + voff); vs1 = *(const bf16x8*)(vb_ + 65536 + voff); ks0 = *(const bf16x8*)(kb_ + voff); ks1 = *(const bf16x8*)(kb_ + 65536 + voff); \
    krs = *(const bf16x8*)(rb_ + voffr); } while (0)
#define SWRITE(b) do { *(LAS bf16x8*)(V_lds + (b) * SHM_V + vst0) = vs0; *(LAS bf16x8*)(V_lds + (b) * SHM_V + vst1) = vs1; const int kc = sc * 2; \
    *(LAS bf16x8*)(K_lds + (b) * SHM_K + KSWZ(sr, kc)) = ks0; *(LAS bf16x8*)(K_lds + (b) * SHM_K + KSWZ(32 + sr, kc)) = ks1; \
    *(LAS bf16x8*)(KR_lds + (b) * SHM_KR + KRSWZ(krr, krc * 2)) = krs; } while (0)
#define SWAIT() asm volatile("s_waitcnt vmcnt(0)" ::: "memory")
#define RESC(a) do { if (__any((a) < 1.f)) { if (hi == 0) al_l[r32] = (a); asm volatile("s_waitcnt lgkmcnt(0)" ::: "memory"); \
    _Pragma("unroll") for (int d = 0; d < 4; ++d) _Pragma("unroll") for (int r = 0; r < 16; ++r) o[d][r] *= al_l[crow(r, hi)]; } } while (0)
    f32x16 p0, p1; float mn, al; bf16x8 pa0, pa1, pa2, pa3;
    const int NT = (q0 + 256) / 64, NM = q0 / 64;
    SLOAD(0); SWAIT(); SWRITE(0); SLOAD(64); __syncthreads();
#pragma unroll 1
    for (int j = 0; j < NT; ++j) {
        const int bf = j & 1;
        SBAR(); qkt(p0, p1, K_lds + bf * SHM_K, KR_lds + bf * SHM_KR, qr, qrl, r32, hi); if (j >= NM) cmask(p0, p1, 64 * j, qpos, hi);
        partialSM(p0, p1, m_reg, mn, al); RESC(al);
        finishSM(p0, p1, al, l_reg, pa0, pa1, pa2, pa3); SBAR();
        if (j + 1 < NT) { SWAIT(); SWRITE(bf ^ 1); }
        if (j + 2 < NT) SLOAD((j + 2) * 64);
        SBAR();
        pv_d0(o, vb0 + bf * SHM_V, pa0, pa1, pa2, pa3);
        __syncthreads();
    }
    if (hi == 0) li_l[r32] = l_reg; asm volatile("s_waitcnt lgkmcnt(0)" ::: "memory");
    char* Ow = (char*)Ob + (size_t)wid * (32 * 1024 * 2);
    unsigned lofs = (unsigned)(4 * hi * 1024 + r32) * 2u; asm volatile("" : "+v"(lofs));
#pragma unroll
    for (int r = 0; r < 16; ++r) { const float rl = __builtin_amdgcn_rcpf(li_l[crow(r, hi)]);
#pragma unroll
        for (int d0 = 0; d0 < 4; ++d0) *(bf16*)(Ow + lofs + (unsigned)(((r & 3) + 8 * (r >> 2)) * 1024 + d0 * 32) * 2u) = (bf16)f2bf(o[d0][r] * rl); }
    __syncthreads();
#undef SLOAD
#undef SWRITE
#undef SWAIT
#undef RESC
}
}

constexpr int DP_CT = 0, DP_KR = 133120, DP_PT = 151552, DP_QK = 153728, DP_QR = 157824;
__device__ __forceinline__ void dec_tables(const Args& A, LAS unsigned char* lds, int j, int tid) {
    const bf16* Qrow = (const bf16*)(A.ws + WS_QP2) + (size_t)(MP + j) * 1536;
#pragma unroll
    for (int q = 0; q < 2; ++q) { const int idx = tid + 512 * q, h = idx >> 7, d = idx & 127; ((LAS float*)(lds + DP_QK))[idx] = bf2f(Qrow[h * 192 + d]) * A.in[I_KNN][d]; }
    { const int h = tid >> 6, e = tid & 63; ((LAS float*)(lds + DP_QR))[tid] = bf2f(Qrow[h * 192 + 128 + e]); }
}
__device__ __forceinline__ void dec_page(const Args& A, LAS unsigned char* lds, int unit, int tid, int lane, int wave) {
    unsigned char* ws = A.ws;
    const int phys = ((const int*)A.in[I_PT])[unit];
    const float* src = A.in[I_CACHE] + (size_t)phys * PAGE * LATW;
#pragma unroll 1
    for (int q0 = 0; q0 < 18; q0 += 6) {
        f32x4 va[6], vb[6];
#pragma unroll
        for (int q = 0; q < 6; ++q) { const int id = (q0 + q) * 512 + tid, row = id / 72, g = id % 72; const float* p = src + (size_t)row * LATW + 8 * g; va[q] = *(const f32x4*)p; vb[q] = *(const f32x4*)(p + 4); }
#pragma unroll
        for (int q = 0; q < 6; ++q) { const int id = (q0 + q) * 512 + tid, row = id / 72, g = id % 72;
            v4u o; o.x = pk2(va[q].x, va[q].y); o.y = pk2(va[q].z, va[q].w); o.z = pk2(vb[q].x, vb[q].y); o.w = pk2(vb[q].z, vb[q].w);
            if (g < 64) *(LAS v4u*)(lds + DP_CT + row * 1040 + g * 16) = o; else *(LAS v4u*)(lds + DP_KR + row * 144 + (g - 64) * 16) = o; }
    }
    __syncthreads();
    const int l31 = lane & 31, hi = lane >> 5, h = wave;
    float ssq[4] = {0.f, 0.f, 0.f, 0.f}, dot[4] = {0.f, 0.f, 0.f, 0.f};
    const bf16* WK = (const bf16*)(ws + WS_WKV);
    LAS const float* QK = (LAS const float*)(lds + DP_QK) + h * 128;
#pragma unroll 1
    for (int e = 0; e < 2; ++e) {
        f32x16 acc[2][4];
#pragma unroll
        for (int mt = 0; mt < 2; ++mt)
#pragma unroll
            for (int nt = 0; nt < 4; ++nt) acc[mt][nt] = f32x16{};
        const bf16* Ab = WK + (size_t)(h * 128 + 64 * e + l31) * 512 + 8 * hi;
        LAS const unsigned char* Bb = lds + DP_CT + l31 * 1040 + hi * 16;
#pragma unroll 2
        for (int ks = 0; ks < 32; ++ks) {
            const bf16x8 a0 = gl_ld8(Ab + 16 * ks), a1 = gl_ld8(Ab + 32 * 512 + 16 * ks);
            bf16x8 bq[4];
#pragma unroll
            for (int nt = 0; nt < 4; ++nt) bq[nt] = lds_ld8(Bb + nt * 32 * 1040 + ks * 32);
#pragma unroll
            for (int nt = 0; nt < 4; ++nt) { acc[0][nt] = MFMA32(a0, bq[nt], acc[0][nt]); acc[1][nt] = MFMA32(a1, bq[nt], acc[1][nt]); }
        }
#pragma unroll
        for (int mt = 0; mt < 2; ++mt)
#pragma unroll
            for (int g = 0; g < 4; ++g) { const f32x4 qv = *(LAS const f32x4*)(QK + 64 * e + 32 * mt + 8 * g + 4 * hi);
#pragma unroll
                for (int nt = 0; nt < 4; ++nt) {
                    const float x0 = acc[mt][nt][4 * g], x1 = acc[mt][nt][4 * g + 1], x2 = acc[mt][nt][4 * g + 2], x3 = acc[mt][nt][4 * g + 3];
                    ssq[nt] += x0 * x0 + x1 * x1 + x2 * x2 + x3 * x3; dot[nt] += x0 * qv.x + x1 * qv.y + x2 * qv.z + x3 * qv.w; } }
    }
#pragma unroll
    for (int nt = 0; nt < 4; ++nt) { ssq[nt] += __shfl_xor(ssq[nt], 32); dot[nt] += __shfl_xor(dot[nt], 32); }
    const float sn0 = dot[0] / sqrtf(ssq[0] * (1.f / 128.f) + EPS), sn1 = dot[1] / sqrtf(ssq[1] * (1.f / 128.f) + EPS);
    const float sn2 = dot[2] / sqrtf(ssq[2] * (1.f / 128.f) + EPS), sn3 = dot[3] / sqrtf(ssq[3] * (1.f / 128.f) + EPS);
    const float snA = hi ? sn2 : sn0, snB = hi ? sn3 : sn1;
    float s[2];
    LAS const float* QR = (LAS const float*)(lds + DP_QR) + h * 64;
#pragma unroll
    for (int u = 0; u < 2; ++u) { const int key = 32 * (2 * hi + u) + l31; float sr = 0.f;
#pragma unroll
        for (int c = 0; c < 8; ++c) { const v4u w = *(LAS const v4u*)(lds + DP_KR + key * 144 + c * 16); const f32x4 q0 = *(LAS const f32x4*)(QR + 8 * c), q1 = *(LAS const f32x4*)(QR + 8 * c + 4);
            sr += lo16(w.x) * q0.x + hi16(w.x) * q0.y + lo16(w.y) * q0.z + hi16(w.y) * q0.w + lo16(w.z) * q1.x + hi16(w.z) * q1.y + lo16(w.w) * q1.z + hi16(w.w) * q1.w; }
        s[u] = ((u ? snB : snA) + sr) * MLA_SCALE; }
    const float mx = wave_max(fmaxf(s[0], s[1]));
    const float p0 = __expf(s[0] - mx), p1 = __expf(s[1] - mx);
    const float lsum = wave_sum(p0 + p1);
    *(LAS bf16*)(lds + DP_PT + h * 272 + (32 * (2 * hi) + l31) * 2) = (bf16)f2bf(p0);
    *(LAS bf16*)(lds + DP_PT + h * 272 + (32 * (2 * hi + 1) + l31) * 2) = (bf16)f2bf(p1);
    if (lane == 0) { float* ml = (float*)(ws + WS_DML) + ((size_t)unit * 8 + h) * 2; ml[0] = mx; ml[1] = lsum; }
    __syncthreads();
    float* DA = (float*)(ws + WS_DACC) + (size_t)unit * 8 * 512;
#pragma unroll 1
    for (int t = 0; t < 2; ++t) { const int cb = 64 * wave + 32 * t + l31;
        f32x16 acc2 = {};
#pragma unroll 2
        for (int ks = 0; ks < 8; ++ks) {
            bf16x8 a = {0, 0, 0, 0, 0, 0, 0, 0};
            if (l31 < 8) a = lds_ld8(lds + DP_PT + l31 * 272 + (16 * ks + 8 * hi) * 2);
            bf16x8 bb;
#pragma unroll
            for (int jj = 0; jj < 8; ++jj) bb[jj] = (short)*(LAS const bf16*)(lds + DP_CT + (16 * ks + 8 * hi + jj) * 1040 + cb * 2);
            acc2 = MFMA32(a, bb, acc2);
        }
#pragma unroll
        for (int r = 0; r < 4; ++r) DA[(size_t)(r + 4 * hi) * 512 + cb] = acc2[r];
    }
    __syncthreads();
}
__device__ __forceinline__ void dec_combine(const Args& A, LAS unsigned char* lds, int unit, int tid, int lane, int wave) {
    unsigned char* ws = A.ws;
    const int j = unit >> 3, h = unit & 7, row = MP + j;
    const bf16* Qrow = (const bf16*)(ws + WS_QP2) + (size_t)row * 1536 + h * 192;
    const bf16* Krow = (const bf16*)(ws + WS_KN) + (size_t)row * 1024 + h * 128;
    const bf16* KRrow = (const bf16*)(ws + WS_KR) + (size_t)row * 64;
    const float snew = wave_sum(bf2f(Qrow[lane]) * bf2f(Krow[lane]) + bf2f(Qrow[lane + 64]) * bf2f(Krow[lane + 64]) + bf2f(Qrow[128 + lane]) * bf2f(KRrow[lane])) * MLA_SCALE;
    const float* ML = (const float*)(ws + WS_DML) + ((size_t)j * NPAGE * 8 + h) * 2;
    const float m0 = ML[(size_t)lane * 16], m1 = ML[(size_t)(lane + 64) * 16], l0 = ML[(size_t)lane * 16 + 1], l1 = ML[(size_t)(lane + 64) * 16 + 1];
    const float M = fmaxf(wave_max(fmaxf(m0, m1)), snew);
    const float wn = __expf(snew - M);
    const float den = wave_sum(__expf(m0 - M) * l0 + __expf(m1 - M) * l1) + wn;
    const float* DA = (const float*)(ws + WS_DACC) + ((size_t)j * NPAGE * 8 + h) * 512 + tid;
    float num = wn * bf2f(((const bf16*)(ws + WS_C))[(size_t)row * 512 + tid]);
#pragma unroll 4
    for (int p = 0; p < NPAGE; ++p) num += __expf(ML[(size_t)p * 16] - M) * DA[(size_t)p * 4096];
    LAS float* lat = (LAS float*)lds; LAS float* red = lat + 512;
    lat[tid] = num / den;
    __syncthreads();
    const int d = tid & 127, qt = tid >> 7;
    const float* Wv = A.in[I_WUV] + (size_t)(qt * 128) * 1024 + h * 128 + d;
    float part = 0.f;
#pragma unroll 8
    for (int c = 0; c < 128; ++c) part += lat[qt * 128 + c] * Wv[(size_t)c * 1024];
    red[tid] = part;
    __syncthreads();
    if (tid < 128) ((bf16*)(ws + WS_YB))[(size_t)row * 1024 + h * 128 + tid] = (bf16)f2bf(red[tid] + red[128 + tid] + red[256 + tid] + red[384 + tid]);
    __syncthreads();
}
__device__ __forceinline__ f32x16 skinny_partial(const bf16* A, const bf16* Bt, int K, int n0, int wave, int lane) {
    const int l31 = lane & 31, hi = lane >> 5, kw = K >> 3, k0 = wave * kw;
    const bf16* ap = A + (size_t)l31 * K + k0 + 8 * hi; const bf16* bp = Bt + (size_t)(n0 + l31) * K + k0 + 8 * hi;
    f32x16 acc = {};
#pragma unroll 8
    for (int ks = 0; ks < (kw >> 4); ++ks) acc = MFMA32(gl_ld8(ap + 16 * ks), gl_ld8(bp + 16 * ks), acc);
    return acc;
}
__device__ __forceinline__ void skinny_put(LAS float* red, const f32x16& acc, int wave, int lane) {
    const int l31 = lane & 31, hi = lane >> 5;
#pragma unroll
    for (int r = 0; r < 16; ++r) red[(wave * 32 + crow(r, hi)) * 32 + l31] = acc[r];
}
__device__ __forceinline__ void skinny_get(LAS const float* red, int tid, float& v0, float& v1) {
    v0 = 0.f; v1 = 0.f;
#pragma unroll
    for (int w = 0; w < 8; ++w) { v0 += red[w * 1024 + tid * 2]; v1 += red[w * 1024 + tid * 2 + 1]; }
}
template <int MODE> __device__ __forceinline__ void skinny_tile(const Args& A, LAS unsigned char* lds, int tile, int tid, int lane, int wave) {
    unsigned char* ws = A.ws; const int n0 = tile * 32;
    LAS float* red = (LAS float*)lds; LAS float* red2 = red + 8192;
    if (MODE == 0) {
        skinny_put(red, skinny_partial((const bf16*)(ws + WS_YA) + (size_t)MP * 1024, (const bf16*)(ws + WS_WYA), 1024, n0, wave, lane), wave, lane);
        skinny_put(red2, skinny_partial((const bf16*)(ws + WS_YB) + (size_t)MP * 1024, (const bf16*)(ws + WS_WYB), 1024, n0, wave, lane), wave, lane);
    } else if (MODE == 1) skinny_put(red, skinny_partial((const bf16*)(ws + WS_T) + (size_t)MP * 1024, (const bf16*)(ws + WS_WO), 1024, n0, wave, lane), wave, lane);
    else if (MODE == 2) skinny_put(red, skinny_partial((const bf16*)(ws + WS_XN2) + (size_t)MP * 1024, (const bf16*)(ws + WS_WUP), 1024, n0, wave, lane), wave, lane);
    else skinny_put(red, skinny_partial((const bf16*)(ws + WS_H) + (size_t)MP * 4096, (const bf16*)(ws + WS_WDN), 4096, n0, wave, lane), wave, lane);
    __syncthreads();
    float v0, v1; skinny_get(red, tid, v0, v1);
    const int row = tid >> 4, col = n0 + 2 * (tid & 15); const size_t grow = (size_t)(MP + row);
    if (MODE == 0) {
        float u0, u1; skinny_get(red2, tid, u0, u1);
        const bf16* g = (const bf16*)(ws + WS_GATES) + grow * 2048 + col;
        const float t0 = bf2f(g[0]) * v0 + bf2f(g[1024]) * u0, t1 = bf2f(g[1]) * v1 + bf2f(g[1025]) * u1;
        *(unsigned*)((bf16*)(ws + WS_T) + grow * 1024 + col) = pk2(t0, t1);
    } else if (MODE == 1) {
        const float* x = A.in[I_XS] + (size_t)row * 1024 + col; float* o = (float*)(ws + WS_X1) + grow * 1024 + col;
        o[0] = x[0] + v0; o[1] = x[1] + v1;
    } else if (MODE == 2) {
        const float a = fmaxf(v0, 0.f), b = fmaxf(v1, 0.f);
        *(unsigned*)((bf16*)(ws + WS_H) + grow * 4096 + col) = pk2(a * a, b * b);
    } else {
        const float* x = (const float*)(ws + WS_X1) + grow * 1024 + col; float* o = A.out + O_YS + (size_t)row * 1024 + col;
        o[0] = x[0] + v0; o[1] = x[1] + v1;
    }
    __syncthreads();
}
#ifndef MK_SINGLE
#define MK_SINGLE 1
#endif
constexpr int N_PHASES = 12;
__global__ void __launch_bounds__(512, 2) mk_fwd(Args args) {
    extern __shared__ __attribute__((aligned(16))) unsigned char lds_raw[];
    LAS unsigned char* lds = (LAS unsigned char*)lds_raw;
    const int tid = threadIdx.x, lane = tid & 63, wave = __builtin_amdgcn_readfirstlane(tid >> 6);
    const int G = gridDim.x, bid = blockIdx.x;
    const int gw = bid * 8 + wave, NGW = G * 8, gtid = bid * 512 + tid, NGT = G * 512;
    volatile LAS unsigned* MISC = (volatile LAS unsigned*)(lds + MISC_OFF);
    if (tid < 32) MISC[tid] = 0u;
    __syncthreads();
    unsigned char* ws = args.ws;
#if MK_SINGLE
    XcdBarrier bar = xcd_barrier_post((unsigned*)(ws + WS_CTL) + 4096, MISC + 8);
#define GRID_BAR() xcd_barrier(bar)
#else
#define GRID_BAR() do {} while (0)
#endif
    const int lo = args.ph_lo, hi = args.ph_hi;
#ifndef PHASE_MASK
#define PHASE_MASK 0xFFFF
#endif
#define IN(k) (((PHASE_MASK >> (k)) & 1) && lo <= (k) && (k) < hi)
#define SEAM(k) do { if (IN(k) && IN((k) + 1)) GRID_BAR(); } while (0)

    if (IN(0)) {
        p0_prologue(args, lds, gw, NGW, wave, lane);
        for (int i = gtid; i < 32 * 2 * 3072; i += NGT) { const int c = i % 3072, r = (i / 3072) % 2, j = i / (2 * 3072);
            args.out[O_CSS + (size_t)(j * 3 + r) * 3072 + c] = args.in[I_SCONV][(size_t)(j * 3 + r + 1) * 3072 + c]; }
        __syncthreads();
    }
    SEAM(0);
    if (IN(1)) {
        pg8::Gemm g{(const pg8::bf16_t*)(ws + WS_XN), (const pg8::bf16_t*)(ws + WS_WIN), MPAD, NIN, 1024};
        pg8::StaticOrder S; S.init(MPAD, NIN, G, bid);
        EpiG1 E{(bf16*)(ws + WS_QKV), (bf16*)(ws + WS_Z), (bf16*)(ws + WS_QD), (bf16*)(ws + WS_KVD), (bf16*)(ws + WS_GATES), (float*)(ws + WS_SM)};
        pg8::gemm_phase<EpiG1, pg8::StaticOrder, true, true>(lds, g, S, E);
    }
    SEAM(1);
    if (IN(2)) {
        p2_rows(args, gw, NGW, lane);
        p2_conv_state(args, gtid, NGT);
    }
    SEAM(2);
    if (IN(3)) {
        { pg8::Gemm g{(const pg8::bf16_t*)(ws + WS_QD), (const pg8::bf16_t*)(ws + WS_WQ), MPAD, 1536, 512};
          pg8::StaticOrder S; S.init(MPAD, 1536, G, bid);
          EpiStore<0> E{(bf16*)(ws + WS_QP), 1536, 6, (bf16*)(ws + WS_QP), 1536};
          pg8::gemm_phase<EpiStore<0>, pg8::StaticOrder, true, true>(lds, g, S, E); }
        { pg8::Gemm g{(const pg8::bf16_t*)(ws + WS_C), (const pg8::bf16_t*)(ws + WS_WKV), MPAD, 2048, 512};
          pg8::StaticOrder S; S.init(MPAD, 2048, G, G - 1 - bid);
          EpiStore<0> E{(bf16*)(ws + WS_KN), 1024, 4, (bf16*)(ws + WS_V), 1024};
          pg8::gemm_phase<EpiStore<0>, pg8::StaticOrder, true, true>(lds, g, S, E); }
        for (int u = bid; u < 2048; u += G) gdn_a_unit(args, lds, u, tid, lane, wave);
        for (int u = bid; u < 256; u += G) gdn_r_unit(args, lds, u, tid, lane, wave);
    }
    SEAM(3);
    if (IN(4)) { p4_rows(args, gw, NGW, lane); }
    SEAM(4);
    if (IN(5)) {
        constexpr int PG = 2, NGRP = 4096 / PG;
        unsigned* qctr = (unsigned*)(ws + WS_CTL) + 64;
#define PULL(k) ({ __syncthreads(); if (tid == 0) MISC[0] = atomicAdd(qctr + 64 * (k), 1u); __syncthreads(); (int)MISC[0]; })
        for (int it = PULL(0); it < 64; it = PULL(0)) gdn_b_unit(args, lds, it, tid, lane, wave);
        for (int u = PULL(1); u < 256; u = PULL(1)) {
            const int bh = u >> 2, pr = u & 3, b = bh >> 3, h = bh & 7;
#pragma unroll 1
            for (int s2 = 0; s2 < 2; ++s2) { const int qb = s2 ? pr : 7 - pr;
                att::attn_block((const bf16*)(ws + WS_QP2) + (size_t)(b * SEQ + 256 * qb) * 1536 + h * 192, (const bf16*)(ws + WS_KN) + (size_t)(b * SEQ) * 1024 + h * 128,
                                (const bf16*)(ws + WS_KR) + (size_t)(b * SEQ) * 64, (const bf16*)(ws + WS_V) + (size_t)(b * SEQ) * 1024 + h * 128,
                                (bf16*)(ws + WS_YB) + (size_t)(b * SEQ + 256 * qb) * 1024 + h * 128, 256 * qb, lds); }
        }
        for (int g = PULL(2); g < NGRP; g = PULL(2)) {
            dec_tables(args, lds, (g * PG) >> 7, tid);
            __syncthreads();
#pragma unroll 1
            for (int p = 0; p < PG; ++p) dec_page(args, lds, g * PG + p, tid, lane, wave);
        }
#undef PULL
    }
    SEAM(5);
    if (IN(6)) { for (int u = bid; u < 256; u += G) dec_combine(args, lds, u, tid, lane, wave); }
    SEAM(6);
    if (IN(7)) {
        for (int t = bid; t < 32; t += G) skinny_tile<0>(args, lds, t, tid, lane, wave);
        pg8::StaticOrder S; S.init(MP, 1024, G, bid);
        { pg8::Gemm g{(const pg8::bf16_t*)(ws + WS_YA), (const pg8::bf16_t*)(ws + WS_WYA), MP, 1024, 1024};
          EpiMerge<1> E{(const bf16*)(ws + WS_GATES), (float*)(ws + WS_TF), (bf16*)(ws + WS_T)};
          pg8::gemm_phase<EpiMerge<1>, pg8::StaticOrder, true, true>(lds, g, S, E); }
        { pg8::Gemm g{(const pg8::bf16_t*)(ws + WS_YB), (const pg8::bf16_t*)(ws + WS_WYB), MP, 1024, 1024};
          EpiMerge<2> E{(const bf16*)(ws + WS_GATES), (float*)(ws + WS_TF), (bf16*)(ws + WS_T)};
          pg8::gemm_phase<EpiMerge<2>, pg8::StaticOrder, true, true>(lds, g, S, E); }
    }
    SEAM(7);
    if (IN(8)) {
        for (int t = bid; t < 32; t += G) skinny_tile<1>(args, lds, t, tid, lane, wave);
        pg8::Gemm g{(const pg8::bf16_t*)(ws + WS_T), (const pg8::bf16_t*)(ws + WS_WO), MP, 1024, 1024};
        pg8::StaticOrder S; S.init(MP, 1024, G, bid);
        EpiRes<0> E{args.in[I_XP], args.in[I_XS], (float*)(ws + WS_X1), args.out};
        pg8::gemm_phase<EpiRes<0>, pg8::StaticOrder, true, true>(lds, g, S, E);
    }
    SEAM(8);
    if (IN(9)) {
        bf16* XN2 = (bf16*)(ws + WS_XN2); const float* X1 = (const float*)(ws + WS_X1);
        for (int m = gw; m < MPAD; m += NGW) {
            if (m < MR) rms_row_to_bf16(X1 + (size_t)m * 1024, args.in[I_NMLP], XN2 + (size_t)m * 1024, lane);
            else { v4u z = {0u, 0u, 0u, 0u}; *((v4u*)(XN2 + (size_t)m * 1024) + lane) = z; *((v4u*)(XN2 + (size_t)m * 1024) + 64 + lane) = z; }
        }
    }
    SEAM(9);
    if (IN(10)) {
        for (int t = bid; t < 128; t += G) skinny_tile<2>(args, lds, t, tid, lane, wave);
        pg8::Gemm g{(const pg8::bf16_t*)(ws + WS_XN2), (const pg8::bf16_t*)(ws + WS_WUP), MP, 4096, 1024};
        pg8::StaticOrder S; S.init(MP, 4096, G, bid);
        EpiStore<1> E{(bf16*)(ws + WS_H), 4096, 16, (bf16*)(ws + WS_H), 4096};
        pg8::gemm_phase<EpiStore<1>, pg8::StaticOrder, true, true>(lds, g, S, E);
    }
    SEAM(10);
    if (IN(11)) {
        for (int t = bid; t < 32; t += G) skinny_tile<3>(args, lds, t, tid, lane, wave);
        pg8::Gemm g{(const pg8::bf16_t*)(ws + WS_H), (const pg8::bf16_t*)(ws + WS_WDN), MP, 1024, 4096};
        pg8::StaticOrder S; S.init(MP, 1024, G, bid);
        EpiRes<1> E{args.in[I_XP], args.in[I_XS], (float*)(ws + WS_X1), args.out};
        pg8::gemm_phase<EpiRes<1>, pg8::StaticOrder, true, true>(lds, g, S, E);
    }
#undef IN
#undef SEAM
}

extern "C" void kernel_launch(void* const* d_in, const int* in_sizes, int n_in, void* d_out, int out_size, void* d_ws, size_t ws_size, hipStream_t stream) {
    static int grid = 0;
    if (grid == 0) {
        if (n_in != 27 || ws_size < WS_END) { fprintf(stderr, "kernel_launch: unexpected n_in %d or ws_size %zu (need %zu)\n", n_in, ws_size, (size_t)WS_END); grid = -1; return; }
        int dev = 0, cus = 0, per_cu = 0;
        if (hipGetDevice(&dev) != hipSuccess || hipDeviceGetAttribute(&cus, hipDeviceAttributeMultiprocessorCount, dev) != hipSuccess) { grid = -1; return; }
        if (hipFuncSetAttribute((const void*)mk_fwd, hipFuncAttributeMaxDynamicSharedMemorySize, LDS_BYTES) != hipSuccess) { fprintf(stderr, "kernel_launch: hipFuncSetAttribute failed\n"); grid = -1; return; }
        if (hipOccupancyMaxActiveBlocksPerMultiprocessor(&per_cu, (const void*)mk_fwd, 512, LDS_BYTES) != hipSuccess || per_cu < 1) fprintf(stderr, "kernel_launch: occupancy query says %d\n", per_cu);
        (void)hipGetLastError();
        grid = cus;
    }
    if (grid < 0) return;
    (void)hipMemsetAsync((char*)d_ws + WS_CTL, 0, CTL_BYTES, stream);
    Args a{};
    for (int i = 0; i < 27; ++i) a.in[i] = (const float*)d_in[i];
    a.out = (float*)d_out; a.ws = (unsigned char*)d_ws;
#if MK_SINGLE
    a.ph_lo = 0; a.ph_hi = N_PHASES;
    hipLaunchKernelGGL(mk_fwd, dim3(grid), dim3(512), LDS_BYTES, stream, a);
#else
    for (int p = 0; p < N_PHASES; ++p) { a.ph_lo = p; a.ph_hi = p + 1; hipLaunchKernelGGL(mk_fwd, dim3(grid), dim3(512), LDS_BYTES, stream, a); }
#endif
    const hipError_t le = hipPeekAtLastError();
    if (le != hipSuccess) fprintf(stderr, "kernel_launch: launch failed: %s\n", hipGetErrorName(le));
}
```

```cpp
#include <hip/hip_runtime.h>
#include <cstdio>
#include <cstdint>
namespace pg8 {
#define PG8_LAS __attribute__((address_space(3)))
typedef unsigned short bf16_t;
typedef short bf16x8 __attribute__((ext_vector_type(8)));
typedef float f32x4 __attribute__((ext_vector_type(4)));
typedef unsigned u32x4 __attribute__((ext_vector_type(4)));
constexpr int BM = 256, BK = 64, HALF = 128, HTB = HALF * BK * 2  , STAGE_BYTES = 8 * HTB, NXCD = 8, WGM = 8;

__host__ __device__ __forceinline__ int lds_byte(int r, int c) { const int st = (r >> 4) * 2 + (c >> 5), rr = r & 15, cc = c & 31, ob = rr * 64 + cc * 2; return st * 1024 + (ob ^ (((ob >> 9) & 1) << 5)); }
__host__ __device__ __forceinline__ void stage_rc(int b, int& R, int& C) { const int st = b / 1024, sb = b % 1024, swz = sb ^ (((sb >> 9) & 1) << 5); R = (st >> 1) * 16 + swz / 64; C = (st & 1) * 32 + (swz % 64) / 2; }
__host__ __device__ __forceinline__ int perm32(int rho) { const int n = rho >> 4, i = rho & 15; return 8 * (i >> 2) + 4 * n + (i & 3); }

struct Unit { int pm, pn; };
struct Gemm { const bf16_t* A; const bf16_t* Bt; int M, N, K; };

struct StaticOrder {
    int nM, nN, nwg, G, c;
    __host__ __device__ void init(int M, int N, int G_, int c_) { nM = M / BM; nN = N / BM; nwg = nM * nN; G = G_; c = c_; }
    __host__ __device__ bool next(int i, Unit& u) const {
        const long L = (long)i * G + c; if (L >= nwg) return false;
        int wgid = (int)L; { const int q = nwg / NXCD, r = nwg % NXCD, xcd = wgid % NXCD, off = wgid / NXCD; wgid = (xcd < r ? xcd * (q + 1) : r * (q + 1) + (xcd - r) * q) + off; }
        const int nig = WGM * nN, gid = wgid / nig, fm = gid * WGM, gsz = (nM - fm) < WGM ? (nM - fm) : WGM;
        u.pm = fm + ((wgid % nig) % gsz); u.pn = (wgid % nig) / gsz; return true;
    }
    __device__ __forceinline__ void a_ready(const Unit&) const {}
    __device__ __forceinline__ void done(const Unit&) const {}
};

__device__ __forceinline__ unsigned cvt_pk_bf16(float lo, float hi) { unsigned r; asm volatile("v_cvt_pk_bf16_f32 %0, %1, %2" : "=v"(r) : "v"(lo), "v"(hi)); return r; }
template <class Epi, class Sched, bool ALIGN_EPI = false, bool SP2 = false>
__device__ __forceinline__ void gemm_phase(PG8_LAS unsigned char* lds, const Gemm g, const Sched& S, const Epi& E) {
    const int tid = threadIdx.x, wid = __builtin_amdgcn_readfirstlane(tid >> 6), lane = tid & 63, wr = wid >> 2, wc = wid & 3, fr = lane & 15, fq = lane >> 4;
    const int K = g.K, nt = K / BK;
    unsigned voffA[2], voffB[2];
#pragma unroll
    for (int i = 0; i < 2; ++i) { int R, C; stage_rc(tid * 16 + i * 8192, R, C); const int Rb = Epi::PERM ? ((R & ~31) + perm32(R & 31)) : R;
        voffA[i] = (unsigned)(R * K + C) * 2u; voffB[i] = (unsigned)(Rb * K + C) * 2u; }
    const size_t kstep = (size_t)(BK * 2);
    const size_t hstep = (size_t)HALF * K * 2;
    const size_t tstep = 2 * hstep;
    const unsigned ldsw = (unsigned)wid * 1024u;
    const int aoff = lds_byte(wr * 64 + fr, fq * 8), boff = lds_byte(wc * 32 + fr, fq * 8);
#define PG8_SA(b, h) (((b) * 2 + (h)) * HTB)
#define PG8_SB(b, h) ((4 + (b) * 2 + (h)) * HTB)
#define PG8_STAGE(bufoff, gbase, voff) do { _Pragma("unroll") for (int _i = 0; _i < 2; ++_i) \
        __builtin_amdgcn_global_load_lds((const unsigned*)((const char*)(gbase) + (voff)[_i]), (PG8_LAS unsigned*)(lds + (bufoff) + ldsw + _i * 8192), 16, 0, 0); } while (0)
#define PG8_LDA(dst, b, h) do { _Pragma("unroll") for (int m = 0; m < 4; ++m) _Pragma("unroll") for (int k = 0; k < 2; ++k) dst[m][k] = *(const PG8_LAS bf16x8*)(lds + PG8_SA(b, h) + aoff + m * 2048 + k * 1024); } while (0)
#define PG8_LDB(dst, b, h) do { _Pragma("unroll") for (int n = 0; n < 2; ++n) _Pragma("unroll") for (int k = 0; k < 2; ++k) dst[n][k] = *(const PG8_LAS bf16x8*)(lds + PG8_SB(b, h) + boff + n * 2048 + k * 1024); } while (0)
#define PG8_MMA(ai, bj, At, Bt) do { __builtin_amdgcn_s_setprio(1); _Pragma("unroll") for (int m = 0; m < 4; ++m) _Pragma("unroll") for (int n = 0; n < 2; ++n) _Pragma("unroll") for (int k = 0; k < 2; ++k) \
        acc[ai][bj][m][n] = __builtin_amdgcn_mfma_f32_16x16x32_bf16(Bt[n][k], At[m][k], acc[ai][bj][m][n], 0, 0, 0); __builtin_amdgcn_s_setprio(0); } while (0)
#define PG8_WAIT_V(n) asm volatile("s_waitcnt vmcnt(" #n ")" ::: "memory")
#define PG8_WAIT_L(n) asm volatile("s_waitcnt lgkmcnt(" #n ")" ::: "memory")
#define PG8_BAR __builtin_amdgcn_s_barrier()
#define PG8_SCHED __builtin_amdgcn_sched_barrier(0)
    Unit cur, nxt; int ui = 0;
    if (!S.next(0, cur)) return;
    f32x4 acc[2][2][4][2];
#pragma unroll
    for (int a = 0; a < 2; ++a)
#pragma unroll
        for (int b = 0; b < 2; ++b)
#pragma unroll
            for (int m = 0; m < 4; ++m)
#pragma unroll
                for (int n = 0; n < 2; ++n) acc[a][b][m][n] = (f32x4){0.f, 0.f, 0.f, 0.f};
    bf16x8 At[4][2], B0[2][2], B1[2][2];
    const char* cA = (const char*)g.A + (size_t)cur.pm * tstep; const char* cB = (const char*)g.Bt + (size_t)cur.pn * tstep;
    S.a_ready(cur);
    if constexpr (SP2) {
        PG8_STAGE(PG8_SB(0, 0), cB, voffB); PG8_STAGE(PG8_SB(0, 1), cB + hstep, voffB); PG8_STAGE(PG8_SA(0, 0), cA, voffA); PG8_STAGE(PG8_SA(0, 1), cA + hstep, voffA);
        if (wr == 1) PG8_BAR;
        PG8_WAIT_V(2); PG8_BAR;
        PG8_STAGE(PG8_SB(1, 0), cB + kstep, voffB); PG8_STAGE(PG8_SA(1, 0), cA + kstep, voffA); PG8_STAGE(PG8_SB(1, 1), cB + hstep + kstep, voffB);
        PG8_WAIT_V(6); PG8_BAR;
    } else {
        PG8_STAGE(PG8_SB(0, 0), cB, voffB); PG8_STAGE(PG8_SA(0, 0), cA, voffA); PG8_STAGE(PG8_SB(0, 1), cB + hstep, voffB); PG8_STAGE(PG8_SA(0, 1), cA + hstep, voffA);
        if (wr == 1) PG8_BAR;
        PG8_WAIT_V(4); PG8_BAR;
        PG8_STAGE(PG8_SB(1, 0), cB + kstep, voffB); PG8_STAGE(PG8_SA(1, 0), cA + kstep, voffA); PG8_STAGE(PG8_SB(1, 1), cB + hstep + kstep, voffB);
        PG8_WAIT_V(6); PG8_BAR;
    }
    for (;;) {
        const bool has_next = S.next(ui + 1, nxt);
        const char* nA = has_next ? (const char*)g.A + (size_t)nxt.pm * tstep : cA; const char* nB = has_next ? (const char*)g.Bt + (size_t)nxt.pn * tstep : cB;
        for (int t = 0; t < nt; t += 2) {
            const bool last = (t == nt - 2);
            const char* a1 = cA + (size_t)(t + 1) * kstep;
            const char* a2 = last ? nA : cA + (size_t)(t + 2) * kstep; const char* b2 = last ? nB : cB + (size_t)(t + 2) * kstep;
            const char* a3 = a2 + kstep; const char* b3 = b2 + kstep;
            if (last && has_next) S.a_ready(nxt);
            if constexpr (SP2) {
            PG8_LDB(B0, 0, 0); PG8_LDB(B1, 0, 1); PG8_SCHED; PG8_LDA(At, 0, 0); PG8_STAGE(PG8_SA(1, 1), a1 + hstep, voffA);
            PG8_WAIT_V(8); PG8_WAIT_L(0); PG8_BAR; PG8_MMA(0, 0, At, B0); PG8_MMA(0, 1, At, B1); PG8_BAR; PG8_SCHED;
            PG8_LDA(At, 0, 1); PG8_STAGE(PG8_SB(0, 0), b2, voffB); PG8_STAGE(PG8_SB(0, 1), b2 + hstep, voffB); PG8_STAGE(PG8_SA(0, 0), a2, voffA);
            PG8_WAIT_V(8); PG8_WAIT_L(0); PG8_BAR; PG8_MMA(1, 0, At, B0); PG8_MMA(1, 1, At, B1); PG8_BAR; PG8_SCHED;
            PG8_LDB(B0, 1, 0); PG8_LDB(B1, 1, 1); PG8_SCHED; PG8_LDA(At, 1, 0); PG8_STAGE(PG8_SA(0, 1), a2 + hstep, voffA);
            PG8_WAIT_V(8); PG8_WAIT_L(0); PG8_BAR; PG8_MMA(0, 0, At, B0); PG8_MMA(0, 1, At, B1); PG8_BAR; PG8_SCHED;
            PG8_LDA(At, 1, 1); PG8_STAGE(PG8_SB(1, 0), b3, voffB); PG8_STAGE(PG8_SB(1, 1), b3 + hstep, voffB); PG8_STAGE(PG8_SA(1, 0), a3, voffA);
            PG8_WAIT_V(8); PG8_WAIT_L(0); PG8_BAR; PG8_MMA(1, 0, At, B0); PG8_MMA(1, 1, At, B1); PG8_BAR; PG8_SCHED;
            } else {
            PG8_LDB(B0, 0, 0); PG8_SCHED; PG8_LDA(At, 0, 0); PG8_STAGE(PG8_SA(1, 1), a1 + hstep, voffA);
            PG8_WAIT_L(8); PG8_BAR; PG8_WAIT_L(0); PG8_MMA(0, 0, At, B0); PG8_BAR; PG8_SCHED;
            PG8_LDB(B1, 0, 1); PG8_STAGE(PG8_SB(0, 0), b2, voffB);
            PG8_BAR; PG8_WAIT_L(0); PG8_MMA(0, 1, At, B1); PG8_BAR;
            PG8_LDA(At, 0, 1); PG8_STAGE(PG8_SA(0, 0), a2, voffA);
            PG8_BAR; PG8_WAIT_L(0); PG8_MMA(1, 0, At, B0); PG8_BAR; PG8_SCHED;
            PG8_STAGE(PG8_SB(0, 1), b2 + hstep, voffB);
            PG8_WAIT_V(6); PG8_BAR; PG8_MMA(1, 1, At, B1); PG8_BAR;
            PG8_LDB(B0, 1, 0); PG8_SCHED; PG8_LDA(At, 1, 0); PG8_STAGE(PG8_SA(0, 1), a2 + hstep, voffA);
            PG8_WAIT_L(8); PG8_BAR; PG8_WAIT_L(0); PG8_MMA(0, 0, At, B0); PG8_BAR; PG8_SCHED;
            PG8_LDB(B1, 1, 1); PG8_STAGE(PG8_SB(1, 0), b3, voffB);
            PG8_BAR; PG8_WAIT_L(0); PG8_MMA(0, 1, At, B1); PG8_BAR;
            PG8_LDA(At, 1, 1); PG8_STAGE(PG8_SA(1, 0), a3, voffA);
            PG8_BAR; PG8_WAIT_L(0); PG8_MMA(1, 0, At, B0); PG8_BAR; PG8_SCHED;
            PG8_STAGE(PG8_SB(1, 1), b3 + hstep, voffB);
            PG8_WAIT_V(6); PG8_BAR; PG8_MMA(1, 1, At, B1); PG8_BAR;
            }
        }
        if constexpr (ALIGN_EPI) { if (wr == 0) PG8_BAR; }
        if constexpr (!Epi::AFTER_DRAIN) { E(acc, cur, wr, wc, fr, fq); S.done(cur); }
        if (!has_next) break;
#pragma unroll
        for (int a = 0; a < 2; ++a)
#pragma unroll
            for (int b = 0; b < 2; ++b)
#pragma unroll
                for (int m = 0; m < 4; ++m)
#pragma unroll
                    for (int n = 0; n < 2; ++n) acc[a][b][m][n] = (f32x4){0.f, 0.f, 0.f, 0.f};
        cur = nxt; cA = nA; cB = nB; ++ui;
        if constexpr (ALIGN_EPI) { if (wr == 1) PG8_BAR; }
    }
    PG8_WAIT_V(0);
    if constexpr (!ALIGN_EPI) { if (wr == 0) PG8_BAR; }
    PG8_BAR;
    if constexpr (Epi::AFTER_DRAIN) { E.fused(acc, cur, wr, wc, fr, fq, lds, wid, lane); S.done(cur); }
#undef PG8_SA
#undef PG8_SB
#undef PG8_STAGE
#undef PG8_LDA
#undef PG8_LDB
#undef PG8_MMA
#undef PG8_WAIT_V
#undef PG8_WAIT_L
#undef PG8_BAR
#undef PG8_SCHED
}
}
#define XB_TMO      128
#define XB_XCNT(j)  (256  + 64 * (j))
#define XB_XSUB(j)  (1280 + 64 * (j))
#define XB_XGEN(j)  (2304 + 64 * (j))
#define XB_TOP      3328
#define XB_TOPGEN   3392
#define XCD_BAR_WORDS 3456
#define XB_SPIN_CAP (1u << 18)
#define LAS __attribute__((address_space(3)))

__device__ __forceinline__ unsigned xb_ld(unsigned* p)              { return __hip_atomic_load(p, __ATOMIC_RELAXED, __HIP_MEMORY_SCOPE_AGENT); }
__device__ __forceinline__ unsigned xb_add(unsigned* p, unsigned v) { return __hip_atomic_fetch_add(p, v, __ATOMIC_RELAXED, __HIP_MEMORY_SCOPE_AGENT); }
__device__ __forceinline__ unsigned xb_xcc_id() { return (unsigned)__builtin_amdgcn_s_getreg((3 << 11) | 20) & 0xFu; }
#define XB_SPIN(cond, bar) do { unsigned _sp = 0; while (cond) { __builtin_amdgcn_s_sleep(1); \
    if ((++_sp & 255u) == 0u) { if (xb_ld(&(bar)[XB_TMO])) break; if (_sp > XB_SPIN_CAP) { atomicAdd(&(bar)[XB_TMO], 1u); break; } } } } while (0)

struct XcdBarrier {
    unsigned* bar; unsigned x;
    volatile LAS unsigned* st;
};

__device__ __forceinline__ XcdBarrier xcd_barrier_post(unsigned* bar, volatile LAS unsigned* st) {
    XcdBarrier b; b.bar = bar; b.x = xb_xcc_id(); b.st = st;
    if (threadIdx.x == 0) (void)xb_add(&bar[XB_XCNT(b.x)], 1u);
    return b;
}
__device__ __forceinline__ void xcd_barrier_complete(unsigned* bar, unsigned x, unsigned& nloc, unsigned& nx) {
    const unsigned G = gridDim.x * gridDim.y * gridDim.z;
    unsigned sum, cnt, mine, sp = 0u;
    for (;;) {
        sum = 0u; cnt = 0u; mine = 0u;
#pragma unroll
        for (unsigned j = 0; j < 16; ++j) { const unsigned c = xb_ld(&bar[XB_XCNT(j)]); sum += c; cnt += (c > 0u) ? 1u : 0u; mine = (j == x) ? c : mine; }
        if (sum == G) break;
        __builtin_amdgcn_s_sleep(1);
        if ((++sp & 255u) == 0u) { if (xb_ld(&bar[XB_TMO])) break; if (sp > XB_SPIN_CAP) { atomicAdd(&bar[XB_TMO], 1u); break; } }
    }
    nloc = mine > 0u ? mine : 1u; nx = cnt > 0u ? cnt : 1u;
}

__device__ __forceinline__ void xcd_barrier(const XcdBarrier& b) {
    asm volatile("s_waitcnt vmcnt(0)" ::: "memory");
    __syncthreads();
    if (threadIdx.x == 0) {
        unsigned* bar = b.bar;
        __builtin_amdgcn_s_waitcnt(0);
        unsigned nloc = b.st[0], nx = b.st[1];
        if (nloc == 0u) { xcd_barrier_complete(bar, b.x, nloc, nx); b.st[0] = nloc; b.st[1] = nx; }
        const unsigned old = xb_add(&bar[XB_XSUB(b.x)], 1u);
        const unsigned gen = old / nloc;
        if (old + 1u == (gen + 1u) * nloc) {
            __builtin_amdgcn_fence(__ATOMIC_RELEASE, "agent");
            asm volatile("s_waitcnt vmcnt(0)" ::: "memory");
            const unsigned og = xb_add(&bar[XB_TOP], 1u);
            const unsigned tg = og / nx;
            if (og + 1u == (tg + 1u) * nx) xb_add(&bar[XB_TOPGEN], 1u);
            else XB_SPIN(xb_ld(&bar[XB_TOPGEN]) == tg, bar);
            __builtin_amdgcn_fence(__ATOMIC_ACQUIRE, "agent");
            xb_add(&bar[XB_XGEN(b.x)], 1u);
            asm volatile("s_waitcnt vmcnt(0)" ::: "memory");
        } else {
            XB_SPIN(xb_ld(&bar[XB_XGEN(b.x)]) == gen, bar);
            __builtin_amdgcn_fence(__ATOMIC_ACQUIRE, "agent");
            asm volatile("s_waitcnt vmcnt(0)" ::: "memory");
        }
    }
    __syncthreads();
}
constexpr int MP = 16384, MS = 32, MR = MP + MS, MPAD = 16640;
constexpr int SEQ = 2048, NB = 8, NH = 8, DM = 1024;
constexpr int QKVW = 3072, NIN = 7424;
constexpr int PAST = 16384, NPAGE = 128, PAGE = 128, LATW = 576;
constexpr float EPS = 1e-6f;
constexpr float MLA_SCALE = 0.07216878364870322f;

constexpr size_t O_YP = 0, O_YS = O_YP + (size_t)MP * 1024, O_ROWSP = O_YS + 32 * 1024, O_GSP = O_ROWSP + (size_t)MP * 576,
                 O_CSP = O_GSP + 8 * 8 * 128 * 128, O_ROWSS = O_CSP + 8 * 3 * 3072, O_GSS = O_ROWSS + 32 * 576, O_CSS = O_GSS + (size_t)32 * 8 * 128 * 128;

constexpr size_t WS_CTL = 0, CTL_BYTES = 1u << 20;
constexpr size_t WS_WIN = CTL_BYTES;
constexpr size_t WS_WQ  = WS_WIN + (size_t)NIN * 1024 * 2;
constexpr size_t WS_WKV = WS_WQ + (size_t)1536 * 512 * 2;
constexpr size_t WS_WYA = WS_WKV + (size_t)2048 * 512 * 2;
constexpr size_t WS_WYB = WS_WYA + (size_t)1024 * 1024 * 2;
constexpr size_t WS_WO  = WS_WYB + (size_t)1024 * 1024 * 2;
constexpr size_t WS_WUP = WS_WO + (size_t)1024 * 1024 * 2;
constexpr size_t WS_WDN = WS_WUP + (size_t)4096 * 1024 * 2;
constexpr size_t WS_XN  = WS_WDN + (size_t)4096 * 1024 * 2;
constexpr size_t WS_QKV = WS_XN + (size_t)MPAD * 1024 * 2;
constexpr size_t WS_Z   = WS_QKV + (size_t)MPAD * 3072 * 2;
constexpr size_t WS_QD  = WS_Z + (size_t)MPAD * 1024 * 2;
constexpr size_t WS_KVD = WS_QD + (size_t)MPAD * 512 * 2;
constexpr size_t WS_SM  = WS_KVD + (size_t)MPAD * 512 * 2;
constexpr size_t WS_GATES = WS_SM + (size_t)MPAD * 128 * 4;
constexpr size_t WS_C   = WS_GATES + (size_t)MPAD * 2048 * 2;
constexpr size_t WS_KR  = WS_C + (size_t)MPAD * 512 * 2;
constexpr size_t WS_BETA = WS_KR + (size_t)MPAD * 64 * 2;
constexpr size_t WS_GLOG = WS_BETA + (size_t)MPAD * 8 * 4;
constexpr size_t WS_QP  = WS_GLOG + (size_t)MPAD * 8 * 4;
constexpr size_t WS_QP2 = WS_QP + (size_t)MPAD * 1536 * 2;
constexpr size_t WS_KN  = WS_QP2 + (size_t)MPAD * 1536 * 2;
constexpr size_t WS_V   = WS_KN + (size_t)MPAD * 1024 * 2;
constexpr size_t WS_YA  = WS_V + (size_t)MPAD * 1024 * 2;
constexpr size_t WS_YB  = WS_YA + (size_t)MPAD * 1024 * 2;
constexpr size_t WS_TF  = WS_YB + (size_t)MPAD * 1024 * 2;
constexpr size_t WS_T   = WS_TF + (size_t)MPAD * 1024 * 4;
constexpr size_t WS_X1  = WS_T + (size_t)MPAD * 1024 * 2;
constexpr size_t WS_XN2 = WS_X1 + (size_t)MPAD * 1024 * 4;
constexpr size_t WS_H   = WS_XN2 + (size_t)MPAD * 1024 * 2;
constexpr size_t WS_GU0 = WS_H + (size_t)MPAD * 4096 * 2;
constexpr size_t WS_GW  = WS_GU0 + (size_t)2048 * 64 * 128 * 4;
constexpr size_t WS_GQG = WS_GW + (size_t)2048 * 64 * 128 * 2;
constexpr size_t WS_GKD = WS_GQG + (size_t)2048 * 64 * 128 * 2;
constexpr size_t WS_GAQK = WS_GKD + (size_t)2048 * 64 * 128 * 2;
constexpr size_t WS_GEND = WS_GAQK + (size_t)2048 * 64 * 64 * 2;
constexpr size_t WS_DML = WS_GEND + (size_t)2048 * 4 * 64;
constexpr size_t WS_DACC = WS_DML + (size_t)4096 * 8 * 2 * 4;
constexpr size_t WS_WKT = WS_DACC + (size_t)4096 * 8 * 512 * 4;
constexpr size_t WS_END = WS_WKT + (size_t)1024 * 512 * 2;

constexpr int LDS_BYTES = 163840;
constexpr int MISC_OFF = LDS_BYTES - 128;

#define GAS __attribute__((address_space(1)))
typedef unsigned short bf16;
typedef unsigned v4u __attribute__((ext_vector_type(4)));
typedef unsigned v2u __attribute__((ext_vector_type(2)));
typedef float f32x4 __attribute__((ext_vector_type(4)));
typedef float f32x16 __attribute__((ext_vector_type(16)));
typedef short bf16x8 __attribute__((ext_vector_type(8)));
#define LDS_WAIT() asm volatile("s_waitcnt lgkmcnt(0)" ::: "memory")
#define VM_WAIT() asm volatile("s_waitcnt vmcnt(0)" ::: "memory")
__device__ __forceinline__ float bf2f(unsigned b) { return __builtin_bit_cast(float, b << 16); }
__device__ __forceinline__ unsigned f2bf(float f) { unsigned u = __builtin_bit_cast(unsigned, f); return (u + 0x7fffu + ((u >> 16) & 1u)) >> 16; }
__device__ __forceinline__ unsigned pk2(float lo, float hi) { return f2bf(lo) | (f2bf(hi) << 16); }
__device__ __forceinline__ float lo16(unsigned w) { return __builtin_bit_cast(float, w << 16); }
__device__ __forceinline__ float hi16(unsigned w) { return __builtin_bit_cast(float, w & 0xffff0000u); }
__device__ __forceinline__ float wave_sum(float v) {
#pragma unroll
    for (int o = 1; o < 64; o <<= 1) v += __shfl_xor(v, o);
    return v;
}
__device__ __forceinline__ float wave_max(float v) {
#pragma unroll
    for (int o = 1; o < 64; o <<= 1) v = fmaxf(v, __shfl_xor(v, o));
    return v;
}
__device__ __forceinline__ float sigmoidf_(float x) { return 1.f / (1.f + __expf(-x)); }
__device__ __forceinline__ float siluf_(float x) { return x / (1.f + __expf(-x)); }

__constant__ float ROPE_INV[32] = {1.000000000e+00f,7.498942614e-01f,5.623413324e-01f,4.216965139e-01f,3.162277639e-01f,2.371373773e-01f,1.778279394e-01f,1.333521307e-01f,
    1.000000015e-01f,7.498941571e-02f,5.623413250e-02f,4.216965288e-02f,3.162277490e-02f,2.371373773e-02f,1.778279431e-02f,1.333521493e-02f,
    9.999999776e-03f,7.498941850e-03f,5.623413250e-03f,4.216964822e-03f,3.162277630e-03f,2.371373586e-03f,1.778279431e-03f,1.333521446e-03f,
    1.000000047e-03f,7.498942432e-04f,5.623413017e-04f,4.216965172e-04f,3.162277571e-04f,2.371373703e-04f,1.778279402e-04f,1.333521504e-04f};

struct Args { const float* in[27]; float* out; unsigned char* ws; int ph_lo, ph_hi; };
enum { I_XP = 0, I_XS, I_CACHE, I_SGDN, I_SCONV, I_PT, I_NMIX, I_WIN, I_CONVW, I_ALOG, I_DTB, I_GDNN, I_QAN, I_WUQ, I_KVAN, I_WUK, I_WUV,
       I_QNN, I_QNR, I_KNN, I_KNR, I_WYA, I_WYB, I_WO, I_NMLP, I_WUP, I_WDN };

__device__ __forceinline__ int src_col(int mode, int n) {
    if (mode == 0) {
        if (n < 4096) return n;
        if (n < 5184) return n + 16;
        if (n < 5200) return n - 5184 + 4096;
        if (n < 5376) return -1;
        return n - 5376 + 5200;
    }
    if (mode == 1) {
        if (n < 1024) return (n >> 7) * 192 + (n & 127);
        const int m = n - 1024; return (m >> 6) * 192 + 128 + (m & 63);
    }
    return n;
}
__device__ __forceinline__ void cvt_item(const float* W, int N, int K, bf16* WT, int row_off, int mode, LAS float* scr, int item, int nblk, int lane) {
    const int kb = item / nblk, nb = item % nblk, k0 = 64 * kb, n0 = 32 * nb;
    const int sc = src_col(mode, n0 + (lane & 31));
#pragma unroll 8
    for (int i = 0; i < 32; ++i) { const int kk = 2 * i + (lane >> 5); scr[kk * 33 + (lane & 31)] = sc >= 0 ? W[(size_t)(k0 + kk) * N + sc] : 0.f; }
    LDS_WAIT(); asm volatile("" ::: "memory");
    const int c = lane & 7;
#pragma unroll
    for (int j = 0; j < 4; ++j) { const int n = (lane >> 3) + 8 * j; const LAS float* s = scr + (8 * c) * 33 + n;
        v4u o; o.x = pk2(s[0 * 33], s[1 * 33]); o.y = pk2(s[2 * 33], s[3 * 33]); o.z = pk2(s[4 * 33], s[5 * 33]); o.w = pk2(s[6 * 33], s[7 * 33]);
        *(v4u*)(WT + (size_t)(row_off + n0 + n) * K + k0 + 8 * c) = o; }
    LDS_WAIT(); asm volatile("" ::: "memory");
}
__device__ __forceinline__ void rms_row_to_bf16(const float* xrow, const float* gain, bf16* orow, int lane) {
    const f32x4* xr = (const f32x4*)xrow + lane; const f32x4* gr = (const f32x4*)gain + lane;
    f32x4 v[4]; float s = 0.f;
#pragma unroll
    for (int j = 0; j < 4; ++j) { v[j] = xr[64 * j]; s += (v[j].x * v[j].x + v[j].y * v[j].y) + (v[j].z * v[j].z + v[j].w * v[j].w); }
    const float r = 1.f / sqrtf(wave_sum(s) * (1.f / 1024.f) + EPS);
    unsigned long long* o8 = (unsigned long long*)orow + lane;
#pragma unroll
    for (int j = 0; j < 4; ++j) { const f32x4 g = gr[64 * j];
        o8[64 * j] = (unsigned long long)pk2(v[j].x * r * g.x, v[j].y * r * g.y) | ((unsigned long long)pk2(v[j].z * r * g.z, v[j].w * r * g.w) << 32); }
}
__device__ __forceinline__ void p0_prologue(const Args& A, LAS unsigned char* lds, int gw, int NGW, int wave, int lane) {
    LAS float* scr = (LAS float*)(lds + wave * 16384);
    unsigned char* ws = A.ws;
    constexpr int I0 = 16 * (NIN / 32), I1 = 8 * (1536 / 32), I2 = 8 * 32, I3 = 8 * 32, I4 = 16 * 32, I5 = I4, I6 = I4, I7 = 16 * 128, I8 = 64 * 32;
    constexpr int NITEMS = I0 + I1 + I2 + I3 + I4 + I5 + I6 + I7 + I8;
    for (int it = gw; it < NITEMS; it += NGW) {
        int r = it;
        if (r < I0) { cvt_item(A.in[I_WIN], 7248, 1024, (bf16*)(ws + WS_WIN), 0, 0, scr, r, NIN / 32, lane); continue; } r -= I0;
        if (r < I1) { cvt_item(A.in[I_WUQ], 1536, 512, (bf16*)(ws + WS_WQ), 0, 1, scr, r, 1536 / 32, lane); continue; } r -= I1;
        if (r < I2) { cvt_item(A.in[I_WUK], 1024, 512, (bf16*)(ws + WS_WKV), 0, 2, scr, r, 32, lane); continue; } r -= I2;
        if (r < I3) { cvt_item(A.in[I_WUV], 1024, 512, (bf16*)(ws + WS_WKV), 1024, 2, scr, r, 32, lane); continue; } r -= I3;
        if (r < I4) { cvt_item(A.in[I_WYA], 1024, 1024, (bf16*)(ws + WS_WYA), 0, 2, scr, r, 32, lane); continue; } r -= I4;
        if (r < I5) { cvt_item(A.in[I_WYB], 1024, 1024, (bf16*)(ws + WS_WYB), 0, 2, scr, r, 32, lane); continue; } r -= I5;
        if (r < I6) { cvt_item(A.in[I_WO], 1024, 1024, (bf16*)(ws + WS_WO), 0, 2, scr, r, 32, lane); continue; } r -= I6;
        if (r < I7) { cvt_item(A.in[I_WUP], 4096, 1024, (bf16*)(ws + WS_WUP), 0, 2, scr, r, 128, lane); continue; } r -= I7;
        cvt_item(A.in[I_WDN], 1024, 4096, (bf16*)(ws + WS_WDN), 0, 2, scr, r, 32, lane);
    }
    bf16* XN = (bf16*)(ws + WS_XN);
    for (int m = gw; m < MPAD; m += NGW) {
        if (m < MR) rms_row_to_bf16(m < MP ? A.in[I_XP] + (size_t)m * 1024 : A.in[I_XS] + (size_t)(m - MP) * 1024, A.in[I_NMIX], XN + (size_t)m * 1024, lane);
        else { v4u z = {0u, 0u, 0u, 0u}; *((v4u*)(XN + (size_t)m * 1024) + lane) = z; *((v4u*)(XN + (size_t)m * 1024) + 64 + lane) = z; }
    }
}

struct EpiG1 {
    static constexpr bool PERM = true, AFTER_DRAIN = false;
    bf16 *QKV, *Z, *QD, *KVD, *GATES; float* SM;
    __device__ __forceinline__ void operator()(const pg8::f32x4 (&acc)[2][2][4][2], const pg8::Unit& u, int wr, int wc, int fr, int fq) const {
        const int row0 = u.pm * 256 + wr * 64 + fr, pn = u.pn, cl = wc * 32 + 8 * fq;
        if (pn == 20) {
#pragma unroll
            for (int ai = 0; ai < 2; ++ai)
#pragma unroll
                for (int m = 0; m < 4; ++m) { float* rowp = SM + (size_t)(row0 + ai * 128 + m * 16) * 128 + cl;
                    *(pg8::f32x4*)rowp = acc[ai][0][m][0]; *(pg8::f32x4*)(rowp + 4) = acc[ai][0][m][1]; }
            return;
        }
        bf16* base; int ld; bool sg = false;
        if (pn < 12) { base = QKV + pn * 256; ld = 3072; }
        else if (pn < 16) { base = Z + (pn - 12) * 256; ld = 1024; }
        else if (pn < 18) { base = QD + (pn - 16) * 256; ld = 512; }
        else if (pn < 20) { base = KVD + (pn - 18) * 256; ld = 512; }
        else { base = GATES + (pn - 21) * 256; ld = 2048; sg = true; }
#pragma unroll
        for (int ai = 0; ai < 2; ++ai)
#pragma unroll
            for (int m = 0; m < 4; ++m) { bf16* rowp = base + (size_t)(row0 + ai * 128 + m * 16) * ld + cl;
#pragma unroll
                for (int bj = 0; bj < 2; ++bj) { pg8::f32x4 v0 = acc[ai][bj][m][0], v1 = acc[ai][bj][m][1];
                    if (sg) { v0 = (pg8::f32x4){sigmoidf_(v0[0]), sigmoidf_(v0[1]), sigmoidf_(v0[2]), sigmoidf_(v0[3])}; v1 = (pg8::f32x4){sigmoidf_(v1[0]), sigmoidf_(v1[1]), sigmoidf_(v1[2]), sigmoidf_(v1[3])}; }
                    pg8::u32x4 w; w.x = pg8::cvt_pk_bf16(v0[0], v0[1]); w.y = pg8::cvt_pk_bf16(v0[2], v0[3]); w.z = pg8::cvt_pk_bf16(v1[0], v1[1]); w.w = pg8::cvt_pk_bf16(v1[2], v1[3]);
                    *(pg8::u32x4*)(rowp + bj * 128) = w; } }
    }
};

__device__ __forceinline__ void p2_rows(const Args& A, int gw, int NGW, int lane) {
    unsigned char* ws = A.ws;
    bf16* QD = (bf16*)(ws + WS_QD); const bf16* KVD = (const bf16*)(ws + WS_KVD); const float* SM = (const float*)(ws + WS_SM);
    bf16* C = (bf16*)(ws + WS_C); bf16* KR = (bf16*)(ws + WS_KR); float* BETA = (float*)(ws + WS_BETA); float* GLOG = (float*)(ws + WS_GLOG);
    for (int m = gw; m < MR; m += NGW) {
        const int pos = m < MP ? (m & (SEQ - 1)) : PAST;
        float* lat = m < MP ? A.out + O_ROWSP + (size_t)m * LATW : A.out + O_ROWSS + (size_t)(m - MP) * LATW;
        {
            v4u w = *((const v4u*)(QD + (size_t)m * 512) + lane);
            float v[8] = {lo16(w.x), hi16(w.x), lo16(w.y), hi16(w.y), lo16(w.z), hi16(w.z), lo16(w.w), hi16(w.w)};
            float s = 0.f;
#pragma unroll
            for (int i = 0; i < 8; ++i) s += v[i] * v[i];
            const float r = 1.f / sqrtf(wave_sum(s) * (1.f / 512.f) + EPS);
            const f32x4 g0 = *((const f32x4*)A.in[I_QAN] + 2 * lane), g1 = *((const f32x4*)A.in[I_QAN] + 2 * lane + 1);
            v4u o; o.x = pk2(v[0] * r * g0.x, v[1] * r * g0.y); o.y = pk2(v[2] * r * g0.z, v[3] * r * g0.w); o.z = pk2(v[4] * r * g1.x, v[5] * r * g1.y); o.w = pk2(v[6] * r * g1.z, v[7] * r * g1.w);
            *((v4u*)(QD + (size_t)m * 512) + lane) = o;
        }
        {
            v4u w = *((const v4u*)(KVD + (size_t)m * 512) + lane);
            float v[8] = {lo16(w.x), hi16(w.x), lo16(w.y), hi16(w.y), lo16(w.z), hi16(w.z), lo16(w.w), hi16(w.w)};
            float s = 0.f;
#pragma unroll
            for (int i = 0; i < 8; ++i) s += v[i] * v[i];
            const float r = 1.f / sqrtf(wave_sum(s) * (1.f / 512.f) + EPS);
            const f32x4 g0 = *((const f32x4*)A.in[I_KVAN] + 2 * lane), g1 = *((const f32x4*)A.in[I_KVAN] + 2 * lane + 1);
            f32x4 c0 = {v[0] * r * g0.x, v[1] * r * g0.y, v[2] * r * g0.z, v[3] * r * g0.w}, c1 = {v[4] * r * g1.x, v[5] * r * g1.y, v[6] * r * g1.z, v[7] * r * g1.w};
            *((f32x4*)lat + 2 * lane) = c0; *((f32x4*)lat + 2 * lane + 1) = c1;
            v4u o; o.x = pk2(c0.x, c0.y); o.y = pk2(c0.z, c0.w); o.z = pk2(c1.x, c1.y); o.w = pk2(c1.z, c1.w);
            *((v4u*)(C + (size_t)m * 512) + lane) = o;
        }
        {
            const float x = SM[(size_t)m * 128 + lane];
            const float r = 1.f / sqrtf(wave_sum(x * x) * (1.f / 64.f) + EPS);
            const float xr = x * r * A.in[I_KNR][lane];
            const float other = __shfl_xor(xr, 32);
            const float ang = (float)pos * ROPE_INV[lane & 31];
            const float cs = cosf(ang), sn = sinf(ang);
            const float o = lane < 32 ? xr * cs - other * sn : other * sn + xr * cs;
            lat[512 + lane] = o;
            KR[(size_t)m * 64 + lane] = (bf16)f2bf(o);
        }
        if (lane < 8) {
            const float b = SM[(size_t)m * 128 + 64 + lane], a = SM[(size_t)m * 128 + 72 + lane];
            BETA[(size_t)m * 8 + lane] = 1.f / (1.f + expf(-b));
            const float xx = a + A.in[I_DTB][lane];
            const float sp = fmaxf(xx, 0.f) + log1pf(expf(-fabsf(xx)));
            GLOG[(size_t)m * 8 + lane] = -expf(A.in[I_ALOG][lane]) * sp;
        }
    }
}
__device__ __forceinline__ void p2_conv_state(const Args& A, int gtid, int NGT) {
    const bf16* QKV = (const bf16*)(A.ws + WS_QKV);
    {
        const bf16* WKV = (const bf16*)(A.ws + WS_WKV); bf16* WKT = (bf16*)(A.ws + WS_WKT);
        for (int c = gtid; c < 65536; c += NGT) { const int blk = c >> 6, l = c & 63, rt = blk >> 5, ks = blk & 31;
            *(v4u*)(WKT + (size_t)c * 8) = *(const v4u*)(WKV + (size_t)(rt * 32 + (l & 31)) * 512 + 16 * ks + 8 * (l >> 5)); }
    }
    for (int i = gtid; i < 8 * 3 * 3072; i += NGT) { const int c = i % 3072, r = (i / 3072) % 3, b = i / (3 * 3072);
        A.out[O_CSP + i] = bf2f(QKV[(size_t)(b * SEQ + SEQ - 3 + r) * 3072 + c]); }
    for (int i = gtid; i < 32 * 3 * 3072; i += NGT) { const int c = i % 3072, r = (i / 3072) % 3, j = i / (3 * 3072);
        A.out[O_CSS + i] = r < 2 ? A.in[I_SCONV][(size_t)(j * 3 + r + 1) * 3072 + c] : bf2f(QKV[(size_t)(MP + j) * 3072 + c]); }
}
__device__ __forceinline__ pg8::u32x4 pack8(const pg8::f32x4& v0, const pg8::f32x4& v1) {
    pg8::u32x4 w; w.x = pg8::cvt_pk_bf16(v0[0], v0[1]); w.y = pg8::cvt_pk_bf16(v0[2], v0[3]); w.z = pg8::cvt_pk_bf16(v1[0], v1[1]); w.w = pg8::cvt_pk_bf16(v1[2], v1[3]); return w;
}
template <int ACT> struct EpiStore {
    static constexpr bool PERM = true, AFTER_DRAIN = false;
    bf16* O0; int ld0; int split; bf16* O1; int ld1;
    __device__ __forceinline__ void operator()(const pg8::f32x4 (&acc)[2][2][4][2], const pg8::Unit& u, int wr, int wc, int fr, int fq) const {
        const int row0 = u.pm * 256 + wr * 64 + fr, cl = wc * 32 + 8 * fq;
        bf16* base; int ld;
        if (u.pn < split) { base = O0 + u.pn * 256; ld = ld0; } else { base = O1 + (u.pn - split) * 256; ld = ld1; }
#pragma unroll
        for (int ai = 0; ai < 2; ++ai)
#pragma unroll
            for (int m = 0; m < 4; ++m) { bf16* rowp = base + (size_t)(row0 + ai * 128 + m * 16) * ld + cl;
#pragma unroll
                for (int bj = 0; bj < 2; ++bj) { pg8::f32x4 v0 = acc[ai][bj][m][0], v1 = acc[ai][bj][m][1];
                    if (ACT == 1) {
#pragma unroll
                        for (int e = 0; e < 4; ++e) { const float a = fmaxf(v0[e], 0.f), b = fmaxf(v1[e], 0.f); v0[e] = a * a; v1[e] = b * b; } }
                    *(pg8::u32x4*)(rowp + bj * 128) = pack8(v0, v1); } }
    }
};
template <int STEP> struct EpiMerge {
    static constexpr bool PERM = true, AFTER_DRAIN = false;
    const bf16* GATES; float* TF; bf16* T;
    __device__ __forceinline__ void operator()(const pg8::f32x4 (&acc)[2][2][4][2], const pg8::Unit& u, int wr, int wc, int fr, int fq) const {
        const int row0 = u.pm * 256 + wr * 64 + fr, c0 = u.pn * 256 + wc * 32 + 8 * fq;
#pragma unroll
        for (int ai = 0; ai < 2; ++ai)
#pragma unroll
            for (int m = 0; m < 4; ++m) { const size_t row = (size_t)(row0 + ai * 128 + m * 16);
#pragma unroll
                for (int bj = 0; bj < 2; ++bj) { const int col = c0 + bj * 128;
                    const v4u gw = *(const v4u*)(GATES + row * 2048 + (STEP == 1 ? 0 : 1024) + col);
                    const float g[8] = {lo16(gw.x), hi16(gw.x), lo16(gw.y), hi16(gw.y), lo16(gw.z), hi16(gw.z), lo16(gw.w), hi16(gw.w)};
                    pg8::f32x4 v0 = acc[ai][bj][m][0], v1 = acc[ai][bj][m][1];
#pragma unroll
                    for (int e = 0; e < 4; ++e) { v0[e] *= g[e]; v1[e] *= g[4 + e]; }
                    float* tp = TF + row * 1024 + col;
                    if (STEP == 1) { *(pg8::f32x4*)tp = v0; *(pg8::f32x4*)(tp + 4) = v1; }
                    else { v0 += *(const pg8::f32x4*)tp; v1 += *(const pg8::f32x4*)(tp + 4); *(pg8::u32x4*)(T + row * 1024 + col) = pack8(v0, v1); } } }
    }
};
template <int MODE> struct EpiRes {
    static constexpr bool PERM = true, AFTER_DRAIN = false;
    const float *XPp, *XSp; float* X1; float* out;
    __device__ __forceinline__ void operator()(const pg8::f32x4 (&acc)[2][2][4][2], const pg8::Unit& u, int wr, int wc, int fr, int fq) const {
        const int row0 = u.pm * 256 + wr * 64 + fr, c0 = u.pn * 256 + wc * 32 + 8 * fq;
#pragma unroll
        for (int ai = 0; ai < 2; ++ai)
#pragma unroll
            for (int m = 0; m < 4; ++m) { const int row = row0 + ai * 128 + m * 16;
                if (row >= MR) continue;
#pragma unroll
                for (int bj = 0; bj < 2; ++bj) { const int col = c0 + bj * 128;
                    const float* src; float* dst;
                    if (MODE == 0) { src = row < MP ? XPp + (size_t)row * 1024 + col : XSp + (size_t)(row - MP) * 1024 + col; dst = X1 + (size_t)row * 1024 + col; }
                    else { src = X1 + (size_t)row * 1024 + col; dst = row < MP ? out + O_YP + (size_t)row * 1024 + col : out + O_YS + (size_t)(row - MP) * 1024 + col; }
                    *(pg8::f32x4*)dst = acc[ai][bj][m][0] + *(const pg8::f32x4*)src; *(pg8::f32x4*)(dst + 4) = acc[ai][bj][m][1] + *(const pg8::f32x4*)(src + 4); } }
    }
};

#define MFMA32(a, b, c) __builtin_amdgcn_mfma_f32_32x32x16_bf16((a), (b), (c), 0, 0, 0)
__device__ __forceinline__ int crow(int r, int hi) { return (r & 3) + 8 * (r >> 2) + 4 * hi; }
__device__ __forceinline__ bf16x8 lds_ld8(LAS const unsigned char* p) { return *(LAS const bf16x8*)p; }
__device__ __forceinline__ bf16x8 gl_ld8(const bf16* p) { return *(const bf16x8*)p; }

constexpr int GA_QH = 0, GA_KH = 17408, GA_KBH = 34816, GA_VBT = 52224, GA_KBGT = 70656, GA_KDT = 89088, GA_LF = 107520, GA_TB = 123904, GA_GS = 133120, GA_BS = 133376;
__device__ __forceinline__ void gdn_a_unit(const Args& A, LAS unsigned char* lds, int unit, int tid, int lane, int wave) {
    unsigned char* ws = A.ws;
    const int b = unit >> 8, h = (unit >> 5) & 7, n = unit & 31;
    const int row0 = b * SEQ + n * 64;
    const bf16* QKV = (const bf16*)(ws + WS_QKV);
    LAS float* Gs = (LAS float*)(lds + GA_GS); LAS float* Bs = (LAS float*)(lds + GA_BS);
    if (wave == 0) {
        float x = ((const float*)(ws + WS_GLOG))[(size_t)(row0 + lane) * 8 + h];
#pragma unroll
        for (int o = 1; o < 64; o <<= 1) { const float y = __shfl_up(x, o); if (lane >= o) x += y; }
        Gs[lane] = x; Bs[lane] = ((const float*)(ws + WS_BETA))[(size_t)(row0 + lane) * 8 + h];
    }
    __syncthreads();
    const float Gend = Gs[63];
    {
        const int cg = tid & 15, rr = tid >> 4;
        bf16* GQG = (bf16*)(ws + WS_GQG) + (size_t)unit * 8192;
#pragma unroll 1
        for (int part = 0; part < 3; ++part) {
            const int colb = part * 1024 + h * 128 + 8 * cg;
            float wgt[4][8];
#pragma unroll
            for (int tap = 0; tap < 4; ++tap) { const f32x4 w0 = *(const f32x4*)(A.in[I_CONVW] + tap * 3072 + colb), w1 = *(const f32x4*)(A.in[I_CONVW] + tap * 3072 + colb + 4);
                wgt[tap][0] = w0.x; wgt[tap][1] = w0.y; wgt[tap][2] = w0.z; wgt[tap][3] = w0.w; wgt[tap][4] = w1.x; wgt[tap][5] = w1.y; wgt[tap][6] = w1.z; wgt[tap][7] = w1.w; }
#pragma unroll
            for (int ri = 0; ri < 2; ++ri) {
                const int i = rr + 32 * ri, tl = n * 64 + i;
                float y[8];
#pragma unroll
                for (int e = 0; e < 8; ++e) y[e] = 0.f;
#pragma unroll
                for (int tap = 0; tap < 4; ++tap) { const int tt = tl - 3 + tap;
                    if (tt >= 0) { const v4u w = *(const v4u*)(QKV + (size_t)(b * SEQ + tt) * 3072 + colb);
                        const float x[8] = {lo16(w.x), hi16(w.x), lo16(w.y), hi16(w.y), lo16(w.z), hi16(w.z), lo16(w.w), hi16(w.w)};
#pragma unroll
                        for (int e = 0; e < 8; ++e) y[e] += wgt[tap][e] * x[e]; } }
                float ss = 0.f;
#pragma unroll
                for (int e = 0; e < 8; ++e) { y[e] = siluf_(y[e]); ss += y[e] * y[e]; }
                ss += __shfl_xor(ss, 1); ss += __shfl_xor(ss, 2); ss += __shfl_xor(ss, 4); ss += __shfl_xor(ss, 8);
                const float rs = 1.f / sqrtf(ss + EPS), beta = Bs[i], eg = __expf(Gs[i]), ed = __expf(Gend - Gs[i]);
                if (part == 0) {
                    float q[8];
#pragma unroll
                    for (int e = 0; e < 8; ++e) q[e] = y[e] * rs * 0.08838834764831845f;
                    v4u o; o.x = pk2(q[0], q[1]); o.y = pk2(q[2], q[3]); o.z = pk2(q[4], q[5]); o.w = pk2(q[6], q[7]);
                    *(LAS v4u*)(lds + GA_QH + i * 272 + cg * 16) = o;
                    v4u g; g.x = pk2(q[0] * eg, q[1] * eg); g.y = pk2(q[2] * eg, q[3] * eg); g.z = pk2(q[4] * eg, q[5] * eg); g.w = pk2(q[6] * eg, q[7] * eg);
                    *(v4u*)(GQG + i * 128 + 8 * cg) = g;
                } else if (part == 1) {
                    float k[8];
#pragma unroll
                    for (int e = 0; e < 8; ++e) k[e] = y[e] * rs;
                    v4u o; o.x = pk2(k[0], k[1]); o.y = pk2(k[2], k[3]); o.z = pk2(k[4], k[5]); o.w = pk2(k[6], k[7]);
                    *(LAS v4u*)(lds + GA_KH + i * 272 + cg * 16) = o;
                    v4u kb; kb.x = pk2(k[0] * beta, k[1] * beta); kb.y = pk2(k[2] * beta, k[3] * beta); kb.z = pk2(k[4] * beta, k[5] * beta); kb.w = pk2(k[6] * beta, k[7] * beta);
                    *(LAS v4u*)(lds + GA_KBH + i * 272 + cg * 16) = kb;
#pragma unroll
                    for (int e = 0; e < 8; ++e) { *(LAS bf16*)(lds + GA_KBGT + (8 * cg + e) * 144 + i * 2) = (bf16)f2bf(k[e] * beta * eg);
                        *(LAS bf16*)(lds + GA_KDT + (8 * cg + e) * 144 + i * 2) = (bf16)f2bf(k[e] * ed); }
                } else {
#pragma unroll
                    for (int e = 0; e < 8; ++e) *(LAS bf16*)(lds + GA_VBT + (8 * cg + e) * 144 + i * 2) = (bf16)f2bf(y[e] * beta);
                }
            }
        }
    }
    __syncthreads();
    const int l31 = lane & 31, hi = lane >> 5;
    {
        const int it = (wave >> 1) & 1, jt = wave & 1; const bool isL = wave < 4;
        f32x16 acc = {};
        if (it >= jt) {
            LAS const unsigned char* Ab = lds + (isL ? GA_KBH : GA_QH) + (32 * it + l31) * 272 + hi * 16;
            LAS const unsigned char* Bb = lds + GA_KH + (32 * jt + l31) * 272 + hi * 16;
#pragma unroll
            for (int ks = 0; ks < 8; ++ks) acc = MFMA32(lds_ld8(Ab + ks * 32), lds_ld8(Bb + ks * 32), acc);
        }
        const int j = 32 * jt + l31; const float Gj = Gs[j];
        bf16* AQ = (bf16*)(ws + WS_GAQK) + (size_t)unit * 4096;
#pragma unroll
        for (int r = 0; r < 16; ++r) { const int i = 32 * it + crow(r, hi);
            const float d = __expf(fminf(Gs[i] - Gj, 0.f));
            if (isL) ((LAS float*)(lds + GA_LF))[i * 64 + j] = (i > j) ? acc[r] * d : 0.f;
            else AQ[i * 64 + j] = (bf16)f2bf((i >= j) ? acc[r] * d : 0.f); }
    }
    __syncthreads();
    if (wave == 0) {
        float T[64];
        LAS const float* Lf = (LAS const float*)(lds + GA_LF);
#pragma unroll
        for (int i = 0; i < 64; ++i) {
            float a = (i == lane) ? 1.f : 0.f;
#pragma unroll
            for (int j4 = 0; j4 < (i + 3) / 4; ++j4) { const f32x4 l4 = *(LAS const f32x4*)(Lf + i * 64 + 4 * j4);
                if (4 * j4 + 0 < i) a -= l4.x * T[4 * j4 + 0];
                if (4 * j4 + 1 < i) a -= l4.y * T[4 * j4 + 1];
                if (4 * j4 + 2 < i) a -= l4.z * T[4 * j4 + 2];
                if (4 * j4 + 3 < i) a -= l4.w * T[4 * j4 + 3]; }
            T[i] = a;
            *(LAS bf16*)(lds + GA_TB + i * 144 + lane * 2) = (bf16)f2bf(a);
        }
    } else {
        bf16* GKD = (bf16*)(ws + WS_GKD) + (size_t)unit * 8192;
        for (int id = tid - 64; id < 1024; id += 448) { const int row = id >> 3, ch = id & 7;
            *(v4u*)(GKD + row * 64 + ch * 8) = *(LAS const v4u*)(lds + GA_KDT + row * 144 + ch * 16); }
    }
    __syncthreads();
    {
        const int nt = wave; LAS const unsigned char* Bb = lds + (nt < 4 ? GA_VBT : GA_KBGT) + (32 * (nt & 3) + l31) * 144 + hi * 16;
        float* GU0 = (float*)(ws + WS_GU0) + (size_t)unit * 8192; bf16* GW = (bf16*)(ws + WS_GW) + (size_t)unit * 8192;
#pragma unroll
        for (int it = 0; it < 2; ++it) {
            f32x16 acc = {};
            LAS const unsigned char* Ab = lds + GA_TB + (32 * it + l31) * 144 + hi * 16;
#pragma unroll
            for (int ks = 0; ks < 4; ++ks) if (ks < 2 * (it + 1)) acc = MFMA32(lds_ld8(Ab + ks * 32), lds_ld8(Bb + ks * 32), acc);
            const int col = 32 * (nt & 3) + l31;
#pragma unroll
            for (int r = 0; r < 16; ++r) { const int i = 32 * it + crow(r, hi);
                if (nt < 4) GU0[i * 128 + col] = acc[r]; else GW[i * 128 + col] = (bf16)f2bf(acc[r]); }
        }
        if (tid == 0) ((float*)(ws + WS_GEND))[unit] = __expf(Gend);
    }
    __syncthreads();
}

constexpr int GB_ST = 0, GB_UT = 34816, GB_OF = 53248;
__device__ __forceinline__ void gdn_b_unit(const Args& A, LAS unsigned char* lds, int bh, int tid, int lane, int wave) {
    unsigned char* ws = A.ws;
    const int b = bh >> 3, h = bh & 7, l31 = lane & 31, hi = lane >> 5;
    const int it = wave >> 2, vt = wave & 3;
    for (int i = tid; i < 34816 / 16; i += 512) *(LAS v4u*)(lds + GB_ST + i * 16) = (v4u){0u, 0u, 0u, 0u};
    f32x16 Sacc[2] = {};
    __syncthreads();
    const bf16* Zb = (const bf16*)(ws + WS_Z); bf16* YA = (bf16*)(ws + WS_YA);
    LAS const unsigned char* Sb = lds + GB_ST + (32 * vt + l31) * 272 + hi * 16;
    LAS const unsigned char* Ub = lds + GB_UT + (32 * vt + l31) * 144 + hi * 16;
#pragma unroll 1
    for (int n = 0; n < 32; ++n) {
        const int cu = bh * 32 + n, r0 = b * SEQ + 64 * n;
        const bf16* GW = (const bf16*)(ws + WS_GW) + (size_t)cu * 8192; const bf16* GQG = (const bf16*)(ws + WS_GQG) + (size_t)cu * 8192;
        const bf16* GKD = (const bf16*)(ws + WS_GKD) + (size_t)cu * 8192; const bf16* GAQ = (const bf16*)(ws + WS_GAQK) + (size_t)cu * 4096;
        const float* GU0 = (const float*)(ws + WS_GU0) + (size_t)cu * 8192; const float gend = ((const float*)(ws + WS_GEND))[cu];
        {
            f32x16 acc = {};
            const bf16* Ab = GW + (32 * it + l31) * 128 + 8 * hi;
#pragma unroll
            for (int ks = 0; ks < 8; ++ks) acc = MFMA32(gl_ld8(Ab + 16 * ks), lds_ld8(Sb + ks * 32), acc);
            float u[16];
#pragma unroll
            for (int r = 0; r < 16; ++r) u[r] = GU0[(32 * it + crow(r, hi)) * 128 + 32 * vt + l31] - acc[r];
#pragma unroll
            for (int g = 0; g < 4; ++g) { v2u w; w.x = pk2(u[4 * g], u[4 * g + 1]); w.y = pk2(u[4 * g + 2], u[4 * g + 3]);
                *(LAS v2u*)(lds + GB_UT + (32 * vt + l31) * 144 + (32 * it + 8 * g + 4 * hi) * 2) = w; }
        }
        __syncthreads();
        {
            f32x16 acc = {};
            const bf16* Ab = GQG + (32 * it + l31) * 128 + 8 * hi;
#pragma unroll
            for (int ks = 0; ks < 8; ++ks) acc = MFMA32(gl_ld8(Ab + 16 * ks), lds_ld8(Sb + ks * 32), acc);
            const bf16* Cb = GAQ + (32 * it + l31) * 64 + 8 * hi;
#pragma unroll
            for (int ks = 0; ks < 4; ++ks) if (ks < 2 * (it + 1)) acc = MFMA32(gl_ld8(Cb + 16 * ks), lds_ld8(Ub + ks * 32), acc);
#pragma unroll
            for (int r = 0; r < 16; ++r) ((LAS float*)(lds + GB_OF))[(32 * it + crow(r, hi)) * 132 + 32 * vt + l31] = acc[r];
        }
        __syncthreads();
        {
#pragma unroll
            for (int t = 0; t < 2; ++t) { const int kt = 2 * (wave >> 2) + t;
                Sacc[t] = Sacc[t] * gend;
                const bf16* Ab = GKD + (32 * kt + l31) * 64 + 8 * hi;
#pragma unroll
                for (int ks = 0; ks < 4; ++ks) Sacc[t] = MFMA32(gl_ld8(Ab + 16 * ks), lds_ld8(Ub + ks * 32), Sacc[t]);
#pragma unroll
                for (int g = 0; g < 4; ++g) { v2u w; w.x = pk2(Sacc[t][4 * g], Sacc[t][4 * g + 1]); w.y = pk2(Sacc[t][4 * g + 2], Sacc[t][4 * g + 3]);
                    *(LAS v2u*)(lds + GB_ST + (32 * vt + l31) * 272 + (32 * kt + 8 * g + 4 * hi) * 2) = w; }
            }
        }
        {
            const int i = tid >> 3, c0 = (tid & 7) * 16;
            LAS const float* orow = (LAS const float*)(lds + GB_OF) + i * 132 + c0;
            float o[16]; float ss = 0.f;
#pragma unroll
            for (int q = 0; q < 4; ++q) { const f32x4 v = *(LAS const f32x4*)(orow + 4 * q); o[4 * q] = v.x; o[4 * q + 1] = v.y; o[4 * q + 2] = v.z; o[4 * q + 3] = v.w; }
#pragma unroll
            for (int e = 0; e < 16; ++e) ss += o[e] * o[e];
            ss += __shfl_xor(ss, 1); ss += __shfl_xor(ss, 2); ss += __shfl_xor(ss, 4);
            const float r = 1.f / sqrtf(ss * (1.f / 128.f) + EPS);
            const size_t off = (size_t)(r0 + i) * 1024 + h * 128 + c0;
            const v4u z0 = *(const v4u*)(Zb + off), z1 = *(const v4u*)(Zb + off + 8);
            const float z[16] = {lo16(z0.x), hi16(z0.x), lo16(z0.y), hi16(z0.y), lo16(z0.z), hi16(z0.z), lo16(z0.w), hi16(z0.w),
                                 lo16(z1.x), hi16(z1.x), lo16(z1.y), hi16(z1.y), lo16(z1.z), hi16(z1.z), lo16(z1.w), hi16(z1.w)};
            float y[16];
#pragma unroll
            for (int e = 0; e < 16; ++e) y[e] = o[e] * r * A.in[I_GDNN][c0 + e] * siluf_(z[e]);
            v4u o0, o1; o0.x = pk2(y[0], y[1]); o0.y = pk2(y[2], y[3]); o0.z = pk2(y[4], y[5]); o0.w = pk2(y[6], y[7]);
            o1.x = pk2(y[8], y[9]); o1.y = pk2(y[10], y[11]); o1.z = pk2(y[12], y[13]); o1.w = pk2(y[14], y[15]);
            *(v4u*)(YA + off) = o0; *(v4u*)(YA + off + 8) = o1;
        }
        __syncthreads();
    }
    float* So = A.out + O_GSP + (size_t)bh * 16384;
#pragma unroll
    for (int t = 0; t < 2; ++t) { const int kt = 2 * (wave >> 2) + t;
#pragma unroll
        for (int r = 0; r < 16; ++r) So[(32 * kt + crow(r, hi)) * 128 + 32 * vt + l31] = Sacc[t][r]; }
    __syncthreads();
}

__device__ __forceinline__ void gdn_r_unit(const Args& A, LAS unsigned char* lds, int unit, int tid, int lane, int wave) {
    unsigned char* ws = A.ws;
    const int j = unit >> 3, h = unit & 7, row = MP + j;
    LAS float* qs = (LAS float*)lds; LAS float* ks = qs + 128; LAS float* vs = qs + 256; LAS float* red = qs + 384;
    LAS float* os = qs + 896;
    if (tid < 384) {
        const int part = tid >> 7, d = tid & 127, col = part * 1024 + h * 128 + d;
        const float* cw = A.in[I_CONVW]; const float* sc = A.in[I_SCONV] + (size_t)j * 3 * 3072;
        const float xn = bf2f(((const bf16*)(ws + WS_QKV))[(size_t)row * 3072 + col]);
        const float y = cw[col] * sc[col] + cw[3072 + col] * sc[3072 + col] + cw[2 * 3072 + col] * sc[2 * 3072 + col] + cw[3 * 3072 + col] * xn;
        qs[tid] = siluf_(y);
    }
    __syncthreads();
    const float rq = 1.f / sqrtf(wave_sum(qs[lane] * qs[lane] + qs[lane + 64] * qs[lane + 64]) + EPS) * 0.08838834764831845f;
    const float rk = 1.f / sqrtf(wave_sum(ks[lane] * ks[lane] + ks[lane + 64] * ks[lane + 64]) + EPS);
    const float beta = ((const float*)(ws + WS_BETA))[(size_t)row * 8 + h], eg = __expf(((const float*)(ws + WS_GLOG))[(size_t)row * 8 + h]);
    const int v = tid & 127, kq = tid >> 7;
    const float* S0 = A.in[I_SGDN] + (size_t)unit * 16384;
    float s[32]; float kv = 0.f;
#pragma unroll
    for (int i = 0; i < 32; ++i) { const int k = 32 * kq + i; s[i] = eg * S0[k * 128 + v]; kv += ks[k] * rk * s[i]; }
    red[kq * 128 + v] = kv;
    __syncthreads();
    const float u = beta * (vs[v] - (red[v] + red[128 + v] + red[256 + v] + red[384 + v]));
    __syncthreads();
    float* So = A.out + O_GSS + (size_t)unit * 16384; float po = 0.f;
#pragma unroll
    for (int i = 0; i < 32; ++i) { const int k = 32 * kq + i; s[i] += ks[k] * rk * u; So[k * 128 + v] = s[i]; po += qs[k] * rq * s[i]; }
    red[kq * 128 + v] = po;
    __syncthreads();
    if (tid < 128) os[tid] = red[tid] + red[128 + tid] + red[256 + tid] + red[384 + tid];
    __syncthreads();
    const float rn = 1.f / sqrtf(wave_sum(os[lane] * os[lane] + os[lane + 64] * os[lane + 64]) * (1.f / 128.f) + EPS);
    if (tid < 128) { const size_t off = (size_t)row * 1024 + h * 128 + tid;
        ((bf16*)(ws + WS_YA))[off] = (bf16)f2bf(os[tid] * rn * A.in[I_GDNN][tid] * siluf_(bf2f(((const bf16*)(ws + WS_Z))[off]))); }
    __syncthreads();
}

__device__ __forceinline__ void p4_rows(const Args& A, int gw, int NGW, int lane) {
    unsigned char* ws = A.ws;
    const bf16* QP = (const bf16*)(ws + WS_QP); bf16* QP2 = (bf16*)(ws + WS_QP2); bf16* KN = (bf16*)(ws + WS_KN);
    const int hh = lane >> 3, l7 = lane & 7;
    for (int m = gw; m < MR; m += NGW) {
        const int pos = m < MP ? (m & (SEQ - 1)) : PAST;
#pragma unroll
        for (int which = 0; which < 2; ++which) {
            const bf16* src = which == 0 ? QP + (size_t)m * 1536 + 16 * lane : KN + (size_t)m * 1024 + 16 * lane;
            const float* gain = (which == 0 ? A.in[I_QNN] : A.in[I_KNN]) + 16 * l7;
            const v4u w0 = *(const v4u*)src, w1 = *(const v4u*)(src + 8);
            float v[16] = {lo16(w0.x), hi16(w0.x), lo16(w0.y), hi16(w0.y), lo16(w0.z), hi16(w0.z), lo16(w0.w), hi16(w0.w),
                           lo16(w1.x), hi16(w1.x), lo16(w1.y), hi16(w1.y), lo16(w1.z), hi16(w1.z), lo16(w1.w), hi16(w1.w)};
            float ss = 0.f;
#pragma unroll
            for (int e = 0; e < 16; ++e) ss += v[e] * v[e];
            ss += __shfl_xor(ss, 1); ss += __shfl_xor(ss, 2); ss += __shfl_xor(ss, 4);
            const float r = 1.f / sqrtf(ss * (1.f / 128.f) + EPS);
#pragma unroll
            for (int e = 0; e < 16; ++e) v[e] = v[e] * r * gain[e];
            v4u o0, o1; o0.x = pk2(v[0], v[1]); o0.y = pk2(v[2], v[3]); o0.z = pk2(v[4], v[5]); o0.w = pk2(v[6], v[7]);
            o1.x = pk2(v[8], v[9]); o1.y = pk2(v[10], v[11]); o1.z = pk2(v[12], v[13]); o1.w = pk2(v[14], v[15]);
            bf16* dst = which == 0 ? QP2 + (size_t)m * 1536 + hh * 192 + 16 * l7 : KN + (size_t)m * 1024 + 16 * lane;
            *(v4u*)dst = o0; *(v4u*)(dst + 8) = o1;
        }
        {
            const v4u w = *(const v4u*)(QP + (size_t)m * 1536 + 1024 + 8 * lane);
            float v[8] = {lo16(w.x), hi16(w.x), lo16(w.y), hi16(w.y), lo16(w.z), hi16(w.z), lo16(w.w), hi16(w.w)};
            float ss = 0.f;
#pragma unroll
            for (int e = 0; e < 8; ++e) ss += v[e] * v[e];
            ss += __shfl_xor(ss, 1); ss += __shfl_xor(ss, 2); ss += __shfl_xor(ss, 4);
            const float r = 1.f / sqrtf(ss * (1.f / 64.f) + EPS);
            float o[8];
#pragma unroll
            for (int e = 0; e < 8; ++e) { const float xn = v[e] * r * A.in[I_QNR][8 * l7 + e]; const float other = __shfl_xor(xn, 4);
                const float ang = (float)pos * ROPE_INV[8 * (l7 & 3) + e]; const float cs = cosf(ang), sn = sinf(ang);
                o[e] = (l7 < 4) ? xn * cs - other * sn : other * sn + xn * cs; }
            v4u ow; ow.x = pk2(o[0], o[1]); ow.y = pk2(o[2], o[3]); ow.z = pk2(o[4], o[5]); ow.w = pk2(o[6], o[7]);
            *(v4u*)(QP2 + (size_t)m * 1536 + hh * 192 + 128 + 8 * l7) = ow;
        }
    }
}
namespace att {
using s16x4 = __attribute__((ext_vector_type(4))) short;
using u32x4 = __attribute__((ext_vector_type(4))) unsigned;
constexpr int SHM_V = 16384, SHM_K = 16384, SHM_KR = 8192;
constexpr int OFF_V = 0, OFF_K = 2 * SHM_V, OFF_KR = OFF_K + 2 * SHM_K, OFF_WS = OFF_KR + 2 * SHM_KR, OFF_QR = OFF_WS + 2048;
constexpr float THR = 8.f;
#define KSWZ(row, colB) ((row) * 256 + ((colB) ^ (((row) & 7) << 4)))
#define KRSWZ(row, colB) ((row) * 128 + ((colB) ^ (((row) & 7) << 4)))
#define SBAR() __builtin_amdgcn_sched_barrier(0)
__device__ __forceinline__ unsigned cvtpk(float lo, float hi) { unsigned r; asm volatile("v_cvt_pk_bf16_f32 %0, %1, %2" : "=v"(r) : "v"(lo), "v"(hi)); return r; }
__device__ __forceinline__ void partialSM(f32x16& p0, f32x16& p1, float& m_reg, float& mn, float& alpha) {
    constexpr float C = MLA_SCALE * 1.4426950408889634f;
    float pmax = p0[0];
#pragma unroll
    for (int r = 1; r < 16; ++r) pmax = fmaxf(pmax, p0[r]);
#pragma unroll
    for (int r = 0; r < 16; ++r) pmax = fmaxf(pmax, p1[r]);
    { auto rr = __builtin_amdgcn_permlane32_swap(__float_as_uint(pmax), __float_as_uint(pmax), false, false);
      pmax = fmaxf(__uint_as_float(rr[0]), __uint_as_float(rr[1])); }
    if (__builtin_expect(__all(pmax - m_reg <= THR / MLA_SCALE), 1)) { mn = m_reg; alpha = 1.f; }
    else { mn = fmaxf(m_reg, pmax); alpha = __builtin_amdgcn_exp2f((m_reg - mn) * C); m_reg = mn; }
    const float mnC = -mn * C;
#pragma unroll
    for (int r = 0; r < 16; ++r) p0[r] = fmaf(p0[r], C, mnC);
#pragma unroll
    for (int r = 0; r < 16; ++r) p1[r] = fmaf(p1[r], C, mnC);
#pragma unroll
    for (int r = 0; r < 16; ++r) p0[r] = __builtin_amdgcn_exp2f(p0[r]);
}
__device__ __forceinline__ void finishSM(f32x16& p0, f32x16& p1, float alpha, float& l_reg, bf16x8& pa0, bf16x8& pa1, bf16x8& pa2, bf16x8& pa3) {
#pragma unroll
    for (int r = 0; r < 16; ++r) p1[r] = __builtin_amdgcn_exp2f(p1[r]);
    float ps = 0;
#pragma unroll
    for (int r = 0; r < 16; ++r) ps += p0[r];
#pragma unroll
    for (int r = 0; r < 16; ++r) ps += p1[r];
    { auto rr = __builtin_amdgcn_permlane32_swap(__float_as_uint(ps), __float_as_uint(ps), false, false);
      ps = __uint_as_float(rr[0]) + __uint_as_float(rr[1]); }
    l_reg = l_reg * alpha + ps;
#define PK4(P, BASE, OUT) do { unsigned a0 = cvtpk(P[BASE + 0], P[BASE + 1]), a1 = cvtpk(P[BASE + 2], P[BASE + 3]);   \
    unsigned b0 = cvtpk(P[BASE + 4], P[BASE + 5]), b1 = cvtpk(P[BASE + 6], P[BASE + 7]);                              \
    auto r0 = __builtin_amdgcn_permlane32_swap(a0, b0, false, false); auto r1 = __builtin_amdgcn_permlane32_swap(a1, b1, false, false); \
    u32x4 w = {r0[0], r1[0], r0[1], r1[1]}; OUT = *reinterpret_cast<bf16x8*>(&w); } while (0)
    PK4(p0, 0, pa0); PK4(p0, 8, pa1); PK4(p1, 0, pa2); PK4(p1, 8, pa3);
#undef PK4
}
__device__ __forceinline__ void qkt(f32x16& p0, f32x16& p1, LAS const unsigned char* Ks, LAS const unsigned char* KRs, const bf16x8* qr, LAS const unsigned char* qrl, int r32, int hi) {
    p0 = f32x16{}; p1 = f32x16{};
#pragma unroll
    for (int d0 = 0; d0 < 8; ++d0) { const int cb = (d0 * 16 + hi * 8) * 2;
        const bf16x8 b0 = *(LAS const bf16x8*)(Ks + KSWZ(r32, cb)), b1 = *(LAS const bf16x8*)(Ks + KSWZ(32 + r32, cb));
        p0 = MFMA32(b0, qr[d0], p0); p1 = MFMA32(b1, qr[d0], p1); if (d0 == 3 || d0 == 7) SBAR(); }
#pragma unroll
    for (int d0 = 0; d0 < 4; ++d0) { const int cb = (d0 * 16 + hi * 8) * 2;
        const bf16x8 b0 = *(LAS const bf16x8*)(KRs + KRSWZ(r32, cb)), b1 = *(LAS const bf16x8*)(KRs + KRSWZ(32 + r32, cb));
        const bf16x8 qq = *(LAS const bf16x8*)(qrl + d0 * 1024);
        p0 = MFMA32(b0, qq, p0); p1 = MFMA32(b1, qq, p1); }
}
__device__ __forceinline__ void cmask(f32x16& p0, f32x16& p1, int key0, int qpos, int hi) {
#pragma unroll
    for (int r = 0; r < 16; ++r) { const int k = key0 + crow(r, hi); if (k > qpos) p0[r] = -1e30f; if (k + 32 > qpos) p1[r] = -1e30f; }
}
__device__ __forceinline__ int v_st(int k, int c) { const int kk = (k & ~0xC) | ((k & 4) << 1) | ((k & 8) >> 1); return ((kk >> 3) * 4 + (c >> 5)) * 512 + ((kk & 7) * 32 + (c & 31)) * 2; }
__device__ __forceinline__ int v_rd_base(int lane) { return ((lane & 3) << 3) | (((lane >> 2) & 3) << 6) | (((lane >> 4) & 1) << 5) | (((lane >> 5) & 1) << 8); }
constexpr int v_rd_off(int d0, int ks, int half) { return d0 * 512 + ks * 4096 + half * 2048; }
template <int OFF> __device__ __forceinline__ s16x4 tr_read(int vb) {
    s16x4 r; asm volatile("ds_read_b64_tr_b16 %0, %1 offset:%2" : "=&v"(r) : "v"(vb), "i"(OFF) : "memory"); return r;
}
template <int D0> __device__ __forceinline__ void pv_one(f32x16& od, int vb, bf16x8 pa0, bf16x8 pa1, bf16x8 pa2, bf16x8 pa3) {
    const s16x4 l0 = tr_read<v_rd_off(D0, 0, 0)>(vb), h0 = tr_read<v_rd_off(D0, 0, 1)>(vb), l1 = tr_read<v_rd_off(D0, 1, 0)>(vb), h1 = tr_read<v_rd_off(D0, 1, 1)>(vb);
    const s16x4 l2 = tr_read<v_rd_off(D0, 2, 0)>(vb), h2 = tr_read<v_rd_off(D0, 2, 1)>(vb), l3 = tr_read<v_rd_off(D0, 3, 0)>(vb), h3 = tr_read<v_rd_off(D0, 3, 1)>(vb);
    asm volatile("s_waitcnt lgkmcnt(0)" ::: "memory"); SBAR();
#define PKV(L, H) (bf16x8){L[0], L[1], L[2], L[3], H[0], H[1], H[2], H[3]}
    od = MFMA32(pa0, PKV(l0, h0), od); od = MFMA32(pa1, PKV(l1, h1), od); od = MFMA32(pa2, PKV(l2, h2), od); od = MFMA32(pa3, PKV(l3, h3), od);
#undef PKV
}
__device__ __forceinline__ void pv_d0(f32x16* o, int vb, bf16x8 pa0, bf16x8 pa1, bf16x8 pa2, bf16x8 pa3) {
    pv_one<0>(o[0], vb, pa0, pa1, pa2, pa3); pv_one<1>(o[1], vb, pa0, pa1, pa2, pa3); pv_one<2>(o[2], vb, pa0, pa1, pa2, pa3); pv_one<3>(o[3], vb, pa0, pa1, pa2, pa3);
}
__device__ __forceinline__ void attn_block(const bf16* __restrict__ Qb, const bf16* __restrict__ Kh, const bf16* __restrict__ KRb, const bf16* __restrict__ Vh,
                                           bf16* __restrict__ Ob, int q0, LAS unsigned char* lds) {
    const int tid = threadIdx.x, wid = __builtin_amdgcn_readfirstlane(tid >> 6), lane = tid & 63, r32 = lane & 31, hi = lane >> 5;
    LAS unsigned char* V_lds = lds + OFF_V; LAS unsigned char* K_lds = lds + OFF_K; LAS unsigned char* KR_lds = lds + OFF_KR;
    LAS float* wsf = (LAS float*)(lds + OFF_WS) + wid * 64; LAS float* li_l = wsf; LAS float* al_l = wsf + 32;
    float m_reg = -1e30f, l_reg = 0; f32x16 o[4] = {}; bf16x8 qr[8];
    LAS unsigned char* qrl = lds + OFF_QR + wid * 4096 + lane * 16;
    { const char* Qw = (const char*)Qb + (size_t)wid * (32 * 1536 * 2); const unsigned qoff = (unsigned)(r32 * 1536 + hi * 8) * 2u;
#pragma unroll
      for (int d0 = 0; d0 < 8; ++d0) qr[d0] = *(const bf16x8*)(Qw + qoff + d0 * 32);
#pragma unroll
      for (int d0 = 0; d0 < 4; ++d0) *(LAS bf16x8*)(qrl + d0 * 1024) = *(const bf16x8*)(Qw + qoff + (8 + d0) * 32); }
    const int qpos = q0 + wid * 32 + r32;
    const int sr = tid >> 4, sc = (tid & 15) * 8, vst0 = v_st(sr, sc), vst1 = v_st(32 + sr, sc);
    const int krr = tid >> 3, krc = (tid & 7) * 8;
    const unsigned voff = (unsigned)(sr * 1024 + sc) * 2u, voffr = (unsigned)(krr * 64 + krc) * 2u;
    const int vb0 = (int)(uintptr_t)V_lds + v_rd_base(lane);
    bf16x8 vs0, vs1, ks0, ks1, krs;
#define SLOAD(k0) do { const char* kb_ = (const char*)Kh + (size_t)(k0) * 2048; const char* vb_ = (const char*)Vh + (size_t)(k0) * 2048; const char* rb_ = (const char*)KRb + (size_t)(k0) * 128; \
    vs0 = *(const bf16x8*)(vb_ + voff); vs1 = *(const bf16x8*)(vb_ + 65536 + voff); ks0 = *(const bf16x8*)(kb_ + voff); ks1 = *(const bf16x8*)(kb_ + 65536 + voff); \
    krs = *(const bf16x8*)(rb_ + voffr); } while (0)
#define SWRITE(b) do { *(LAS bf16x8*)(V_lds + (b) * SHM_V + vst0) = vs0; *(LAS bf16x8*)(V_lds + (b) * SHM_V + vst1) = vs1; const int kc = sc * 2; \
    *(LAS bf16x8*)(K_lds + (b) * SHM_K + KSWZ(sr, kc)) = ks0; *(LAS bf16x8*)(K_lds + (b) * SHM_K + KSWZ(32 + sr, kc)) = ks1; \
    *(LAS bf16x8*)(KR_lds + (b) * SHM_KR + KRSWZ(krr, krc * 2)) = krs; } while (0)
#define SWAIT() asm volatile("s_waitcnt vmcnt(0)" ::: "memory")
#define RESC(a) do { if (__any((a) < 1.f)) { if (hi == 0) al_l[r32] = (a); asm volatile("s_waitcnt lgkmcnt(0)" ::: "memory"); \
    _Pragma("unroll") for (int d = 0; d < 4; ++d) _Pragma("unroll") for (int r = 0; r < 16; ++r) o[d][r] *= al_l[crow(r, hi)]; } } while (0)
    f32x16 p0, p1; float mn, al; bf16x8 pa0, pa1, pa2, pa3;
    const int NT = (q0 + 256) / 64, NM = q0 / 64;
    SLOAD(0); SWAIT(); SWRITE(0); SLOAD(64); __syncthreads();
#pragma unroll 1
    for (int j = 0; j < NT; ++j) {
        const int bf = j & 1;
        SBAR(); qkt(p0, p1, K_lds + bf * SHM_K, KR_lds + bf * SHM_KR, qr, qrl, r32, hi); if (j >= NM) cmask(p0, p1, 64 * j, qpos, hi);
        partialSM(p0, p1, m_reg, mn, al); RESC(al);
        finishSM(p0, p1, al, l_reg, pa0, pa1, pa2, pa3); SBAR();
        if (j + 1 < NT) { SWAIT(); SWRITE(bf ^ 1); }
        if (j + 2 < NT) SLOAD((j + 2) * 64);
        SBAR();
        pv_d0(o, vb0 + bf * SHM_V, pa0, pa1, pa2, pa3);
        __syncthreads();
    }
    if (hi == 0) li_l[r32] = l_reg; asm volatile("s_waitcnt lgkmcnt(0)" ::: "memory");
    char* Ow = (char*)Ob + (size_t)wid * (32 * 1024 * 2);
    unsigned lofs = (unsigned)(4 * hi * 1024 + r32) * 2u; asm volatile("" : "+v"(lofs));
#pragma unroll
    for (int r = 0; r < 16; ++r) { const float rl = __builtin_amdgcn_rcpf(li_l[crow(r, hi)]);
#pragma unroll
        for (int d0 = 0; d0 < 4; ++d0) *(bf16*)(Ow + lofs + (unsigned)(((r & 3) + 8 * (r >> 2)) * 1024 + d0 * 32) * 2u) = (bf16)f2bf(o[d0][r] * rl); }
    __syncthreads();
#undef SLOAD
#undef SWRITE
#undef SWAIT
#undef RESC
}
}

constexpr int DP_CT = 0, DP_KR = 133120, DP_PT = 151552, DP_QK = 153728, DP_QR = 157824;
__device__ __forceinline__ void dec_tables(const Args& A, LAS unsigned char* lds, int j, int tid_) {
    int tid = tid_; asm volatile("" : "+v"(tid));
    const bf16* Qrow = (const bf16*)(A.ws + WS_QP2) + (size_t)(MP + j) * 1536;
#pragma unroll
    for (int q = 0; q < 2; ++q) { const int idx = tid + 512 * q, h = idx >> 7, d = idx & 127; ((LAS float*)(lds + DP_QK))[idx] = bf2f(Qrow[h * 192 + d]) * A.in[I_KNN][d]; }
    { const int h = tid >> 6, e = tid & 63; ((LAS float*)(lds + DP_QR))[tid] = bf2f(Qrow[h * 192 + 128 + e]); }
}
__device__ __forceinline__ void dec_page(const Args& A, LAS unsigned char* lds, int unit, int tid, int lane, int wave) {
    unsigned char* ws = A.ws;
    const int phys = ((const int*)A.in[I_PT])[unit];
    const float* src = A.in[I_CACHE] + (size_t)phys * PAGE * LATW;
#pragma unroll 1
    for (int q0 = 0; q0 < 18; q0 += 6) {
        f32x4 va[6], vb[6];
#pragma unroll
        for (int q = 0; q < 6; ++q) { const int id = (q0 + q) * 512 + tid, row = id / 72, g = id % 72; const float* p = src + (size_t)row * LATW + 8 * g; va[q] = *(const f32x4*)p; vb[q] = *(const f32x4*)(p + 4); }
#pragma unroll
        for (int q = 0; q < 6; ++q) { const int id = (q0 + q) * 512 + tid, row = id / 72, g = id % 72;
            v4u o; o.x = pk2(va[q].x, va[q].y); o.y = pk2(va[q].z, va[q].w); o.z = pk2(vb[q].x, vb[q].y); o.w = pk2(vb[q].z, vb[q].w);
            if (g < 64) *(LAS v4u*)(lds + DP_CT + row * 1040 + g * 16) = o; else *(LAS v4u*)(lds + DP_KR + row * 144 + (g - 64) * 16) = o; }
    }
    __syncthreads();
    const int l31 = lane & 31, hi = lane >> 5, h = wave;
    float ssq[4] = {0.f, 0.f, 0.f, 0.f}, dot[4] = {0.f, 0.f, 0.f, 0.f};
    const bf16* WK = (const bf16*)(ws + WS_WKV);
    LAS const float* QK = (LAS const float*)(lds + DP_QK) + h * 128;
#pragma unroll 1
    for (int e = 0; e < 2; ++e) {
        f32x16 acc[2][4];
#pragma unroll
        for (int mt = 0; mt < 2; ++mt)
#pragma unroll
            for (int nt = 0; nt < 4; ++nt) acc[mt][nt] = f32x16{};
        const bf16* Ab = WK + (size_t)(h * 128 + 64 * e + l31) * 512 + 8 * hi;
        LAS const unsigned char* Bb = lds + DP_CT + l31 * 1040 + hi * 16;
#pragma unroll 2
        for (int ks = 0; ks < 32; ++ks) {
            const bf16x8 a0 = gl_ld8(Ab + 16 * ks), a1 = gl_ld8(Ab + 32 * 512 + 16 * ks);
            bf16x8 bq[4];
#pragma unroll
            for (int nt = 0; nt < 4; ++nt) bq[nt] = lds_ld8(Bb + nt * 32 * 1040 + ks * 32);
#pragma unroll
            for (int nt = 0; nt < 4; ++nt) { acc[0][nt] = MFMA32(a0, bq[nt], acc[0][nt]); acc[1][nt] = MFMA32(a1, bq[nt], acc[1][nt]); }
        }
#pragma unroll
        for (int mt = 0; mt < 2; ++mt)
#pragma unroll
            for (int g = 0; g < 4; ++g) { const f32x4 qv = *(LAS const f32x4*)(QK + 64 * e + 32 * mt + 8 * g + 4 * hi);
#pragma unroll
                for (int nt = 0; nt < 4; ++nt) {
                    const float x0 = acc[mt][nt][4 * g], x1 = acc[mt][nt][4 * g + 1], x2 = acc[mt][nt][4 * g + 2], x3 = acc[mt][nt][4 * g + 3];
                    ssq[nt] += x0 * x0 + x1 * x1 + x2 * x2 + x3 * x3; dot[nt] += x0 * qv.x + x1 * qv.y + x2 * qv.z + x3 * qv.w; } }
    }
#pragma unroll
    for (int nt = 0; nt < 4; ++nt) { ssq[nt] += __shfl_xor(ssq[nt], 32); dot[nt] += __shfl_xor(dot[nt], 32); }
    const float sn0 = dot[0] / sqrtf(ssq[0] * (1.f / 128.f) + EPS), sn1 = dot[1] / sqrtf(ssq[1] * (1.f / 128.f) + EPS);
    const float sn2 = dot[2] / sqrtf(ssq[2] * (1.f / 128.f) + EPS), sn3 = dot[3] / sqrtf(ssq[3] * (1.f / 128.f) + EPS);
    const float snA = hi ? sn2 : sn0, snB = hi ? sn3 : sn1;
    float s[2];
    LAS const float* QR = (LAS const float*)(lds + DP_QR) + h * 64;
#pragma unroll
    for (int u = 0; u < 2; ++u) { const int key = 32 * (2 * hi + u) + l31; float sr = 0.f;
#pragma unroll
        for (int c = 0; c < 8; ++c) { const v4u w = *(LAS const v4u*)(lds + DP_KR + key * 144 + c * 16); const f32x4 q0 = *(LAS const f32x4*)(QR + 8 * c), q1 = *(LAS const f32x4*)(QR + 8 * c + 4);
            sr += lo16(w.x) * q0.x + hi16(w.x) * q0.y + lo16(w.y) * q0.z + hi16(w.y) * q0.w + lo16(w.z) * q1.x + hi16(w.z) * q1.y + lo16(w.w) * q1.z + hi16(w.w) * q1.w; }
        s[u] = ((u ? snB : snA) + sr) * MLA_SCALE; }
    const float mx = wave_max(fmaxf(s[0], s[1]));
    const float p0 = __expf(s[0] - mx), p1 = __expf(s[1] - mx);
    const float lsum = wave_sum(p0 + p1);
    *(LAS bf16*)(lds + DP_PT + h * 272 + (32 * (2 * hi) + l31) * 2) = (bf16)f2bf(p0);
    *(LAS bf16*)(lds + DP_PT + h * 272 + (32 * (2 * hi + 1) + l31) * 2) = (bf16)f2bf(p1);
    if (lane == 0) { float* ml = (float*)(ws + WS_DML) + ((size_t)unit * 8 + h) * 2; ml[0] = mx; ml[1] = lsum; }
    __syncthreads();
    float* DA = (float*)(ws + WS_DACC) + (size_t)unit * 8 * 512;
#pragma unroll 1
    for (int t = 0; t < 2; ++t) { const int cb = 64 * wave + 32 * t + l31;
        f32x16 acc2 = {};
#pragma unroll 2
        for (int ks = 0; ks < 8; ++ks) {
            bf16x8 a = {0, 0, 0, 0, 0, 0, 0, 0};
            if (l31 < 8) a = lds_ld8(lds + DP_PT + l31 * 272 + (16 * ks + 8 * hi) * 2);
            bf16x8 bb;
#pragma unroll
            for (int jj = 0; jj < 8; ++jj) bb[jj] = (short)*(LAS const bf16*)(lds + DP_CT + (16 * ks + 8 * hi + jj) * 1040 + cb * 2);
            acc2 = MFMA32(a, bb, acc2);
        }
#pragma unroll
        for (int r = 0; r < 4; ++r) DA[(size_t)(r + 4 * hi) * 512 + cb] = acc2[r];
    }
    __syncthreads();
}
__device__ __forceinline__ void dec_combine(const Args& A, LAS unsigned char* lds, int unit, int tid, int lane, int wave) {
    unsigned char* ws = A.ws;
    const int j = unit >> 3, h = unit & 7, row = MP + j;
    const bf16* Qrow = (const bf16*)(ws + WS_QP2) + (size_t)row * 1536 + h * 192;
    const bf16* Krow = (const bf16*)(ws + WS_KN) + (size_t)row * 1024 + h * 128;
    const bf16* KRrow = (const bf16*)(ws + WS_KR) + (size_t)row * 64;
    const float snew = wave_sum(bf2f(Qrow[lane]) * bf2f(Krow[lane]) + bf2f(Qrow[lane + 64]) * bf2f(Krow[lane + 64]) + bf2f(Qrow[128 + lane]) * bf2f(KRrow[lane])) * MLA_SCALE;
    const float* ML = (const float*)(ws + WS_DML) + ((size_t)j * NPAGE * 8 + h) * 2;
    const float m0 = ML[(size_t)lane * 16], m1 = ML[(size_t)(lane + 64) * 16], l0 = ML[(size_t)lane * 16 + 1], l1 = ML[(size_t)(lane + 64) * 16 + 1];
    const float M = fmaxf(wave_max(fmaxf(m0, m1)), snew);
    const float wn = __expf(snew - M);
    const float den = wave_sum(__expf(m0 - M) * l0 + __expf(m1 - M) * l1) + wn;
    const float* DA = (const float*)(ws + WS_DACC) + ((size_t)j * NPAGE * 8 + h) * 512 + tid;
    float num = wn * bf2f(((const bf16*)(ws + WS_C))[(size_t)row * 512 + tid]);
#pragma unroll 4
    for (int p = 0; p < NPAGE; ++p) num += __expf(ML[(size_t)p * 16] - M) * DA[(size_t)p * 4096];
    LAS float* lat = (LAS float*)lds; LAS float* red = lat + 512;
    lat[tid] = num / den;
    __syncthreads();
    const int d = tid & 127, qt = tid >> 7;
    const float* Wv = A.in[I_WUV] + (size_t)(qt * 128) * 1024 + h * 128 + d;
    float part = 0.f;
#pragma unroll 8
    for (int c = 0; c < 128; ++c) part += lat[qt * 128 + c] * Wv[(size_t)c * 1024];
    red[tid] = part;
    __syncthreads();
    if (tid < 128) ((bf16*)(ws + WS_YB))[(size_t)row * 1024 + h * 128 + tid] = (bf16)f2bf(red[tid] + red[128 + tid] + red[256 + tid] + red[384 + tid]);
    __syncthreads();
}
__device__ __forceinline__ f32x16 skinny_partial(const bf16* A, const bf16* Bt, int K, int n0, int wave, int lane) {
    const int l31 = lane & 31, hi = lane >> 5, kw = K >> 3, k0 = wave * kw;
    const bf16* ap = A + (size_t)l31 * K + k0 + 8 * hi; const bf16* bp = Bt + (size_t)(n0 + l31) * K + k0 + 8 * hi;
    f32x16 acc = {};
#pragma unroll 8
    for (int ks = 0; ks < (kw >> 4); ++ks) acc = MFMA32(gl_ld8(ap + 16 * ks), gl_ld8(bp + 16 * ks), acc);
    return acc;
}
__device__ __forceinline__ void skinny_put(LAS float* red, const f32x16& acc, int wave, int lane) {
    const int l31 = lane & 31, hi = lane >> 5;
#pragma unroll
    for (int r = 0; r < 16; ++r) red[(wave * 32 + crow(r, hi)) * 32 + l31] = acc[r];
}
__device__ __forceinline__ void skinny_get(LAS const float* red, int tid, float& v0, float& v1) {
    v0 = 0.f; v1 = 0.f;
#pragma unroll
    for (int w = 0; w < 8; ++w) { v0 += red[w * 1024 + tid * 2]; v1 += red[w * 1024 + tid * 2 + 1]; }
}
template <int MODE> __device__ __forceinline__ void skinny_tile(const Args& A, LAS unsigned char* lds, int tile, int tid, int lane, int wave) {
    unsigned char* ws = A.ws; const int n0 = tile * 32;
    LAS float* red = (LAS float*)lds; LAS float* red2 = red + 8192;
    if (MODE == 0) {
        skinny_put(red, skinny_partial((const bf16*)(ws + WS_YA) + (size_t)MP * 1024, (const bf16*)(ws + WS_WYA), 1024, n0, wave, lane), wave, lane);
        skinny_put(red2, skinny_partial((const bf16*)(ws + WS_YB) + (size_t)MP * 1024, (const bf16*)(ws + WS_WYB), 1024, n0, wave, lane), wave, lane);
    } else if (MODE == 1) skinny_put(red, skinny_partial((const bf16*)(ws + WS_T) + (size_t)MP * 1024, (const bf16*)(ws + WS_WO), 1024, n0, wave, lane), wave, lane);
    else if (MODE == 2) skinny_put(red, skinny_partial((const bf16*)(ws + WS_XN2) + (size_t)MP * 1024, (const bf16*)(ws + WS_WUP), 1024, n0, wave, lane), wave, lane);
    else skinny_put(red, skinny_partial((const bf16*)(ws + WS_H) + (size_t)MP * 4096, (const bf16*)(ws + WS_WDN), 4096, n0, wave, lane), wave, lane);
    __syncthreads();
    float v0, v1; skinny_get(red, tid, v0, v1);
    const int row = tid >> 4, col = n0 + 2 * (tid & 15); const size_t grow = (size_t)(MP + row);
    if (MODE == 0) {
        float u0, u1; skinny_get(red2, tid, u0, u1);
        const bf16* g = (const bf16*)(ws + WS_GATES) + grow * 2048 + col;
        const float t0 = bf2f(g[0]) * v0 + bf2f(g[1024]) * u0, t1 = bf2f(g[1]) * v1 + bf2f(g[1025]) * u1;
        *(unsigned*)((bf16*)(ws + WS_T) + grow * 1024 + col) = pk2(t0, t1);
    } else if (MODE == 1) {
        const float* x = A.in[I_XS] + (size_t)row * 1024 + col; float* o = (float*)(ws + WS_X1) + grow * 1024 + col;
        o[0] = x[0] + v0; o[1] = x[1] + v1;
    } else if (MODE == 2) {
        const float a = fmaxf(v0, 0.f), b = fmaxf(v1, 0.f);
        *(unsigned*)((bf16*)(ws + WS_H) + grow * 4096 + col) = pk2(a * a, b * b);
    } else {
        const float* x = (const float*)(ws + WS_X1) + grow * 1024 + col; float* o = A.out + O_YS + (size_t)row * 1024 + col;
        o[0] = x[0] + v0; o[1] = x[1] + v1;
    }
    __syncthreads();
}
struct DecPk { v4u p[36]; };
#ifndef DEC_RD
#define DEC_RD 16
#endif
constexpr int RD = DEC_RD;
__device__ __forceinline__ void dec_load_sync(const Args& A, LAS unsigned char* lds, int unit, int tid) {
    const int phys = ((const int*)A.in[I_PT])[unit];
    const float* src = A.in[I_CACHE] + (size_t)phys * PAGE * LATW;
#pragma unroll 1
    for (int q0 = 0; q0 < 18; q0 += 6) {
        f32x4 va[6], vb[6];
#pragma unroll
        for (int q = 0; q < 6; ++q) { const int id = (q0 + q) * 512 + tid, row = id / 72, g = id % 72; const float* p = src + (size_t)row * LATW + 8 * g; va[q] = *(const f32x4*)p; vb[q] = *(const f32x4*)(p + 4); }
#pragma unroll
        for (int q = 0; q < 6; ++q) { const int id = (q0 + q) * 512 + tid, row = id / 72, g = id % 72;
            v4u o; o.x = pk2(va[q].x, va[q].y); o.y = pk2(va[q].z, va[q].w); o.z = pk2(vb[q].x, vb[q].y); o.w = pk2(vb[q].z, vb[q].w);
            if (g < 64) *(LAS v4u*)(lds + DP_CT + row * 1040 + g * 16) = o; else *(LAS v4u*)(lds + DP_KR + row * 144 + (g - 64) * 16) = o; }
    }
    __syncthreads();
}
__device__ __forceinline__ void dec_prefetch(const Args& A, int unit, int lt, DecPk& pk) {
    const int phys = __builtin_amdgcn_readfirstlane(((const int*)A.in[I_PT])[unit]);
    const char* src = (const char*)(A.in[I_CACHE] + (size_t)phys * PAGE * LATW);
    const unsigned lo = (unsigned)lt * 32u;
#pragma unroll
    for (int q0 = 0; q0 < 36; q0 += 12) {
        f32x4 va[12], vb[12];
#pragma unroll
        for (int q = 0; q < 12; ++q) { const char* p = src + (size_t)(q0 + q) * 8192 + lo; va[q] = __builtin_nontemporal_load((const f32x4*)p); vb[q] = __builtin_nontemporal_load((const f32x4*)(p + 16)); }
#pragma unroll
        for (int q = 0; q < 12; ++q) { v4u o; o.x = pg8::cvt_pk_bf16(va[q].x, va[q].y); o.y = pg8::cvt_pk_bf16(va[q].z, va[q].w); o.z = pg8::cvt_pk_bf16(vb[q].x, vb[q].y); o.w = pg8::cvt_pk_bf16(vb[q].z, vb[q].w); pk.p[q0 + q] = o; }
    }
}
__device__ __forceinline__ void dec_store(LAS unsigned char* lds, int lt, const DecPk& pk) {
    int ltx = lt; asm volatile("" : "+v"(ltx));
#pragma unroll
    for (int q = 0; q < 36; ++q) { const int id = q * 256 + ltx, row = id / 72, g = id - row * 72;
        const int off = g < 64 ? DP_CT + row * 1040 + g * 16 : DP_KR + row * 144 + (g - 64) * 16;
        *(LAS v4u*)(lds + off) = pk.p[q]; }
}
__device__ __forceinline__ void dec_ring_fill(const Args& A, int mw, int lane, bf16x8 (&a)[RD]) {
    const __amdgpu_buffer_rsrc_t rs = __builtin_amdgcn_make_buffer_rsrc((void*)(A.ws + WS_WKT), 0, 1024 * 512 * 2, 0x00020000);
    const unsigned voff = (unsigned)lane * 16u; const int so = 256 * mw * 1024;
#pragma unroll
    for (int d = 0; d < RD; ++d) a[d] = __builtin_bit_cast(bf16x8, __builtin_amdgcn_raw_buffer_load_b128(rs, voff, so + d * 1024, 0));
}
__device__ __forceinline__ void dec_mfma(const Args& A, LAS unsigned char* lds, int unit, int mw, int lane, bf16x8 (&a)[RD]) {
    const int l31_ = lane & 31, hi_ = lane >> 5;
    const __amdgpu_buffer_rsrc_t rs = __builtin_amdgcn_make_buffer_rsrc((void*)(A.ws + WS_WKT), 0, 1024 * 512 * 2, 0x00020000);
    const unsigned voff = (unsigned)lane * 16u; const int so = 256 * mw * 1024;
    LAS const unsigned char* Bb = lds + DP_CT + l31_ * 1040 + hi_ * 16;
    float ssq[4] = {0.f, 0.f, 0.f, 0.f}, dot[4] = {0.f, 0.f, 0.f, 0.f};
    bf16x8 bc0 = lds_ld8(Bb), bc1 = lds_ld8(Bb + 33280), bc2 = lds_ld8(Bb + 2 * 33280), bc3 = lds_ld8(Bb + 3 * 33280), bd0, bd1, bd2, bd3;
#pragma unroll 1
    for (int jb = 0; jb < 8; ++jb) {
        f32x16 acc[4];
#pragma unroll
        for (int nt = 0; nt < 4; ++nt) acc[nt] = f32x16{};
#pragma unroll 1
        for (int blk = 0; blk < 32 / RD; ++blk) {
            const int nj = (blk == 32 / RD - 1) ? ((jb + 1) & 7) : jb, nk = (blk == 32 / RD - 1) ? 0 : (blk + 1) * RD;
            const int nb = so + nj * 32 * 1024 + 1024 * nk;
            LAS const unsigned char* Bk = Bb + blk * (32 * RD);
            LAS const unsigned char* Bn = Bb + ((blk + 1) & (32 / RD - 1)) * (32 * RD);
#pragma unroll
            for (int d = 0; d < RD; d += 2) {
                {
                    LAS const unsigned char* Bx = Bk + (d + 1) * 32;
                    bd0 = lds_ld8(Bx); bd1 = lds_ld8(Bx + 33280); bd2 = lds_ld8(Bx + 2 * 33280); bd3 = lds_ld8(Bx + 3 * 33280);
                    __builtin_amdgcn_sched_barrier(0);
                    acc[0] = MFMA32(a[d], bc0, acc[0]); acc[1] = MFMA32(a[d], bc1, acc[1]); acc[2] = MFMA32(a[d], bc2, acc[2]); acc[3] = MFMA32(a[d], bc3, acc[3]);
                    a[d] = __builtin_bit_cast(bf16x8, __builtin_amdgcn_raw_buffer_load_b128(rs, voff, nb + d * 1024, 0));
                    __builtin_amdgcn_sched_barrier(0);
                }
                {
                    LAS const unsigned char* Bx = (d + 2 < RD) ? Bk + (d + 2) * 32 : Bn;
                    bc0 = lds_ld8(Bx); bc1 = lds_ld8(Bx + 33280); bc2 = lds_ld8(Bx + 2 * 33280); bc3 = lds_ld8(Bx + 3 * 33280);
                    __builtin_amdgcn_sched_barrier(0);
                    acc[0] = MFMA32(a[d + 1], bd0, acc[0]); acc[1] = MFMA32(a[d + 1], bd1, acc[1]); acc[2] = MFMA32(a[d + 1], bd2, acc[2]); acc[3] = MFMA32(a[d + 1], bd3, acc[3]);
                    a[d + 1] = __builtin_bit_cast(bf16x8, __builtin_amdgcn_raw_buffer_load_b128(rs, voff, nb + (d + 1) * 1024, 0));
                    __builtin_amdgcn_sched_barrier(0);
                }
            }
        }
        const int e4 = jb & 3, h = 2 * mw + (jb >> 2);
        int l31 = l31_, hi = hi_; asm volatile("" : "+v"(l31), "+v"(hi));
        LAS const float* QK = (LAS const float*)(lds + DP_QK) + h * 128 + 32 * e4 + 4 * hi;
#pragma unroll
        for (int g = 0; g < 4; ++g) { const f32x4 qv = *(LAS const f32x4*)(QK + 8 * g);
#pragma unroll
            for (int nt = 0; nt < 4; ++nt) {
                const float x0 = acc[nt][4 * g], x1 = acc[nt][4 * g + 1], x2 = acc[nt][4 * g + 2], x3 = acc[nt][4 * g + 3];
                ssq[nt] += x0 * x0 + x1 * x1 + x2 * x2 + x3 * x3; dot[nt] += x0 * qv.x + x1 * qv.y + x2 * qv.z + x3 * qv.w; } }
        if (e4 == 3) {
#pragma unroll
            for (int nt = 0; nt < 4; ++nt) { ssq[nt] += __shfl_xor(ssq[nt], 32); dot[nt] += __shfl_xor(dot[nt], 32); }
            const float sn0 = dot[0] / sqrtf(ssq[0] * (1.f / 128.f) + EPS), sn1 = dot[1] / sqrtf(ssq[1] * (1.f / 128.f) + EPS);
            const float sn2 = dot[2] / sqrtf(ssq[2] * (1.f / 128.f) + EPS), sn3 = dot[3] / sqrtf(ssq[3] * (1.f / 128.f) + EPS);
            const float snA = hi ? sn2 : sn0, snB = hi ? sn3 : sn1;
            float s[2];
            LAS const float* QR = (LAS const float*)(lds + DP_QR) + h * 64;
#pragma unroll
            for (int u = 0; u < 2; ++u) { const int key = 32 * (2 * hi + u) + l31; float sr = 0.f;
#pragma unroll
                for (int c = 0; c < 8; ++c) { const v4u w = *(LAS const v4u*)(lds + DP_KR + key * 144 + c * 16); const f32x4 q0 = *(LAS const f32x4*)(QR + 8 * c), q1 = *(LAS const f32x4*)(QR + 8 * c + 4);
                    sr += lo16(w.x) * q0.x + hi16(w.x) * q0.y + lo16(w.y) * q0.z + hi16(w.y) * q0.w + lo16(w.z) * q1.x + hi16(w.z) * q1.y + lo16(w.w) * q1.z + hi16(w.w) * q1.w; }
                s[u] = ((u ? snB : snA) + sr) * MLA_SCALE; }
            const float mx = wave_max(fmaxf(s[0], s[1]));
            const float p0 = __expf(s[0] - mx), p1 = __expf(s[1] - mx);
            const float lsum = wave_sum(p0 + p1);
            *(LAS bf16*)(lds + DP_PT + h * 272 + (32 * (2 * hi) + l31) * 2) = (bf16)f2bf(p0);
            *(LAS bf16*)(lds + DP_PT + h * 272 + (32 * (2 * hi + 1) + l31) * 2) = (bf16)f2bf(p1);
            if (l31 + hi == 0) { float* ml = (float*)(A.ws + WS_DML) + ((size_t)unit * 8 + h) * 2; ml[0] = mx; ml[1] = lsum; }
#pragma unroll
            for (int nt = 0; nt < 4; ++nt) { ssq[nt] = 0.f; dot[nt] = 0.f; }
        }
    }
}
__device__ __forceinline__ void dec_pv(const Args& A, LAS unsigned char* lds, int unit, int lane, int wave) {
    int l31 = lane & 31, hi = lane >> 5; asm volatile("" : "+v"(l31), "+v"(hi));
    float* DA = (float*)(A.ws + WS_DACC) + (size_t)unit * 8 * 512;
#pragma unroll 1
    for (int t = 0; t < 2; ++t) { const int cb = 64 * wave + 32 * t + l31;
        f32x16 acc2 = {};
#pragma unroll 2
        for (int ks = 0; ks < 8; ++ks) {
            bf16x8 a = {0, 0, 0, 0, 0, 0, 0, 0};
            if (l31 < 8) a = lds_ld8(lds + DP_PT + l31 * 272 + (16 * ks + 8 * hi) * 2);
            bf16x8 bb;
#pragma unroll
            for (int jj = 0; jj < 8; ++jj) bb[jj] = (short)*(LAS const bf16*)(lds + DP_CT + (16 * ks + 8 * hi + jj) * 1040 + cb * 2);
            acc2 = MFMA32(a, bb, acc2);
        }
#pragma unroll
        for (int r = 0; r < 4; ++r) DA[(size_t)(r + 4 * hi) * 512 + cb] = acc2[r];
    }
}
template <bool MF> __device__ __forceinline__ void dec_loop(const Args& A, LAS unsigned char* lds, volatile LAS unsigned* MISC, unsigned* qc, int g, int tid, int lane, int wave) {
    constexpr int PG = 4, NGRP = 4096 / PG;
#define DPULL() ({ __syncthreads(); if (tid == 0) MISC[0] = atomicAdd(qc, 1u); __syncthreads(); (int)MISC[0]; })
    int jcur = -1;
#ifdef PROBE_K
    unsigned long long pt0 = 0, pdt = 0;
#define DPS(k) do { if ((k) == PROBE_K) pt0 = __builtin_amdgcn_s_memrealtime(); } while (0)
#define DPE(k) do { if ((k) == PROBE_K) pdt += __builtin_amdgcn_s_memrealtime() - pt0; } while (0)
#else
#define DPS(k) do {} while (0)
#define DPE(k) do {} while (0)
#endif
    bf16x8 a[RD];
    if (MF) dec_ring_fill(A, wave, lane, a);
#pragma unroll 1
    while (g < NGRP) {
        const int gn = DPULL();
        const int j = (g * PG) >> 7;
        if (j != jcur) { dec_tables(A, lds, j, tid); jcur = j; __syncthreads(); }
#pragma unroll 1
        for (int p = 0; p < PG; ++p) {
            const int unit = g * PG + p, np = (p + 1 < PG) ? unit + 1 : (gn < NGRP ? gn * PG : -1);
            DecPk pk;
            DPS(64); DPS(60); DPS(61);
            if (MF) { dec_mfma(A, lds, unit, wave, lane, a); DPE(60); }
            else if (np >= 0) { dec_prefetch(A, np, tid - 256, pk); DPE(61); }
            __syncthreads();
            DPS(62);
            dec_pv(A, lds, unit, lane, wave);
            __syncthreads();
            DPE(62); DPS(63);
            if (MF) { if (np >= 0) dec_ring_fill(A, wave, lane, a); }
            else if (np >= 0) dec_store(lds, tid - 256, pk);
            __syncthreads();
            DPE(63); DPE(64);
        }
        g = gn;
    }
#ifdef PROBE_K
    if (blockIdx.x == 0 && PROBE_K >= 60) { const unsigned long long te = __builtin_amdgcn_s_memrealtime(); while (__builtin_amdgcn_s_memrealtime() - te < (unsigned long long)PROBE_MULT * pdt) __builtin_amdgcn_s_sleep(8); }
#endif
}
__device__ __forceinline__ void dec_run(const Args& A, LAS unsigned char* lds, volatile LAS unsigned* MISC, unsigned* qc, int tid, int lane, int wave) {
    const int g = DPULL();
    if (g >= 1024) return;
    dec_load_sync(A, lds, g * 4, tid);
    if (wave < 4) dec_loop<true>(A, lds, MISC, qc, g, tid, lane, wave);
    else dec_loop<false>(A, lds, MISC, qc, g, tid, lane, wave);
#undef DPULL
}
#ifndef MK_SINGLE
#define MK_SINGLE 1
#endif
constexpr int N_PHASES = 12;
__global__ void __launch_bounds__(512, 2) mk_fwd(Args args) {
    extern __shared__ __attribute__((aligned(16))) unsigned char lds_raw[];
    LAS unsigned char* lds = (LAS unsigned char*)lds_raw;
    const int tid = threadIdx.x, lane = tid & 63, wave = __builtin_amdgcn_readfirstlane(tid >> 6);
    const int G = gridDim.x, bid = blockIdx.x;
    const int gw = bid * 8 + wave, NGW = G * 8, gtid = bid * 512 + tid, NGT = G * 512;
    volatile LAS unsigned* MISC = (volatile LAS unsigned*)(lds + MISC_OFF);
    if (tid < 32) MISC[tid] = 0u;
    __syncthreads();
    unsigned char* ws = args.ws;
#if MK_SINGLE
    XcdBarrier bar = xcd_barrier_post((unsigned*)(ws + WS_CTL) + 4096, MISC + 8);
#define GRID_BAR() xcd_barrier(bar)
#else
#define GRID_BAR() do {} while (0)
#endif
    const int lo = args.ph_lo, hi = args.ph_hi;
#ifdef PROBE_K
    unsigned long long pt0 = 0, pdt = 0;
#define PSTART(k) do { if ((k) == PROBE_K) pt0 = __builtin_amdgcn_s_memrealtime(); } while (0)
#define PEND(k) do { if ((k) == PROBE_K) pdt += __builtin_amdgcn_s_memrealtime() - pt0; } while (0)
#else
#define PSTART(k) do {} while (0)
#define PEND(k) do {} while (0)
#endif
#ifndef PHASE_MASK
#define PHASE_MASK 0xFFFF
#endif
#define IN(k) (((PHASE_MASK >> (k)) & 1) && lo <= (k) && (k) < hi)
#define SEAM(k) do { if (IN(k) && IN((k) + 1)) GRID_BAR(); } while (0)

    PSTART(0);
    if (IN(0)) {
        p0_prologue(args, lds, gw, NGW, wave, lane);
        for (int i = gtid; i < 32 * 2 * 3072; i += NGT) { const int c = i % 3072, r = (i / 3072) % 2, j = i / (2 * 3072);
            args.out[O_CSS + (size_t)(j * 3 + r) * 3072 + c] = args.in[I_SCONV][(size_t)(j * 3 + r + 1) * 3072 + c]; }
        __syncthreads();
    }
    SEAM(0);
    PEND(0);
    PSTART(1);
    if (IN(1)) {
        pg8::Gemm g{(const pg8::bf16_t*)(ws + WS_XN), (const pg8::bf16_t*)(ws + WS_WIN), MPAD, NIN, 1024};
        pg8::StaticOrder S; S.init(MPAD, NIN, G, bid);
        EpiG1 E{(bf16*)(ws + WS_QKV), (bf16*)(ws + WS_Z), (bf16*)(ws + WS_QD), (bf16*)(ws + WS_KVD), (bf16*)(ws + WS_GATES), (float*)(ws + WS_SM)};
        pg8::gemm_phase<EpiG1, pg8::StaticOrder, true, true>(lds, g, S, E);
    }
    SEAM(1);
    PEND(1);
    PSTART(2);
    if (IN(2)) {
        p2_rows(args, gw, NGW, lane);
        p2_conv_state(args, gtid, NGT);
    }
    SEAM(2);
    PEND(2);
    PSTART(3);
    if (IN(3)) {
        { pg8::Gemm g{(const pg8::bf16_t*)(ws + WS_QD), (const pg8::bf16_t*)(ws + WS_WQ), MPAD, 1536, 512};
          pg8::StaticOrder S; S.init(MPAD, 1536, G, bid);
          EpiStore<0> E{(bf16*)(ws + WS_QP), 1536, 6, (bf16*)(ws + WS_QP), 1536};
          pg8::gemm_phase<EpiStore<0>, pg8::StaticOrder, true, true>(lds, g, S, E); }
        { pg8::Gemm g{(const pg8::bf16_t*)(ws + WS_C), (const pg8::bf16_t*)(ws + WS_WKV), MPAD, 2048, 512};
          pg8::StaticOrder S; S.init(MPAD, 2048, G, G - 1 - bid);
          EpiStore<0> E{(bf16*)(ws + WS_KN), 1024, 4, (bf16*)(ws + WS_V), 1024};
          pg8::gemm_phase<EpiStore<0>, pg8::StaticOrder, true, true>(lds, g, S, E); }
        for (int u = bid; u < 2048; u += G) gdn_a_unit(args, lds, u, tid, lane, wave);
        for (int u = bid; u < 256; u += G) gdn_r_unit(args, lds, u, tid, lane, wave);
    }
    SEAM(3);
    PEND(3);
    PSTART(4);
    if (IN(4)) { p4_rows(args, gw, NGW, lane); }
    SEAM(4);
    PEND(4);
    PSTART(5);
    if (IN(5)) {
        unsigned* qctr = (unsigned*)(ws + WS_CTL) + 64;
#define PULL(k) ({ __syncthreads(); if (tid == 0) MISC[0] = atomicAdd(qctr + 64 * (k), 1u); __syncthreads(); (int)MISC[0]; })
        PSTART(50);
        for (int it = PULL(0); it < 64; it = PULL(0)) gdn_b_unit(args, lds, it, tid, lane, wave);
        PEND(50); PSTART(51);
        for (int u = PULL(1); u < 256; u = PULL(1)) {
            const int bh = u >> 2, pr = u & 3, b = bh >> 3, h = bh & 7;
#pragma unroll 1
            for (int s2 = 0; s2 < 2; ++s2) { const int qb = s2 ? pr : 7 - pr;
                att::attn_block((const bf16*)(ws + WS_QP2) + (size_t)(b * SEQ + 256 * qb) * 1536 + h * 192, (const bf16*)(ws + WS_KN) + (size_t)(b * SEQ) * 1024 + h * 128,
                                (const bf16*)(ws + WS_KR) + (size_t)(b * SEQ) * 64, (const bf16*)(ws + WS_V) + (size_t)(b * SEQ) * 1024 + h * 128,
                                (bf16*)(ws + WS_YB) + (size_t)(b * SEQ + 256 * qb) * 1024 + h * 128, 256 * qb, lds); }
        }
        PEND(51); PSTART(52);
        dec_run(args, lds, MISC, qctr + 128, tid, lane, wave);
        PEND(52);
#undef PULL
    }
    SEAM(5);
    PEND(5);
    PSTART(6);
    if (IN(6)) { for (int u = bid; u < 256; u += G) dec_combine(args, lds, u, tid, lane, wave); }
    SEAM(6);
    PEND(6);
    PSTART(7);
    if (IN(7)) {
        for (int t = bid; t < 32; t += G) skinny_tile<0>(args, lds, t, tid, lane, wave);
        pg8::StaticOrder S; S.init(MP, 1024, G, bid);
        { pg8::Gemm g{(const pg8::bf16_t*)(ws + WS_YA), (const pg8::bf16_t*)(ws + WS_WYA), MP, 1024, 1024};
          EpiMerge<1> E{(const bf16*)(ws + WS_GATES), (float*)(ws + WS_TF), (bf16*)(ws + WS_T)};
          pg8::gemm_phase<EpiMerge<1>, pg8::StaticOrder, true, true>(lds, g, S, E); }
        { pg8::Gemm g{(const pg8::bf16_t*)(ws + WS_YB), (const pg8::bf16_t*)(ws + WS_WYB), MP, 1024, 1024};
          EpiMerge<2> E{(const bf16*)(ws + WS_GATES), (float*)(ws + WS_TF), (bf16*)(ws + WS_T)};
          pg8::gemm_phase<EpiMerge<2>, pg8::StaticOrder, true, true>(lds, g, S, E); }
    }
    SEAM(7);
    PEND(7);
    PSTART(8);
    if (IN(8)) {
        for (int t = bid; t < 32; t += G) skinny_tile<1>(args, lds, t, tid, lane, wave);
        pg8::Gemm g{(const pg8::bf16_t*)(ws + WS_T), (const pg8::bf16_t*)(ws + WS_WO), MP, 1024, 1024};
        pg8::StaticOrder S; S.init(MP, 1024, G, bid);
        EpiRes<0> E{args.in[I_XP], args.in[I_XS], (float*)(ws + WS_X1), args.out};
        pg8::gemm_phase<EpiRes<0>, pg8::StaticOrder, true, true>(lds, g, S, E);
    }
    SEAM(8);
    PEND(8);
    PSTART(9);
    if (IN(9)) {
        bf16* XN2 = (bf16*)(ws + WS_XN2); const float* X1 = (const float*)(ws + WS_X1);
        for (int m = gw; m < MPAD; m += NGW) {
            if (m < MR) rms_row_to_bf16(X1 + (size_t)m * 1024, args.in[I_NMLP], XN2 + (size_t)m * 1024, lane);
            else { v4u z = {0u, 0u, 0u, 0u}; *((v4u*)(XN2 + (size_t)m * 1024) + lane) = z; *((v4u*)(XN2 + (size_t)m * 1024) + 64 + lane) = z; }
        }
    }
    SEAM(9);
    PEND(9);
    PSTART(10);
    if (IN(10)) {
        for (int t = bid; t < 128; t += G) skinny_tile<2>(args, lds, t, tid, lane, wave);
        pg8::Gemm g{(const pg8::bf16_t*)(ws + WS_XN2), (const pg8::bf16_t*)(ws + WS_WUP), MP, 4096, 1024};
        pg8::StaticOrder S; S.init(MP, 4096, G, bid);
        EpiStore<1> E{(bf16*)(ws + WS_H), 4096, 16, (bf16*)(ws + WS_H), 4096};
        pg8::gemm_phase<EpiStore<1>, pg8::StaticOrder, true, true>(lds, g, S, E);
    }
    SEAM(10);
    PEND(10);
    PSTART(11);
    if (IN(11)) {
        for (int t = bid; t < 32; t += G) skinny_tile<3>(args, lds, t, tid, lane, wave);
        pg8::Gemm g{(const pg8::bf16_t*)(ws + WS_H), (const pg8::bf16_t*)(ws + WS_WDN), MP, 1024, 4096};
        pg8::StaticOrder S; S.init(MP, 1024, G, bid);
        EpiRes<1> E{args.in[I_XP], args.in[I_XS], (float*)(ws + WS_X1), args.out};
        pg8::gemm_phase<EpiRes<1>, pg8::StaticOrder, true, true>(lds, g, S, E);
    }
    PEND(11);
#ifdef PROBE_K
    if (bid == 0) { const unsigned long long te = __builtin_amdgcn_s_memrealtime(); while (__builtin_amdgcn_s_memrealtime() - te < (unsigned long long)PROBE_MULT * pdt) __builtin_amdgcn_s_sleep(8); }
#endif
#undef IN
#undef SEAM
}

extern "C" void kernel_launch(void* const* d_in, const int* in_sizes, int n_in, void* d_out, int out_size, void* d_ws, size_t ws_size, hipStream_t stream) {
    static int grid = 0;
    if (grid == 0) {
        if (n_in != 27 || ws_size < WS_END) { fprintf(stderr, "kernel_launch: unexpected n_in %d or ws_size %zu (need %zu)\n", n_in, ws_size, (size_t)WS_END); grid = -1; return; }
        int dev = 0, cus = 0, per_cu = 0;
        if (hipGetDevice(&dev) != hipSuccess || hipDeviceGetAttribute(&cus, hipDeviceAttributeMultiprocessorCount, dev) != hipSuccess) { grid = -1; return; }
        if (hipFuncSetAttribute((const void*)mk_fwd, hipFuncAttributeMaxDynamicSharedMemorySize, LDS_BYTES) != hipSuccess) { fprintf(stderr, "kernel_launch: hipFuncSetAttribute failed\n"); grid = -1; return; }
        if (hipOccupancyMaxActiveBlocksPerMultiprocessor(&per_cu, (const void*)mk_fwd, 512, LDS_BYTES) != hipSuccess || per_cu < 1) fprintf(stderr, "kernel_launch: occupancy query says %d\n", per_cu);
        (void)hipGetLastError();
        grid = cus;
    }
    if (grid < 0) return;
    (void)hipMemsetAsync((char*)d_ws + WS_CTL, 0, CTL_BYTES, stream);
    Args a{};
    for (int i = 0; i < 27; ++i) a.in[i] = (const float*)d_in[i];
    a.out = (float*)d_out; a.ws = (unsigned char*)d_ws;
#if MK_SINGLE
    a.ph_lo = 0; a.ph_hi = N_PHASES;
    hipLaunchKernelGGL(mk_fwd, dim3(grid), dim3(512), LDS_BYTES, stream, a);
#else
    for (int p = 0; p < N_PHASES; ++p) { a.ph_lo = p; a.ph_hi = p + 1; hipLaunchKernelGGL(mk_fwd, dim3(grid), dim3(512), LDS_BYTES, stream, a); }
#endif
    const hipError_t le = hipPeekAtLastError();
    if (le != hipSuccess) fprintf(stderr, "kernel_launch: launch failed: %s\n", hipGetErrorName(le));
}
```

```cpp
#include <hip/hip_runtime.h>
#include <cstdio>
#include <cstdint>
namespace pg8 {
#define PG8_LAS __attribute__((address_space(3)))
typedef unsigned short bf16_t;
typedef short bf16x8 __attribute__((ext_vector_type(8)));
typedef float f32x4 __attribute__((ext_vector_type(4)));
typedef unsigned u32x4 __attribute__((ext_vector_type(4)));
constexpr int BM = 256, BK = 64, HALF = 128, HTB = HALF * BK * 2  , STAGE_BYTES = 8 * HTB, NXCD = 8, WGM = 8;

__host__ __device__ __forceinline__ int lds_byte(int r, int c) { const int st = (r >> 4) * 2 + (c >> 5), rr = r & 15, cc = c & 31, ob = rr * 64 + cc * 2; return st * 1024 + (ob ^ (((ob >> 9) & 1) << 5)); }
__host__ __device__ __forceinline__ void stage_rc(int b, int& R, int& C) { const int st = b / 1024, sb = b % 1024, swz = sb ^ (((sb >> 9) & 1) << 5); R = (st >> 1) * 16 + swz / 64; C = (st & 1) * 32 + (swz % 64) / 2; }
__host__ __device__ __forceinline__ int perm32(int rho) { const int n = rho >> 4, i = rho & 15; return 8 * (i >> 2) + 4 * n + (i & 3); }

struct Unit { int pm, pn; };
struct Gemm { const bf16_t* A; const bf16_t* Bt; int M, N, K; };

struct StaticOrder {
    int nM, nN, nwg, G, c;
    __host__ __device__ void init(int M, int N, int G_, int c_) { nM = M / BM; nN = N / BM; nwg = nM * nN; G = G_; c = c_; }
    __host__ __device__ bool next(int i, Unit& u) const {
        const long L = (long)i * G + c; if (L >= nwg) return false;
        int wgid = (int)L; { const int q = nwg / NXCD, r = nwg % NXCD, xcd = wgid % NXCD, off = wgid / NXCD; wgid = (xcd < r ? xcd * (q + 1) : r * (q + 1) + (xcd - r) * q) + off; }
        const int nig = WGM * nN, gid = wgid / nig, fm = gid * WGM, gsz = (nM - fm) < WGM ? (nM - fm) : WGM;
        u.pm = fm + ((wgid % nig) % gsz); u.pn = (wgid % nig) / gsz; return true;
    }
    __device__ __forceinline__ void a_ready(const Unit&) const {}
    __device__ __forceinline__ void done(const Unit&) const {}
};

__device__ __forceinline__ unsigned cvt_pk_bf16(float lo, float hi) { unsigned r; asm volatile("v_cvt_pk_bf16_f32 %0, %1, %2" : "=v"(r) : "v"(lo), "v"(hi)); return r; }
template <class Epi, class Sched, bool ALIGN_EPI = false, bool SP2 = false>
__device__ __forceinline__ void gemm_phase(PG8_LAS unsigned char* lds, const Gemm g, const Sched& S, const Epi& E) {
    const int tid = threadIdx.x, wid = __builtin_amdgcn_readfirstlane(tid >> 6), lane = tid & 63, wr = wid >> 2, wc = wid & 3, fr = lane & 15, fq = lane >> 4;
    const int K = g.K, nt = K / BK;
    unsigned voffA[2], voffB[2];
#pragma unroll
    for (int i = 0; i < 2; ++i) { int R, C; stage_rc(tid * 16 + i * 8192, R, C); const int Rb = Epi::PERM ? ((R & ~31) + perm32(R & 31)) : R;
        voffA[i] = (unsigned)(R * K + C) * 2u; voffB[i] = (unsigned)(Rb * K + C) * 2u; }
    const size_t kstep = (size_t)(BK * 2);
    const size_t hstep = (size_t)HALF * K * 2;
    const size_t tstep = 2 * hstep;
    const unsigned ldsw = (unsigned)wid * 1024u;
    const int aoff = lds_byte(wr * 64 + fr, fq * 8), boff = lds_byte(wc * 32 + fr, fq * 8);
#define PG8_SA(b, h) (((b) * 2 + (h)) * HTB)
#define PG8_SB(b, h) ((4 + (b) * 2 + (h)) * HTB)
#define PG8_STAGE(bufoff, gbase, voff) do { _Pragma("unroll") for (int _i = 0; _i < 2; ++_i) \
        __builtin_amdgcn_global_load_lds((const unsigned*)((const char*)(gbase) + (voff)[_i]), (PG8_LAS unsigned*)(lds + (bufoff) + ldsw + _i * 8192), 16, 0, 0); } while (0)
#define PG8_LDA(dst, b, h) do { _Pragma("unroll") for (int m = 0; m < 4; ++m) _Pragma("unroll") for (int k = 0; k < 2; ++k) dst[m][k] = *(const PG8_LAS bf16x8*)(lds + PG8_SA(b, h) + aoff + m * 2048 + k * 1024); } while (0)
#define PG8_LDB(dst, b, h) do { _Pragma("unroll") for (int n = 0; n < 2; ++n) _Pragma("unroll") for (int k = 0; k < 2; ++k) dst[n][k] = *(const PG8_LAS bf16x8*)(lds + PG8_SB(b, h) + boff + n * 2048 + k * 1024); } while (0)
#define PG8_MMA(ai, bj, At, Bt) do { __builtin_amdgcn_s_setprio(1); _Pragma("unroll") for (int m = 0; m < 4; ++m) _Pragma("unroll") for (int n = 0; n < 2; ++n) _Pragma("unroll") for (int k = 0; k < 2; ++k) \
        acc[ai][bj][m][n] = __builtin_amdgcn_mfma_f32_16x16x32_bf16(Bt[n][k], At[m][k], acc[ai][bj][m][n], 0, 0, 0); __builtin_amdgcn_s_setprio(0); } while (0)
#define PG8_WAIT_V(n) asm volatile("s_waitcnt vmcnt(" #n ")" ::: "memory")
#define PG8_WAIT_L(n) asm volatile("s_waitcnt lgkmcnt(" #n ")" ::: "memory")
#define PG8_BAR __builtin_amdgcn_s_barrier()
#define PG8_SCHED __builtin_amdgcn_sched_barrier(0)
    Unit cur, nxt; int ui = 0;
    if (!S.next(0, cur)) return;
    f32x4 acc[2][2][4][2];
#pragma unroll
    for (int a = 0; a < 2; ++a)
#pragma unroll
        for (int b = 0; b < 2; ++b)
#pragma unroll
            for (int m = 0; m < 4; ++m)
#pragma unroll
                for (int n = 0; n < 2; ++n) acc[a][b][m][n] = (f32x4){0.f, 0.f, 0.f, 0.f};
    bf16x8 At[4][2], B0[2][2], B1[2][2];
    const char* cA = (const char*)g.A + (size_t)cur.pm * tstep; const char* cB = (const char*)g.Bt + (size_t)cur.pn * tstep;
    S.a_ready(cur);
    if constexpr (SP2) {
        PG8_STAGE(PG8_SB(0, 0), cB, voffB); PG8_STAGE(PG8_SB(0, 1), cB + hstep, voffB); PG8_STAGE(PG8_SA(0, 0), cA, voffA); PG8_STAGE(PG8_SA(0, 1), cA + hstep, voffA);
        if (wr == 1) PG8_BAR;
        PG8_WAIT_V(2); PG8_BAR;
        PG8_STAGE(PG8_SB(1, 0), cB + kstep, voffB); PG8_STAGE(PG8_SA(1, 0), cA + kstep, voffA); PG8_STAGE(PG8_SB(1, 1), cB + hstep + kstep, voffB);
        PG8_WAIT_V(6); PG8_BAR;
    } else {
        PG8_STAGE(PG8_SB(0, 0), cB, voffB); PG8_STAGE(PG8_SA(0, 0), cA, voffA); PG8_STAGE(PG8_SB(0, 1), cB + hstep, voffB); PG8_STAGE(PG8_SA(0, 1), cA + hstep, voffA);
        if (wr == 1) PG8_BAR;
        PG8_WAIT_V(4); PG8_BAR;
        PG8_STAGE(PG8_SB(1, 0), cB + kstep, voffB); PG8_STAGE(PG8_SA(1, 0), cA + kstep, voffA); PG8_STAGE(PG8_SB(1, 1), cB + hstep + kstep, voffB);
        PG8_WAIT_V(6); PG8_BAR;
    }
    for (;;) {
        const bool has_next = S.next(ui + 1, nxt);
        const char* nA = has_next ? (const char*)g.A + (size_t)nxt.pm * tstep : cA; const char* nB = has_next ? (const char*)g.Bt + (size_t)nxt.pn * tstep : cB;
        for (int t = 0; t < nt; t += 2) {
            const bool last = (t == nt - 2);
            const char* a1 = cA + (size_t)(t + 1) * kstep;
            const char* a2 = last ? nA : cA + (size_t)(t + 2) * kstep; const char* b2 = last ? nB : cB + (size_t)(t + 2) * kstep;
            const char* a3 = a2 + kstep; const char* b3 = b2 + kstep;
            if (last && has_next) S.a_ready(nxt);
            if constexpr (SP2) {
            PG8_LDB(B0, 0, 0); PG8_LDB(B1, 0, 1); PG8_SCHED; PG8_LDA(At, 0, 0); PG8_STAGE(PG8_SA(1, 1), a1 + hstep, voffA);
            PG8_WAIT_V(8); PG8_WAIT_L(0); PG8_BAR; PG8_MMA(0, 0, At, B0); PG8_MMA(0, 1, At, B1); PG8_BAR; PG8_SCHED;
            PG8_LDA(At, 0, 1); PG8_STAGE(PG8_SB(0, 0), b2, voffB); PG8_STAGE(PG8_SB(0, 1), b2 + hstep, voffB); PG8_STAGE(PG8_SA(0, 0), a2, voffA);
            PG8_WAIT_V(8); PG8_WAIT_L(0); PG8_BAR; PG8_MMA(1, 0, At, B0); PG8_MMA(1, 1, At, B1); PG8_BAR; PG8_SCHED;
            PG8_LDB(B0, 1, 0); PG8_LDB(B1, 1, 1); PG8_SCHED; PG8_LDA(At, 1, 0); PG8_STAGE(PG8_SA(0, 1), a2 + hstep, voffA);
            PG8_WAIT_V(8); PG8_WAIT_L(0); PG8_BAR; PG8_MMA(0, 0, At, B0); PG8_MMA(0, 1, At, B1); PG8_BAR; PG8_SCHED;
            PG8_LDA(At, 1, 1); PG8_STAGE(PG8_SB(1, 0), b3, voffB); PG8_STAGE(PG8_SB(1, 1), b3 + hstep, voffB); PG8_STAGE(PG8_SA(1, 0), a3, voffA);
            PG8_WAIT_V(8); PG8_WAIT_L(0); PG8_BAR; PG8_MMA(1, 0, At, B0); PG8_MMA(1, 1, At, B1); PG8_BAR; PG8_SCHED;
            } else {
            PG8_LDB(B0, 0, 0); PG8_SCHED; PG8_LDA(At, 0, 0); PG8_STAGE(PG8_SA(1, 1), a1 + hstep, voffA);
            PG8_WAIT_L(8); PG8_BAR; PG8_WAIT_L(0); PG8_MMA(0, 0, At, B0); PG8_BAR; PG8_SCHED;
            PG8_LDB(B1, 0, 1); PG8_STAGE(PG8_SB(0, 0), b2, voffB);
            PG8_BAR; PG8_WAIT_L(0); PG8_MMA(0, 1, At, B1); PG8_BAR;
            PG8_LDA(At, 0, 1); PG8_STAGE(PG8_SA(0, 0), a2, voffA);
            PG8_BAR; PG8_WAIT_L(0); PG8_MMA(1, 0, At, B0); PG8_BAR; PG8_SCHED;
            PG8_STAGE(PG8_SB(0, 1), b2 + hstep, voffB);
            PG8_WAIT_V(6); PG8_BAR; PG8_MMA(1, 1, At, B1); PG8_BAR;
            PG8_LDB(B0, 1, 0); PG8_SCHED; PG8_LDA(At, 1, 0); PG8_STAGE(PG8_SA(0, 1), a2 + hstep, voffA);
            PG8_WAIT_L(8); PG8_BAR; PG8_WAIT_L(0); PG8_MMA(0, 0, At, B0); PG8_BAR; PG8_SCHED;
            PG8_LDB(B1, 1, 1); PG8_STAGE(PG8_SB(1, 0), b3, voffB);
            PG8_BAR; PG8_WAIT_L(0); PG8_MMA(0, 1, At, B1); PG8_BAR;
            PG8_LDA(At, 1, 1); PG8_STAGE(PG8_SA(1, 0), a3, voffA);
            PG8_BAR; PG8_WAIT_L(0); PG8_MMA(1, 0, At, B0); PG8_BAR; PG8_SCHED;
            PG8_STAGE(PG8_SB(1, 1), b3 + hstep, voffB);
            PG8_WAIT_V(6); PG8_BAR; PG8_MMA(1, 1, At, B1); PG8_BAR;
            }
        }
        if constexpr (ALIGN_EPI) { if (wr == 0) PG8_BAR; }
        if constexpr (!Epi::AFTER_DRAIN) { E(acc, cur, wr, wc, fr, fq); S.done(cur); }
        if (!has_next) break;
#pragma unroll
        for (int a = 0; a < 2; ++a)
#pragma unroll
            for (int b = 0; b < 2; ++b)
#pragma unroll
                for (int m = 0; m < 4; ++m)
#pragma unroll
                    for (int n = 0; n < 2; ++n) acc[a][b][m][n] = (f32x4){0.f, 0.f, 0.f, 0.f};
        cur = nxt; cA = nA; cB = nB; ++ui;
        if constexpr (ALIGN_EPI) { if (wr == 1) PG8_BAR; }
    }
    PG8_WAIT_V(0);
    if constexpr (!ALIGN_EPI) { if (wr == 0) PG8_BAR; }
    PG8_BAR;
    if constexpr (Epi::AFTER_DRAIN) { E.fused(acc, cur, wr, wc, fr, fq, lds, wid, lane); S.done(cur); }
#undef PG8_SA
#undef PG8_SB
#undef PG8_STAGE
#undef PG8_LDA
#undef PG8_LDB
#undef PG8_MMA
#undef PG8_WAIT_V
#undef PG8_WAIT_L
#undef PG8_BAR
#undef PG8_SCHED
}
}
#define XB_TMO      128
#define XB_XCNT(j)  (256  + 64 * (j))
#define XB_XSUB(j)  (1280 + 64 * (j))
#define XB_XGEN(j)  (2304 + 64 * (j))
#define XB_TOP      3328
#define XB_TOPGEN   3392
#define XCD_BAR_WORDS 3456
#define XB_SPIN_CAP (1u << 18)
#define LAS __attribute__((address_space(3)))

__device__ __forceinline__ unsigned xb_ld(unsigned* p)              { return __hip_atomic_load(p, __ATOMIC_RELAXED, __HIP_MEMORY_SCOPE_AGENT); }
__device__ __forceinline__ unsigned xb_add(unsigned* p, unsigned v) { return __hip_atomic_fetch_add(p, v, __ATOMIC_RELAXED, __HIP_MEMORY_SCOPE_AGENT); }
__device__ __forceinline__ unsigned xb_xcc_id() { return (unsigned)__builtin_amdgcn_s_getreg((3 << 11) | 20) & 0xFu; }
#define XB_SPIN(cond, bar) do { unsigned _sp = 0; while (cond) { __builtin_amdgcn_s_sleep(1); \
    if ((++_sp & 255u) == 0u) { if (xb_ld(&(bar)[XB_TMO])) break; if (_sp > XB_SPIN_CAP) { atomicAdd(&(bar)[XB_TMO], 1u); break; } } } } while (0)

struct XcdBarrier {
    unsigned* bar; unsigned x;
    volatile LAS unsigned* st;
};

__device__ __forceinline__ XcdBarrier xcd_barrier_post(unsigned* bar, volatile LAS unsigned* st) {
    XcdBarrier b; b.bar = bar; b.x = xb_xcc_id(); b.st = st;
    if (threadIdx.x == 0) (void)xb_add(&bar[XB_XCNT(b.x)], 1u);
    return b;
}
__device__ __forceinline__ void xcd_barrier_complete(unsigned* bar, unsigned x, unsigned& nloc, unsigned& nx) {
    const unsigned G = gridDim.x * gridDim.y * gridDim.z;
    unsigned sum, cnt, mine, sp = 0u;
    for (;;) {
        sum = 0u; cnt = 0u; mine = 0u;
#pragma unroll
        for (unsigned j = 0; j < 16; ++j) { const unsigned c = xb_ld(&bar[XB_XCNT(j)]); sum += c; cnt += (c > 0u) ? 1u : 0u; mine = (j == x) ? c : mine; }
        if (sum == G) break;
        __builtin_amdgcn_s_sleep(1);
        if ((++sp & 255u) == 0u) { if (xb_ld(&bar[XB_TMO])) break; if (sp > XB_SPIN_CAP) { atomicAdd(&bar[XB_TMO], 1u); break; } }
    }
    nloc = mine > 0u ? mine : 1u; nx = cnt > 0u ? cnt : 1u;
}

__device__ __forceinline__ void xcd_barrier(const XcdBarrier& b) {
    asm volatile("s_waitcnt vmcnt(0)" ::: "memory");
    __syncthreads();
    if (threadIdx.x == 0) {
        unsigned* bar = b.bar;
        __builtin_amdgcn_s_waitcnt(0);
        unsigned nloc = b.st[0], nx = b.st[1];
        if (nloc == 0u) { xcd_barrier_complete(bar, b.x, nloc, nx); b.st[0] = nloc; b.st[1] = nx; }
        const unsigned old = xb_add(&bar[XB_XSUB(b.x)], 1u);
        const unsigned gen = old / nloc;
        if (old + 1u == (gen + 1u) * nloc) {
            __builtin_amdgcn_fence(__ATOMIC_RELEASE, "agent");
            asm volatile("s_waitcnt vmcnt(0)" ::: "memory");
            const unsigned og = xb_add(&bar[XB_TOP], 1u);
            const unsigned tg = og / nx;
            if (og + 1u == (tg + 1u) * nx) xb_add(&bar[XB_TOPGEN], 1u);
            else XB_SPIN(xb_ld(&bar[XB_TOPGEN]) == tg, bar);
            __builtin_amdgcn_fence(__ATOMIC_ACQUIRE, "agent");
            xb_add(&bar[XB_XGEN(b.x)], 1u);
            asm volatile("s_waitcnt vmcnt(0)" ::: "memory");
        } else {
            XB_SPIN(xb_ld(&bar[XB_XGEN(b.x)]) == gen, bar);
            __builtin_amdgcn_fence(__ATOMIC_ACQUIRE, "agent");
            asm volatile("s_waitcnt vmcnt(0)" ::: "memory");
        }
    }
    __syncthreads();
}
constexpr int MP = 16384, MS = 32, MR = MP + MS, MPAD = 16640;
constexpr int SEQ = 2048, NB = 8, NH = 8, DM = 1024;
constexpr int QKVW = 3072, NIN = 7424;
constexpr int PAST = 16384, NPAGE = 128, PAGE = 128, LATW = 576;
constexpr float EPS = 1e-6f;
constexpr float MLA_SCALE = 0.07216878364870322f;

constexpr size_t O_YP = 0, O_YS = O_YP + (size_t)MP * 1024, O_ROWSP = O_YS + 32 * 1024, O_GSP = O_ROWSP + (size_t)MP * 576,
                 O_CSP = O_GSP + 8 * 8 * 128 * 128, O_ROWSS = O_CSP + 8 * 3 * 3072, O_GSS = O_ROWSS + 32 * 576, O_CSS = O_GSS + (size_t)32 * 8 * 128 * 128;

constexpr size_t WS_CTL = 0, CTL_BYTES = 1u << 20;
constexpr size_t WS_WIN = CTL_BYTES;
constexpr size_t WS_WQ  = WS_WIN + (size_t)NIN * 1024 * 2;
constexpr size_t WS_WKV = WS_WQ + (size_t)1536 * 512 * 2;
constexpr size_t WS_WYA = WS_WKV + (size_t)2048 * 512 * 2;
constexpr size_t WS_WYB = WS_WYA + (size_t)1024 * 1024 * 2;
constexpr size_t WS_WO  = WS_WYB + (size_t)1024 * 1024 * 2;
constexpr size_t WS_WUP = WS_WO + (size_t)1024 * 1024 * 2;
constexpr size_t WS_WDN = WS_WUP + (size_t)4096 * 1024 * 2;
constexpr size_t WS_XN  = WS_WDN + (size_t)4096 * 1024 * 2;
constexpr size_t WS_QKV = WS_XN + (size_t)MPAD * 1024 * 2;
constexpr size_t WS_Z   = WS_QKV + (size_t)MPAD * 3072 * 2;
constexpr size_t WS_QD  = WS_Z + (size_t)MPAD * 1024 * 2;
constexpr size_t WS_KVD = WS_QD + (size_t)MPAD * 512 * 2;
constexpr size_t WS_SM  = WS_KVD + (size_t)MPAD * 512 * 2;
constexpr size_t WS_GATES = WS_SM + (size_t)MPAD * 128 * 4;
constexpr size_t WS_C   = WS_GATES + (size_t)MPAD * 2048 * 2;
constexpr size_t WS_KR  = WS_C + (size_t)MPAD * 512 * 2;
constexpr size_t WS_BETA = WS_KR + (size_t)MPAD * 64 * 2;
constexpr size_t WS_GLOG = WS_BETA + (size_t)MPAD * 8 * 4;
constexpr size_t WS_QP  = WS_GLOG + (size_t)MPAD * 8 * 4;
constexpr size_t WS_QP2 = WS_QP + (size_t)MPAD * 1536 * 2;
constexpr size_t WS_KN  = WS_QP2 + (size_t)MPAD * 1536 * 2;
constexpr size_t WS_V   = WS_KN + (size_t)MPAD * 1024 * 2;
constexpr size_t WS_YA  = WS_V + (size_t)MPAD * 1024 * 2;
constexpr size_t WS_YB  = WS_YA + (size_t)MPAD * 1024 * 2;
constexpr size_t WS_TF  = WS_YB + (size_t)MPAD * 1024 * 2;
constexpr size_t WS_T   = WS_TF + (size_t)MPAD * 1024 * 4;
constexpr size_t WS_X1  = WS_T + (size_t)MPAD * 1024 * 2;
constexpr size_t WS_XN2 = WS_X1 + (size_t)MPAD * 1024 * 4;
constexpr size_t WS_H   = WS_XN2 + (size_t)MPAD * 1024 * 2;
constexpr size_t WS_GU0 = WS_H + (size_t)MPAD * 4096 * 2;
constexpr size_t WS_GW  = WS_GU0 + (size_t)2048 * 64 * 128 * 4;
constexpr size_t WS_GQG = WS_GW + (size_t)2048 * 64 * 128 * 2;
constexpr size_t WS_GKD = WS_GQG + (size_t)2048 * 64 * 128 * 2;
constexpr size_t WS_GAQK = WS_GKD + (size_t)2048 * 64 * 128 * 2;
constexpr size_t WS_GEND = WS_GAQK + (size_t)2048 * 64 * 64 * 2;
constexpr size_t WS_DML = WS_GEND + (size_t)2048 * 4 * 64;
constexpr size_t WS_DACC = WS_DML + (size_t)4096 * 8 * 2 * 4;
constexpr size_t WS_WKT = WS_DACC + (size_t)4096 * 8 * 512 * 4;
constexpr size_t WS_END = WS_WKT + (size_t)1024 * 512 * 2;

constexpr int LDS_BYTES = 163840;
constexpr int MISC_OFF = LDS_BYTES - 128;

#define GAS __attribute__((address_space(1)))
typedef unsigned short bf16;
typedef unsigned v4u __attribute__((ext_vector_type(4)));
typedef unsigned v2u __attribute__((ext_vector_type(2)));
typedef float f32x4 __attribute__((ext_vector_type(4)));
typedef float f32x16 __attribute__((ext_vector_type(16)));
typedef short bf16x8 __attribute__((ext_vector_type(8)));
#define LDS_WAIT() asm volatile("s_waitcnt lgkmcnt(0)" ::: "memory")
#define VM_WAIT() asm volatile("s_waitcnt vmcnt(0)" ::: "memory")
#define LBAR() asm volatile("s_waitcnt lgkmcnt(0)\n\ts_barrier" ::: "memory")
__device__ __forceinline__ float bf2f(unsigned b) { return __builtin_bit_cast(float, b << 16); }
__device__ __forceinline__ unsigned f2bf(float f) { unsigned u = __builtin_bit_cast(unsigned, f); return (u + 0x7fffu + ((u >> 16) & 1u)) >> 16; }
__device__ __forceinline__ unsigned pk2(float lo, float hi) { return f2bf(lo) | (f2bf(hi) << 16); }
__device__ __forceinline__ float lo16(unsigned w) { return __builtin_bit_cast(float, w << 16); }
__device__ __forceinline__ float hi16(unsigned w) { return __builtin_bit_cast(float, w & 0xffff0000u); }
__device__ __forceinline__ float wave_sum(float v) {
#pragma unroll
    for (int o = 1; o < 64; o <<= 1) v += __shfl_xor(v, o);
    return v;
}
__device__ __forceinline__ float wave_max(float v) {
#pragma unroll
    for (int o = 1; o < 64; o <<= 1) v = fmaxf(v, __shfl_xor(v, o));
    return v;
}
__device__ __forceinline__ float sigmoidf_(float x) { return __builtin_amdgcn_rcpf(1.f + __expf(-x)); }
__device__ __forceinline__ float siluf_(float x) { return x * __builtin_amdgcn_rcpf(1.f + __expf(-x)); }

__constant__ float ROPE_INV[32] = {1.000000000e+00f,7.498942614e-01f,5.623413324e-01f,4.216965139e-01f,3.162277639e-01f,2.371373773e-01f,1.778279394e-01f,1.333521307e-01f,
    1.000000015e-01f,7.498941571e-02f,5.623413250e-02f,4.216965288e-02f,3.162277490e-02f,2.371373773e-02f,1.778279431e-02f,1.333521493e-02f,
    9.999999776e-03f,7.498941850e-03f,5.623413250e-03f,4.216964822e-03f,3.162277630e-03f,2.371373586e-03f,1.778279431e-03f,1.333521446e-03f,
    1.000000047e-03f,7.498942432e-04f,5.623413017e-04f,4.216965172e-04f,3.162277571e-04f,2.371373703e-04f,1.778279402e-04f,1.333521504e-04f};

struct Args { const float* in[27]; float* out; unsigned char* ws; int ph_lo, ph_hi; };
enum { I_XP = 0, I_XS, I_CACHE, I_SGDN, I_SCONV, I_PT, I_NMIX, I_WIN, I_CONVW, I_ALOG, I_DTB, I_GDNN, I_QAN, I_WUQ, I_KVAN, I_WUK, I_WUV,
       I_QNN, I_QNR, I_KNN, I_KNR, I_WYA, I_WYB, I_WO, I_NMLP, I_WUP, I_WDN };

__device__ __forceinline__ int src_col(int mode, int n) {
    if (mode == 0) {
        if (n < 4096) return n;
        if (n < 5184) return n + 16;
        if (n < 5200) return n - 5184 + 4096;
        if (n < 5376) return -1;
        return n - 5376 + 5200;
    }
    if (mode == 1) {
        if (n < 1024) return (n >> 7) * 192 + (n & 127);
        const int m = n - 1024; return (m >> 6) * 192 + 128 + (m & 63);
    }
    return n;
}
__device__ __forceinline__ void cvt_item(const float* W, int N, int K, bf16* WT, int row_off, int mode, LAS float* scr, int item, int nblk, int lane) {
    const int kb = item / nblk, nb = item % nblk, k0 = 64 * kb, n0 = 32 * nb;
    const int sc = src_col(mode, n0 + (lane & 31));
#pragma unroll 8
    for (int i = 0; i < 32; ++i) { const int kk = 2 * i + (lane >> 5); scr[kk * 33 + (lane & 31)] = sc >= 0 ? W[(size_t)(k0 + kk) * N + sc] : 0.f; }
    LDS_WAIT(); asm volatile("" ::: "memory");
    const int c = lane & 7;
#pragma unroll
    for (int j = 0; j < 4; ++j) { const int n = (lane >> 3) + 8 * j; const LAS float* s = scr + (8 * c) * 33 + n;
        v4u o; o.x = pk2(s[0 * 33], s[1 * 33]); o.y = pk2(s[2 * 33], s[3 * 33]); o.z = pk2(s[4 * 33], s[5 * 33]); o.w = pk2(s[6 * 33], s[7 * 33]);
        *(v4u*)(WT + (size_t)(row_off + n0 + n) * K + k0 + 8 * c) = o; }
    LDS_WAIT(); asm volatile("" ::: "memory");
}
__device__ __forceinline__ void rms_row_to_bf16(const float* xrow, const float* gain, bf16* orow, int lane) {
    const f32x4* xr = (const f32x4*)xrow + lane; const f32x4* gr = (const f32x4*)gain + lane;
    f32x4 v[4]; float s = 0.f;
#pragma unroll
    for (int j = 0; j < 4; ++j) { v[j] = xr[64 * j]; s += (v[j].x * v[j].x + v[j].y * v[j].y) + (v[j].z * v[j].z + v[j].w * v[j].w); }
    const float r = 1.f / sqrtf(wave_sum(s) * (1.f / 1024.f) + EPS);
    unsigned long long* o8 = (unsigned long long*)orow + lane;
#pragma unroll
    for (int j = 0; j < 4; ++j) { const f32x4 g = gr[64 * j];
        o8[64 * j] = (unsigned long long)pk2(v[j].x * r * g.x, v[j].y * r * g.y) | ((unsigned long long)pk2(v[j].z * r * g.z, v[j].w * r * g.w) << 32); }
}
__device__ __forceinline__ void p0_prologue(const Args& A, LAS unsigned char* lds, int gw, int NGW, int wave, int lane) {
    LAS float* scr = (LAS float*)(lds + wave * 16384);
    unsigned char* ws = A.ws;
    constexpr int I0 = 16 * (NIN / 32), I1 = 8 * (1536 / 32), I2 = 8 * 32, I3 = 8 * 32, I4 = 16 * 32, I5 = I4, I6 = I4, I7 = 16 * 128, I8 = 64 * 32;
    constexpr int NITEMS = I0 + I1 + I2 + I3 + I4 + I5 + I6 + I7 + I8;
    for (int it = gw; it < NITEMS; it += NGW) {
        int r = it;
        if (r < I0) { cvt_item(A.in[I_WIN], 7248, 1024, (bf16*)(ws + WS_WIN), 0, 0, scr, r, NIN / 32, lane); continue; } r -= I0;
        if (r < I1) { cvt_item(A.in[I_WUQ], 1536, 512, (bf16*)(ws + WS_WQ), 0, 1, scr, r, 1536 / 32, lane); continue; } r -= I1;
        if (r < I2) { cvt_item(A.in[I_WUK], 1024, 512, (bf16*)(ws + WS_WKV), 0, 2, scr, r, 32, lane); continue; } r -= I2;
        if (r < I3) { cvt_item(A.in[I_WUV], 1024, 512, (bf16*)(ws + WS_WKV), 1024, 2, scr, r, 32, lane); continue; } r -= I3;
        if (r < I4) { cvt_item(A.in[I_WYA], 1024, 1024, (bf16*)(ws + WS_WYA), 0, 2, scr, r, 32, lane); continue; } r -= I4;
        if (r < I5) { cvt_item(A.in[I_WYB], 1024, 1024, (bf16*)(ws + WS_WYB), 0, 2, scr, r, 32, lane); continue; } r -= I5;
        if (r < I6) { cvt_item(A.in[I_WO], 1024, 1024, (bf16*)(ws + WS_WO), 0, 2, scr, r, 32, lane); continue; } r -= I6;
        if (r < I7) { cvt_item(A.in[I_WUP], 4096, 1024, (bf16*)(ws + WS_WUP), 0, 2, scr, r, 128, lane); continue; } r -= I7;
        cvt_item(A.in[I_WDN], 1024, 4096, (bf16*)(ws + WS_WDN), 0, 2, scr, r, 32, lane);
    }
    bf16* XN = (bf16*)(ws + WS_XN);
    for (int m = gw; m < MPAD; m += NGW) {
        if (m < MR) rms_row_to_bf16(m < MP ? A.in[I_XP] + (size_t)m * 1024 : A.in[I_XS] + (size_t)(m - MP) * 1024, A.in[I_NMIX], XN + (size_t)m * 1024, lane);
        else { v4u z = {0u, 0u, 0u, 0u}; *((v4u*)(XN + (size_t)m * 1024) + lane) = z; *((v4u*)(XN + (size_t)m * 1024) + 64 + lane) = z; }
    }
}

struct EpiG1 {
    static constexpr bool PERM = true, AFTER_DRAIN = false;
    bf16 *QKV, *Z, *QD, *KVD, *GATES; float* SM;
    __device__ __forceinline__ void operator()(const pg8::f32x4 (&acc)[2][2][4][2], const pg8::Unit& u, int wr, int wc, int fr, int fq) const {
        const int row0 = u.pm * 256 + wr * 64 + fr, pn = u.pn, cl = wc * 32 + 8 * fq;
        if (pn == 20) {
#pragma unroll
            for (int ai = 0; ai < 2; ++ai)
#pragma unroll
                for (int m = 0; m < 4; ++m) { float* rowp = SM + (size_t)(row0 + ai * 128 + m * 16) * 128 + cl;
                    *(pg8::f32x4*)rowp = acc[ai][0][m][0]; *(pg8::f32x4*)(rowp + 4) = acc[ai][0][m][1]; }
            return;
        }
        bf16* base; int ld; bool sg = false;
        if (pn < 12) { base = QKV + pn * 256; ld = 3072; }
        else if (pn < 16) { base = Z + (pn - 12) * 256; ld = 1024; }
        else if (pn < 18) { base = QD + (pn - 16) * 256; ld = 512; }
        else if (pn < 20) { base = KVD + (pn - 18) * 256; ld = 512; }
        else { base = GATES + (pn - 21) * 256; ld = 2048; sg = true; }
#pragma unroll
        for (int ai = 0; ai < 2; ++ai)
#pragma unroll
            for (int m = 0; m < 4; ++m) { bf16* rowp = base + (size_t)(row0 + ai * 128 + m * 16) * ld + cl;
#pragma unroll
                for (int bj = 0; bj < 2; ++bj) { pg8::f32x4 v0 = acc[ai][bj][m][0], v1 = acc[ai][bj][m][1];
                    if (sg) { v0 = (pg8::f32x4){sigmoidf_(v0[0]), sigmoidf_(v0[1]), sigmoidf_(v0[2]), sigmoidf_(v0[3])}; v1 = (pg8::f32x4){sigmoidf_(v1[0]), sigmoidf_(v1[1]), sigmoidf_(v1[2]), sigmoidf_(v1[3])}; }
                    pg8::u32x4 w; w.x = pg8::cvt_pk_bf16(v0[0], v0[1]); w.y = pg8::cvt_pk_bf16(v0[2], v0[3]); w.z = pg8::cvt_pk_bf16(v1[0], v1[1]); w.w = pg8::cvt_pk_bf16(v1[2], v1[3]);
                    *(pg8::u32x4*)(rowp + bj * 128) = w; } }
    }
};

__device__ __forceinline__ void p2_rows(const Args& A, int gw, int NGW, int lane) {
    unsigned char* ws = A.ws;
    bf16* QD = (bf16*)(ws + WS_QD); const bf16* KVD = (const bf16*)(ws + WS_KVD); const float* SM = (const float*)(ws + WS_SM);
    bf16* C = (bf16*)(ws + WS_C); bf16* KR = (bf16*)(ws + WS_KR); float* BETA = (float*)(ws + WS_BETA); float* GLOG = (float*)(ws + WS_GLOG);
    for (int m = gw; m < MR; m += NGW) {
        const int pos = m < MP ? (m & (SEQ - 1)) : PAST;
        float* lat = m < MP ? A.out + O_ROWSP + (size_t)m * LATW : A.out + O_ROWSS + (size_t)(m - MP) * LATW;
        {
            v4u w = *((const v4u*)(QD + (size_t)m * 512) + lane);
            float v[8] = {lo16(w.x), hi16(w.x), lo16(w.y), hi16(w.y), lo16(w.z), hi16(w.z), lo16(w.w), hi16(w.w)};
            float s = 0.f;
#pragma unroll
            for (int i = 0; i < 8; ++i) s += v[i] * v[i];
            const float r = 1.f / sqrtf(wave_sum(s) * (1.f / 512.f) + EPS);
            const f32x4 g0 = *((const f32x4*)A.in[I_QAN] + 2 * lane), g1 = *((const f32x4*)A.in[I_QAN] + 2 * lane + 1);
            v4u o; o.x = pk2(v[0] * r * g0.x, v[1] * r * g0.y); o.y = pk2(v[2] * r * g0.z, v[3] * r * g0.w); o.z = pk2(v[4] * r * g1.x, v[5] * r * g1.y); o.w = pk2(v[6] * r * g1.z, v[7] * r * g1.w);
            *((v4u*)(QD + (size_t)m * 512) + lane) = o;
        }
        {
            v4u w = *((const v4u*)(KVD + (size_t)m * 512) + lane);
            float v[8] = {lo16(w.x), hi16(w.x), lo16(w.y), hi16(w.y), lo16(w.z), hi16(w.z), lo16(w.w), hi16(w.w)};
            float s = 0.f;
#pragma unroll
            for (int i = 0; i < 8; ++i) s += v[i] * v[i];
            const float r = 1.f / sqrtf(wave_sum(s) * (1.f / 512.f) + EPS);
            const f32x4 g0 = *((const f32x4*)A.in[I_KVAN] + 2 * lane), g1 = *((const f32x4*)A.in[I_KVAN] + 2 * lane + 1);
            f32x4 c0 = {v[0] * r * g0.x, v[1] * r * g0.y, v[2] * r * g0.z, v[3] * r * g0.w}, c1 = {v[4] * r * g1.x, v[5] * r * g1.y, v[6] * r * g1.z, v[7] * r * g1.w};
            *((f32x4*)lat + 2 * lane) = c0; *((f32x4*)lat + 2 * lane + 1) = c1;
            v4u o; o.x = pk2(c0.x, c0.y); o.y = pk2(c0.z, c0.w); o.z = pk2(c1.x, c1.y); o.w = pk2(c1.z, c1.w);
            *((v4u*)(C + (size_t)m * 512) + lane) = o;
        }
        {
            const float x = SM[(size_t)m * 128 + lane];
            const float r = 1.f / sqrtf(wave_sum(x * x) * (1.f / 64.f) + EPS);
            const float xr = x * r * A.in[I_KNR][lane];
            const float other = __shfl_xor(xr, 32);
            const float ang = (float)pos * ROPE_INV[lane & 31];
            const float cs = cosf(ang), sn = sinf(ang);
            const float o = lane < 32 ? xr * cs - other * sn : other * sn + xr * cs;
            lat[512 + lane] = o;
            KR[(size_t)m * 64 + lane] = (bf16)f2bf(o);
        }
        if (lane < 8) {
            const float b = SM[(size_t)m * 128 + 64 + lane], a = SM[(size_t)m * 128 + 72 + lane];
            BETA[(size_t)m * 8 + lane] = 1.f / (1.f + expf(-b));
            const float xx = a + A.in[I_DTB][lane];
            const float sp = fmaxf(xx, 0.f) + log1pf(expf(-fabsf(xx)));
            GLOG[(size_t)m * 8 + lane] = -expf(A.in[I_ALOG][lane]) * sp;
        }
    }
}
__device__ __forceinline__ void p2_conv_state(const Args& A, int gtid, int NGT) {
    const bf16* QKV = (const bf16*)(A.ws + WS_QKV);
    {
        const bf16* WKV = (const bf16*)(A.ws + WS_WKV); bf16* WKT = (bf16*)(A.ws + WS_WKT);
        for (int c = gtid; c < 65536; c += NGT) { const int blk = c >> 6, l = c & 63, rt = blk >> 5, ks = blk & 31;
            *(v4u*)(WKT + (size_t)c * 8) = *(const v4u*)(WKV + (size_t)(rt * 32 + (l & 31)) * 512 + 16 * ks + 8 * (l >> 5)); }
    }
    for (int i = gtid; i < 8 * 3 * 3072; i += NGT) { const int c = i % 3072, r = (i / 3072) % 3, b = i / (3 * 3072);
        A.out[O_CSP + i] = bf2f(QKV[(size_t)(b * SEQ + SEQ - 3 + r) * 3072 + c]); }
    for (int i = gtid; i < 32 * 3 * 3072; i += NGT) { const int c = i % 3072, r = (i / 3072) % 3, j = i / (3 * 3072);
        A.out[O_CSS + i] = r < 2 ? A.in[I_SCONV][(size_t)(j * 3 + r + 1) * 3072 + c] : bf2f(QKV[(size_t)(MP + j) * 3072 + c]); }
}
__device__ __forceinline__ pg8::u32x4 pack8(const pg8::f32x4& v0, const pg8::f32x4& v1) {
    pg8::u32x4 w; w.x = pg8::cvt_pk_bf16(v0[0], v0[1]); w.y = pg8::cvt_pk_bf16(v0[2], v0[3]); w.z = pg8::cvt_pk_bf16(v1[0], v1[1]); w.w = pg8::cvt_pk_bf16(v1[2], v1[3]); return w;
}
template <int ACT> struct EpiStore {
    static constexpr bool PERM = true, AFTER_DRAIN = false;
    bf16* O0; int ld0; int split; bf16* O1; int ld1;
    __device__ __forceinline__ void operator()(const pg8::f32x4 (&acc)[2][2][4][2], const pg8::Unit& u, int wr, int wc, int fr, int fq) const {
        const int row0 = u.pm * 256 + wr * 64 + fr, cl = wc * 32 + 8 * fq;
        bf16* base; int ld;
        if (u.pn < split) { base = O0 + u.pn * 256; ld = ld0; } else { base = O1 + (u.pn - split) * 256; ld = ld1; }
#pragma unroll
        for (int ai = 0; ai < 2; ++ai)
#pragma unroll
            for (int m = 0; m < 4; ++m) { bf16* rowp = base + (size_t)(row0 + ai * 128 + m * 16) * ld + cl;
#pragma unroll
                for (int bj = 0; bj < 2; ++bj) { pg8::f32x4 v0 = acc[ai][bj][m][0], v1 = acc[ai][bj][m][1];
                    if (ACT == 1) {
#pragma unroll
                        for (int e = 0; e < 4; ++e) { const float a = fmaxf(v0[e], 0.f), b = fmaxf(v1[e], 0.f); v0[e] = a * a; v1[e] = b * b; } }
                    *(pg8::u32x4*)(rowp + bj * 128) = pack8(v0, v1); } }
    }
};
template <int STEP> struct EpiMerge {
    static constexpr bool PERM = true, AFTER_DRAIN = false;
    const bf16* GATES; float* TF; bf16* T;
    __device__ __forceinline__ void operator()(const pg8::f32x4 (&acc)[2][2][4][2], const pg8::Unit& u, int wr, int wc, int fr, int fq) const {
        const int row0 = u.pm * 256 + wr * 64 + fr, c0 = u.pn * 256 + wc * 32 + 8 * fq;
#pragma unroll
        for (int ai = 0; ai < 2; ++ai)
#pragma unroll
            for (int m = 0; m < 4; ++m) { const size_t row = (size_t)(row0 + ai * 128 + m * 16);
#pragma unroll
                for (int bj = 0; bj < 2; ++bj) { const int col = c0 + bj * 128;
                    const v4u gw = *(const v4u*)(GATES + row * 2048 + (STEP == 1 ? 0 : 1024) + col);
                    const float g[8] = {lo16(gw.x), hi16(gw.x), lo16(gw.y), hi16(gw.y), lo16(gw.z), hi16(gw.z), lo16(gw.w), hi16(gw.w)};
                    pg8::f32x4 v0 = acc[ai][bj][m][0], v1 = acc[ai][bj][m][1];
#pragma unroll
                    for (int e = 0; e < 4; ++e) { v0[e] *= g[e]; v1[e] *= g[4 + e]; }
                    float* tp = TF + row * 1024 + col;
                    if (STEP == 1) { *(pg8::f32x4*)tp = v0; *(pg8::f32x4*)(tp + 4) = v1; }
                    else { v0 += *(const pg8::f32x4*)tp; v1 += *(const pg8::f32x4*)(tp + 4); *(pg8::u32x4*)(T + row * 1024 + col) = pack8(v0, v1); } } }
    }
};
template <int MODE> struct EpiRes {
    static constexpr bool PERM = true, AFTER_DRAIN = false;
    const float *XPp, *XSp; float* X1; float* out;
    __device__ __forceinline__ void operator()(const pg8::f32x4 (&acc)[2][2][4][2], const pg8::Unit& u, int wr, int wc, int fr, int fq) const {
        const int row0 = u.pm * 256 + wr * 64 + fr, c0 = u.pn * 256 + wc * 32 + 8 * fq;
#pragma unroll
        for (int ai = 0; ai < 2; ++ai)
#pragma unroll
            for (int m = 0; m < 4; ++m) { const int row = row0 + ai * 128 + m * 16;
                if (row >= MR) continue;
#pragma unroll
                for (int bj = 0; bj < 2; ++bj) { const int col = c0 + bj * 128;
                    const float* src; float* dst;
                    if (MODE == 0) { src = row < MP ? XPp + (size_t)row * 1024 + col : XSp + (size_t)(row - MP) * 1024 + col; dst = X1 + (size_t)row * 1024 + col; }
                    else { src = X1 + (size_t)row * 1024 + col; dst = row < MP ? out + O_YP + (size_t)row * 1024 + col : out + O_YS + (size_t)(row - MP) * 1024 + col; }
                    *(pg8::f32x4*)dst = acc[ai][bj][m][0] + *(const pg8::f32x4*)src; *(pg8::f32x4*)(dst + 4) = acc[ai][bj][m][1] + *(const pg8::f32x4*)(src + 4); } }
    }
};

#define MFMA32(a, b, c) __builtin_amdgcn_mfma_f32_32x32x16_bf16((a), (b), (c), 0, 0, 0)
__device__ __forceinline__ int crow(int r, int hi) { return (r & 3) + 8 * (r >> 2) + 4 * hi; }
__device__ __forceinline__ bf16x8 lds_ld8(LAS const unsigned char* p) { return *(LAS const bf16x8*)p; }
__device__ __forceinline__ bf16x8 gl_ld8(const bf16* p) { return *(const bf16x8*)p; }

constexpr int GA_QH = 0, GA_KH = 17408, GA_KBH = 34816, GA_VBT = 52224, GA_KBGT = 70656, GA_KDT = 89088, GA_LF = 107520, GA_TB = 123904, GA_GS = 133120, GA_BS = 133376, GA_T32 = 133632, GA_X32 = 141824;
__device__ __forceinline__ void gdn_a_unit(const Args& A, LAS unsigned char* lds, int unit, int tid, int lane, int wave) {
    unsigned char* ws = A.ws;
    const int b = unit >> 8, h = (unit >> 5) & 7, n = unit & 31;
    const int row0 = b * SEQ + n * 64;
#ifdef PROBE_K
    unsigned long long pt0 = 0, pdt = 0;
#define GPS(k) do { if ((k) == PROBE_K) pt0 = __builtin_amdgcn_s_memrealtime(); } while (0)
#define GPE(k) do { if ((k) == PROBE_K) pdt += __builtin_amdgcn_s_memrealtime() - pt0; } while (0)
#else
#define GPS(k) do {} while (0)
#define GPE(k) do {} while (0)
#endif
    GPS(74); GPS(70);
    const bf16* QKV = (const bf16*)(ws + WS_QKV);
    LAS float* Gs = (LAS float*)(lds + GA_GS); LAS float* Bs = (LAS float*)(lds + GA_BS);
    float Gend;
    {
        const int cg = tid & 15, rr = tid >> 4;
        v4u xw[3][2][4];
#pragma unroll
        for (int part = 0; part < 3; ++part)
#pragma unroll
            for (int ri = 0; ri < 2; ++ri)
#pragma unroll
                for (int tap = 0; tap < 4; ++tap) { const int tt = n * 64 + rr + 32 * ri - 3 + tap;
                    xw[part][ri][tap] = tt >= 0 ? *(const v4u*)(QKV + (size_t)(b * SEQ + tt) * 3072 + part * 1024 + h * 128 + 8 * cg) : (v4u){0u, 0u, 0u, 0u}; }
        float gx = ((const float*)(ws + WS_GLOG))[(size_t)(row0 + lane) * 8 + h];
        const float be0 = ((const float*)(ws + WS_BETA))[(size_t)(row0 + rr) * 8 + h], be1 = ((const float*)(ws + WS_BETA))[(size_t)(row0 + rr + 32) * 8 + h];
#pragma unroll
        for (int o = 1; o < 64; o <<= 1) { const float y = __shfl_up(gx, o); if (lane >= o) gx += y; }
        if (wave == 0) { Gs[lane] = gx; Bs[lane] = ((const float*)(ws + WS_BETA))[(size_t)(row0 + lane) * 8 + h]; }
        Gend = __shfl(gx, 63);
        const float Gr0 = __shfl(gx, rr), Gr1 = __shfl(gx, rr + 32);
        bf16* GQG = (bf16*)(ws + WS_GQG) + (size_t)unit * 8192;
#pragma unroll
        for (int part = 0; part < 3; ++part) {
            const int colb = part * 1024 + h * 128 + 8 * cg;
            float wgt[4][8];
#pragma unroll
            for (int tap = 0; tap < 4; ++tap) { const f32x4 w0 = *(const f32x4*)(A.in[I_CONVW] + tap * 3072 + colb), w1 = *(const f32x4*)(A.in[I_CONVW] + tap * 3072 + colb + 4);
                wgt[tap][0] = w0.x; wgt[tap][1] = w0.y; wgt[tap][2] = w0.z; wgt[tap][3] = w0.w; wgt[tap][4] = w1.x; wgt[tap][5] = w1.y; wgt[tap][6] = w1.z; wgt[tap][7] = w1.w; }
#pragma unroll
            for (int ri = 0; ri < 2; ++ri) {
                const int i = rr + 32 * ri;
                float y[8];
#pragma unroll
                for (int e = 0; e < 8; ++e) y[e] = 0.f;
#pragma unroll
                for (int tap = 0; tap < 4; ++tap) { const v4u w = xw[part][ri][tap];
                    const float x[8] = {lo16(w.x), hi16(w.x), lo16(w.y), hi16(w.y), lo16(w.z), hi16(w.z), lo16(w.w), hi16(w.w)};
#pragma unroll
                    for (int e = 0; e < 8; ++e) y[e] += wgt[tap][e] * x[e]; }
                float ss = 0.f;
#pragma unroll
                for (int e = 0; e < 8; ++e) { y[e] = siluf_(y[e]); ss += y[e] * y[e]; }
                ss += __shfl_xor(ss, 1); ss += __shfl_xor(ss, 2); ss += __shfl_xor(ss, 4); ss += __shfl_xor(ss, 8);
                const float Gi = ri ? Gr1 : Gr0;
                const float rs = 1.f / sqrtf(ss + EPS), beta = ri ? be1 : be0, eg = __expf(Gi), ed = __expf(Gend - Gi);
                if (part == 0) {
                    float q[8];
#pragma unroll
                    for (int e = 0; e < 8; ++e) q[e] = y[e] * rs * 0.08838834764831845f;
                    v4u o; o.x = pk2(q[0], q[1]); o.y = pk2(q[2], q[3]); o.z = pk2(q[4], q[5]); o.w = pk2(q[6], q[7]);
                    *(LAS v4u*)(lds + GA_QH + i * 272 + cg * 16) = o;
                    v4u g; g.x = pk2(q[0] * eg, q[1] * eg); g.y = pk2(q[2] * eg, q[3] * eg); g.z = pk2(q[4] * eg, q[5] * eg); g.w = pk2(q[6] * eg, q[7] * eg);
                    *(v4u*)(GQG + i * 128 + 8 * cg) = g;
                } else if (part == 1) {
                    float k[8];
#pragma unroll
                    for (int e = 0; e < 8; ++e) k[e] = y[e] * rs;
                    v4u o; o.x = pk2(k[0], k[1]); o.y = pk2(k[2], k[3]); o.z = pk2(k[4], k[5]); o.w = pk2(k[6], k[7]);
                    *(LAS v4u*)(lds + GA_KH + i * 272 + cg * 16) = o;
                    v4u kb; kb.x = pk2(k[0] * beta, k[1] * beta); kb.y = pk2(k[2] * beta, k[3] * beta); kb.z = pk2(k[4] * beta, k[5] * beta); kb.w = pk2(k[6] * beta, k[7] * beta);
                    *(LAS v4u*)(lds + GA_KBH + i * 272 + cg * 16) = kb;
#pragma unroll
                    for (int e = 0; e < 8; ++e) { *(LAS bf16*)(lds + GA_KBGT + (8 * cg + e) * 144 + i * 2) = (bf16)f2bf(k[e] * beta * eg);
                        *(LAS bf16*)(lds + GA_KDT + (8 * cg + e) * 144 + i * 2) = (bf16)f2bf(k[e] * ed); }
                } else {
#pragma unroll
                    for (int e = 0; e < 8; ++e) *(LAS bf16*)(lds + GA_VBT + (8 * cg + e) * 144 + i * 2) = (bf16)f2bf(y[e] * beta);
                }
            }
            __builtin_amdgcn_sched_barrier(0);
        }
    }
    __syncthreads();
    GPE(70); GPS(71);
    int l31 = lane & 31, hi = lane >> 5; asm volatile("" : "+v"(l31), "+v"(hi));
    {
        const int it = (wave >> 1) & 1, jt = wave & 1; const bool isL = wave < 4;
        f32x16 acc = {};
        if (it >= jt) {
            LAS const unsigned char* Ab = lds + (isL ? GA_KBH : GA_QH) + (32 * it + l31) * 272 + hi * 16;
            LAS const unsigned char* Bb = lds + GA_KH + (32 * jt + l31) * 272 + hi * 16;
#pragma unroll
            for (int ks = 0; ks < 8; ++ks) acc = MFMA32(lds_ld8(Ab + ks * 32), lds_ld8(Bb + ks * 32), acc);
        }
        const int j = 32 * jt + l31; const float Gj = Gs[j];
        bf16* AQ = (bf16*)(ws + WS_GAQK) + (size_t)unit * 4096;
#pragma unroll
        for (int r = 0; r < 16; ++r) { const int i = 32 * it + crow(r, hi);
            const float d = __expf(fminf(Gs[i] - Gj, 0.f));
            if (isL) ((LAS float*)(lds + GA_LF))[i * 64 + j] = (i > j) ? acc[r] * d : 0.f;
            else AQ[i * 64 + j] = (bf16)f2bf((i >= j) ? acc[r] * d : 0.f); }
    }
    __syncthreads();
    GPE(71); GPS(72);
    {
        LAS const float* Lf = (LAS const float*)(lds + GA_LF);
        LAS float* T32 = (LAS float*)(lds + GA_T32); LAS float* X32 = (LAS float*)(lds + GA_X32);
        if (wave == 0) {
            int lx = lane; asm volatile("" : "+v"(lx));
            const int hb = lx >> 5, c = lx & 31;
            LAS const float* Lb = Lf + (32 * hb) * 64 + 32 * hb;
            float T[32];
#pragma unroll
            for (int i = 0; i < 32; ++i) {
                float a0 = (i == c) ? 1.f : 0.f, a1 = 0.f;
#pragma unroll
                for (int j4 = 0; j4 < (i + 3) / 4; ++j4) { const f32x4 l4 = *(LAS const f32x4*)(Lb + i * 64 + 4 * j4);
                    if (4 * j4 + 0 < i) a0 -= l4.x * T[4 * j4 + 0];
                    if (4 * j4 + 1 < i) a1 -= l4.y * T[4 * j4 + 1];
                    if (4 * j4 + 2 < i) a0 -= l4.z * T[4 * j4 + 2];
                    if (4 * j4 + 3 < i) a1 -= l4.w * T[4 * j4 + 3]; }
                T[i] = a0 + a1;
                T32[hb * 1024 + i * 32 + c] = T[i];
                *(LAS bf16*)(lds + GA_TB + (32 * hb + i) * 144 + (32 * hb + c) * 2) = (bf16)f2bf(T[i]);
                if (hb == 0) *(LAS bf16*)(lds + GA_TB + i * 144 + (32 + c) * 2) = (bf16)0;
            }
        } else {
            bf16* GKD = (bf16*)(ws + WS_GKD) + (size_t)unit * 8192;
            int t0 = tid; asm volatile("" : "+v"(t0));
            for (int id = t0 - 64; id < 1024; id += 448) { const int row = id >> 3, ch = id & 7;
                *(v4u*)(GKD + row * 64 + ch * 8) = *(LAS const v4u*)(lds + GA_KDT + row * 144 + ch * 16); }
        }
        __syncthreads();
        int tidx = tid; asm volatile("" : "+v"(tidx));
        const int r = tidx >> 4, c2 = (tidx & 15) * 2;
        {
            float x0 = 0.f, x1 = 0.f;
#pragma unroll 8
            for (int k = 0; k < 32; ++k) { const float l = Lf[(32 + r) * 64 + k]; x0 += l * T32[k * 32 + c2]; x1 += l * T32[k * 32 + c2 + 1]; }
            X32[r * 32 + c2] = x0; X32[r * 32 + c2 + 1] = x1;
        }
        __syncthreads();
        {
            float x0 = 0.f, x1 = 0.f;
#pragma unroll 8
            for (int k = 0; k < 32; ++k) { const float t = T32[1024 + r * 32 + k]; x0 += t * X32[k * 32 + c2]; x1 += t * X32[k * 32 + c2 + 1]; }
            *(LAS unsigned*)(lds + GA_TB + (32 + r) * 144 + c2 * 2) = pk2(-x0, -x1);
        }
    }
    __syncthreads();
    GPE(72); GPS(73);
    {
        const int nt = wave; LAS const unsigned char* Bb = lds + (nt < 4 ? GA_VBT : GA_KBGT) + (32 * (nt & 3) + l31) * 144 + hi * 16;
        float* GU0 = (float*)(ws + WS_GU0) + (size_t)unit * 8192; bf16* GW = (bf16*)(ws + WS_GW) + (size_t)unit * 8192;
#pragma unroll
        for (int it = 0; it < 2; ++it) {
            f32x16 acc = {};
            LAS const unsigned char* Ab = lds + GA_TB + (32 * it + l31) * 144 + hi * 16;
#pragma unroll
            for (int ks = 0; ks < 4; ++ks) if (ks < 2 * (it + 1)) acc = MFMA32(lds_ld8(Ab + ks * 32), lds_ld8(Bb + ks * 32), acc);
            const int col = 32 * (nt & 3) + l31;
#pragma unroll
            for (int r = 0; r < 16; ++r) { const int i = 32 * it + crow(r, hi);
                if (nt < 4) GU0[i * 128 + col] = acc[r]; else GW[i * 128 + col] = (bf16)f2bf(acc[r]); }
        }
        if (tid == 0) ((float*)(ws + WS_GEND))[unit] = __expf(Gend);
    }
    __syncthreads();
    GPE(73); GPE(74);
#ifdef PROBE_K
    if (blockIdx.x == PROBE_B && PROBE_K >= 70 && PROBE_K < 80) { const unsigned long long te = __builtin_amdgcn_s_memrealtime(); while (__builtin_amdgcn_s_memrealtime() - te < (unsigned long long)PROBE_MULT * pdt) __builtin_amdgcn_s_sleep(8); }
#endif
}

constexpr int GB_ST = 0, GB_UT = 34816, GB_OF = 53248;
__device__ __forceinline__ void gdn_b_unit(const Args& A, LAS unsigned char* lds, int bh, int tid, int lane, int wave) {
    unsigned char* ws = A.ws;
    const int b = bh >> 3, h = bh & 7, l31 = lane & 31, hi = lane >> 5;
    const int it = wave >> 2, vt = wave & 3;
    for (int i = tid; i < 34816 / 16; i += 512) *(LAS v4u*)(lds + GB_ST + i * 16) = (v4u){0u, 0u, 0u, 0u};
    f32x16 Sacc[2] = {};
    __syncthreads();
    const bf16* Zb = (const bf16*)(ws + WS_Z); bf16* YA = (bf16*)(ws + WS_YA);
    LAS const unsigned char* Sb = lds + GB_ST + (32 * vt + l31) * 272 + hi * 16;
    LAS const unsigned char* Ub = lds + GB_UT + (32 * vt + l31) * 144 + hi * 16;
    const int di = tid >> 3, dc0 = (tid & 7) * 16;
    bf16x8 wA[8], qA[8], cA[4], kA[2][4]; float u0[16]; v4u zz[2]; float gend;
#define BL8(rs_, vo_, so_) __builtin_bit_cast(bf16x8, __builtin_amdgcn_raw_buffer_load_b128((rs_), (vo_), (so_), 0))
#define MKRS(p_, bytes_) __builtin_amdgcn_make_buffer_rsrc((void*)(p_), 0, (bytes_), 0x00020000)
    const unsigned voW = (unsigned)((32 * it + l31) * 128 + 8 * hi) * 2u, voA = (unsigned)((32 * it + l31) * 64 + 8 * hi) * 2u, voK = (unsigned)((64 * it + l31) * 64 + 8 * hi) * 2u;
    const unsigned voU = (unsigned)((32 * it + 4 * hi) * 128 + 32 * vt + l31) * 4u, voZ = (unsigned)(di * 1024 + h * 128 + dc0) * 2u;
#define GB_LD_W(n_) do { const int cu_ = bh * 32 + (n_); const __amdgpu_buffer_rsrc_t rW_ = MKRS((const bf16*)(ws + WS_GW) + (size_t)cu_ * 8192, 16384), rU_ = MKRS((const float*)(ws + WS_GU0) + (size_t)cu_ * 8192, 32768); \
        _Pragma("unroll") for (int ks = 0; ks < 8; ++ks) wA[ks] = BL8(rW_, voW, ks * 32); \
        _Pragma("unroll") for (int r = 0; r < 16; ++r) u0[r] = __builtin_bit_cast(float, __builtin_amdgcn_raw_buffer_load_b32(rU_, voU, ((r & 3) + 8 * (r >> 2)) * 512, 0)); } while (0)
#define GB_LD_Q(n_) do { const int cu_ = bh * 32 + (n_); const __amdgpu_buffer_rsrc_t rQ_ = MKRS((const bf16*)(ws + WS_GQG) + (size_t)cu_ * 8192, 16384), rA_ = MKRS((const bf16*)(ws + WS_GAQK) + (size_t)cu_ * 4096, 8192); \
        _Pragma("unroll") for (int ks = 0; ks < 8; ++ks) qA[ks] = BL8(rQ_, voW, ks * 32); \
        _Pragma("unroll") for (int ks = 0; ks < 4; ++ks) cA[ks] = BL8(rA_, voA, ks * 32); } while (0)
#define GB_LD_K(n_) do { const int cu_ = bh * 32 + (n_); const __amdgpu_buffer_rsrc_t rK_ = MKRS((const bf16*)(ws + WS_GKD) + (size_t)cu_ * 8192, 16384), rZ_ = MKRS(Zb + (size_t)(b * SEQ + 64 * (n_)) * 1024, 64 * 1024 * 2); \
        _Pragma("unroll") for (int ks = 0; ks < 4; ++ks) { kA[0][ks] = BL8(rK_, voK, ks * 32); kA[1][ks] = BL8(rK_, voK, 32 * 64 * 2 + ks * 32); } \
        zz[0] = __builtin_amdgcn_raw_buffer_load_b128(rZ_, voZ, 0, 0); zz[1] = __builtin_amdgcn_raw_buffer_load_b128(rZ_, voZ, 16, 0); \
        gend = ((const float*)(ws + WS_GEND))[cu_]; } while (0)
#ifdef PROBE_K
    unsigned long long pt0 = 0, pdt = 0;
#endif
    GB_LD_W(0); GB_LD_Q(0);
#pragma unroll 1
    for (int n = 0; n < 32; ++n) {
        const int r0 = b * SEQ + 64 * n;
        GPS(80); GPS(84);
        GB_LD_K(n);
        {
            f32x16 acc = {};
#pragma unroll
            for (int ks = 0; ks < 8; ++ks) acc = MFMA32(wA[ks], lds_ld8(Sb + ks * 32), acc);
            float u[16];
#pragma unroll
            for (int r = 0; r < 16; ++r) u[r] = u0[r] - acc[r];
#pragma unroll
            for (int g = 0; g < 4; ++g) { v2u w; w.x = pk2(u[4 * g], u[4 * g + 1]); w.y = pk2(u[4 * g + 2], u[4 * g + 3]);
                *(LAS v2u*)(lds + GB_UT + (32 * vt + l31) * 144 + (32 * it + 8 * g + 4 * hi) * 2) = w; }
        }
        LBAR();
        GPE(80); GPS(81);
        if (n + 1 < 32) GB_LD_W(n + 1);
        {
            f32x16 acc = {};
#pragma unroll
            for (int ks = 0; ks < 8; ++ks) acc = MFMA32(qA[ks], lds_ld8(Sb + ks * 32), acc);
#pragma unroll
            for (int ks = 0; ks < 4; ++ks) if (ks < 2 * (it + 1)) acc = MFMA32(cA[ks], lds_ld8(Ub + ks * 32), acc);
#pragma unroll
            for (int r = 0; r < 16; ++r) ((LAS float*)(lds + GB_OF))[(32 * it + crow(r, hi)) * 132 + 32 * vt + l31] = acc[r];
        }
        LBAR();
        GPE(81); GPS(82);
        if (n + 1 < 32) GB_LD_Q(n + 1);
        {
#pragma unroll
            for (int t = 0; t < 2; ++t) { const int kt = 2 * (wave >> 2) + t;
                Sacc[t] = Sacc[t] * gend;
#pragma unroll
                for (int ks = 0; ks < 4; ++ks) Sacc[t] = MFMA32(kA[t][ks], lds_ld8(Ub + ks * 32), Sacc[t]);
#pragma unroll
                for (int g = 0; g < 4; ++g) { v2u w; w.x = pk2(Sacc[t][4 * g], Sacc[t][4 * g + 1]); w.y = pk2(Sacc[t][4 * g + 2], Sacc[t][4 * g + 3]);
                    *(LAS v2u*)(lds + GB_ST + (32 * vt + l31) * 272 + (32 * kt + 8 * g + 4 * hi) * 2) = w; }
            }
        }
        {
            LAS const float* orow = (LAS const float*)(lds + GB_OF) + di * 132 + dc0;
            float o[16]; float ss = 0.f;
#pragma unroll
            for (int q = 0; q < 4; ++q) { const f32x4 v = *(LAS const f32x4*)(orow + 4 * q); o[4 * q] = v.x; o[4 * q + 1] = v.y; o[4 * q + 2] = v.z; o[4 * q + 3] = v.w; }
#pragma unroll
            for (int e = 0; e < 16; ++e) ss += o[e] * o[e];
            ss += __shfl_xor(ss, 1); ss += __shfl_xor(ss, 2); ss += __shfl_xor(ss, 4);
            const float r = 1.f / sqrtf(ss * (1.f / 128.f) + EPS);
            const size_t off = (size_t)(r0 + di) * 1024 + h * 128 + dc0;
            const v4u z0 = zz[0], z1 = zz[1];
            const float z[16] = {lo16(z0.x), hi16(z0.x), lo16(z0.y), hi16(z0.y), lo16(z0.z), hi16(z0.z), lo16(z0.w), hi16(z0.w),
                                 lo16(z1.x), hi16(z1.x), lo16(z1.y), hi16(z1.y), lo16(z1.z), hi16(z1.z), lo16(z1.w), hi16(z1.w)};
            float y[16];
#pragma unroll
            for (int e = 0; e < 16; ++e) y[e] = o[e] * r * A.in[I_GDNN][dc0 + e] * siluf_(z[e]);
            v4u o0, o1; o0.x = pk2(y[0], y[1]); o0.y = pk2(y[2], y[3]); o0.z = pk2(y[4], y[5]); o0.w = pk2(y[6], y[7]);
            o1.x = pk2(y[8], y[9]); o1.y = pk2(y[10], y[11]); o1.z = pk2(y[12], y[13]); o1.w = pk2(y[14], y[15]);
            *(v4u*)(YA + off) = o0; *(v4u*)(YA + off + 8) = o1;
        }
        GPE(82); GPS(83);
        LBAR();
        GPE(83); GPE(84);
    }
#undef GB_LD_W
#undef GB_LD_Q
#undef GB_LD_K
#undef BL8
#undef MKRS
#ifdef PROBE_K
    if (bh == 0 && tid == 0 && PROBE_K >= 80 && PROBE_K < 90) ((volatile LAS unsigned*)(lds + MISC_OFF))[16] = (unsigned)pdt;
#endif
    float* So = A.out + O_GSP + (size_t)bh * 16384;
#pragma unroll
    for (int t = 0; t < 2; ++t) { const int kt = 2 * (wave >> 2) + t;
#pragma unroll
        for (int r = 0; r < 16; ++r) So[(32 * kt + crow(r, hi)) * 128 + 32 * vt + l31] = Sacc[t][r]; }
    __syncthreads();
}

__device__ __forceinline__ void gdn_r_unit(const Args& A, LAS unsigned char* lds, int unit, int tid, int lane, int wave) {
    unsigned char* ws = A.ws;
    const int j = unit >> 3, h = unit & 7, row = MP + j;
    LAS float* qs = (LAS float*)lds; LAS float* ks = qs + 128; LAS float* vs = qs + 256; LAS float* red = qs + 384;
    LAS float* os = qs + 896;
    if (tid < 384) {
        const int part = tid >> 7, d = tid & 127, col = part * 1024 + h * 128 + d;
        const float* cw = A.in[I_CONVW]; const float* sc = A.in[I_SCONV] + (size_t)j * 3 * 3072;
        const float xn = bf2f(((const bf16*)(ws + WS_QKV))[(size_t)row * 3072 + col]);
        const float y = cw[col] * sc[col] + cw[3072 + col] * sc[3072 + col] + cw[2 * 3072 + col] * sc[2 * 3072 + col] + cw[3 * 3072 + col] * xn;
        qs[tid] = siluf_(y);
    }
    __syncthreads();
    const float rq = 1.f / sqrtf(wave_sum(qs[lane] * qs[lane] + qs[lane + 64] * qs[lane + 64]) + EPS) * 0.08838834764831845f;
    const float rk = 1.f / sqrtf(wave_sum(ks[lane] * ks[lane] + ks[lane + 64] * ks[lane + 64]) + EPS);
    const float beta = ((const float*)(ws + WS_BETA))[(size_t)row * 8 + h], eg = __expf(((const float*)(ws + WS_GLOG))[(size_t)row * 8 + h]);
    const int v = tid & 127, kq = tid >> 7;
    const float* S0 = A.in[I_SGDN] + (size_t)unit * 16384;
    float s[32]; float kv = 0.f;
#pragma unroll
    for (int i = 0; i < 32; ++i) { const int k = 32 * kq + i; s[i] = eg * S0[k * 128 + v]; kv += ks[k] * rk * s[i]; }
    red[kq * 128 + v] = kv;
    __syncthreads();
    const float u = beta * (vs[v] - (red[v] + red[128 + v] + red[256 + v] + red[384 + v]));
    __syncthreads();
    float* So = A.out + O_GSS + (size_t)unit * 16384; float po = 0.f;
#pragma unroll
    for (int i = 0; i < 32; ++i) { const int k = 32 * kq + i; s[i] += ks[k] * rk * u; So[k * 128 + v] = s[i]; po += qs[k] * rq * s[i]; }
    red[kq * 128 + v] = po;
    __syncthreads();
    if (tid < 128) os[tid] = red[tid] + red[128 + tid] + red[256 + tid] + red[384 + tid];
    __syncthreads();
    const float rn = 1.f / sqrtf(wave_sum(os[lane] * os[lane] + os[lane + 64] * os[lane + 64]) * (1.f / 128.f) + EPS);
    if (tid < 128) { const size_t off = (size_t)row * 1024 + h * 128 + tid;
        ((bf16*)(ws + WS_YA))[off] = (bf16)f2bf(os[tid] * rn * A.in[I_GDNN][tid] * siluf_(bf2f(((const bf16*)(ws + WS_Z))[off]))); }
    __syncthreads();
}

__device__ __forceinline__ void p4_rows(const Args& A, int gw, int NGW, int lane) {
    unsigned char* ws = A.ws;
    const bf16* QP = (const bf16*)(ws + WS_QP); bf16* QP2 = (bf16*)(ws + WS_QP2); bf16* KN = (bf16*)(ws + WS_KN);
    const int hh = lane >> 3, l7 = lane & 7;
    for (int m = gw; m < MR; m += NGW) {
        const int pos = m < MP ? (m & (SEQ - 1)) : PAST;
#pragma unroll
        for (int which = 0; which < 2; ++which) {
            const bf16* src = which == 0 ? QP + (size_t)m * 1536 + 16 * lane : KN + (size_t)m * 1024 + 16 * lane;
            const float* gain = (which == 0 ? A.in[I_QNN] : A.in[I_KNN]) + 16 * l7;
            const v4u w0 = *(const v4u*)src, w1 = *(const v4u*)(src + 8);
            float v[16] = {lo16(w0.x), hi16(w0.x), lo16(w0.y), hi16(w0.y), lo16(w0.z), hi16(w0.z), lo16(w0.w), hi16(w0.w),
                           lo16(w1.x), hi16(w1.x), lo16(w1.y), hi16(w1.y), lo16(w1.z), hi16(w1.z), lo16(w1.w), hi16(w1.w)};
            float ss = 0.f;
#pragma unroll
            for (int e = 0; e < 16; ++e) ss += v[e] * v[e];
            ss += __shfl_xor(ss, 1); ss += __shfl_xor(ss, 2); ss += __shfl_xor(ss, 4);
            const float r = 1.f / sqrtf(ss * (1.f / 128.f) + EPS);
#pragma unroll
            for (int e = 0; e < 16; ++e) v[e] = v[e] * r * gain[e];
            v4u o0, o1; o0.x = pk2(v[0], v[1]); o0.y = pk2(v[2], v[3]); o0.z = pk2(v[4], v[5]); o0.w = pk2(v[6], v[7]);
            o1.x = pk2(v[8], v[9]); o1.y = pk2(v[10], v[11]); o1.z = pk2(v[12], v[13]); o1.w = pk2(v[14], v[15]);
            bf16* dst = which == 0 ? QP2 + (size_t)m * 1536 + hh * 192 + 16 * l7 : KN + (size_t)m * 1024 + 16 * lane;
            *(v4u*)dst = o0; *(v4u*)(dst + 8) = o1;
        }
        {
            const v4u w = *(const v4u*)(QP + (size_t)m * 1536 + 1024 + 8 * lane);
            float v[8] = {lo16(w.x), hi16(w.x), lo16(w.y), hi16(w.y), lo16(w.z), hi16(w.z), lo16(w.w), hi16(w.w)};
            float ss = 0.f;
#pragma unroll
            for (int e = 0; e < 8; ++e) ss += v[e] * v[e];
            ss += __shfl_xor(ss, 1); ss += __shfl_xor(ss, 2); ss += __shfl_xor(ss, 4);
            const float r = 1.f / sqrtf(ss * (1.f / 64.f) + EPS);
            float o[8];
#pragma unroll
            for (int e = 0; e < 8; ++e) { const float xn = v[e] * r * A.in[I_QNR][8 * l7 + e]; const float other = __shfl_xor(xn, 4);
                const float ang = (float)pos * ROPE_INV[8 * (l7 & 3) + e]; const float cs = cosf(ang), sn = sinf(ang);
                o[e] = (l7 < 4) ? xn * cs - other * sn : other * sn + xn * cs; }
            v4u ow; ow.x = pk2(o[0], o[1]); ow.y = pk2(o[2], o[3]); ow.z = pk2(o[4], o[5]); ow.w = pk2(o[6], o[7]);
            *(v4u*)(QP2 + (size_t)m * 1536 + hh * 192 + 128 + 8 * l7) = ow;
        }
    }
}
namespace att {
using s16x4 = __attribute__((ext_vector_type(4))) short;
using u32x4 = __attribute__((ext_vector_type(4))) unsigned;
constexpr int SHM_V = 16384, SHM_K = 16384, SHM_KR = 8192;
constexpr int OFF_V = 0, OFF_K = 2 * SHM_V, OFF_KR = OFF_K + 2 * SHM_K, OFF_WS = OFF_KR + 2 * SHM_KR, OFF_QR = OFF_WS + 2048;
constexpr float THR = 8.f;
#define KSWZ(row, colB) ((row) * 256 + ((colB) ^ (((row) & 7) << 4)))
#define KRSWZ(row, colB) ((row) * 128 + ((colB) ^ (((row) & 7) << 4)))
#define SBAR() __builtin_amdgcn_sched_barrier(0)
__device__ __forceinline__ unsigned cvtpk(float lo, float hi) { unsigned r; asm volatile("v_cvt_pk_bf16_f32 %0, %1, %2" : "=v"(r) : "v"(lo), "v"(hi)); return r; }
__device__ __forceinline__ void partialSM(f32x16& p0, f32x16& p1, float& m_reg, float& mn, float& alpha) {
    constexpr float C = MLA_SCALE * 1.4426950408889634f;
    float pmax = p0[0];
#pragma unroll
    for (int r = 1; r < 16; ++r) pmax = fmaxf(pmax, p0[r]);
#pragma unroll
    for (int r = 0; r < 16; ++r) pmax = fmaxf(pmax, p1[r]);
    { auto rr = __builtin_amdgcn_permlane32_swap(__float_as_uint(pmax), __float_as_uint(pmax), false, false);
      pmax = fmaxf(__uint_as_float(rr[0]), __uint_as_float(rr[1])); }
    if (__builtin_expect(__all(pmax - m_reg <= THR / MLA_SCALE), 1)) { mn = m_reg; alpha = 1.f; }
    else { mn = fmaxf(m_reg, pmax); alpha = __builtin_amdgcn_exp2f((m_reg - mn) * C); m_reg = mn; }
    const float mnC = -mn * C;
#pragma unroll
    for (int r = 0; r < 16; ++r) p0[r] = fmaf(p0[r], C, mnC);
#pragma unroll
    for (int r = 0; r < 16; ++r) p1[r] = fmaf(p1[r], C, mnC);
#pragma unroll
    for (int r = 0; r < 16; ++r) p0[r] = __builtin_amdgcn_exp2f(p0[r]);
}
__device__ __forceinline__ void finishSM(f32x16& p0, f32x16& p1, float alpha, float& l_reg, bf16x8& pa0, bf16x8& pa1, bf16x8& pa2, bf16x8& pa3) {
#pragma unroll
    for (int r = 0; r < 16; ++r) p1[r] = __builtin_amdgcn_exp2f(p1[r]);
    float ps = 0;
#pragma unroll
    for (int r = 0; r < 16; ++r) ps += p0[r];
#pragma unroll
    for (int r = 0; r < 16; ++r) ps += p1[r];
    { auto rr = __builtin_amdgcn_permlane32_swap(__float_as_uint(ps), __float_as_uint(ps), false, false);
      ps = __uint_as_float(rr[0]) + __uint_as_float(rr[1]); }
    l_reg = l_reg * alpha + ps;
#define PK4(P, BASE, OUT) do { unsigned a0 = cvtpk(P[BASE + 0], P[BASE + 1]), a1 = cvtpk(P[BASE + 2], P[BASE + 3]);   \
    unsigned b0 = cvtpk(P[BASE + 4], P[BASE + 5]), b1 = cvtpk(P[BASE + 6], P[BASE + 7]);                              \
    auto r0 = __builtin_amdgcn_permlane32_swap(a0, b0, false, false); auto r1 = __builtin_amdgcn_permlane32_swap(a1, b1, false, false); \
    u32x4 w = {r0[0], r1[0], r0[1], r1[1]}; OUT = *reinterpret_cast<bf16x8*>(&w); } while (0)
    PK4(p0, 0, pa0); PK4(p0, 8, pa1); PK4(p1, 0, pa2); PK4(p1, 8, pa3);
#undef PK4
}
__device__ __forceinline__ void qkt(f32x16& p0, f32x16& p1, LAS const unsigned char* Ks, LAS const unsigned char* KRs, const bf16x8* qr, LAS const unsigned char* qrl, int r32, int hi) {
    p0 = f32x16{}; p1 = f32x16{};
#pragma unroll
    for (int d0 = 0; d0 < 8; ++d0) { const int cb = (d0 * 16 + hi * 8) * 2;
        const bf16x8 b0 = *(LAS const bf16x8*)(Ks + KSWZ(r32, cb)), b1 = *(LAS const bf16x8*)(Ks + KSWZ(32 + r32, cb));
        p0 = MFMA32(b0, qr[d0], p0); p1 = MFMA32(b1, qr[d0], p1); if (d0 == 3 || d0 == 7) SBAR(); }
#pragma unroll
    for (int d0 = 0; d0 < 4; ++d0) { const int cb = (d0 * 16 + hi * 8) * 2;
        const bf16x8 b0 = *(LAS const bf16x8*)(KRs + KRSWZ(r32, cb)), b1 = *(LAS const bf16x8*)(KRs + KRSWZ(32 + r32, cb));
        const bf16x8 qq = *(LAS const bf16x8*)(qrl + d0 * 1024);
        p0 = MFMA32(b0, qq, p0); p1 = MFMA32(b1, qq, p1); }
}
__device__ __forceinline__ void cmask(f32x16& p0, f32x16& p1, int key0, int qpos, int hi) {
#pragma unroll
    for (int r = 0; r < 16; ++r) { const int k = key0 + crow(r, hi); if (k > qpos) p0[r] = -1e30f; if (k + 32 > qpos) p1[r] = -1e30f; }
}
__device__ __forceinline__ int v_st(int k, int c) { const int kk = (k & ~0xC) | ((k & 4) << 1) | ((k & 8) >> 1); return ((kk >> 3) * 4 + (c >> 5)) * 512 + ((kk & 7) * 32 + (c & 31)) * 2; }
__device__ __forceinline__ int v_rd_base(int lane) { return ((lane & 3) << 3) | (((lane >> 2) & 3) << 6) | (((lane >> 4) & 1) << 5) | (((lane >> 5) & 1) << 8); }
constexpr int v_rd_off(int d0, int ks, int half) { return d0 * 512 + ks * 4096 + half * 2048; }
template <int OFF> __device__ __forceinline__ s16x4 tr_read(int vb) {
    s16x4 r; asm volatile("ds_read_b64_tr_b16 %0, %1 offset:%2" : "=&v"(r) : "v"(vb), "i"(OFF) : "memory"); return r;
}
template <int D0> __device__ __forceinline__ void pv_one(f32x16& od, int vb, bf16x8 pa0, bf16x8 pa1, bf16x8 pa2, bf16x8 pa3) {
    const s16x4 l0 = tr_read<v_rd_off(D0, 0, 0)>(vb), h0 = tr_read<v_rd_off(D0, 0, 1)>(vb), l1 = tr_read<v_rd_off(D0, 1, 0)>(vb), h1 = tr_read<v_rd_off(D0, 1, 1)>(vb);
    const s16x4 l2 = tr_read<v_rd_off(D0, 2, 0)>(vb), h2 = tr_read<v_rd_off(D0, 2, 1)>(vb), l3 = tr_read<v_rd_off(D0, 3, 0)>(vb), h3 = tr_read<v_rd_off(D0, 3, 1)>(vb);
    asm volatile("s_waitcnt lgkmcnt(0)" ::: "memory"); SBAR();
#define PKV(L, H) (bf16x8){L[0], L[1], L[2], L[3], H[0], H[1], H[2], H[3]}
    od = MFMA32(pa0, PKV(l0, h0), od); od = MFMA32(pa1, PKV(l1, h1), od); od = MFMA32(pa2, PKV(l2, h2), od); od = MFMA32(pa3, PKV(l3, h3), od);
#undef PKV
}
__device__ __forceinline__ void pv_d0(f32x16* o, int vb, bf16x8 pa0, bf16x8 pa1, bf16x8 pa2, bf16x8 pa3) {
    pv_one<0>(o[0], vb, pa0, pa1, pa2, pa3); pv_one<1>(o[1], vb, pa0, pa1, pa2, pa3); pv_one<2>(o[2], vb, pa0, pa1, pa2, pa3); pv_one<3>(o[3], vb, pa0, pa1, pa2, pa3);
}
__device__ __forceinline__ void attn_block(const bf16* __restrict__ Qb, const bf16* __restrict__ Kh, const bf16* __restrict__ KRb, const bf16* __restrict__ Vh,
                                           bf16* __restrict__ Ob, int q0, LAS unsigned char* lds) {
    const int tid = threadIdx.x, wid = __builtin_amdgcn_readfirstlane(tid >> 6), lane = tid & 63, r32 = lane & 31, hi = lane >> 5;
    LAS unsigned char* V_lds = lds + OFF_V; LAS unsigned char* K_lds = lds + OFF_K; LAS unsigned char* KR_lds = lds + OFF_KR;
    LAS float* wsf = (LAS float*)(lds + OFF_WS) + wid * 64; LAS float* li_l = wsf; LAS float* al_l = wsf + 32;
    float m_reg = -1e30f, l_reg = 0; f32x16 o[4] = {}; bf16x8 qr[8];
    LAS unsigned char* qrl = lds + OFF_QR + wid * 4096 + lane * 16;
    { const char* Qw = (const char*)Qb + (size_t)wid * (32 * 1536 * 2); const unsigned qoff = (unsigned)(r32 * 1536 + hi * 8) * 2u;
#pragma unroll
      for (int d0 = 0; d0 < 8; ++d0) qr[d0] = *(const bf16x8*)(Qw + qoff + d0 * 32);
#pragma unroll
      for (int d0 = 0; d0 < 4; ++d0) *(LAS bf16x8*)(qrl + d0 * 1024) = *(const bf16x8*)(Qw + qoff + (8 + d0) * 32); }
    const int qpos = q0 + wid * 32 + r32;
    const int sr = tid >> 4, sc = (tid & 15) * 8, vst0 = v_st(sr, sc), vst1 = v_st(32 + sr, sc);
    const int krr = tid >> 3, krc = (tid & 7) * 8;
    const unsigned voff = (unsigned)(sr * 1024 + sc) * 2u, voffr = (unsigned)(krr * 64 + krc) * 2u;
    const int vb0 = (int)(uintptr_t)V_lds + v_rd_base(lane);
    bf16x8 vs0, vs1, ks0, ks1, krs;
#define SLOAD(k0) do { const char* kb_ = (const char*)Kh + (size_t)(k0) * 2048; const char* vb_ = (const char*)Vh + (size_t)(k0) * 2048; const char* rb_ = (const char*)KRb + (size_t)(k0) * 128; \
    vs0 = *(const bf16x8*)(vb_ + voff); vs1 = *(const bf16x8*)(vb_ + 65536 + voff); ks0 = *(const bf16x8*)(kb_ + voff); ks1 = *(const bf16x8*)(kb_ + 65536 + voff); \
    krs = *(const bf16x8*)(rb_ + voffr); } while (0)
#define SWRITE(b) do { *(LAS bf16x8*)(V_lds + (b) * SHM_V + vst0) = vs0; *(LAS bf16x8*)(V_lds + (b) * SHM_V + vst1) = vs1; const int kc = sc * 2; \
    *(LAS bf16x8*)(K_lds + (b) * SHM_K + KSWZ(sr, kc)) = ks0; *(LAS bf16x8*)(K_lds + (b) * SHM_K + KSWZ(32 + sr, kc)) = ks1; \
    *(LAS bf16x8*)(KR_lds + (b) * SHM_KR + KRSWZ(krr, krc * 2)) = krs; } while (0)
#define SWAIT() asm volatile("s_waitcnt vmcnt(0)" ::: "memory")
#define RESC(a) do { if (__any((a) < 1.f)) { if (hi == 0) al_l[r32] = (a); asm volatile("s_waitcnt lgkmcnt(0)" ::: "memory"); \
    _Pragma("unroll") for (int d = 0; d < 4; ++d) _Pragma("unroll") for (int r = 0; r < 16; ++r) o[d][r] *= al_l[crow(r, hi)]; } } while (0)
    f32x16 p0, p1; float mn, al; bf16x8 pa0, pa1, pa2, pa3;
    const int NT = (q0 + 256) / 64, NM = q0 / 64;
    SLOAD(0); SWAIT(); SWRITE(0); SLOAD(64); __syncthreads();
#pragma unroll 1
    for (int j = 0; j < NT; ++j) {
        const int bf = j & 1;
        SBAR(); qkt(p0, p1, K_lds + bf * SHM_K, KR_lds + bf * SHM_KR, qr, qrl, r32, hi); if (j >= NM) cmask(p0, p1, 64 * j, qpos, hi);
        partialSM(p0, p1, m_reg, mn, al); RESC(al);
        finishSM(p0, p1, al, l_reg, pa0, pa1, pa2, pa3); SBAR();
        if (j + 1 < NT) { SWAIT(); SWRITE(bf ^ 1); }
        if (j + 2 < NT) SLOAD((j + 2) * 64);
        SBAR();
        pv_d0(o, vb0 + bf * SHM_V, pa0, pa1, pa2, pa3);
        __syncthreads();
    }
    if (hi == 0) li_l[r32] = l_reg; asm volatile("s_waitcnt lgkmcnt(0)" ::: "memory");
    char* Ow = (char*)Ob + (size_t)wid * (32 * 1024 * 2);
    unsigned lofs = (unsigned)(4 * hi * 1024 + r32) * 2u; asm volatile("" : "+v"(lofs));
#pragma unroll
    for (int r = 0; r < 16; ++r) { const float rl = __builtin_amdgcn_rcpf(li_l[crow(r, hi)]);
#pragma unroll
        for (int d0 = 0; d0 < 4; ++d0) *(bf16*)(Ow + lofs + (unsigned)(((r & 3) + 8 * (r >> 2)) * 1024 + d0 * 32) * 2u) = (bf16)f2bf(o[d0][r] * rl); }
    __syncthreads();
#undef SLOAD
#undef SWRITE
#undef SWAIT
#undef RESC
}
}

constexpr int DP_CT = 0, DP_KR = 133120, DP_PT = 151552, DP_QK = 153728, DP_QR = 157824;
__device__ __forceinline__ void dec_tables(const Args& A, LAS unsigned char* lds, int j, int tid_) {
    int tid = tid_; asm volatile("" : "+v"(tid));
    const bf16* Qrow = (const bf16*)(A.ws + WS_QP2) + (size_t)(MP + j) * 1536;
#pragma unroll
    for (int q = 0; q < 2; ++q) { const int idx = tid + 512 * q, h = idx >> 7, d = idx & 127; ((LAS float*)(lds + DP_QK))[idx] = bf2f(Qrow[h * 192 + d]) * A.in[I_KNN][d]; }
    { const int h = tid >> 6, e = tid & 63; ((LAS float*)(lds + DP_QR))[tid] = bf2f(Qrow[h * 192 + 128 + e]); }
}
__device__ __forceinline__ void dec_page(const Args& A, LAS unsigned char* lds, int unit, int tid, int lane, int wave) {
    unsigned char* ws = A.ws;
    const int phys = ((const int*)A.in[I_PT])[unit];
    const float* src = A.in[I_CACHE] + (size_t)phys * PAGE * LATW;
#pragma unroll 1
    for (int q0 = 0; q0 < 18; q0 += 6) {
        f32x4 va[6], vb[6];
#pragma unroll
        for (int q = 0; q < 6; ++q) { const int id = (q0 + q) * 512 + tid, row = id / 72, g = id % 72; const float* p = src + (size_t)row * LATW + 8 * g; va[q] = *(const f32x4*)p; vb[q] = *(const f32x4*)(p + 4); }
#pragma unroll
        for (int q = 0; q < 6; ++q) { const int id = (q0 + q) * 512 + tid, row = id / 72, g = id % 72;
            v4u o; o.x = pk2(va[q].x, va[q].y); o.y = pk2(va[q].z, va[q].w); o.z = pk2(vb[q].x, vb[q].y); o.w = pk2(vb[q].z, vb[q].w);
            if (g < 64) *(LAS v4u*)(lds + DP_CT + row * 1040 + g * 16) = o; else *(LAS v4u*)(lds + DP_KR + row * 144 + (g - 64) * 16) = o; }
    }
    __syncthreads();
    const int l31 = lane & 31, hi = lane >> 5, h = wave;
    float ssq[4] = {0.f, 0.f, 0.f, 0.f}, dot[4] = {0.f, 0.f, 0.f, 0.f};
    const bf16* WK = (const bf16*)(ws + WS_WKV);
    LAS const float* QK = (LAS const float*)(lds + DP_QK) + h * 128;
#pragma unroll 1
    for (int e = 0; e < 2; ++e) {
        f32x16 acc[2][4];
#pragma unroll
        for (int mt = 0; mt < 2; ++mt)
#pragma unroll
            for (int nt = 0; nt < 4; ++nt) acc[mt][nt] = f32x16{};
        const bf16* Ab = WK + (size_t)(h * 128 + 64 * e + l31) * 512 + 8 * hi;
        LAS const unsigned char* Bb = lds + DP_CT + l31 * 1040 + hi * 16;
#pragma unroll 2
        for (int ks = 0; ks < 32; ++ks) {
            const bf16x8 a0 = gl_ld8(Ab + 16 * ks), a1 = gl_ld8(Ab + 32 * 512 + 16 * ks);
            bf16x8 bq[4];
#pragma unroll
            for (int nt = 0; nt < 4; ++nt) bq[nt] = lds_ld8(Bb + nt * 32 * 1040 + ks * 32);
#pragma unroll
            for (int nt = 0; nt < 4; ++nt) { acc[0][nt] = MFMA32(a0, bq[nt], acc[0][nt]); acc[1][nt] = MFMA32(a1, bq[nt], acc[1][nt]); }
        }
#pragma unroll
        for (int mt = 0; mt < 2; ++mt)
#pragma unroll
            for (int g = 0; g < 4; ++g) { const f32x4 qv = *(LAS const f32x4*)(QK + 64 * e + 32 * mt + 8 * g + 4 * hi);
#pragma unroll
                for (int nt = 0; nt < 4; ++nt) {
                    const float x0 = acc[mt][nt][4 * g], x1 = acc[mt][nt][4 * g + 1], x2 = acc[mt][nt][4 * g + 2], x3 = acc[mt][nt][4 * g + 3];
                    ssq[nt] += x0 * x0 + x1 * x1 + x2 * x2 + x3 * x3; dot[nt] += x0 * qv.x + x1 * qv.y + x2 * qv.z + x3 * qv.w; } }
    }
#pragma unroll
    for (int nt = 0; nt < 4; ++nt) { ssq[nt] += __shfl_xor(ssq[nt], 32); dot[nt] += __shfl_xor(dot[nt], 32); }
    const float sn0 = dot[0] / sqrtf(ssq[0] * (1.f / 128.f) + EPS), sn1 = dot[1] / sqrtf(ssq[1] * (1.f / 128.f) + EPS);
    const float sn2 = dot[2] / sqrtf(ssq[2] * (1.f / 128.f) + EPS), sn3 = dot[3] / sqrtf(ssq[3] * (1.f / 128.f) + EPS);
    const float snA = hi ? sn2 : sn0, snB = hi ? sn3 : sn1;
    float s[2];
    LAS const float* QR = (LAS const float*)(lds + DP_QR) + h * 64;
#pragma unroll
    for (int u = 0; u < 2; ++u) { const int key = 32 * (2 * hi + u) + l31; float sr = 0.f;
#pragma unroll
        for (int c = 0; c < 8; ++c) { const v4u w = *(LAS const v4u*)(lds + DP_KR + key * 144 + c * 16); const f32x4 q0 = *(LAS const f32x4*)(QR + 8 * c), q1 = *(LAS const f32x4*)(QR + 8 * c + 4);
            sr += lo16(w.x) * q0.x + hi16(w.x) * q0.y + lo16(w.y) * q0.z + hi16(w.y) * q0.w + lo16(w.z) * q1.x + hi16(w.z) * q1.y + lo16(w.w) * q1.z + hi16(w.w) * q1.w; }
        s[u] = ((u ? snB : snA) + sr) * MLA_SCALE; }
    const float mx = wave_max(fmaxf(s[0], s[1]));
    const float p0 = __expf(s[0] - mx), p1 = __expf(s[1] - mx);
    const float lsum = wave_sum(p0 + p1);
    *(LAS bf16*)(lds + DP_PT + h * 272 + (32 * (2 * hi) + l31) * 2) = (bf16)f2bf(p0);
    *(LAS bf16*)(lds + DP_PT + h * 272 + (32 * (2 * hi + 1) + l31) * 2) = (bf16)f2bf(p1);
    if (lane == 0) { float* ml = (float*)(ws + WS_DML) + ((size_t)unit * 8 + h) * 2; ml[0] = mx; ml[1] = lsum; }
    __syncthreads();
    float* DA = (float*)(ws + WS_DACC) + (size_t)unit * 8 * 512;
#pragma unroll 1
    for (int t = 0; t < 2; ++t) { const int cb = 64 * wave + 32 * t + l31;
        f32x16 acc2 = {};
#pragma unroll 2
        for (int ks = 0; ks < 8; ++ks) {
            bf16x8 a = {0, 0, 0, 0, 0, 0, 0, 0};
            if (l31 < 8) a = lds_ld8(lds + DP_PT + l31 * 272 + (16 * ks + 8 * hi) * 2);
            bf16x8 bb;
#pragma unroll
            for (int jj = 0; jj < 8; ++jj) bb[jj] = (short)*(LAS const bf16*)(lds + DP_CT + (16 * ks + 8 * hi + jj) * 1040 + cb * 2);
            acc2 = MFMA32(a, bb, acc2);
        }
#pragma unroll
        for (int r = 0; r < 4; ++r) DA[(size_t)(r + 4 * hi) * 512 + cb] = acc2[r];
    }
    __syncthreads();
}
__device__ __forceinline__ void dec_combine(const Args& A, LAS unsigned char* lds, int unit, int tid, int lane, int wave) {
    unsigned char* ws = A.ws;
    const int j = unit >> 3, h = unit & 7, row = MP + j;
    const bf16* Qrow = (const bf16*)(ws + WS_QP2) + (size_t)row * 1536 + h * 192;
    const bf16* Krow = (const bf16*)(ws + WS_KN) + (size_t)row * 1024 + h * 128;
    const bf16* KRrow = (const bf16*)(ws + WS_KR) + (size_t)row * 64;
    const float snew = wave_sum(bf2f(Qrow[lane]) * bf2f(Krow[lane]) + bf2f(Qrow[lane + 64]) * bf2f(Krow[lane + 64]) + bf2f(Qrow[128 + lane]) * bf2f(KRrow[lane])) * MLA_SCALE;
    const float* ML = (const float*)(ws + WS_DML) + ((size_t)j * NPAGE * 8 + h) * 2;
    const float m0 = ML[(size_t)lane * 16], m1 = ML[(size_t)(lane + 64) * 16], l0 = ML[(size_t)lane * 16 + 1], l1 = ML[(size_t)(lane + 64) * 16 + 1];
    const float M = fmaxf(wave_max(fmaxf(m0, m1)), snew);
    const float wn = __expf(snew - M);
    const float den = wave_sum(__expf(m0 - M) * l0 + __expf(m1 - M) * l1) + wn;
    const float* DA = (const float*)(ws + WS_DACC) + ((size_t)j * NPAGE * 8 + h) * 512 + tid;
    float num = wn * bf2f(((const bf16*)(ws + WS_C))[(size_t)row * 512 + tid]);
#pragma unroll 4
    for (int p = 0; p < NPAGE; ++p) num += __expf(ML[(size_t)p * 16] - M) * DA[(size_t)p * 4096];
    LAS float* lat = (LAS float*)lds; LAS float* red = lat + 512;
    lat[tid] = num / den;
    __syncthreads();
    const int d = tid & 127, qt = tid >> 7;
    const float* Wv = A.in[I_WUV] + (size_t)(qt * 128) * 1024 + h * 128 + d;
    float part = 0.f;
#pragma unroll 8
    for (int c = 0; c < 128; ++c) part += lat[qt * 128 + c] * Wv[(size_t)c * 1024];
    red[tid] = part;
    __syncthreads();
    if (tid < 128) ((bf16*)(ws + WS_YB))[(size_t)row * 1024 + h * 128 + tid] = (bf16)f2bf(red[tid] + red[128 + tid] + red[256 + tid] + red[384 + tid]);
    __syncthreads();
}
__device__ __forceinline__ f32x16 skinny_partial(const bf16* A, const bf16* Bt, int K, int n0, int wave, int lane) {
    const int l31 = lane & 31, hi = lane >> 5, kw = K >> 3, k0 = wave * kw;
    const bf16* ap = A + (size_t)l31 * K + k0 + 8 * hi; const bf16* bp = Bt + (size_t)(n0 + l31) * K + k0 + 8 * hi;
    f32x16 acc = {};
#pragma unroll 8
    for (int ks = 0; ks < (kw >> 4); ++ks) acc = MFMA32(gl_ld8(ap + 16 * ks), gl_ld8(bp + 16 * ks), acc);
    return acc;
}
__device__ __forceinline__ void skinny_put(LAS float* red, const f32x16& acc, int wave, int lane) {
    const int l31 = lane & 31, hi = lane >> 5;
#pragma unroll
    for (int r = 0; r < 16; ++r) red[(wave * 32 + crow(r, hi)) * 32 + l31] = acc[r];
}
__device__ __forceinline__ void skinny_get(LAS const float* red, int tid, float& v0, float& v1) {
    v0 = 0.f; v1 = 0.f;
#pragma unroll
    for (int w = 0; w < 8; ++w) { v0 += red[w * 1024 + tid * 2]; v1 += red[w * 1024 + tid * 2 + 1]; }
}
template <int MODE> __device__ __forceinline__ void skinny_tile(const Args& A, LAS unsigned char* lds, int tile, int tid, int lane, int wave) {
    unsigned char* ws = A.ws; const int n0 = tile * 32;
    LAS float* red = (LAS float*)lds; LAS float* red2 = red + 8192;
    if (MODE == 0) {
        skinny_put(red, skinny_partial((const bf16*)(ws + WS_YA) + (size_t)MP * 1024, (const bf16*)(ws + WS_WYA), 1024, n0, wave, lane), wave, lane);
        skinny_put(red2, skinny_partial((const bf16*)(ws + WS_YB) + (size_t)MP * 1024, (const bf16*)(ws + WS_WYB), 1024, n0, wave, lane), wave, lane);
    } else if (MODE == 1) skinny_put(red, skinny_partial((const bf16*)(ws + WS_T) + (size_t)MP * 1024, (const bf16*)(ws + WS_WO), 1024, n0, wave, lane), wave, lane);
    else if (MODE == 2) skinny_put(red, skinny_partial((const bf16*)(ws + WS_XN2) + (size_t)MP * 1024, (const bf16*)(ws + WS_WUP), 1024, n0, wave, lane), wave, lane);
    else skinny_put(red, skinny_partial((const bf16*)(ws + WS_H) + (size_t)MP * 4096, (const bf16*)(ws + WS_WDN), 4096, n0, wave, lane), wave, lane);
    __syncthreads();
    float v0, v1; skinny_get(red, tid, v0, v1);
    const int row = tid >> 4, col = n0 + 2 * (tid & 15); const size_t grow = (size_t)(MP + row);
    if (MODE == 0) {
        float u0, u1; skinny_get(red2, tid, u0, u1);
        const bf16* g = (const bf16*)(ws + WS_GATES) + grow * 2048 + col;
        const float t0 = bf2f(g[0]) * v0 + bf2f(g[1024]) * u0, t1 = bf2f(g[1]) * v1 + bf2f(g[1025]) * u1;
        *(unsigned*)((bf16*)(ws + WS_T) + grow * 1024 + col) = pk2(t0, t1);
    } else if (MODE == 1) {
        const float* x = A.in[I_XS] + (size_t)row * 1024 + col; float* o = (float*)(ws + WS_X1) + grow * 1024 + col;
        o[0] = x[0] + v0; o[1] = x[1] + v1;
    } else if (MODE == 2) {
        const float a = fmaxf(v0, 0.f), b = fmaxf(v1, 0.f);
        *(unsigned*)((bf16*)(ws + WS_H) + grow * 4096 + col) = pk2(a * a, b * b);
    } else {
        const float* x = (const float*)(ws + WS_X1) + grow * 1024 + col; float* o = A.out + O_YS + (size_t)row * 1024 + col;
        o[0] = x[0] + v0; o[1] = x[1] + v1;
    }
    __syncthreads();
}
struct DecPk { v4u p[36]; };
#ifndef DEC_RD
#define DEC_RD 16
#endif
constexpr int RD = DEC_RD;
__device__ __forceinline__ void dec_load_sync(const Args& A, LAS unsigned char* lds, int unit, int tid) {
    const int phys = ((const int*)A.in[I_PT])[unit];
    const float* src = A.in[I_CACHE] + (size_t)phys * PAGE * LATW;
#pragma unroll 1
    for (int q0 = 0; q0 < 18; q0 += 6) {
        f32x4 va[6], vb[6];
#pragma unroll
        for (int q = 0; q < 6; ++q) { const int id = (q0 + q) * 512 + tid, row = id / 72, g = id % 72; const float* p = src + (size_t)row * LATW + 8 * g; va[q] = *(const f32x4*)p; vb[q] = *(const f32x4*)(p + 4); }
#pragma unroll
        for (int q = 0; q < 6; ++q) { const int id = (q0 + q) * 512 + tid, row = id / 72, g = id % 72;
            v4u o; o.x = pk2(va[q].x, va[q].y); o.y = pk2(va[q].z, va[q].w); o.z = pk2(vb[q].x, vb[q].y); o.w = pk2(vb[q].z, vb[q].w);
            if (g < 64) *(LAS v4u*)(lds + DP_CT + row * 1040 + g * 16) = o; else *(LAS v4u*)(lds + DP_KR + row * 144 + (g - 64) * 16) = o; }
    }
    __syncthreads();
}
__device__ __forceinline__ void dec_prefetch(const Args& A, int unit, int lt, DecPk& pk) {
    const int phys = __builtin_amdgcn_readfirstlane(((const int*)A.in[I_PT])[unit]);
    const char* src = (const char*)(A.in[I_CACHE] + (size_t)phys * PAGE * LATW);
    const unsigned lo = (unsigned)lt * 32u;
#pragma unroll
    for (int q0 = 0; q0 < 36; q0 += 12) {
        f32x4 va[12], vb[12];
#pragma unroll
        for (int q = 0; q < 12; ++q) { const char* p = src + (size_t)(q0 + q) * 8192 + lo; va[q] = __builtin_nontemporal_load((const f32x4*)p); vb[q] = __builtin_nontemporal_load((const f32x4*)(p + 16)); }
#pragma unroll
        for (int q = 0; q < 12; ++q) { v4u o; o.x = pg8::cvt_pk_bf16(va[q].x, va[q].y); o.y = pg8::cvt_pk_bf16(va[q].z, va[q].w); o.z = pg8::cvt_pk_bf16(vb[q].x, vb[q].y); o.w = pg8::cvt_pk_bf16(vb[q].z, vb[q].w); pk.p[q0 + q] = o; }
    }
}
__device__ __forceinline__ void dec_store(LAS unsigned char* lds, int lt, const DecPk& pk) {
    int ltx = lt; asm volatile("" : "+v"(ltx));
#pragma unroll
    for (int q = 0; q < 36; ++q) { const int id = q * 256 + ltx, row = id / 72, g = id - row * 72;
        const int off = g < 64 ? DP_CT + row * 1040 + g * 16 : DP_KR + row * 144 + (g - 64) * 16;
        *(LAS v4u*)(lds + off) = pk.p[q]; }
}
__device__ __forceinline__ void dec_ring_fill(const Args& A, int mw, int lane, bf16x8 (&a)[RD]) {
    const __amdgpu_buffer_rsrc_t rs = __builtin_amdgcn_make_buffer_rsrc((void*)(A.ws + WS_WKT), 0, 1024 * 512 * 2, 0x00020000);
    const unsigned voff = (unsigned)lane * 16u; const int so = 256 * mw * 1024;
#pragma unroll
    for (int d = 0; d < RD; ++d) a[d] = __builtin_bit_cast(bf16x8, __builtin_amdgcn_raw_buffer_load_b128(rs, voff, so + d * 1024, 0));
}
__device__ __forceinline__ void dec_mfma(const Args& A, LAS unsigned char* lds, int unit, int mw, int lane, bf16x8 (&a)[RD]) {
    const int l31_ = lane & 31, hi_ = lane >> 5;
    const __amdgpu_buffer_rsrc_t rs = __builtin_amdgcn_make_buffer_rsrc((void*)(A.ws + WS_WKT), 0, 1024 * 512 * 2, 0x00020000);
    const unsigned voff = (unsigned)lane * 16u; const int so = 256 * mw * 1024;
    LAS const unsigned char* Bb = lds + DP_CT + l31_ * 1040 + hi_ * 16;
    float ssq[4] = {0.f, 0.f, 0.f, 0.f}, dot[4] = {0.f, 0.f, 0.f, 0.f};
    bf16x8 bc0 = lds_ld8(Bb), bc1 = lds_ld8(Bb + 33280), bc2 = lds_ld8(Bb + 2 * 33280), bc3 = lds_ld8(Bb + 3 * 33280), bd0, bd1, bd2, bd3;
#pragma unroll 1
    for (int jb = 0; jb < 8; ++jb) {
        f32x16 acc[4];
#pragma unroll
        for (int nt = 0; nt < 4; ++nt) acc[nt] = f32x16{};
#pragma unroll 1
        for (int blk = 0; blk < 32 / RD; ++blk) {
            const int nj = (blk == 32 / RD - 1) ? ((jb + 1) & 7) : jb, nk = (blk == 32 / RD - 1) ? 0 : (blk + 1) * RD;
            const int nb = so + nj * 32 * 1024 + 1024 * nk;
            LAS const unsigned char* Bk = Bb + blk * (32 * RD);
            LAS const unsigned char* Bn = Bb + ((blk + 1) & (32 / RD - 1)) * (32 * RD);
#pragma unroll
            for (int d = 0; d < RD; d += 2) {
                {
                    LAS const unsigned char* Bx = Bk + (d + 1) * 32;
                    bd0 = lds_ld8(Bx); bd1 = lds_ld8(Bx + 33280); bd2 = lds_ld8(Bx + 2 * 33280); bd3 = lds_ld8(Bx + 3 * 33280);
                    __builtin_amdgcn_sched_barrier(0);
                    acc[0] = MFMA32(a[d], bc0, acc[0]); acc[1] = MFMA32(a[d], bc1, acc[1]); acc[2] = MFMA32(a[d], bc2, acc[2]); acc[3] = MFMA32(a[d], bc3, acc[3]);
                    a[d] = __builtin_bit_cast(bf16x8, __builtin_amdgcn_raw_buffer_load_b128(rs, voff, nb + d * 1024, 0));
                    __builtin_amdgcn_sched_barrier(0);
                }
                {
                    LAS const unsigned char* Bx = (d + 2 < RD) ? Bk + (d + 2) * 32 : Bn;
                    bc0 = lds_ld8(Bx); bc1 = lds_ld8(Bx + 33280); bc2 = lds_ld8(Bx + 2 * 33280); bc3 = lds_ld8(Bx + 3 * 33280);
                    __builtin_amdgcn_sched_barrier(0);
                    acc[0] = MFMA32(a[d + 1], bd0, acc[0]); acc[1] = MFMA32(a[d + 1], bd1, acc[1]); acc[2] = MFMA32(a[d + 1], bd2, acc[2]); acc[3] = MFMA32(a[d + 1], bd3, acc[3]);
                    a[d + 1] = __builtin_bit_cast(bf16x8, __builtin_amdgcn_raw_buffer_load_b128(rs, voff, nb + (d + 1) * 1024, 0));
                    __builtin_amdgcn_sched_barrier(0);
                }
            }
        }
        const int e4 = jb & 3, h = 2 * mw + (jb >> 2);
        int l31 = l31_, hi = hi_; asm volatile("" : "+v"(l31), "+v"(hi));
        LAS const float* QK = (LAS const float*)(lds + DP_QK) + h * 128 + 32 * e4 + 4 * hi;
#pragma unroll
        for (int g = 0; g < 4; ++g) { const f32x4 qv = *(LAS const f32x4*)(QK + 8 * g);
#pragma unroll
            for (int nt = 0; nt < 4; ++nt) {
                const float x0 = acc[nt][4 * g], x1 = acc[nt][4 * g + 1], x2 = acc[nt][4 * g + 2], x3 = acc[nt][4 * g + 3];
                ssq[nt] += x0 * x0 + x1 * x1 + x2 * x2 + x3 * x3; dot[nt] += x0 * qv.x + x1 * qv.y + x2 * qv.z + x3 * qv.w; } }
        if (e4 == 3) {
#pragma unroll
            for (int nt = 0; nt < 4; ++nt) { ssq[nt] += __shfl_xor(ssq[nt], 32); dot[nt] += __shfl_xor(dot[nt], 32); }
            const float sn0 = dot[0] / sqrtf(ssq[0] * (1.f / 128.f) + EPS), sn1 = dot[1] / sqrtf(ssq[1] * (1.f / 128.f) + EPS);
            const float sn2 = dot[2] / sqrtf(ssq[2] * (1.f / 128.f) + EPS), sn3 = dot[3] / sqrtf(ssq[3] * (1.f / 128.f) + EPS);
            const float snA = hi ? sn2 : sn0, snB = hi ? sn3 : sn1;
            float s[2];
            LAS const float* QR = (LAS const float*)(lds + DP_QR) + h * 64;
#pragma unroll
            for (int u = 0; u < 2; ++u) { const int key = 32 * (2 * hi + u) + l31; float sr = 0.f;
#pragma unroll
                for (int c = 0; c < 8; ++c) { const v4u w = *(LAS const v4u*)(lds + DP_KR + key * 144 + c * 16); const f32x4 q0 = *(LAS const f32x4*)(QR + 8 * c), q1 = *(LAS const f32x4*)(QR + 8 * c + 4);
                    sr += lo16(w.x) * q0.x + hi16(w.x) * q0.y + lo16(w.y) * q0.z + hi16(w.y) * q0.w + lo16(w.z) * q1.x + hi16(w.z) * q1.y + lo16(w.w) * q1.z + hi16(w.w) * q1.w; }
                s[u] = ((u ? snB : snA) + sr) * MLA_SCALE; }
            const float mx = wave_max(fmaxf(s[0], s[1]));
            const float p0 = __expf(s[0] - mx), p1 = __expf(s[1] - mx);
            const float lsum = wave_sum(p0 + p1);
            *(LAS bf16*)(lds + DP_PT + h * 272 + (32 * (2 * hi) + l31) * 2) = (bf16)f2bf(p0);
            *(LAS bf16*)(lds + DP_PT + h * 272 + (32 * (2 * hi + 1) + l31) * 2) = (bf16)f2bf(p1);
            if (l31 + hi == 0) { float* ml = (float*)(A.ws + WS_DML) + ((size_t)unit * 8 + h) * 2; ml[0] = mx; ml[1] = lsum; }
#pragma unroll
            for (int nt = 0; nt < 4; ++nt) { ssq[nt] = 0.f; dot[nt] = 0.f; }
        }
    }
}
__device__ __forceinline__ void dec_pv(const Args& A, LAS unsigned char* lds, int unit, int lane, int wave) {
    int l31 = lane & 31, hi = lane >> 5; asm volatile("" : "+v"(l31), "+v"(hi));
    float* DA = (float*)(A.ws + WS_DACC) + (size_t)unit * 8 * 512;
#pragma unroll 1
    for (int t = 0; t < 2; ++t) { const int cb = 64 * wave + 32 * t + l31;
        f32x16 acc2 = {};
#pragma unroll 2
        for (int ks = 0; ks < 8; ++ks) {
            bf16x8 a = {0, 0, 0, 0, 0, 0, 0, 0};
            if (l31 < 8) a = lds_ld8(lds + DP_PT + l31 * 272 + (16 * ks + 8 * hi) * 2);
            bf16x8 bb;
#pragma unroll
            for (int jj = 0; jj < 8; ++jj) bb[jj] = (short)*(LAS const bf16*)(lds + DP_CT + (16 * ks + 8 * hi + jj) * 1040 + cb * 2);
            acc2 = MFMA32(a, bb, acc2);
        }
#pragma unroll
        for (int r = 0; r < 4; ++r) DA[(size_t)(r + 4 * hi) * 512 + cb] = acc2[r];
    }
}
constexpr int NG4 = 896;
template <bool MF> __device__ __forceinline__ void dec_loop(const Args& A, LAS unsigned char* lds, volatile LAS unsigned* MISC, unsigned* qc, int g, int tid, int lane, int wave) {
    constexpr int NGRP = NG4 + (4096 - 4 * NG4) / 2;
#define GFIRST(g_) ((g_) < NG4 ? 4 * (g_) : 4 * NG4 + 2 * ((g_) - NG4))
#define GCOUNT(g_) ((g_) < NG4 ? 4 : 2)
#define DPULL() ({ __syncthreads(); if (tid == 0) MISC[0] = atomicAdd(qc, 1u); __syncthreads(); (int)MISC[0]; })
    int jcur = -1;
#ifdef PROBE_K
#ifndef PROBE_B
#define PROBE_B 0
#endif
    unsigned long long pt0 = 0, pdt = 0;
#define DPS(k) do { if ((k) == PROBE_K) pt0 = __builtin_amdgcn_s_memrealtime(); } while (0)
#define DPE(k) do { if ((k) == PROBE_K) pdt += __builtin_amdgcn_s_memrealtime() - pt0; } while (0)
#else
#define DPS(k) do {} while (0)
#define DPE(k) do {} while (0)
#endif
    bf16x8 a[RD];
    if (MF) dec_ring_fill(A, wave, lane, a);
#pragma unroll 1
    while (g < NGRP) {
        const int gn = DPULL();
        const int j = GFIRST(g) >> 7, PG = GCOUNT(g), u0 = GFIRST(g);
        if (j != jcur) { dec_tables(A, lds, j, tid); jcur = j; __syncthreads(); }
#pragma unroll 1
        for (int p = 0; p < PG; ++p) {
            const int unit = u0 + p, np = (p + 1 < PG) ? unit + 1 : (gn < NGRP ? GFIRST(gn) : -1);
            DecPk pk;
            DPS(64); DPS(60); DPS(61);
#ifdef PROBE_K
            const unsigned long long ck0 = __builtin_readcyclecounter();
#endif
            if (MF) { dec_mfma(A, lds, unit, wave, lane, a); DPE(60);
#ifdef PROBE_K
                if (PROBE_K == 66) pdt += (__builtin_readcyclecounter() - ck0) / 24;
#endif
            }
            else if (np >= 0) { dec_prefetch(A, np, tid - 256, pk); DPE(61); }
            LBAR();
            DPS(62);
            dec_pv(A, lds, unit, lane, wave);
            LBAR();
            DPE(62); DPS(63);
            if (MF) { if (np >= 0) dec_ring_fill(A, wave, lane, a); }
            else if (np >= 0) dec_store(lds, tid - 256, pk);
            LBAR();
            DPE(63); DPE(64);
#ifdef PROBE_K
            if (PROBE_K == 65) pdt += 1000;
#endif
        }
        g = gn;
    }
#ifdef PROBE_K
    if (blockIdx.x == PROBE_B && PROBE_K >= 60) { const unsigned long long te = __builtin_amdgcn_s_memrealtime(); while (__builtin_amdgcn_s_memrealtime() - te < (unsigned long long)PROBE_MULT * pdt) __builtin_amdgcn_s_sleep(8); }
#endif
}
__device__ __forceinline__ void dec_run(const Args& A, LAS unsigned char* lds, volatile LAS unsigned* MISC, unsigned* qc, int tid, int lane, int wave) {
    const int g = DPULL();
    if (g >= 896 + 256) return;
    dec_load_sync(A, lds, GFIRST(g), tid);
    if (wave < 4) dec_loop<true>(A, lds, MISC, qc, g, tid, lane, wave);
    else dec_loop<false>(A, lds, MISC, qc, g, tid, lane, wave);
#undef DPULL
#undef GFIRST
#undef GCOUNT
}
#ifndef MK_SINGLE
#define MK_SINGLE 1
#endif
constexpr int N_PHASES = 12;
__global__ void __launch_bounds__(512, 2) mk_fwd(Args args) {
    extern __shared__ __attribute__((aligned(16))) unsigned char lds_raw[];
    LAS unsigned char* lds = (LAS unsigned char*)lds_raw;
    const int tid = threadIdx.x, lane = tid & 63, wave = __builtin_amdgcn_readfirstlane(tid >> 6);
    const int G = gridDim.x, bid = blockIdx.x;
    const int gw = bid * 8 + wave, NGW = G * 8, gtid = bid * 512 + tid, NGT = G * 512;
    volatile LAS unsigned* MISC = (volatile LAS unsigned*)(lds + MISC_OFF);
    if (tid < 32) MISC[tid] = 0u;
    __syncthreads();
    unsigned char* ws = args.ws;
#if MK_SINGLE
    XcdBarrier bar = xcd_barrier_post((unsigned*)(ws + WS_CTL) + 4096, MISC + 8);
#define GRID_BAR() xcd_barrier(bar)
#else
#define GRID_BAR() do {} while (0)
#endif
    const int lo = args.ph_lo, hi = args.ph_hi;
#ifdef PROBE_K
#ifndef PROBE_B
#define PROBE_B 0
#endif
    unsigned long long pt0 = 0, pdt = 0;
#define PSTART(k) do { if ((k) == PROBE_K) pt0 = __builtin_amdgcn_s_memrealtime(); } while (0)
#define PEND(k) do { if ((k) == PROBE_K) pdt += __builtin_amdgcn_s_memrealtime() - pt0; } while (0)
#else
#define PSTART(k) do {} while (0)
#define PEND(k) do {} while (0)
#endif
#ifndef PHASE_MASK
#define PHASE_MASK 0xFFFF
#endif
#define IN(k) (((PHASE_MASK >> (k)) & 1) && lo <= (k) && (k) < hi)
#define SEAM(k) do { if (IN(k) && IN((k) + 1)) GRID_BAR(); } while (0)

    PSTART(0);
    if (IN(0)) {
        p0_prologue(args, lds, gw, NGW, wave, lane);
        for (int i = gtid; i < 32 * 2 * 3072; i += NGT) { const int c = i % 3072, r = (i / 3072) % 2, j = i / (2 * 3072);
            args.out[O_CSS + (size_t)(j * 3 + r) * 3072 + c] = args.in[I_SCONV][(size_t)(j * 3 + r + 1) * 3072 + c]; }
        __syncthreads();
    }
    SEAM(0);
    PEND(0);
    PSTART(1);
    if (IN(1)) {
        pg8::Gemm g{(const pg8::bf16_t*)(ws + WS_XN), (const pg8::bf16_t*)(ws + WS_WIN), MPAD, NIN, 1024};
        pg8::StaticOrder S; S.init(MPAD, NIN, G, bid);
        EpiG1 E{(bf16*)(ws + WS_QKV), (bf16*)(ws + WS_Z), (bf16*)(ws + WS_QD), (bf16*)(ws + WS_KVD), (bf16*)(ws + WS_GATES), (float*)(ws + WS_SM)};
        pg8::gemm_phase<EpiG1, pg8::StaticOrder, true, true>(lds, g, S, E);
    }
    SEAM(1);
    PEND(1);
    PSTART(2);
    if (IN(2)) {
        p2_rows(args, gw, NGW, lane);
        p2_conv_state(args, gtid, NGT);
    }
    SEAM(2);
    PEND(2);
    PSTART(3);
    if (IN(3)) {
        { pg8::Gemm g{(const pg8::bf16_t*)(ws + WS_QD), (const pg8::bf16_t*)(ws + WS_WQ), MPAD, 1536, 512};
          pg8::StaticOrder S; S.init(MPAD, 1536, G, bid);
          EpiStore<0> E{(bf16*)(ws + WS_QP), 1536, 6, (bf16*)(ws + WS_QP), 1536};
          pg8::gemm_phase<EpiStore<0>, pg8::StaticOrder, true, true>(lds, g, S, E); }
        { pg8::Gemm g{(const pg8::bf16_t*)(ws + WS_C), (const pg8::bf16_t*)(ws + WS_WKV), MPAD, 2048, 512};
          pg8::StaticOrder S; S.init(MPAD, 2048, G, G - 1 - bid);
          EpiStore<0> E{(bf16*)(ws + WS_KN), 1024, 4, (bf16*)(ws + WS_V), 1024};
          pg8::gemm_phase<EpiStore<0>, pg8::StaticOrder, true, true>(lds, g, S, E); }
        PSTART(31);
        for (int u = bid; u < 2048; u += G) gdn_a_unit(args, lds, u, tid, lane, wave);
        PEND(31); PSTART(32);
        for (int u = bid; u < 256; u += G) gdn_r_unit(args, lds, u, tid, lane, wave);
        PEND(32);
    }
    SEAM(3);
    PEND(3);
    PSTART(4);
    if (IN(4)) { p4_rows(args, gw, NGW, lane); }
    SEAM(4);
    PEND(4);
    PSTART(5);
    if (IN(5)) {
        unsigned* qctr = (unsigned*)(ws + WS_CTL) + 64;
#define PULL(k) ({ __syncthreads(); if (tid == 0) MISC[0] = atomicAdd(qctr + 64 * (k), 1u); __syncthreads(); (int)MISC[0]; })
        PSTART(50);
        for (int it = PULL(0); it < 64; it = PULL(0)) gdn_b_unit(args, lds, it, tid, lane, wave);
        PEND(50); PSTART(51);
        for (int u = PULL(1); u < 256; u = PULL(1)) {
            const int bh = u >> 2, pr = u & 3, b = bh >> 3, h = bh & 7;
#pragma unroll 1
            for (int s2 = 0; s2 < 2; ++s2) { const int qb = s2 ? pr : 7 - pr;
                att::attn_block((const bf16*)(ws + WS_QP2) + (size_t)(b * SEQ + 256 * qb) * 1536 + h * 192, (const bf16*)(ws + WS_KN) + (size_t)(b * SEQ) * 1024 + h * 128,
                                (const bf16*)(ws + WS_KR) + (size_t)(b * SEQ) * 64, (const bf16*)(ws + WS_V) + (size_t)(b * SEQ) * 1024 + h * 128,
                                (bf16*)(ws + WS_YB) + (size_t)(b * SEQ + 256 * qb) * 1024 + h * 128, 256 * qb, lds); }
        }
        PEND(51); PSTART(52);
        dec_run(args, lds, MISC, qctr + 128, tid, lane, wave);
        PEND(52);
#undef PULL
    }
    SEAM(5);
    PEND(5);
    PSTART(6);
    if (IN(6)) { for (int u = bid; u < 256; u += G) dec_combine(args, lds, u, tid, lane, wave); }
    SEAM(6);
    PEND(6);
    PSTART(7);
    if (IN(7)) {
        for (int t = bid; t < 32; t += G) skinny_tile<0>(args, lds, t, tid, lane, wave);
        pg8::StaticOrder S; S.init(MP, 1024, G, bid);
        { pg8::Gemm g{(const pg8::bf16_t*)(ws + WS_YA), (const pg8::bf16_t*)(ws + WS_WYA), MP, 1024, 1024};
          EpiMerge<1> E{(const bf16*)(ws + WS_GATES), (float*)(ws + WS_TF), (bf16*)(ws + WS_T)};
          pg8::gemm_phase<EpiMerge<1>, pg8::StaticOrder, true, true>(lds, g, S, E); }
        { pg8::Gemm g{(const pg8::bf16_t*)(ws + WS_YB), (const pg8::bf16_t*)(ws + WS_WYB), MP, 1024, 1024};
          EpiMerge<2> E{(const bf16*)(ws + WS_GATES), (float*)(ws + WS_TF), (bf16*)(ws + WS_T)};
          pg8::gemm_phase<EpiMerge<2>, pg8::StaticOrder, true, true>(lds, g, S, E); }
    }
    SEAM(7);
    PEND(7);
    PSTART(8);
    if (IN(8)) {
        for (int t = bid; t < 32; t += G) skinny_tile<1>(args, lds, t, tid, lane, wave);
        pg8::Gemm g{(const pg8::bf16_t*)(ws + WS_T), (const pg8::bf16_t*)(ws + WS_WO), MP, 1024, 1024};
        pg8::StaticOrder S; S.init(MP, 1024, G, bid);
        EpiRes<0> E{args.in[I_XP], args.in[I_XS], (float*)(ws + WS_X1), args.out};
        pg8::gemm_phase<EpiRes<0>, pg8::StaticOrder, true, true>(lds, g, S, E);
    }
    SEAM(8);
    PEND(8);
    PSTART(9);
    if (IN(9)) {
        bf16* XN2 = (bf16*)(ws + WS_XN2); const float* X1 = (const float*)(ws + WS_X1);
        for (int m = gw; m < MPAD; m += NGW) {
            if (m < MR) rms_row_to_bf16(X1 + (size_t)m * 1024, args.in[I_NMLP], XN2 + (size_t)m * 1024, lane);
            else { v4u z = {0u, 0u, 0u, 0u}; *((v4u*)(XN2 + (size_t)m * 1024) + lane) = z; *((v4u*)(XN2 + (size_t)m * 1024) + 64 + lane) = z; }
        }
    }
    SEAM(9);
    PEND(9);
    PSTART(10);
    if (IN(10)) {
        for (int t = bid; t < 128; t += G) skinny_tile<2>(args, lds, t, tid, lane, wave);
        pg8::Gemm g{(const pg8::bf16_t*)(ws + WS_XN2), (const pg8::bf16_t*)(ws + WS_WUP), MP, 4096, 1024};
        pg8::StaticOrder S; S.init(MP, 4096, G, bid);
        EpiStore<1> E{(bf16*)(ws + WS_H), 4096, 16, (bf16*)(ws + WS_H), 4096};
        pg8::gemm_phase<EpiStore<1>, pg8::StaticOrder, true, true>(lds, g, S, E);
    }
    SEAM(10);
    PEND(10);
    PSTART(11);
    if (IN(11)) {
        for (int t = bid; t < 32; t += G) skinny_tile<3>(args, lds, t, tid, lane, wave);
        pg8::Gemm g{(const pg8::bf16_t*)(ws + WS_H), (const pg8::bf16_t*)(ws + WS_WDN), MP, 1024, 4096};
        pg8::StaticOrder S; S.init(MP, 1024, G, bid);
        EpiRes<1> E{args.in[I_XP], args.in[I_XS], (float*)(ws + WS_X1), args.out};
        pg8::gemm_phase<EpiRes<1>, pg8::StaticOrder, true, true>(lds, g, S, E);
    }
    PEND(11);
#ifdef PROBE_K
    if (PROBE_K >= 80 && PROBE_K < 90) { __syncthreads(); pdt = MISC[16]; }
    if (bid == PROBE_B || (PROBE_K >= 80 && PROBE_K < 90)) { const unsigned long long te = __builtin_amdgcn_s_memrealtime(); while (__builtin_amdgcn_s_memrealtime() - te < (unsigned long long)PROBE_MULT * pdt) __builtin_amdgcn_s_sleep(8); }
#endif
#undef IN
#undef SEAM
}

extern "C" void kernel_launch(void* const* d_in, const int* in_sizes, int n_in, void* d_out, int out_size, void* d_ws, size_t ws_size, hipStream_t stream) {
    static int grid = 0;
    if (grid == 0) {
        if (n_in != 27 || ws_size < WS_END) { fprintf(stderr, "kernel_launch: unexpected n_in %d or ws_size %zu (need %zu)\n", n_in, ws_size, (size_t)WS_END); grid = -1; return; }
        int dev = 0, cus = 0, per_cu = 0;
        if (hipGetDevice(&dev) != hipSuccess || hipDeviceGetAttribute(&cus, hipDeviceAttributeMultiprocessorCount, dev) != hipSuccess) { grid = -1; return; }
        if (hipFuncSetAttribute((const void*)mk_fwd, hipFuncAttributeMaxDynamicSharedMemorySize, LDS_BYTES) != hipSuccess) { fprintf(stderr, "kernel_launch: hipFuncSetAttribute failed\n"); grid = -1; return; }
        if (hipOccupancyMaxActiveBlocksPerMultiprocessor(&per_cu, (const void*)mk_fwd, 512, LDS_BYTES) != hipSuccess || per_cu < 1) fprintf(stderr, "kernel_launch: occupancy query says %d\n", per_cu);
        (void)hipGetLastError();
        grid = cus;
    }
    if (grid < 0) return;
    (void)hipMemsetAsync((char*)d_ws + WS_CTL, 0, CTL_BYTES, stream);
    Args a{};
    for (int i = 0; i < 27; ++i) a.in[i] = (const float*)d_in[i];
    a.out = (float*)d_out; a.ws = (unsigned char*)d_ws;
#if MK_SINGLE
    a.ph_lo = 0; a.ph_hi = N_PHASES;
    hipLaunchKernelGGL(mk_fwd, dim3(grid), dim3(512), LDS_BYTES, stream, a);
#else
    for (int p = 0; p < N_PHASES; ++p) { a.ph_lo = p; a.ph_hi = p + 1; hipLaunchKernelGGL(mk_fwd, dim3(grid), dim3(512), LDS_BYTES, stream, a); }
#endif
    const hipError_t le = hipPeekAtLastError();
    if (le != hipSuccess) fprintf(stderr, "kernel_launch: launch failed: %s\n", hipGetErrorName(le));
}
```

```cpp
#include <hip/hip_runtime.h>
#include <cstdio>
#include <cstdint>
namespace pg8 {
#define PG8_LAS __attribute__((address_space(3)))
typedef unsigned short bf16_t;
typedef short bf16x8 __attribute__((ext_vector_type(8)));
typedef float f32x4 __attribute__((ext_vector_type(4)));
typedef unsigned u32x4 __attribute__((ext_vector_type(4)));
constexpr int BM = 256, BK = 64, HALF = 128, HTB = HALF * BK * 2  , STAGE_BYTES = 8 * HTB, NXCD = 8, WGM = 8;

__host__ __device__ __forceinline__ int lds_byte(int r, int c) { const int st = (r >> 4) * 2 + (c >> 5), rr = r & 15, cc = c & 31, ob = rr * 64 + cc * 2; return st * 1024 + (ob ^ (((ob >> 9) & 1) << 5)); }
__host__ __device__ __forceinline__ void stage_rc(int b, int& R, int& C) { const int st = b / 1024, sb = b % 1024, swz = sb ^ (((sb >> 9) & 1) << 5); R = (st >> 1) * 16 + swz / 64; C = (st & 1) * 32 + (swz % 64) / 2; }
__host__ __device__ __forceinline__ int perm32(int rho) { const int n = rho >> 4, i = rho & 15; return 8 * (i >> 2) + 4 * n + (i & 3); }

struct Unit { int pm, pn; };
struct Gemm { const bf16_t* A; const bf16_t* Bt; int M, N, K; };

struct StaticOrder {
    int nM, nN, nwg, G, c;
    __host__ __device__ void init(int M, int N, int G_, int c_) { nM = M / BM; nN = N / BM; nwg = nM * nN; G = G_; c = c_; }
    __host__ __device__ bool next(int i, Unit& u) const {
        const long L = (long)i * G + c; if (L >= nwg) return false;
        int wgid = (int)L; { const int q = nwg / NXCD, r = nwg % NXCD, xcd = wgid % NXCD, off = wgid / NXCD; wgid = (xcd < r ? xcd * (q + 1) : r * (q + 1) + (xcd - r) * q) + off; }
        const int nig = WGM * nN, gid = wgid / nig, fm = gid * WGM, gsz = (nM - fm) < WGM ? (nM - fm) : WGM;
        u.pm = fm + ((wgid % nig) % gsz); u.pn = (wgid % nig) / gsz; return true;
    }
    __device__ __forceinline__ void a_ready(const Unit&) const {}
    __device__ __forceinline__ void done(const Unit&) const {}
};

__device__ __forceinline__ unsigned cvt_pk_bf16(float lo, float hi) { unsigned r; asm volatile("v_cvt_pk_bf16_f32 %0, %1, %2" : "=v"(r) : "v"(lo), "v"(hi)); return r; }
template <class Epi, class Sched, bool ALIGN_EPI = false, bool SP2 = false>
__device__ __forceinline__ void gemm_phase(PG8_LAS unsigned char* lds, const Gemm g, const Sched& S, const Epi& E) {
    const int tid = threadIdx.x, wid = __builtin_amdgcn_readfirstlane(tid >> 6), lane = tid & 63, wr = wid >> 2, wc = wid & 3, fr = lane & 15, fq = lane >> 4;
    const int K = g.K, nt = K / BK;
    unsigned voffA[2], voffB[2];
#pragma unroll
    for (int i = 0; i < 2; ++i) { int R, C; stage_rc(tid * 16 + i * 8192, R, C); const int Rb = Epi::PERM ? ((R & ~31) + perm32(R & 31)) : R;
        voffA[i] = (unsigned)(R * K + C) * 2u; voffB[i] = (unsigned)(Rb * K + C) * 2u; }
    const size_t kstep = (size_t)(BK * 2);
    const size_t hstep = (size_t)HALF * K * 2;
    const size_t tstep = 2 * hstep;
    const unsigned ldsw = (unsigned)wid * 1024u;
    const int aoff = lds_byte(wr * 64 + fr, fq * 8), boff = lds_byte(wc * 32 + fr, fq * 8);
#define PG8_SA(b, h) (((b) * 2 + (h)) * HTB)
#define PG8_SB(b, h) ((4 + (b) * 2 + (h)) * HTB)
#define PG8_STAGE(bufoff, gbase, voff) do { _Pragma("unroll") for (int _i = 0; _i < 2; ++_i) \
        __builtin_amdgcn_global_load_lds((const unsigned*)((const char*)(gbase) + (voff)[_i]), (PG8_LAS unsigned*)(lds + (bufoff) + ldsw + _i * 8192), 16, 0, 0); } while (0)
#define PG8_LDA(dst, b, h) do { _Pragma("unroll") for (int m = 0; m < 4; ++m) _Pragma("unroll") for (int k = 0; k < 2; ++k) dst[m][k] = *(const PG8_LAS bf16x8*)(lds + PG8_SA(b, h) + aoff + m * 2048 + k * 1024); } while (0)
#define PG8_LDB(dst, b, h) do { _Pragma("unroll") for (int n = 0; n < 2; ++n) _Pragma("unroll") for (int k = 0; k < 2; ++k) dst[n][k] = *(const PG8_LAS bf16x8*)(lds + PG8_SB(b, h) + boff + n * 2048 + k * 1024); } while (0)
#define PG8_MMA(ai, bj, At, Bt) do { __builtin_amdgcn_s_setprio(1); _Pragma("unroll") for (int m = 0; m < 4; ++m) _Pragma("unroll") for (int n = 0; n < 2; ++n) _Pragma("unroll") for (int k = 0; k < 2; ++k) \
        acc[ai][bj][m][n] = __builtin_amdgcn_mfma_f32_16x16x32_bf16(Bt[n][k], At[m][k], acc[ai][bj][m][n], 0, 0, 0); __builtin_amdgcn_s_setprio(0); } while (0)
#define PG8_WAIT_V(n) asm volatile("s_waitcnt vmcnt(" #n ")" ::: "memory")
#define PG8_WAIT_L(n) asm volatile("s_waitcnt lgkmcnt(" #n ")" ::: "memory")
#define PG8_BAR __builtin_amdgcn_s_barrier()
#define PG8_SCHED __builtin_amdgcn_sched_barrier(0)
    Unit cur, nxt; int ui = 0;
    if (!S.next(0, cur)) return;
    f32x4 acc[2][2][4][2];
#pragma unroll
    for (int a = 0; a < 2; ++a)
#pragma unroll
        for (int b = 0; b < 2; ++b)
#pragma unroll
            for (int m = 0; m < 4; ++m)
#pragma unroll
                for (int n = 0; n < 2; ++n) acc[a][b][m][n] = (f32x4){0.f, 0.f, 0.f, 0.f};
    bf16x8 At[4][2], B0[2][2], B1[2][2];
    const char* cA = (const char*)g.A + (size_t)cur.pm * tstep; const char* cB = (const char*)g.Bt + (size_t)cur.pn * tstep;
    S.a_ready(cur);
    if constexpr (SP2) {
        PG8_STAGE(PG8_SB(0, 0), cB, voffB); PG8_STAGE(PG8_SB(0, 1), cB + hstep, voffB); PG8_STAGE(PG8_SA(0, 0), cA, voffA); PG8_STAGE(PG8_SA(0, 1), cA + hstep, voffA);
        if (wr == 1) PG8_BAR;
        PG8_WAIT_V(2); PG8_BAR;
        PG8_STAGE(PG8_SB(1, 0), cB + kstep, voffB); PG8_STAGE(PG8_SA(1, 0), cA + kstep, voffA); PG8_STAGE(PG8_SB(1, 1), cB + hstep + kstep, voffB);
        PG8_WAIT_V(6); PG8_BAR;
    } else {
        PG8_STAGE(PG8_SB(0, 0), cB, voffB); PG8_STAGE(PG8_SA(0, 0), cA, voffA); PG8_STAGE(PG8_SB(0, 1), cB + hstep, voffB); PG8_STAGE(PG8_SA(0, 1), cA + hstep, voffA);
        if (wr == 1) PG8_BAR;
        PG8_WAIT_V(4); PG8_BAR;
        PG8_STAGE(PG8_SB(1, 0), cB + kstep, voffB); PG8_STAGE(PG8_SA(1, 0), cA + kstep, voffA); PG8_STAGE(PG8_SB(1, 1), cB + hstep + kstep, voffB);
        PG8_WAIT_V(6); PG8_BAR;
    }
    for (;;) {
        const bool has_next = S.next(ui + 1, nxt);
        const char* nA = has_next ? (const char*)g.A + (size_t)nxt.pm * tstep : cA; const char* nB = has_next ? (const char*)g.Bt + (size_t)nxt.pn * tstep : cB;
        for (int t = 0; t < nt; t += 2) {
            const bool last = (t == nt - 2);
            const char* a1 = cA + (size_t)(t + 1) * kstep;
            const char* a2 = last ? nA : cA + (size_t)(t + 2) * kstep; const char* b2 = last ? nB : cB + (size_t)(t + 2) * kstep;
            const char* a3 = a2 + kstep; const char* b3 = b2 + kstep;
            if (last && has_next) S.a_ready(nxt);
            if constexpr (SP2) {
            PG8_LDB(B0, 0, 0); PG8_LDB(B1, 0, 1); PG8_SCHED; PG8_LDA(At, 0, 0); PG8_STAGE(PG8_SA(1, 1), a1 + hstep, voffA);
            PG8_WAIT_V(8); PG8_WAIT_L(0); PG8_BAR; PG8_MMA(0, 0, At, B0); PG8_MMA(0, 1, At, B1); PG8_BAR; PG8_SCHED;
            PG8_LDA(At, 0, 1); PG8_STAGE(PG8_SB(0, 0), b2, voffB); PG8_STAGE(PG8_SB(0, 1), b2 + hstep, voffB); PG8_STAGE(PG8_SA(0, 0), a2, voffA);
            PG8_WAIT_V(8); PG8_WAIT_L(0); PG8_BAR; PG8_MMA(1, 0, At, B0); PG8_MMA(1, 1, At, B1); PG8_BAR; PG8_SCHED;
            PG8_LDB(B0, 1, 0); PG8_LDB(B1, 1, 1); PG8_SCHED; PG8_LDA(At, 1, 0); PG8_STAGE(PG8_SA(0, 1), a2 + hstep, voffA);
            PG8_WAIT_V(8); PG8_WAIT_L(0); PG8_BAR; PG8_MMA(0, 0, At, B0); PG8_MMA(0, 1, At, B1); PG8_BAR; PG8_SCHED;
            PG8_LDA(At, 1, 1); PG8_STAGE(PG8_SB(1, 0), b3, voffB); PG8_STAGE(PG8_SB(1, 1), b3 + hstep, voffB); PG8_STAGE(PG8_SA(1, 0), a3, voffA);
            PG8_WAIT_V(8); PG8_WAIT_L(0); PG8_BAR; PG8_MMA(1, 0, At, B0); PG8_MMA(1, 1, At, B1); PG8_BAR; PG8_SCHED;
            } else {
            PG8_LDB(B0, 0, 0); PG8_SCHED; PG8_LDA(At, 0, 0); PG8_STAGE(PG8_SA(1, 1), a1 + hstep, voffA);
            PG8_WAIT_L(8); PG8_BAR; PG8_WAIT_L(0); PG8_MMA(0, 0, At, B0); PG8_BAR; PG8_SCHED;
            PG8_LDB(B1, 0, 1); PG8_STAGE(PG8_SB(0, 0), b2, voffB);
            PG8_BAR; PG8_WAIT_L(0); PG8_MMA(0, 1, At, B1); PG8_BAR;
            PG8_LDA(At, 0, 1); PG8_STAGE(PG8_SA(0, 0), a2, voffA);
            PG8_BAR; PG8_WAIT_L(0); PG8_MMA(1, 0, At, B0); PG8_BAR; PG8_SCHED;
            PG8_STAGE(PG8_SB(0, 1), b2 + hstep, voffB);
            PG8_WAIT_V(6); PG8_BAR; PG8_MMA(1, 1, At, B1); PG8_BAR;
            PG8_LDB(B0, 1, 0); PG8_SCHED; PG8_LDA(At, 1, 0); PG8_STAGE(PG8_SA(0, 1), a2 + hstep, voffA);
            PG8_WAIT_L(8); PG8_BAR; PG8_WAIT_L(0); PG8_MMA(0, 0, At, B0); PG8_BAR; PG8_SCHED;
            PG8_LDB(B1, 1, 1); PG8_STAGE(PG8_SB(1, 0), b3, voffB);
            PG8_BAR; PG8_WAIT_L(0); PG8_MMA(0, 1, At, B1); PG8_BAR;
            PG8_LDA(At, 1, 1); PG8_STAGE(PG8_SA(1, 0), a3, voffA);
            PG8_BAR; PG8_WAIT_L(0); PG8_MMA(1, 0, At, B0); PG8_BAR; PG8_SCHED;
            PG8_STAGE(PG8_SB(1, 1), b3 + hstep, voffB);
            PG8_WAIT_V(6); PG8_BAR; PG8_MMA(1, 1, At, B1); PG8_BAR;
            }
        }
        if constexpr (ALIGN_EPI) { if (wr == 0) PG8_BAR; }
        if constexpr (!Epi::AFTER_DRAIN) { E(acc, cur, wr, wc, fr, fq); S.done(cur); }
        if (!has_next) break;
#pragma unroll
        for (int a = 0; a < 2; ++a)
#pragma unroll
            for (int b = 0; b < 2; ++b)
#pragma unroll
                for (int m = 0; m < 4; ++m)
#pragma unroll
                    for (int n = 0; n < 2; ++n) acc[a][b][m][n] = (f32x4){0.f, 0.f, 0.f, 0.f};
        cur = nxt; cA = nA; cB = nB; ++ui;
        if constexpr (ALIGN_EPI) { if (wr == 1) PG8_BAR; }
    }
    PG8_WAIT_V(0);
    if constexpr (!ALIGN_EPI) { if (wr == 0) PG8_BAR; }
    PG8_BAR;
    if constexpr (Epi::AFTER_DRAIN) { E.fused(acc, cur, wr, wc, fr, fq, lds, wid, lane); S.done(cur); }
#undef PG8_SA
#undef PG8_SB
#undef PG8_STAGE
#undef PG8_LDA
#undef PG8_LDB
#undef PG8_MMA
#undef PG8_WAIT_V
#undef PG8_WAIT_L
#undef PG8_BAR
#undef PG8_SCHED
}
}
#define XB_TMO      128
#define XB_XCNT(j)  (256  + 64 * (j))
#define XB_XSUB(j)  (1280 + 64 * (j))
#define XB_XGEN(j)  (2304 + 64 * (j))
#define XB_TOP      3328
#define XB_TOPGEN   3392
#define XCD_BAR_WORDS 3456
#define XB_SPIN_CAP (1u << 18)
#define LAS __attribute__((address_space(3)))

__device__ __forceinline__ unsigned xb_ld(unsigned* p)              { return __hip_atomic_load(p, __ATOMIC_RELAXED, __HIP_MEMORY_SCOPE_AGENT); }
__device__ __forceinline__ unsigned xb_add(unsigned* p, unsigned v) { return __hip_atomic_fetch_add(p, v, __ATOMIC_RELAXED, __HIP_MEMORY_SCOPE_AGENT); }
__device__ __forceinline__ unsigned xb_xcc_id() { return (unsigned)__builtin_amdgcn_s_getreg((3 << 11) | 20) & 0xFu; }
#define XB_SPIN(cond, bar) do { unsigned _sp = 0; while (cond) { __builtin_amdgcn_s_sleep(1); \
    if ((++_sp & 255u) == 0u) { if (xb_ld(&(bar)[XB_TMO])) break; if (_sp > XB_SPIN_CAP) { atomicAdd(&(bar)[XB_TMO], 1u); break; } } } } while (0)

struct XcdBarrier {
    unsigned* bar; unsigned x;
    volatile LAS unsigned* st;
};

__device__ __forceinline__ XcdBarrier xcd_barrier_post(unsigned* bar, volatile LAS unsigned* st) {
    XcdBarrier b; b.bar = bar; b.x = xb_xcc_id(); b.st = st;
    if (threadIdx.x == 0) (void)xb_add(&bar[XB_XCNT(b.x)], 1u);
    return b;
}
__device__ __forceinline__ void xcd_barrier_complete(unsigned* bar, unsigned x, unsigned& nloc, unsigned& nx) {
    const unsigned G = gridDim.x * gridDim.y * gridDim.z;
    unsigned sum, cnt, mine, sp = 0u;
    for (;;) {
        sum = 0u; cnt = 0u; mine = 0u;
#pragma unroll
        for (unsigned j = 0; j < 16; ++j) { const unsigned c = xb_ld(&bar[XB_XCNT(j)]); sum += c; cnt += (c > 0u) ? 1u : 0u; mine = (j == x) ? c : mine; }
        if (sum == G) break;
        __builtin_amdgcn_s_sleep(1);
        if ((++sp & 255u) == 0u) { if (xb_ld(&bar[XB_TMO])) break; if (sp > XB_SPIN_CAP) { atomicAdd(&bar[XB_TMO], 1u); break; } }
    }
    nloc = mine > 0u ? mine : 1u; nx = cnt > 0u ? cnt : 1u;
}

__device__ __forceinline__ void xcd_barrier(const XcdBarrier& b) {
    asm volatile("s_waitcnt vmcnt(0)" ::: "memory");
    __syncthreads();
    if (threadIdx.x == 0) {
        unsigned* bar = b.bar;
        __builtin_amdgcn_s_waitcnt(0);
        unsigned nloc = b.st[0], nx = b.st[1];
        if (nloc == 0u) { xcd_barrier_complete(bar, b.x, nloc, nx); b.st[0] = nloc; b.st[1] = nx; }
        const unsigned old = xb_add(&bar[XB_XSUB(b.x)], 1u);
        const unsigned gen = old / nloc;
        if (old + 1u == (gen + 1u) * nloc) {
            __builtin_amdgcn_fence(__ATOMIC_RELEASE, "agent");
            asm volatile("s_waitcnt vmcnt(0)" ::: "memory");
            const unsigned og = xb_add(&bar[XB_TOP], 1u);
            const unsigned tg = og / nx;
            if (og + 1u == (tg + 1u) * nx) xb_add(&bar[XB_TOPGEN], 1u);
            else XB_SPIN(xb_ld(&bar[XB_TOPGEN]) == tg, bar);
            __builtin_amdgcn_fence(__ATOMIC_ACQUIRE, "agent");
            xb_add(&bar[XB_XGEN(b.x)], 1u);
            asm volatile("s_waitcnt vmcnt(0)" ::: "memory");
        } else {
            XB_SPIN(xb_ld(&bar[XB_XGEN(b.x)]) == gen, bar);
            __builtin_amdgcn_fence(__ATOMIC_ACQUIRE, "agent");
            asm volatile("s_waitcnt vmcnt(0)" ::: "memory");
        }
    }
    __syncthreads();
}
constexpr int MP = 16384, MS = 32, MR = MP + MS, MPAD = 16640;
constexpr int SEQ = 2048, NB = 8, NH = 8, DM = 1024;
constexpr int QKVW = 3072, NIN = 7424;
constexpr int PAST = 16384, NPAGE = 128, PAGE = 128, LATW = 576;
constexpr float EPS = 1e-6f;
constexpr float MLA_SCALE = 0.07216878364870322f;

constexpr size_t O_YP = 0, O_YS = O_YP + (size_t)MP * 1024, O_ROWSP = O_YS + 32 * 1024, O_GSP = O_ROWSP + (size_t)MP * 576,
                 O_CSP = O_GSP + 8 * 8 * 128 * 128, O_ROWSS = O_CSP + 8 * 3 * 3072, O_GSS = O_ROWSS + 32 * 576, O_CSS = O_GSS + (size_t)32 * 8 * 128 * 128;

constexpr size_t WS_CTL = 0, CTL_BYTES = 1u << 20;
constexpr size_t WS_WIN = CTL_BYTES;
constexpr size_t WS_WQ  = WS_WIN + (size_t)NIN * 1024 * 2;
constexpr size_t WS_WKV = WS_WQ + (size_t)1536 * 512 * 2;
constexpr size_t WS_WYA = WS_WKV + (size_t)2048 * 512 * 2;
constexpr size_t WS_WYB = WS_WYA + (size_t)1024 * 1024 * 2;
constexpr size_t WS_WO  = WS_WYB + (size_t)1024 * 1024 * 2;
constexpr size_t WS_WUP = WS_WO + (size_t)1024 * 1024 * 2;
constexpr size_t WS_WDN = WS_WUP + (size_t)4096 * 1024 * 2;
constexpr size_t WS_XN  = WS_WDN + (size_t)4096 * 1024 * 2;
constexpr size_t WS_QKV = WS_XN + (size_t)MPAD * 1024 * 2;
constexpr size_t WS_Z   = WS_QKV + (size_t)MPAD * 3072 * 2;
constexpr size_t WS_QD  = WS_Z + (size_t)MPAD * 1024 * 2;
constexpr size_t WS_KVD = WS_QD + (size_t)MPAD * 512 * 2;
constexpr size_t WS_SM  = WS_KVD + (size_t)MPAD * 512 * 2;
constexpr size_t WS_GATES = WS_SM + (size_t)MPAD * 128 * 4;
constexpr size_t WS_C   = WS_GATES + (size_t)MPAD * 2048 * 2;
constexpr size_t WS_KR  = WS_C + (size_t)MPAD * 512 * 2;
constexpr size_t WS_BETA = WS_KR + (size_t)MPAD * 64 * 2;
constexpr size_t WS_GLOG = WS_BETA + (size_t)MPAD * 8 * 4;
constexpr size_t WS_QP  = WS_GLOG + (size_t)MPAD * 8 * 4;
constexpr size_t WS_QP2 = WS_QP + (size_t)MPAD * 1536 * 2;
constexpr size_t WS_KN  = WS_QP2 + (size_t)MPAD * 1536 * 2;
constexpr size_t WS_V   = WS_KN + (size_t)MPAD * 1024 * 2;
constexpr size_t WS_YA  = WS_V + (size_t)MPAD * 1024 * 2;
constexpr size_t WS_YB  = WS_YA + (size_t)MPAD * 1024 * 2;
constexpr size_t WS_TF  = WS_YB + (size_t)MPAD * 1024 * 2;
constexpr size_t WS_T   = WS_TF + (size_t)MPAD * 1024 * 4;
constexpr size_t WS_X1  = WS_T + (size_t)MPAD * 1024 * 2;
constexpr size_t WS_XN2 = WS_X1 + (size_t)MPAD * 1024 * 4;
constexpr size_t WS_RX = WS_CTL + (256u << 10);
constexpr size_t WS_H   = WS_XN2 + (size_t)MPAD * 1024 * 2;
constexpr size_t WS_GU0 = WS_H + (size_t)MPAD * 4096 * 2;
constexpr size_t WS_GW  = WS_GU0 + (size_t)2048 * 64 * 128 * 4;
constexpr size_t WS_GQG = WS_GW + (size_t)2048 * 64 * 128 * 2;
constexpr size_t WS_GKD = WS_GQG + (size_t)2048 * 64 * 128 * 2;
constexpr size_t WS_GAQK = WS_GKD + (size_t)2048 * 64 * 128 * 2;
constexpr size_t WS_GEND = WS_GAQK + (size_t)2048 * 64 * 64 * 2;
constexpr size_t WS_DML = WS_GEND + (size_t)2048 * 4 * 64;
constexpr size_t WS_DACC = WS_DML + (size_t)4096 * 8 * 2 * 4;
constexpr size_t WS_WKT = WS_DACC + (size_t)4096 * 8 * 512 * 4;
constexpr size_t WS_END = WS_WKT + (size_t)1024 * 512 * 2;

constexpr int LDS_BYTES = 163840;
constexpr int MISC_OFF = LDS_BYTES - 128;

#define GAS __attribute__((address_space(1)))
typedef unsigned short bf16;
typedef unsigned v4u __attribute__((ext_vector_type(4)));
typedef unsigned v2u __attribute__((ext_vector_type(2)));
typedef float f32x4 __attribute__((ext_vector_type(4)));
typedef float f32x16 __attribute__((ext_vector_type(16)));
typedef short bf16x8 __attribute__((ext_vector_type(8)));
#define LDS_WAIT() asm volatile("s_waitcnt lgkmcnt(0)" ::: "memory")
#define VM_WAIT() asm volatile("s_waitcnt vmcnt(0)" ::: "memory")
#define LBAR() asm volatile("s_waitcnt lgkmcnt(0)\n\ts_barrier" ::: "memory")
__device__ __forceinline__ float bf2f(unsigned b) { return __builtin_bit_cast(float, b << 16); }
__device__ __forceinline__ unsigned f2bf(float f) { unsigned u = __builtin_bit_cast(unsigned, f); return (u + 0x7fffu + ((u >> 16) & 1u)) >> 16; }
__device__ __forceinline__ unsigned pk2(float lo, float hi) { return f2bf(lo) | (f2bf(hi) << 16); }
__device__ __forceinline__ float lo16(unsigned w) { return __builtin_bit_cast(float, w << 16); }
__device__ __forceinline__ float hi16(unsigned w) { return __builtin_bit_cast(float, w & 0xffff0000u); }
__device__ __forceinline__ float wave_sum(float v) {
#pragma unroll
    for (int o = 1; o < 64; o <<= 1) v += __shfl_xor(v, o);
    return v;
}
__device__ __forceinline__ float wave_max(float v) {
#pragma unroll
    for (int o = 1; o < 64; o <<= 1) v = fmaxf(v, __shfl_xor(v, o));
    return v;
}
__device__ __forceinline__ float sigmoidf_(float x) { return __builtin_amdgcn_rcpf(1.f + __expf(-x)); }
__device__ __forceinline__ float siluf_(float x) { return x * __builtin_amdgcn_rcpf(1.f + __expf(-x)); }

__constant__ float ROPE_INV[32] = {1.000000000e+00f,7.498942614e-01f,5.623413324e-01f,4.216965139e-01f,3.162277639e-01f,2.371373773e-01f,1.778279394e-01f,1.333521307e-01f,
    1.000000015e-01f,7.498941571e-02f,5.623413250e-02f,4.216965288e-02f,3.162277490e-02f,2.371373773e-02f,1.778279431e-02f,1.333521493e-02f,
    9.999999776e-03f,7.498941850e-03f,5.623413250e-03f,4.216964822e-03f,3.162277630e-03f,2.371373586e-03f,1.778279431e-03f,1.333521446e-03f,
    1.000000047e-03f,7.498942432e-04f,5.623413017e-04f,4.216965172e-04f,3.162277571e-04f,2.371373703e-04f,1.778279402e-04f,1.333521504e-04f};

struct Args { const float* in[27]; float* out; unsigned char* ws; int ph_lo, ph_hi; };
enum { I_XP = 0, I_XS, I_CACHE, I_SGDN, I_SCONV, I_PT, I_NMIX, I_WIN, I_CONVW, I_ALOG, I_DTB, I_GDNN, I_QAN, I_WUQ, I_KVAN, I_WUK, I_WUV,
       I_QNN, I_QNR, I_KNN, I_KNR, I_WYA, I_WYB, I_WO, I_NMLP, I_WUP, I_WDN };

__device__ __forceinline__ int src_col(int mode, int n) {
    if (mode == 0) {
        if (n < 4096) return n;
        if (n < 5184) return n + 16;
        if (n < 5200) return n - 5184 + 4096;
        if (n < 5376) return -1;
        return n - 5376 + 5200;
    }
    if (mode == 1) {
        if (n < 1024) return (n >> 7) * 192 + (n & 127);
        const int m = n - 1024; return (m >> 6) * 192 + 128 + (m & 63);
    }
    return n;
}
__device__ __forceinline__ void cvt_item(const float* W, int N, int K, bf16* WT, int row_off, int mode, LAS float* scr, int item, int nblk, int lane, const float* kscale = nullptr) {
    const int kb = item / nblk, nb = item % nblk, k0 = 64 * kb, n0 = 32 * nb;
    const int sc = src_col(mode, n0 + (lane & 31));
#pragma unroll
    for (int i = 0; i < 32; ++i) { const int kk = 2 * i + (lane >> 5); scr[kk * 33 + (lane & 31)] = sc >= 0 ? W[(size_t)(k0 + kk) * N + sc] * (kscale ? kscale[k0 + kk] : 1.f) : 0.f; }
    LDS_WAIT(); asm volatile("" ::: "memory");
    const int c = lane & 7;
#pragma unroll
    for (int j = 0; j < 4; ++j) { const int n = (lane >> 3) + 8 * j; const LAS float* s = scr + (8 * c) * 33 + n;
        v4u o; o.x = pk2(s[0 * 33], s[1 * 33]); o.y = pk2(s[2 * 33], s[3 * 33]); o.z = pk2(s[4 * 33], s[5 * 33]); o.w = pk2(s[6 * 33], s[7 * 33]);
        *(v4u*)(WT + (size_t)(row_off + n0 + n) * K + k0 + 8 * c) = o; }
    LDS_WAIT(); asm volatile("" ::: "memory");
}
__device__ __forceinline__ void rms_row_finish(const f32x4 (&v)[4], const float* gain, bf16* orow, int lane) {
    const f32x4* gr = (const f32x4*)gain + lane; float s = 0.f;
#pragma unroll
    for (int j = 0; j < 4; ++j) s += (v[j].x * v[j].x + v[j].y * v[j].y) + (v[j].z * v[j].z + v[j].w * v[j].w);
    const float r = 1.f / sqrtf(wave_sum(s) * (1.f / 1024.f) + EPS);
    unsigned long long* o8 = (unsigned long long*)orow + lane;
#pragma unroll
    for (int j = 0; j < 4; ++j) { const f32x4 g = gr[64 * j];
        o8[64 * j] = (unsigned long long)pk2(v[j].x * r * g.x, v[j].y * r * g.y) | ((unsigned long long)pk2(v[j].z * r * g.z, v[j].w * r * g.w) << 32); }
}
template <bool LATE> __device__ __forceinline__ void cvt_weights(const Args& A, LAS unsigned char* lds, int gw, int NGW, int wave, int lane) {
    LAS float* scr = (LAS float*)(lds + wave * 16384);
    unsigned char* ws = A.ws;
    constexpr int I0 = 16 * (NIN / 32), I1 = 8 * (1536 / 32), I2 = 8 * 32, I3 = 8 * 32, I4 = 16 * 32, I5 = I4, I6 = I4, I7 = 16 * 128, I8 = 64 * 32;
    if (!LATE) {
        for (int it = gw; it < I0 + I1 + I2 + I3; it += NGW) {
            int r = it;
            if (r < I0) { cvt_item(A.in[I_WIN], 7248, 1024, (bf16*)(ws + WS_WIN), 0, 0, scr, r, NIN / 32, lane); continue; } r -= I0;
            if (r < I1) { cvt_item(A.in[I_WUQ], 1536, 512, (bf16*)(ws + WS_WQ), 0, 1, scr, r, 1536 / 32, lane); continue; } r -= I1;
            if (r < I2) { cvt_item(A.in[I_WUK], 1024, 512, (bf16*)(ws + WS_WKV), 0, 2, scr, r, 32, lane); continue; } r -= I2;
            cvt_item(A.in[I_WUV], 1024, 512, (bf16*)(ws + WS_WKV), 1024, 2, scr, r, 32, lane);
        }
    } else {
        for (int it = gw; it < I4 + I5 + I6 + I7 + I8; it += NGW) {
            int r = it;
            if (r < I4) { cvt_item(A.in[I_WYA], 1024, 1024, (bf16*)(ws + WS_WYA), 0, 2, scr, r, 32, lane); continue; } r -= I4;
            if (r < I5) { cvt_item(A.in[I_WYB], 1024, 1024, (bf16*)(ws + WS_WYB), 0, 2, scr, r, 32, lane); continue; } r -= I5;
            if (r < I6) { cvt_item(A.in[I_WO], 1024, 1024, (bf16*)(ws + WS_WO), 0, 2, scr, r, 32, lane); continue; } r -= I6;
            if (r < I7) { cvt_item(A.in[I_WUP], 4096, 1024, (bf16*)(ws + WS_WUP), 0, 2, scr, r, 128, lane, A.in[I_NMLP]); continue; } r -= I7;
            cvt_item(A.in[I_WDN], 1024, 4096, (bf16*)(ws + WS_WDN), 0, 2, scr, r, 32, lane);
        }
    }
}
__device__ __forceinline__ void p0_prologue(const Args& A, LAS unsigned char* lds, int gw, int NGW, int wave, int lane) {
    unsigned char* ws = A.ws;
    cvt_weights<false>(A, lds, gw, NGW, wave, lane);
    bf16* XN = (bf16*)(ws + WS_XN);
#define XROW(m_) ((m_) < MP ? A.in[I_XP] + (size_t)(m_) * 1024 : A.in[I_XS] + (size_t)((m_) - MP) * 1024)
    f32x4 v[4], vn[4];
    if (gw < MR) {
#pragma unroll
        for (int j = 0; j < 4; ++j) v[j] = ((const f32x4*)XROW(gw) + lane)[64 * j]; }
    for (int m = gw; m < MPAD; m += NGW) {
        const int mn = m + NGW;
        if (mn < MR) {
#pragma unroll
            for (int j = 0; j < 4; ++j) vn[j] = ((const f32x4*)XROW(mn) + lane)[64 * j]; }
        if (m < MR) rms_row_finish(v, A.in[I_NMIX], XN + (size_t)m * 1024, lane);
        else { v4u z = {0u, 0u, 0u, 0u}; *((v4u*)(XN + (size_t)m * 1024) + lane) = z; *((v4u*)(XN + (size_t)m * 1024) + 64 + lane) = z; }
#pragma unroll
        for (int j = 0; j < 4; ++j) v[j] = vn[j];
    }
#undef XROW
}

struct EpiG1 {
    static constexpr bool PERM = true, AFTER_DRAIN = false;
    bf16 *QKV, *Z, *QD, *KVD, *GATES; float* SM;
    __device__ __forceinline__ void operator()(const pg8::f32x4 (&acc)[2][2][4][2], const pg8::Unit& u, int wr, int wc, int fr, int fq) const {
        const int row0 = u.pm * 256 + wr * 64 + fr, pn = u.pn, cl = wc * 32 + 8 * fq;
        if (pn == 20) {
#pragma unroll
            for (int ai = 0; ai < 2; ++ai)
#pragma unroll
                for (int m = 0; m < 4; ++m) { float* rowp = SM + (size_t)(row0 + ai * 128 + m * 16) * 128 + cl;
                    *(pg8::f32x4*)rowp = acc[ai][0][m][0]; *(pg8::f32x4*)(rowp + 4) = acc[ai][0][m][1]; }
            return;
        }
        bf16* base; int ld; bool sg = false;
        if (pn < 12) { base = QKV + pn * 256; ld = 3072; }
        else if (pn < 16) { base = Z + (pn - 12) * 256; ld = 1024; }
        else if (pn < 18) { base = QD + (pn - 16) * 256; ld = 512; }
        else if (pn < 20) { base = KVD + (pn - 18) * 256; ld = 512; }
        else { base = GATES + (pn - 21) * 256; ld = 2048; sg = true; }
#pragma unroll
        for (int ai = 0; ai < 2; ++ai)
#pragma unroll
            for (int m = 0; m < 4; ++m) { bf16* rowp = base + (size_t)(row0 + ai * 128 + m * 16) * ld + cl;
#pragma unroll
                for (int bj = 0; bj < 2; ++bj) { pg8::f32x4 v0 = acc[ai][bj][m][0], v1 = acc[ai][bj][m][1];
                    if (sg) { v0 = (pg8::f32x4){sigmoidf_(v0[0]), sigmoidf_(v0[1]), sigmoidf_(v0[2]), sigmoidf_(v0[3])}; v1 = (pg8::f32x4){sigmoidf_(v1[0]), sigmoidf_(v1[1]), sigmoidf_(v1[2]), sigmoidf_(v1[3])}; }
                    pg8::u32x4 w; w.x = pg8::cvt_pk_bf16(v0[0], v0[1]); w.y = pg8::cvt_pk_bf16(v0[2], v0[3]); w.z = pg8::cvt_pk_bf16(v1[0], v1[1]); w.w = pg8::cvt_pk_bf16(v1[2], v1[3]);
                    *(pg8::u32x4*)(rowp + bj * 128) = w; } }
    }
};

__device__ __forceinline__ void p2_rows(const Args& A, int gw, int NGW, int lane) {
    unsigned char* ws = A.ws;
    bf16* QD = (bf16*)(ws + WS_QD); const bf16* KVD = (const bf16*)(ws + WS_KVD); const float* SM = (const float*)(ws + WS_SM);
    bf16* C = (bf16*)(ws + WS_C); bf16* KR = (bf16*)(ws + WS_KR); float* BETA = (float*)(ws + WS_BETA); float* GLOG = (float*)(ws + WS_GLOG);
    v4u wq = {0u, 0u, 0u, 0u}, wk = wq, wqn = wq, wkn = wq; float xs = 0.f, xb = 0.f, xa = 0.f, xsn = 0.f, xbn = 0.f, xan = 0.f;
    if (gw < MR) { wq = *((const v4u*)(QD + (size_t)gw * 512) + lane); wk = *((const v4u*)(KVD + (size_t)gw * 512) + lane); xs = SM[(size_t)gw * 128 + lane];
        if (lane < 8) { xb = SM[(size_t)gw * 128 + 64 + lane]; xa = SM[(size_t)gw * 128 + 72 + lane]; } }
    for (int m = gw; m < MR; m += NGW) {
        const int mn = m + NGW;
        if (mn < MR) { wqn = *((const v4u*)(QD + (size_t)mn * 512) + lane); wkn = *((const v4u*)(KVD + (size_t)mn * 512) + lane); xsn = SM[(size_t)mn * 128 + lane];
            if (lane < 8) { xbn = SM[(size_t)mn * 128 + 64 + lane]; xan = SM[(size_t)mn * 128 + 72 + lane]; } }
        const int pos = m < MP ? (m & (SEQ - 1)) : PAST;
        float* lat = m < MP ? A.out + O_ROWSP + (size_t)m * LATW : A.out + O_ROWSS + (size_t)(m - MP) * LATW;
        {
            v4u w = wq;
            float v[8] = {lo16(w.x), hi16(w.x), lo16(w.y), hi16(w.y), lo16(w.z), hi16(w.z), lo16(w.w), hi16(w.w)};
            float s = 0.f;
#pragma unroll
            for (int i = 0; i < 8; ++i) s += v[i] * v[i];
            const float r = 1.f / sqrtf(wave_sum(s) * (1.f / 512.f) + EPS);
            const f32x4 g0 = *((const f32x4*)A.in[I_QAN] + 2 * lane), g1 = *((const f32x4*)A.in[I_QAN] + 2 * lane + 1);
            v4u o; o.x = pk2(v[0] * r * g0.x, v[1] * r * g0.y); o.y = pk2(v[2] * r * g0.z, v[3] * r * g0.w); o.z = pk2(v[4] * r * g1.x, v[5] * r * g1.y); o.w = pk2(v[6] * r * g1.z, v[7] * r * g1.w);
            *((v4u*)(QD + (size_t)m * 512) + lane) = o;
        }
        {
            v4u w = wk;
            float v[8] = {lo16(w.x), hi16(w.x), lo16(w.y), hi16(w.y), lo16(w.z), hi16(w.z), lo16(w.w), hi16(w.w)};
            float s = 0.f;
#pragma unroll
            for (int i = 0; i < 8; ++i) s += v[i] * v[i];
            const float r = 1.f / sqrtf(wave_sum(s) * (1.f / 512.f) + EPS);
            const f32x4 g0 = *((const f32x4*)A.in[I_KVAN] + 2 * lane), g1 = *((const f32x4*)A.in[I_KVAN] + 2 * lane + 1);
            f32x4 c0 = {v[0] * r * g0.x, v[1] * r * g0.y, v[2] * r * g0.z, v[3] * r * g0.w}, c1 = {v[4] * r * g1.x, v[5] * r * g1.y, v[6] * r * g1.z, v[7] * r * g1.w};
            *((f32x4*)lat + 2 * lane) = c0; *((f32x4*)lat + 2 * lane + 1) = c1;
            v4u o; o.x = pk2(c0.x, c0.y); o.y = pk2(c0.z, c0.w); o.z = pk2(c1.x, c1.y); o.w = pk2(c1.z, c1.w);
            *((v4u*)(C + (size_t)m * 512) + lane) = o;
        }
        {
            const float x = xs;
            const float r = 1.f / sqrtf(wave_sum(x * x) * (1.f / 64.f) + EPS);
            const float xr = x * r * A.in[I_KNR][lane];
            const float other = __shfl_xor(xr, 32);
            const float ang = (float)pos * ROPE_INV[lane & 31];
            const float cs = cosf(ang), sn = sinf(ang);
            const float o = lane < 32 ? xr * cs - other * sn : other * sn + xr * cs;
            lat[512 + lane] = o;
            KR[(size_t)m * 64 + lane] = (bf16)f2bf(o);
        }
        if (lane < 8) {
            const float b = xb, a = xa;
            BETA[(size_t)m * 8 + lane] = 1.f / (1.f + expf(-b));
            const float xx = a + A.in[I_DTB][lane];
            const float sp = fmaxf(xx, 0.f) + log1pf(expf(-fabsf(xx)));
            GLOG[(size_t)m * 8 + lane] = -expf(A.in[I_ALOG][lane]) * sp;
        }
        wq = wqn; wk = wkn; xs = xsn; xb = xbn; xa = xan;
    }
}
__device__ __forceinline__ void p2_conv_state(const Args& A, int gtid, int NGT) {
    const bf16* QKV = (const bf16*)(A.ws + WS_QKV);
    {
        const bf16* WKV = (const bf16*)(A.ws + WS_WKV); bf16* WKT = (bf16*)(A.ws + WS_WKT);
        for (int c = gtid; c < 65536; c += NGT) { const int blk = c >> 6, l = c & 63, rt = blk >> 5, ks = blk & 31;
            *(v4u*)(WKT + (size_t)c * 8) = *(const v4u*)(WKV + (size_t)(rt * 32 + (l & 31)) * 512 + 16 * ks + 8 * (l >> 5)); }
    }
    for (int i = gtid; i < 8 * 3 * 3072; i += NGT) { const int c = i % 3072, r = (i / 3072) % 3, b = i / (3 * 3072);
        A.out[O_CSP + i] = bf2f(QKV[(size_t)(b * SEQ + SEQ - 3 + r) * 3072 + c]); }
    for (int i = gtid; i < 32 * 3 * 3072; i += NGT) { const int c = i % 3072, r = (i / 3072) % 3, j = i / (3 * 3072);
        A.out[O_CSS + i] = r < 2 ? A.in[I_SCONV][(size_t)(j * 3 + r + 1) * 3072 + c] : bf2f(QKV[(size_t)(MP + j) * 3072 + c]); }
}
__device__ __forceinline__ pg8::u32x4 pack8(const pg8::f32x4& v0, const pg8::f32x4& v1) {
    pg8::u32x4 w; w.x = pg8::cvt_pk_bf16(v0[0], v0[1]); w.y = pg8::cvt_pk_bf16(v0[2], v0[3]); w.z = pg8::cvt_pk_bf16(v1[0], v1[1]); w.w = pg8::cvt_pk_bf16(v1[2], v1[3]); return w;
}
template <int ACT> struct EpiStore {
    static constexpr bool PERM = true, AFTER_DRAIN = false;
    bf16* O0; int ld0; int split; bf16* O1; int ld1;
    __device__ __forceinline__ void operator()(const pg8::f32x4 (&acc)[2][2][4][2], const pg8::Unit& u, int wr, int wc, int fr, int fq) const {
        const int row0 = u.pm * 256 + wr * 64 + fr, cl = wc * 32 + 8 * fq;
        bf16* base; int ld;
        if (u.pn < split) { base = O0 + u.pn * 256; ld = ld0; } else { base = O1 + (u.pn - split) * 256; ld = ld1; }
#pragma unroll
        for (int ai = 0; ai < 2; ++ai)
#pragma unroll
            for (int m = 0; m < 4; ++m) { bf16* rowp = base + (size_t)(row0 + ai * 128 + m * 16) * ld + cl;
#pragma unroll
                for (int bj = 0; bj < 2; ++bj) { pg8::f32x4 v0 = acc[ai][bj][m][0], v1 = acc[ai][bj][m][1];
                    if (ACT == 1) {
#pragma unroll
                        for (int e = 0; e < 4; ++e) { const float a = fmaxf(v0[e], 0.f), b = fmaxf(v1[e], 0.f); v0[e] = a * a; v1[e] = b * b; } }
                    *(pg8::u32x4*)(rowp + bj * 128) = pack8(v0, v1); } }
    }
};
struct EpiUp {
    static constexpr bool PERM = true, AFTER_DRAIN = false;
    bf16* H; const float* RX;
    __device__ __forceinline__ void operator()(const pg8::f32x4 (&acc)[2][2][4][2], const pg8::Unit& u, int wr, int wc, int fr, int fq) const {
        const int row0 = u.pm * 256 + wr * 64 + fr, cl = u.pn * 256 + wc * 32 + 8 * fq;
#pragma unroll
        for (int ai = 0; ai < 2; ++ai)
#pragma unroll
            for (int m = 0; m < 4; ++m) { const int row = row0 + ai * 128 + m * 16; const float r = __builtin_amdgcn_rsqf(RX[row] * (1.f / 1024.f) + EPS);
                bf16* rowp = H + (size_t)row * 4096 + cl;
#pragma unroll
                for (int bj = 0; bj < 2; ++bj) { pg8::f32x4 v0 = acc[ai][bj][m][0], v1 = acc[ai][bj][m][1];
#pragma unroll
                    for (int e = 0; e < 4; ++e) { const float a = fmaxf(v0[e] * r, 0.f), b = fmaxf(v1[e] * r, 0.f); v0[e] = a * a; v1[e] = b * b; }
                    *(pg8::u32x4*)(rowp + bj * 128) = pack8(v0, v1); } }
    }
};
template <int STEP> struct EpiMerge {
    static constexpr bool PERM = true, AFTER_DRAIN = false;
    const bf16* GATES; float* TF; bf16* T;
    __device__ __forceinline__ void operator()(const pg8::f32x4 (&acc)[2][2][4][2], const pg8::Unit& u, int wr, int wc, int fr, int fq) const {
        const int row0 = u.pm * 256 + wr * 64 + fr, c0 = u.pn * 256 + wc * 32 + 8 * fq;
#pragma unroll
        for (int ai = 0; ai < 2; ++ai)
#pragma unroll
            for (int m = 0; m < 4; ++m) { const size_t row = (size_t)(row0 + ai * 128 + m * 16);
#pragma unroll
                for (int bj = 0; bj < 2; ++bj) { const int col = c0 + bj * 128;
                    const v4u gw = *(const v4u*)(GATES + row * 2048 + (STEP == 1 ? 0 : 1024) + col);
                    const float g[8] = {lo16(gw.x), hi16(gw.x), lo16(gw.y), hi16(gw.y), lo16(gw.z), hi16(gw.z), lo16(gw.w), hi16(gw.w)};
                    pg8::f32x4 v0 = acc[ai][bj][m][0], v1 = acc[ai][bj][m][1];
#pragma unroll
                    for (int e = 0; e < 4; ++e) { v0[e] *= g[e]; v1[e] *= g[4 + e]; }
                    float* tp = TF + row * 1024 + col;
                    if (STEP == 1) { *(pg8::f32x4*)tp = v0; *(pg8::f32x4*)(tp + 4) = v1; }
                    else { v0 += *(const pg8::f32x4*)tp; v1 += *(const pg8::f32x4*)(tp + 4); *(pg8::u32x4*)(T + row * 1024 + col) = pack8(v0, v1); } } }
    }
};
template <int MODE> struct EpiRes {
    static constexpr bool PERM = true, AFTER_DRAIN = false;
    const float *XPp, *XSp; float* X1; float* out; bf16* XB; float* RX;
    __device__ __forceinline__ void operator()(const pg8::f32x4 (&acc)[2][2][4][2], const pg8::Unit& u, int wr, int wc, int fr, int fq) const {
        const int row0 = u.pm * 256 + wr * 64 + fr, c0 = u.pn * 256 + wc * 32 + 8 * fq;
        float ss[2][4] = {{0.f, 0.f, 0.f, 0.f}, {0.f, 0.f, 0.f, 0.f}};
#pragma unroll
        for (int ai = 0; ai < 2; ++ai)
#pragma unroll
            for (int m = 0; m < 4; ++m) { const int row = row0 + ai * 128 + m * 16;
                if (row >= MR) continue;
#pragma unroll
                for (int bj = 0; bj < 2; ++bj) { const int col = c0 + bj * 128;
                    const float* src; float* dst;
                    if (MODE == 0) { src = row < MP ? XPp + (size_t)row * 1024 + col : XSp + (size_t)(row - MP) * 1024 + col; dst = X1 + (size_t)row * 1024 + col; }
                    else { src = X1 + (size_t)row * 1024 + col; dst = row < MP ? out + O_YP + (size_t)row * 1024 + col : out + O_YS + (size_t)(row - MP) * 1024 + col; }
                    const pg8::f32x4 y0 = acc[ai][bj][m][0] + *(const pg8::f32x4*)src, y1 = acc[ai][bj][m][1] + *(const pg8::f32x4*)(src + 4);
                    *(pg8::f32x4*)dst = y0; *(pg8::f32x4*)(dst + 4) = y1;
                    if (MODE == 0) { *(pg8::u32x4*)(XB + (size_t)row * 1024 + col) = pack8(y0, y1);
                        ss[ai][m] += (y0[0] * y0[0] + y0[1] * y0[1]) + (y0[2] * y0[2] + y0[3] * y0[3]) + (y1[0] * y1[0] + y1[1] * y1[1]) + (y1[2] * y1[2] + y1[3] * y1[3]); } } }
        if (MODE == 0) {
#pragma unroll
            for (int ai = 0; ai < 2; ++ai)
#pragma unroll
                for (int m = 0; m < 4; ++m) { float v = ss[ai][m]; v += __shfl_xor(v, 16); v += __shfl_xor(v, 32);
                    const int row = row0 + ai * 128 + m * 16; if (fq == 0 && row < MR) atomicAdd(RX + row, v); } }
    }
};

#define MFMA32(a, b, c) __builtin_amdgcn_mfma_f32_32x32x16_bf16((a), (b), (c), 0, 0, 0)
__device__ __forceinline__ int crow(int r, int hi) { return (r & 3) + 8 * (r >> 2) + 4 * hi; }
__device__ __forceinline__ bf16x8 lds_ld8(LAS const unsigned char* p) { return *(LAS const bf16x8*)p; }
__device__ __forceinline__ bf16x8 gl_ld8(const bf16* p) { return *(const bf16x8*)p; }

constexpr int GA_QH = 0, GA_KH = 17408, GA_KBH = 34816, GA_VBT = 52224, GA_KBGT = 70656, GA_KDT = 89088, GA_LF = 107520, GA_TB = 123904, GA_GS = 133120, GA_BS = 133376, GA_T32 = 133632, GA_X32 = 141824;
__device__ __forceinline__ void gdn_a_unit(const Args& A, LAS unsigned char* lds, int unit, int tid, int lane, int wave) {
    unsigned char* ws = A.ws;
    const int b = unit >> 8, h = (unit >> 5) & 7, n = unit & 31;
    const int row0 = b * SEQ + n * 64;
#ifdef PROBE_K
    unsigned long long pt0 = 0, pdt = 0;
#define GPS(k) do { if ((k) == PROBE_K) pt0 = __builtin_amdgcn_s_memrealtime(); } while (0)
#define GPE(k) do { if ((k) == PROBE_K) pdt += __builtin_amdgcn_s_memrealtime() - pt0; } while (0)
#else
#define GPS(k) do {} while (0)
#define GPE(k) do {} while (0)
#endif
    GPS(74); GPS(70);
    const bf16* QKV = (const bf16*)(ws + WS_QKV);
    LAS float* Gs = (LAS float*)(lds + GA_GS); LAS float* Bs = (LAS float*)(lds + GA_BS);
    float Gend;
    {
        const int cg = tid & 15, rr = tid >> 4;
        v4u xw[3][2][4];
#pragma unroll
        for (int part = 0; part < 3; ++part)
#pragma unroll
            for (int ri = 0; ri < 2; ++ri)
#pragma unroll
                for (int tap = 0; tap < 4; ++tap) { const int tt = n * 64 + rr + 32 * ri - 3 + tap;
                    xw[part][ri][tap] = tt >= 0 ? *(const v4u*)(QKV + (size_t)(b * SEQ + tt) * 3072 + part * 1024 + h * 128 + 8 * cg) : (v4u){0u, 0u, 0u, 0u}; }
        float gx = ((const float*)(ws + WS_GLOG))[(size_t)(row0 + lane) * 8 + h];
        const float be0 = ((const float*)(ws + WS_BETA))[(size_t)(row0 + rr) * 8 + h], be1 = ((const float*)(ws + WS_BETA))[(size_t)(row0 + rr + 32) * 8 + h];
#pragma unroll
        for (int o = 1; o < 64; o <<= 1) { const float y = __shfl_up(gx, o); if (lane >= o) gx += y; }
        if (wave == 0) { Gs[lane] = gx; Bs[lane] = ((const float*)(ws + WS_BETA))[(size_t)(row0 + lane) * 8 + h]; }
        Gend = __shfl(gx, 63);
        const float Gr0 = __shfl(gx, rr), Gr1 = __shfl(gx, rr + 32);
        bf16* GQG = (bf16*)(ws + WS_GQG) + (size_t)unit * 8192;
#pragma unroll
        for (int part = 0; part < 3; ++part) {
            const int colb = part * 1024 + h * 128 + 8 * cg;
            float wgt[4][8];
#pragma unroll
            for (int tap = 0; tap < 4; ++tap) { const f32x4 w0 = *(const f32x4*)(A.in[I_CONVW] + tap * 3072 + colb), w1 = *(const f32x4*)(A.in[I_CONVW] + tap * 3072 + colb + 4);
                wgt[tap][0] = w0.x; wgt[tap][1] = w0.y; wgt[tap][2] = w0.z; wgt[tap][3] = w0.w; wgt[tap][4] = w1.x; wgt[tap][5] = w1.y; wgt[tap][6] = w1.z; wgt[tap][7] = w1.w; }
#pragma unroll
            for (int ri = 0; ri < 2; ++ri) {
                const int i = rr + 32 * ri;
                float y[8];
#pragma unroll
                for (int e = 0; e < 8; ++e) y[e] = 0.f;
#pragma unroll
                for (int tap = 0; tap < 4; ++tap) { const v4u w = xw[part][ri][tap];
                    const float x[8] = {lo16(w.x), hi16(w.x), lo16(w.y), hi16(w.y), lo16(w.z), hi16(w.z), lo16(w.w), hi16(w.w)};
#pragma unroll
                    for (int e = 0; e < 8; ++e) y[e] += wgt[tap][e] * x[e]; }
                float ss = 0.f;
#pragma unroll
                for (int e = 0; e < 8; ++e) { y[e] = siluf_(y[e]); ss += y[e] * y[e]; }
                ss += __shfl_xor(ss, 1); ss += __shfl_xor(ss, 2); ss += __shfl_xor(ss, 4); ss += __shfl_xor(ss, 8);
                const float Gi = ri ? Gr1 : Gr0;
                const float rs = 1.f / sqrtf(ss + EPS), beta = ri ? be1 : be0, eg = __expf(Gi), ed = __expf(Gend - Gi);
                if (part == 0) {
                    float q[8];
#pragma unroll
                    for (int e = 0; e < 8; ++e) q[e] = y[e] * rs * 0.08838834764831845f;
                    v4u o; o.x = pk2(q[0], q[1]); o.y = pk2(q[2], q[3]); o.z = pk2(q[4], q[5]); o.w = pk2(q[6], q[7]);
                    *(LAS v4u*)(lds + GA_QH + i * 272 + cg * 16) = o;
                    v4u g; g.x = pk2(q[0] * eg, q[1] * eg); g.y = pk2(q[2] * eg, q[3] * eg); g.z = pk2(q[4] * eg, q[5] * eg); g.w = pk2(q[6] * eg, q[7] * eg);
                    *(v4u*)(GQG + i * 128 + 8 * cg) = g;
                } else if (part == 1) {
                    float k[8];
#pragma unroll
                    for (int e = 0; e < 8; ++e) k[e] = y[e] * rs;
                    v4u o; o.x = pk2(k[0], k[1]); o.y = pk2(k[2], k[3]); o.z = pk2(k[4], k[5]); o.w = pk2(k[6], k[7]);
                    *(LAS v4u*)(lds + GA_KH + i * 272 + cg * 16) = o;
                    v4u kb; kb.x = pk2(k[0] * beta, k[1] * beta); kb.y = pk2(k[2] * beta, k[3] * beta); kb.z = pk2(k[4] * beta, k[5] * beta); kb.w = pk2(k[6] * beta, k[7] * beta);
                    *(LAS v4u*)(lds + GA_KBH + i * 272 + cg * 16) = kb;
#pragma unroll
                    for (int e = 0; e < 8; ++e) { *(LAS bf16*)(lds + GA_KBGT + (8 * cg + e) * 144 + i * 2) = (bf16)f2bf(k[e] * beta * eg);
                        *(LAS bf16*)(lds + GA_KDT + (8 * cg + e) * 144 + i * 2) = (bf16)f2bf(k[e] * ed); }
                } else {
#pragma unroll
                    for (int e = 0; e < 8; ++e) *(LAS bf16*)(lds + GA_VBT + (8 * cg + e) * 144 + i * 2) = (bf16)f2bf(y[e] * beta);
                }
            }
            __builtin_amdgcn_sched_barrier(0);
        }
    }
    __syncthreads();
    GPE(70); GPS(71);
    int l31 = lane & 31, hi = lane >> 5; asm volatile("" : "+v"(l31), "+v"(hi));
    {
        const int it = (wave >> 1) & 1, jt = wave & 1; const bool isL = wave < 4;
        f32x16 acc = {};
        if (it >= jt) {
            LAS const unsigned char* Ab = lds + (isL ? GA_KBH : GA_QH) + (32 * it + l31) * 272 + hi * 16;
            LAS const unsigned char* Bb = lds + GA_KH + (32 * jt + l31) * 272 + hi * 16;
#pragma unroll
            for (int ks = 0; ks < 8; ++ks) acc = MFMA32(lds_ld8(Ab + ks * 32), lds_ld8(Bb + ks * 32), acc);
        }
        const int j = 32 * jt + l31; const float Gj = Gs[j];
        bf16* AQ = (bf16*)(ws + WS_GAQK) + (size_t)unit * 4096;
#pragma unroll
        for (int r = 0; r < 16; ++r) { const int i = 32 * it + crow(r, hi);
            const float d = __expf(fminf(Gs[i] - Gj, 0.f));
            if (isL) ((LAS float*)(lds + GA_LF))[i * 64 + j] = (i > j) ? acc[r] * d : 0.f;
            else AQ[i * 64 + j] = (bf16)f2bf((i >= j) ? acc[r] * d : 0.f); }
    }
    __syncthreads();
    GPE(71); GPS(72);
    {
        LAS const float* Lf = (LAS const float*)(lds + GA_LF);
        LAS float* T32 = (LAS float*)(lds + GA_T32); LAS float* X32 = (LAS float*)(lds + GA_X32);
        if (wave == 0) {
            int lx = lane; asm volatile("" : "+v"(lx));
            const int hb = lx >> 5, c = lx & 31;
            LAS const float* Lb = Lf + (32 * hb) * 64 + 32 * hb;
            float T[32];
#pragma unroll
            for (int i = 0; i < 32; ++i) {
                float a0 = (i == c) ? 1.f : 0.f, a1 = 0.f;
#pragma unroll
                for (int j4 = 0; j4 < (i + 3) / 4; ++j4) { const f32x4 l4 = *(LAS const f32x4*)(Lb + i * 64 + 4 * j4);
                    if (4 * j4 + 0 < i) a0 -= l4.x * T[4 * j4 + 0];
                    if (4 * j4 + 1 < i) a1 -= l4.y * T[4 * j4 + 1];
                    if (4 * j4 + 2 < i) a0 -= l4.z * T[4 * j4 + 2];
                    if (4 * j4 + 3 < i) a1 -= l4.w * T[4 * j4 + 3]; }
                T[i] = a0 + a1;
                T32[hb * 1024 + i * 32 + c] = T[i];
                *(LAS bf16*)(lds + GA_TB + (32 * hb + i) * 144 + (32 * hb + c) * 2) = (bf16)f2bf(T[i]);
                if (hb == 0) *(LAS bf16*)(lds + GA_TB + i * 144 + (32 + c) * 2) = (bf16)0;
            }
        } else {
            bf16* GKD = (bf16*)(ws + WS_GKD) + (size_t)unit * 8192;
            int t0 = tid; asm volatile("" : "+v"(t0));
            for (int id = t0 - 64; id < 1024; id += 448) { const int row = id >> 3, ch = id & 7;
                *(v4u*)(GKD + row * 64 + ch * 8) = *(LAS const v4u*)(lds + GA_KDT + row * 144 + ch * 16); }
        }
        __syncthreads();
        int tidx = tid; asm volatile("" : "+v"(tidx));
        const int r = tidx >> 4, c2 = (tidx & 15) * 2;
        {
            float x0 = 0.f, x1 = 0.f;
#pragma unroll 8
            for (int k = 0; k < 32; ++k) { const float l = Lf[(32 + r) * 64 + k]; x0 += l * T32[k * 32 + c2]; x1 += l * T32[k * 32 + c2 + 1]; }
            X32[r * 32 + c2] = x0; X32[r * 32 + c2 + 1] = x1;
        }
        __syncthreads();
        {
            float x0 = 0.f, x1 = 0.f;
#pragma unroll 8
            for (int k = 0; k < 32; ++k) { const float t = T32[1024 + r * 32 + k]; x0 += t * X32[k * 32 + c2]; x1 += t * X32[k * 32 + c2 + 1]; }
            *(LAS unsigned*)(lds + GA_TB + (32 + r) * 144 + c2 * 2) = pk2(-x0, -x1);
        }
    }
    __syncthreads();
    GPE(72); GPS(73);
    {
        const int nt = wave; LAS const unsigned char* Bb = lds + (nt < 4 ? GA_VBT : GA_KBGT) + (32 * (nt & 3) + l31) * 144 + hi * 16;
        float* GU0 = (float*)(ws + WS_GU0) + (size_t)unit * 8192; bf16* GW = (bf16*)(ws + WS_GW) + (size_t)unit * 8192;
#pragma unroll
        for (int it = 0; it < 2; ++it) {
            f32x16 acc = {};
            LAS const unsigned char* Ab = lds + GA_TB + (32 * it + l31) * 144 + hi * 16;
#pragma unroll
            for (int ks = 0; ks < 4; ++ks) if (ks < 2 * (it + 1)) acc = MFMA32(lds_ld8(Ab + ks * 32), lds_ld8(Bb + ks * 32), acc);
            const int col = 32 * (nt & 3) + l31;
#pragma unroll
            for (int r = 0; r < 16; ++r) { const int i = 32 * it + crow(r, hi);
                if (nt < 4) GU0[i * 128 + col] = acc[r]; else GW[i * 128 + col] = (bf16)f2bf(acc[r]); }
        }
        if (tid == 0) ((float*)(ws + WS_GEND))[unit] = __expf(Gend);
    }
    __syncthreads();
    GPE(73); GPE(74);
#ifdef PROBE_K
    if (blockIdx.x == PROBE_B && PROBE_K >= 70 && PROBE_K < 80) { const unsigned long long te = __builtin_amdgcn_s_memrealtime(); while (__builtin_amdgcn_s_memrealtime() - te < (unsigned long long)PROBE_MULT * pdt) __builtin_amdgcn_s_sleep(8); }
#endif
}

constexpr int GB_ST = 0, GB_UT = 34816, GB_OF = 53248;
__device__ __forceinline__ void gdn_b_unit(const Args& A, LAS unsigned char* lds, int bh, int tid, int lane, int wave) {
    unsigned char* ws = A.ws;
    const int b = bh >> 3, h = bh & 7, l31 = lane & 31, hi = lane >> 5;
    const int it = wave >> 2, vt = wave & 3;
    for (int i = tid; i < 34816 / 16; i += 512) *(LAS v4u*)(lds + GB_ST + i * 16) = (v4u){0u, 0u, 0u, 0u};
    f32x16 Sacc[2] = {};
    __syncthreads();
    const bf16* Zb = (const bf16*)(ws + WS_Z); bf16* YA = (bf16*)(ws + WS_YA);
    LAS const unsigned char* Sb = lds + GB_ST + (32 * vt + l31) * 272 + hi * 16;
    LAS const unsigned char* Ub = lds + GB_UT + (32 * vt + l31) * 144 + hi * 16;
    const int di = tid >> 3, dc0 = (tid & 7) * 16;
    bf16x8 wA[8], qA[8], cA[4], kA[2][4]; float u0[16]; v4u zz[2]; float gend;
#define BL8(rs_, vo_, so_) __builtin_bit_cast(bf16x8, __builtin_amdgcn_raw_buffer_load_b128((rs_), (vo_), (so_), 0))
#define MKRS(p_, bytes_) __builtin_amdgcn_make_buffer_rsrc((void*)(p_), 0, (bytes_), 0x00020000)
    const unsigned voW = (unsigned)((32 * it + l31) * 128 + 8 * hi) * 2u, voA = (unsigned)((32 * it + l31) * 64 + 8 * hi) * 2u, voK = (unsigned)((64 * it + l31) * 64 + 8 * hi) * 2u;
    const unsigned voU = (unsigned)((32 * it + 4 * hi) * 128 + 32 * vt + l31) * 4u, voZ = (unsigned)(di * 1024 + h * 128 + dc0) * 2u;
#define GB_LD_W(n_) do { const int cu_ = bh * 32 + (n_); const __amdgpu_buffer_rsrc_t rW_ = MKRS((const bf16*)(ws + WS_GW) + (size_t)cu_ * 8192, 16384), rU_ = MKRS((const float*)(ws + WS_GU0) + (size_t)cu_ * 8192, 32768); \
        _Pragma("unroll") for (int ks = 0; ks < 8; ++ks) wA[ks] = BL8(rW_, voW, ks * 32); \
        _Pragma("unroll") for (int r = 0; r < 16; ++r) u0[r] = __builtin_bit_cast(float, __builtin_amdgcn_raw_buffer_load_b32(rU_, voU, ((r & 3) + 8 * (r >> 2)) * 512, 0)); } while (0)
#define GB_LD_Q(n_) do { const int cu_ = bh * 32 + (n_); const __amdgpu_buffer_rsrc_t rQ_ = MKRS((const bf16*)(ws + WS_GQG) + (size_t)cu_ * 8192, 16384), rA_ = MKRS((const bf16*)(ws + WS_GAQK) + (size_t)cu_ * 4096, 8192); \
        _Pragma("unroll") for (int ks = 0; ks < 8; ++ks) qA[ks] = BL8(rQ_, voW, ks * 32); \
        _Pragma("unroll") for (int ks = 0; ks < 4; ++ks) cA[ks] = BL8(rA_, voA, ks * 32); } while (0)
#define GB_LD_K(n_) do { const int cu_ = bh * 32 + (n_); const __amdgpu_buffer_rsrc_t rK_ = MKRS((const bf16*)(ws + WS_GKD) + (size_t)cu_ * 8192, 16384), rZ_ = MKRS(Zb + (size_t)(b * SEQ + 64 * (n_)) * 1024, 64 * 1024 * 2); \
        _Pragma("unroll") for (int ks = 0; ks < 4; ++ks) { kA[0][ks] = BL8(rK_, voK, ks * 32); kA[1][ks] = BL8(rK_, voK, 32 * 64 * 2 + ks * 32); } \
        zz[0] = __builtin_amdgcn_raw_buffer_load_b128(rZ_, voZ, 0, 0); zz[1] = __builtin_amdgcn_raw_buffer_load_b128(rZ_, voZ, 16, 0); \
        gend = ((const float*)(ws + WS_GEND))[cu_]; } while (0)
#ifdef PROBE_K
    unsigned long long pt0 = 0, pdt = 0;
#endif
    GB_LD_W(0); GB_LD_Q(0);
#pragma unroll 1
    for (int n = 0; n < 32; ++n) {
        const int r0 = b * SEQ + 64 * n;
        GPS(80); GPS(84);
        GB_LD_K(n);
        {
            f32x16 acc = {};
#pragma unroll
            for (int ks = 0; ks < 8; ++ks) acc = MFMA32(wA[ks], lds_ld8(Sb + ks * 32), acc);
            float u[16];
#pragma unroll
            for (int r = 0; r < 16; ++r) u[r] = u0[r] - acc[r];
#pragma unroll
            for (int g = 0; g < 4; ++g) { v2u w; w.x = pk2(u[4 * g], u[4 * g + 1]); w.y = pk2(u[4 * g + 2], u[4 * g + 3]);
                *(LAS v2u*)(lds + GB_UT + (32 * vt + l31) * 144 + (32 * it + 8 * g + 4 * hi) * 2) = w; }
        }
        LBAR();
        GPE(80); GPS(81);
        if (n + 1 < 32) GB_LD_W(n + 1);
        {
            f32x16 acc = {};
#pragma unroll
            for (int ks = 0; ks < 8; ++ks) acc = MFMA32(qA[ks], lds_ld8(Sb + ks * 32), acc);
#pragma unroll
            for (int ks = 0; ks < 4; ++ks) if (ks < 2 * (it + 1)) acc = MFMA32(cA[ks], lds_ld8(Ub + ks * 32), acc);
#pragma unroll
            for (int r = 0; r < 16; ++r) ((LAS float*)(lds + GB_OF))[(32 * it + crow(r, hi)) * 132 + 32 * vt + l31] = acc[r];
        }
        LBAR();
        GPE(81); GPS(82);
        if (n + 1 < 32) GB_LD_Q(n + 1);
        {
#pragma unroll
            for (int t = 0; t < 2; ++t) { const int kt = 2 * (wave >> 2) + t;
                Sacc[t] = Sacc[t] * gend;
#pragma unroll
                for (int ks = 0; ks < 4; ++ks) Sacc[t] = MFMA32(kA[t][ks], lds_ld8(Ub + ks * 32), Sacc[t]);
#pragma unroll
                for (int g = 0; g < 4; ++g) { v2u w; w.x = pk2(Sacc[t][4 * g], Sacc[t][4 * g + 1]); w.y = pk2(Sacc[t][4 * g + 2], Sacc[t][4 * g + 3]);
                    *(LAS v2u*)(lds + GB_ST + (32 * vt + l31) * 272 + (32 * kt + 8 * g + 4 * hi) * 2) = w; }
            }
        }
        {
            LAS const float* orow = (LAS const float*)(lds + GB_OF) + di * 132 + dc0;
            float o[16]; float ss = 0.f;
#pragma unroll
            for (int q = 0; q < 4; ++q) { const f32x4 v = *(LAS const f32x4*)(orow + 4 * q); o[4 * q] = v.x; o[4 * q + 1] = v.y; o[4 * q + 2] = v.z; o[4 * q + 3] = v.w; }
#pragma unroll
            for (int e = 0; e < 16; ++e) ss += o[e] * o[e];
            ss += __shfl_xor(ss, 1); ss += __shfl_xor(ss, 2); ss += __shfl_xor(ss, 4);
            const float r = 1.f / sqrtf(ss * (1.f / 128.f) + EPS);
            const size_t off = (size_t)(r0 + di) * 1024 + h * 128 + dc0;
            const v4u z0 = zz[0], z1 = zz[1];
            const float z[16] = {lo16(z0.x), hi16(z0.x), lo16(z0.y), hi16(z0.y), lo16(z0.z), hi16(z0.z), lo16(z0.w), hi16(z0.w),
                                 lo16(z1.x), hi16(z1.x), lo16(z1.y), hi16(z1.y), lo16(z1.z), hi16(z1.z), lo16(z1.w), hi16(z1.w)};
            float y[16];
#pragma unroll
            for (int e = 0; e < 16; ++e) y[e] = o[e] * r * A.in[I_GDNN][dc0 + e] * siluf_(z[e]);
            v4u o0, o1; o0.x = pk2(y[0], y[1]); o0.y = pk2(y[2], y[3]); o0.z = pk2(y[4], y[5]); o0.w = pk2(y[6], y[7]);
            o1.x = pk2(y[8], y[9]); o1.y = pk2(y[10], y[11]); o1.z = pk2(y[12], y[13]); o1.w = pk2(y[14], y[15]);
            *(v4u*)(YA + off) = o0; *(v4u*)(YA + off + 8) = o1;
        }
        GPE(82); GPS(83);
        LBAR();
        GPE(83); GPE(84);
    }
#undef GB_LD_W
#undef GB_LD_Q
#undef GB_LD_K
#undef BL8
#undef MKRS
#ifdef PROBE_K
    if (bh == 0 && tid == 0 && PROBE_K >= 80 && PROBE_K < 90) ((volatile LAS unsigned*)(lds + MISC_OFF))[16] = (unsigned)pdt;
#endif
    float* So = A.out + O_GSP + (size_t)bh * 16384;
#pragma unroll
    for (int t = 0; t < 2; ++t) { const int kt = 2 * (wave >> 2) + t;
#pragma unroll
        for (int r = 0; r < 16; ++r) So[(32 * kt + crow(r, hi)) * 128 + 32 * vt + l31] = Sacc[t][r]; }
    __syncthreads();
}

__device__ __forceinline__ void gdn_r_unit(const Args& A, LAS unsigned char* lds, int unit, int tid, int lane, int wave) {
    unsigned char* ws = A.ws;
    const int j = unit >> 3, h = unit & 7, row = MP + j;
    LAS float* qs = (LAS float*)lds; LAS float* ks = qs + 128; LAS float* vs = qs + 256; LAS float* red = qs + 384;
    LAS float* os = qs + 896;
    if (tid < 384) {
        const int part = tid >> 7, d = tid & 127, col = part * 1024 + h * 128 + d;
        const float* cw = A.in[I_CONVW]; const float* sc = A.in[I_SCONV] + (size_t)j * 3 * 3072;
        const float xn = bf2f(((const bf16*)(ws + WS_QKV))[(size_t)row * 3072 + col]);
        const float y = cw[col] * sc[col] + cw[3072 + col] * sc[3072 + col] + cw[2 * 3072 + col] * sc[2 * 3072 + col] + cw[3 * 3072 + col] * xn;
        qs[tid] = siluf_(y);
    }
    __syncthreads();
    const float rq = 1.f / sqrtf(wave_sum(qs[lane] * qs[lane] + qs[lane + 64] * qs[lane + 64]) + EPS) * 0.08838834764831845f;
    const float rk = 1.f / sqrtf(wave_sum(ks[lane] * ks[lane] + ks[lane + 64] * ks[lane + 64]) + EPS);
    const float beta = ((const float*)(ws + WS_BETA))[(size_t)row * 8 + h], eg = __expf(((const float*)(ws + WS_GLOG))[(size_t)row * 8 + h]);
    const int v = tid & 127, kq = tid >> 7;
    const float* S0 = A.in[I_SGDN] + (size_t)unit * 16384;
    float s[32]; float kv = 0.f;
#pragma unroll
    for (int i = 0; i < 32; ++i) { const int k = 32 * kq + i; s[i] = eg * S0[k * 128 + v]; kv += ks[k] * rk * s[i]; }
    red[kq * 128 + v] = kv;
    __syncthreads();
    const float u = beta * (vs[v] - (red[v] + red[128 + v] + red[256 + v] + red[384 + v]));
    __syncthreads();
    float* So = A.out + O_GSS + (size_t)unit * 16384; float po = 0.f;
#pragma unroll
    for (int i = 0; i < 32; ++i) { const int k = 32 * kq + i; s[i] += ks[k] * rk * u; So[k * 128 + v] = s[i]; po += qs[k] * rq * s[i]; }
    red[kq * 128 + v] = po;
    __syncthreads();
    if (tid < 128) os[tid] = red[tid] + red[128 + tid] + red[256 + tid] + red[384 + tid];
    __syncthreads();
    const float rn = 1.f / sqrtf(wave_sum(os[lane] * os[lane] + os[lane + 64] * os[lane + 64]) * (1.f / 128.f) + EPS);
    if (tid < 128) { const size_t off = (size_t)row * 1024 + h * 128 + tid;
        ((bf16*)(ws + WS_YA))[off] = (bf16)f2bf(os[tid] * rn * A.in[I_GDNN][tid] * siluf_(bf2f(((const bf16*)(ws + WS_Z))[off]))); }
    __syncthreads();
}

__device__ __forceinline__ void p4_rows(const Args& A, int gw, int NGW, int lane) {
    unsigned char* ws = A.ws;
    const bf16* QP = (const bf16*)(ws + WS_QP); bf16* QP2 = (bf16*)(ws + WS_QP2); bf16* KN = (bf16*)(ws + WS_KN);
    const int hh = lane >> 3, l7 = lane & 7;
    v4u pw[2][2], pr = {0u, 0u, 0u, 0u}, pwn[2][2], prn = pr;
#define P4LOAD(m_, W_, R_) do { const bf16* s0_ = QP + (size_t)(m_) * 1536 + 16 * lane; const bf16* s1_ = KN + (size_t)(m_) * 1024 + 16 * lane; \
        W_[0][0] = *(const v4u*)s0_; W_[0][1] = *(const v4u*)(s0_ + 8); W_[1][0] = *(const v4u*)s1_; W_[1][1] = *(const v4u*)(s1_ + 8); R_ = *(const v4u*)(QP + (size_t)(m_) * 1536 + 1024 + 8 * lane); } while (0)
    if (gw < MR) P4LOAD(gw, pw, pr);
    for (int m = gw; m < MR; m += NGW) {
        const int mn = m + NGW;
        if (mn < MR) P4LOAD(mn, pwn, prn);
        const int pos = m < MP ? (m & (SEQ - 1)) : PAST;
#pragma unroll
        for (int which = 0; which < 2; ++which) {
            const float* gain = (which == 0 ? A.in[I_QNN] : A.in[I_KNN]) + 16 * l7;
            const v4u w0 = pw[which][0], w1 = pw[which][1];
            float v[16] = {lo16(w0.x), hi16(w0.x), lo16(w0.y), hi16(w0.y), lo16(w0.z), hi16(w0.z), lo16(w0.w), hi16(w0.w),
                           lo16(w1.x), hi16(w1.x), lo16(w1.y), hi16(w1.y), lo16(w1.z), hi16(w1.z), lo16(w1.w), hi16(w1.w)};
            float ss = 0.f;
#pragma unroll
            for (int e = 0; e < 16; ++e) ss += v[e] * v[e];
            ss += __shfl_xor(ss, 1); ss += __shfl_xor(ss, 2); ss += __shfl_xor(ss, 4);
            const float r = 1.f / sqrtf(ss * (1.f / 128.f) + EPS);
#pragma unroll
            for (int e = 0; e < 16; ++e) v[e] = v[e] * r * gain[e];
            v4u o0, o1; o0.x = pk2(v[0], v[1]); o0.y = pk2(v[2], v[3]); o0.z = pk2(v[4], v[5]); o0.w = pk2(v[6], v[7]);
            o1.x = pk2(v[8], v[9]); o1.y = pk2(v[10], v[11]); o1.z = pk2(v[12], v[13]); o1.w = pk2(v[14], v[15]);
            bf16* dst = which == 0 ? QP2 + (size_t)m * 1536 + hh * 192 + 16 * l7 : KN + (size_t)m * 1024 + 16 * lane;
            *(v4u*)dst = o0; *(v4u*)(dst + 8) = o1;
        }
        {
            const v4u w = pr;
            float v[8] = {lo16(w.x), hi16(w.x), lo16(w.y), hi16(w.y), lo16(w.z), hi16(w.z), lo16(w.w), hi16(w.w)};
            float ss = 0.f;
#pragma unroll
            for (int e = 0; e < 8; ++e) ss += v[e] * v[e];
            ss += __shfl_xor(ss, 1); ss += __shfl_xor(ss, 2); ss += __shfl_xor(ss, 4);
            const float r = 1.f / sqrtf(ss * (1.f / 64.f) + EPS);
            float o[8];
#pragma unroll
            for (int e = 0; e < 8; ++e) { const float xn = v[e] * r * A.in[I_QNR][8 * l7 + e]; const float other = __shfl_xor(xn, 4);
                const float ang = (float)pos * ROPE_INV[8 * (l7 & 3) + e]; const float cs = cosf(ang), sn = sinf(ang);
                o[e] = (l7 < 4) ? xn * cs - other * sn : other * sn + xn * cs; }
            v4u ow; ow.x = pk2(o[0], o[1]); ow.y = pk2(o[2], o[3]); ow.z = pk2(o[4], o[5]); ow.w = pk2(o[6], o[7]);
            *(v4u*)(QP2 + (size_t)m * 1536 + hh * 192 + 128 + 8 * l7) = ow;
        }
        pw[0][0] = pwn[0][0]; pw[0][1] = pwn[0][1]; pw[1][0] = pwn[1][0]; pw[1][1] = pwn[1][1]; pr = prn;
    }
#undef P4LOAD
}
namespace att {
using s16x4 = __attribute__((ext_vector_type(4))) short;
using u32x4 = __attribute__((ext_vector_type(4))) unsigned;
constexpr int SHM_V = 16384, SHM_K = 16384, SHM_KR = 8192;
constexpr int OFF_V = 0, OFF_K = 2 * SHM_V, OFF_KR = OFF_K + 2 * SHM_K, OFF_WS = OFF_KR + 2 * SHM_KR, OFF_QR = OFF_WS + 2048;
constexpr float THR = 8.f;
#define KSWZ(row, colB) ((row) * 256 + ((colB) ^ (((row) & 7) << 4)))
#define KRSWZ(row, colB) ((row) * 128 + ((colB) ^ (((row) & 7) << 4)))
#define SBAR() __builtin_amdgcn_sched_barrier(0)
__device__ __forceinline__ unsigned cvtpk(float lo, float hi) { unsigned r; asm volatile("v_cvt_pk_bf16_f32 %0, %1, %2" : "=v"(r) : "v"(lo), "v"(hi)); return r; }
__device__ __forceinline__ void partialSM(f32x16& p0, f32x16& p1, float& m_reg, float& mn, float& alpha) {
    constexpr float C = MLA_SCALE * 1.4426950408889634f;
    float pmax = p0[0];
#pragma unroll
    for (int r = 1; r < 16; ++r) pmax = fmaxf(pmax, p0[r]);
#pragma unroll
    for (int r = 0; r < 16; ++r) pmax = fmaxf(pmax, p1[r]);
    { auto rr = __builtin_amdgcn_permlane32_swap(__float_as_uint(pmax), __float_as_uint(pmax), false, false);
      pmax = fmaxf(__uint_as_float(rr[0]), __uint_as_float(rr[1])); }
    if (__builtin_expect(__all(pmax - m_reg <= THR / MLA_SCALE), 1)) { mn = m_reg; alpha = 1.f; }
    else { mn = fmaxf(m_reg, pmax); alpha = __builtin_amdgcn_exp2f((m_reg - mn) * C); m_reg = mn; }
    const float mnC = -mn * C;
#pragma unroll
    for (int r = 0; r < 16; ++r) p0[r] = fmaf(p0[r], C, mnC);
#pragma unroll
    for (int r = 0; r < 16; ++r) p1[r] = fmaf(p1[r], C, mnC);
#pragma unroll
    for (int r = 0; r < 16; ++r) p0[r] = __builtin_amdgcn_exp2f(p0[r]);
}
__device__ __forceinline__ void finishSM(f32x16& p0, f32x16& p1, float alpha, float& l_reg, bf16x8& pa0, bf16x8& pa1, bf16x8& pa2, bf16x8& pa3) {
#pragma unroll
    for (int r = 0; r < 16; ++r) p1[r] = __builtin_amdgcn_exp2f(p1[r]);
    float ps = 0;
#pragma unroll
    for (int r = 0; r < 16; ++r) ps += p0[r];
#pragma unroll
    for (int r = 0; r < 16; ++r) ps += p1[r];
    { auto rr = __builtin_amdgcn_permlane32_swap(__float_as_uint(ps), __float_as_uint(ps), false, false);
      ps = __uint_as_float(rr[0]) + __uint_as_float(rr[1]); }
    l_reg = l_reg * alpha + ps;
#define PK4(P, BASE, OUT) do { unsigned a0 = cvtpk(P[BASE + 0], P[BASE + 1]), a1 = cvtpk(P[BASE + 2], P[BASE + 3]);   \
    unsigned b0 = cvtpk(P[BASE + 4], P[BASE + 5]), b1 = cvtpk(P[BASE + 6], P[BASE + 7]);                              \
    auto r0 = __builtin_amdgcn_permlane32_swap(a0, b0, false, false); auto r1 = __builtin_amdgcn_permlane32_swap(a1, b1, false, false); \
    u32x4 w = {r0[0], r1[0], r0[1], r1[1]}; OUT = *reinterpret_cast<bf16x8*>(&w); } while (0)
    PK4(p0, 0, pa0); PK4(p0, 8, pa1); PK4(p1, 0, pa2); PK4(p1, 8, pa3);
#undef PK4
}
__device__ __forceinline__ void qkt(f32x16& p0, f32x16& p1, LAS const unsigned char* Ks, LAS const unsigned char* KRs, const bf16x8* qr, LAS const unsigned char* qrl, int r32, int hi) {
    p0 = f32x16{}; p1 = f32x16{};
#pragma unroll
    for (int d0 = 0; d0 < 8; ++d0) { const int cb = (d0 * 16 + hi * 8) * 2;
        const bf16x8 b0 = *(LAS const bf16x8*)(Ks + KSWZ(r32, cb)), b1 = *(LAS const bf16x8*)(Ks + KSWZ(32 + r32, cb));
        p0 = MFMA32(b0, qr[d0], p0); p1 = MFMA32(b1, qr[d0], p1); if (d0 == 3 || d0 == 7) SBAR(); }
#pragma unroll
    for (int d0 = 0; d0 < 4; ++d0) { const int cb = (d0 * 16 + hi * 8) * 2;
        const bf16x8 b0 = *(LAS const bf16x8*)(KRs + KRSWZ(r32, cb)), b1 = *(LAS const bf16x8*)(KRs + KRSWZ(32 + r32, cb));
        const bf16x8 qq = *(LAS const bf16x8*)(qrl + d0 * 1024);
        p0 = MFMA32(b0, qq, p0); p1 = MFMA32(b1, qq, p1); }
}
__device__ __forceinline__ void cmask(f32x16& p0, f32x16& p1, int key0, int qpos, int hi) {
#pragma unroll
    for (int r = 0; r < 16; ++r) { const int k = key0 + crow(r, hi); if (k > qpos) p0[r] = -1e30f; if (k + 32 > qpos) p1[r] = -1e30f; }
}
__device__ __forceinline__ int v_st(int k, int c) { const int kk = (k & ~0xC) | ((k & 4) << 1) | ((k & 8) >> 1); return ((kk >> 3) * 4 + (c >> 5)) * 512 + ((kk & 7) * 32 + (c & 31)) * 2; }
__device__ __forceinline__ int v_rd_base(int lane) { return ((lane & 3) << 3) | (((lane >> 2) & 3) << 6) | (((lane >> 4) & 1) << 5) | (((lane >> 5) & 1) << 8); }
constexpr int v_rd_off(int d0, int ks, int half) { return d0 * 512 + ks * 4096 + half * 2048; }
template <int OFF> __device__ __forceinline__ s16x4 tr_read(int vb) {
    s16x4 r; asm volatile("ds_read_b64_tr_b16 %0, %1 offset:%2" : "=&v"(r) : "v"(vb), "i"(OFF) : "memory"); return r;
}
template <int D0> __device__ __forceinline__ void pv_one(f32x16& od, int vb, bf16x8 pa0, bf16x8 pa1, bf16x8 pa2, bf16x8 pa3) {
    const s16x4 l0 = tr_read<v_rd_off(D0, 0, 0)>(vb), h0 = tr_read<v_rd_off(D0, 0, 1)>(vb), l1 = tr_read<v_rd_off(D0, 1, 0)>(vb), h1 = tr_read<v_rd_off(D0, 1, 1)>(vb);
    const s16x4 l2 = tr_read<v_rd_off(D0, 2, 0)>(vb), h2 = tr_read<v_rd_off(D0, 2, 1)>(vb), l3 = tr_read<v_rd_off(D0, 3, 0)>(vb), h3 = tr_read<v_rd_off(D0, 3, 1)>(vb);
    asm volatile("s_waitcnt lgkmcnt(0)" ::: "memory"); SBAR();
#define PKV(L, H) (bf16x8){L[0], L[1], L[2], L[3], H[0], H[1], H[2], H[3]}
    od = MFMA32(pa0, PKV(l0, h0), od); od = MFMA32(pa1, PKV(l1, h1), od); od = MFMA32(pa2, PKV(l2, h2), od); od = MFMA32(pa3, PKV(l3, h3), od);
#undef PKV
}
__device__ __forceinline__ void pv_d0(f32x16* o, int vb, bf16x8 pa0, bf16x8 pa1, bf16x8 pa2, bf16x8 pa3) {
    pv_one<0>(o[0], vb, pa0, pa1, pa2, pa3); pv_one<1>(o[1], vb, pa0, pa1, pa2, pa3); pv_one<2>(o[2], vb, pa0, pa1, pa2, pa3); pv_one<3>(o[3], vb, pa0, pa1, pa2, pa3);
}
__device__ __forceinline__ void attn_block(const bf16* __restrict__ Qb, const bf16* __restrict__ Kh, const bf16* __restrict__ KRb, const bf16* __restrict__ Vh,
                                           bf16* __restrict__ Ob, int q0, LAS unsigned char* lds) {
    const int tid = threadIdx.x, wid = __builtin_amdgcn_readfirstlane(tid >> 6), lane = tid & 63, r32 = lane & 31, hi = lane >> 5;
    LAS unsigned char* V_lds = lds + OFF_V; LAS unsigned char* K_lds = lds + OFF_K; LAS unsigned char* KR_lds = lds + OFF_KR;
    LAS float* wsf = (LAS float*)(lds + OFF_WS) + wid * 64; LAS float* li_l = wsf; LAS float* al_l = wsf + 32;
    float m_reg = -1e30f, l_reg = 0; f32x16 o[4] = {}; bf16x8 qr[8];
    LAS unsigned char* qrl = lds + OFF_QR + wid * 4096 + lane * 16;
    { const char* Qw = (const char*)Qb + (size_t)wid * (32 * 1536 * 2); const unsigned qoff = (unsigned)(r32 * 1536 + hi * 8) * 2u;
#pragma unroll
      for (int d0 = 0; d0 < 8; ++d0) qr[d0] = *(const bf16x8*)(Qw + qoff + d0 * 32);
#pragma unroll
      for (int d0 = 0; d0 < 4; ++d0) *(LAS bf16x8*)(qrl + d0 * 1024) = *(const bf16x8*)(Qw + qoff + (8 + d0) * 32); }
    const int qpos = q0 + wid * 32 + r32;
    const int sr = tid >> 4, sc = (tid & 15) * 8, vst0 = v_st(sr, sc), vst1 = v_st(32 + sr, sc);
    const int krr = tid >> 3, krc = (tid & 7) * 8;
    const unsigned voff = (unsigned)(sr * 1024 + sc) * 2u, voffr = (unsigned)(krr * 64 + krc) * 2u;
    const int vb0 = (int)(uintptr_t)V_lds + v_rd_base(lane);
    bf16x8 vs0, vs1, ks0, ks1, krs;
#define SLOAD(k0) do { const char* kb_ = (const char*)Kh + (size_t)(k0) * 2048; const char* vb_ = (const char*)Vh + (size_t)(k0) * 2048; const char* rb_ = (const char*)KRb + (size_t)(k0) * 128; \
    vs0 = *(const bf16x8*)(vb_ + voff); vs1 = *(const bf16x8*)(vb_ + 65536 + voff); ks0 = *(const bf16x8*)(kb_ + voff); ks1 = *(const bf16x8*)(kb_ + 65536 + voff); \
    krs = *(const bf16x8*)(rb_ + voffr); } while (0)
#define SWRITE(b) do { *(LAS bf16x8*)(V_lds + (b) * SHM_V + vst0) = vs0; *(LAS bf16x8*)(V_lds + (b) * SHM_V + vst1) = vs1; const int kc = sc * 2; \
    *(LAS bf16x8*)(K_lds + (b) * SHM_K + KSWZ(sr, kc)) = ks0; *(LAS bf16x8*)(K_lds + (b) * SHM_K + KSWZ(32 + sr, kc)) = ks1; \
    *(LAS bf16x8*)(KR_lds + (b) * SHM_KR + KRSWZ(krr, krc * 2)) = krs; } while (0)
#define SWAIT() asm volatile("s_waitcnt vmcnt(0)" ::: "memory")
#define RESC(a) do { if (__any((a) < 1.f)) { if (hi == 0) al_l[r32] = (a); asm volatile("s_waitcnt lgkmcnt(0)" ::: "memory"); \
    _Pragma("unroll") for (int d = 0; d < 4; ++d) _Pragma("unroll") for (int r = 0; r < 16; ++r) o[d][r] *= al_l[crow(r, hi)]; } } while (0)
    f32x16 p0, p1; float mn, al; bf16x8 pa0, pa1, pa2, pa3;
    const int NT = (q0 + 256) / 64, NM = q0 / 64;
    SLOAD(0); SWAIT(); SWRITE(0); SLOAD(64); __syncthreads();
#pragma unroll 1
    for (int j = 0; j < NT; ++j) {
        const int bf = j & 1;
        SBAR(); qkt(p0, p1, K_lds + bf * SHM_K, KR_lds + bf * SHM_KR, qr, qrl, r32, hi); if (j >= NM) cmask(p0, p1, 64 * j, qpos, hi);
        partialSM(p0, p1, m_reg, mn, al); RESC(al);
        finishSM(p0, p1, al, l_reg, pa0, pa1, pa2, pa3); SBAR();
        if (j + 1 < NT) { SWAIT(); SWRITE(bf ^ 1); }
        if (j + 2 < NT) SLOAD((j + 2) * 64);
        SBAR();
        pv_d0(o, vb0 + bf * SHM_V, pa0, pa1, pa2, pa3);
        __syncthreads();
    }
    if (hi == 0) li_l[r32] = l_reg; asm volatile("s_waitcnt lgkmcnt(0)" ::: "memory");
    char* Ow = (char*)Ob + (size_t)wid * (32 * 1024 * 2);
    unsigned lofs = (unsigned)(4 * hi * 1024 + r32) * 2u; asm volatile("" : "+v"(lofs));
#pragma unroll
    for (int r = 0; r < 16; ++r) { const float rl = __builtin_amdgcn_rcpf(li_l[crow(r, hi)]);
#pragma unroll
        for (int d0 = 0; d0 < 4; ++d0) *(bf16*)(Ow + lofs + (unsigned)(((r & 3) + 8 * (r >> 2)) * 1024 + d0 * 32) * 2u) = (bf16)f2bf(o[d0][r] * rl); }
    __syncthreads();
#undef SLOAD
#undef SWRITE
#undef SWAIT
#undef RESC
}
}

constexpr int DP_CT = 0, DP_KR = 133120, DP_PT = 151552, DP_QK = 153728, DP_QR = 157824;
__device__ __forceinline__ void dec_tables(const Args& A, LAS unsigned char* lds, int j, int tid_) {
    int tid = tid_; asm volatile("" : "+v"(tid));
    const bf16* Qrow = (const bf16*)(A.ws + WS_QP2) + (size_t)(MP + j) * 1536;
#pragma unroll
    for (int q = 0; q < 2; ++q) { const int idx = tid + 512 * q, h = idx >> 7, d = idx & 127; ((LAS float*)(lds + DP_QK))[idx] = bf2f(Qrow[h * 192 + d]) * A.in[I_KNN][d]; }
    { const int h = tid >> 6, e = tid & 63; ((LAS float*)(lds + DP_QR))[tid] = bf2f(Qrow[h * 192 + 128 + e]); }
}
__device__ __forceinline__ void dec_page(const Args& A, LAS unsigned char* lds, int unit, int tid, int lane, int wave) {
    unsigned char* ws = A.ws;
    const int phys = ((const int*)A.in[I_PT])[unit];
    const float* src = A.in[I_CACHE] + (size_t)phys * PAGE * LATW;
#pragma unroll 1
    for (int q0 = 0; q0 < 18; q0 += 6) {
        f32x4 va[6], vb[6];
#pragma unroll
        for (int q = 0; q < 6; ++q) { const int id = (q0 + q) * 512 + tid, row = id / 72, g = id % 72; const float* p = src + (size_t)row * LATW + 8 * g; va[q] = *(const f32x4*)p; vb[q] = *(const f32x4*)(p + 4); }
#pragma unroll
        for (int q = 0; q < 6; ++q) { const int id = (q0 + q) * 512 + tid, row = id / 72, g = id % 72;
            v4u o; o.x = pk2(va[q].x, va[q].y); o.y = pk2(va[q].z, va[q].w); o.z = pk2(vb[q].x, vb[q].y); o.w = pk2(vb[q].z, vb[q].w);
            if (g < 64) *(LAS v4u*)(lds + DP_CT + row * 1040 + g * 16) = o; else *(LAS v4u*)(lds + DP_KR + row * 144 + (g - 64) * 16) = o; }
    }
    __syncthreads();
    const int l31 = lane & 31, hi = lane >> 5, h = wave;
    float ssq[4] = {0.f, 0.f, 0.f, 0.f}, dot[4] = {0.f, 0.f, 0.f, 0.f};
    const bf16* WK = (const bf16*)(ws + WS_WKV);
    LAS const float* QK = (LAS const float*)(lds + DP_QK) + h * 128;
#pragma unroll 1
    for (int e = 0; e < 2; ++e) {
        f32x16 acc[2][4];
#pragma unroll
        for (int mt = 0; mt < 2; ++mt)
#pragma unroll
            for (int nt = 0; nt < 4; ++nt) acc[mt][nt] = f32x16{};
        const bf16* Ab = WK + (size_t)(h * 128 + 64 * e + l31) * 512 + 8 * hi;
        LAS const unsigned char* Bb = lds + DP_CT + l31 * 1040 + hi * 16;
#pragma unroll 2
        for (int ks = 0; ks < 32; ++ks) {
            const bf16x8 a0 = gl_ld8(Ab + 16 * ks), a1 = gl_ld8(Ab + 32 * 512 + 16 * ks);
            bf16x8 bq[4];
#pragma unroll
            for (int nt = 0; nt < 4; ++nt) bq[nt] = lds_ld8(Bb + nt * 32 * 1040 + ks * 32);
#pragma unroll
            for (int nt = 0; nt < 4; ++nt) { acc[0][nt] = MFMA32(a0, bq[nt], acc[0][nt]); acc[1][nt] = MFMA32(a1, bq[nt], acc[1][nt]); }
        }
#pragma unroll
        for (int mt = 0; mt < 2; ++mt)
#pragma unroll
            for (int g = 0; g < 4; ++g) { const f32x4 qv = *(LAS const f32x4*)(QK + 64 * e + 32 * mt + 8 * g + 4 * hi);
#pragma unroll
                for (int nt = 0; nt < 4; ++nt) {
                    const float x0 = acc[mt][nt][4 * g], x1 = acc[mt][nt][4 * g + 1], x2 = acc[mt][nt][4 * g + 2], x3 = acc[mt][nt][4 * g + 3];
                    ssq[nt] += x0 * x0 + x1 * x1 + x2 * x2 + x3 * x3; dot[nt] += x0 * qv.x + x1 * qv.y + x2 * qv.z + x3 * qv.w; } }
    }
#pragma unroll
    for (int nt = 0; nt < 4; ++nt) { ssq[nt] += __shfl_xor(ssq[nt], 32); dot[nt] += __shfl_xor(dot[nt], 32); }
    const float sn0 = dot[0] / sqrtf(ssq[0] * (1.f / 128.f) + EPS), sn1 = dot[1] / sqrtf(ssq[1] * (1.f / 128.f) + EPS);
    const float sn2 = dot[2] / sqrtf(ssq[2] * (1.f / 128.f) + EPS), sn3 = dot[3] / sqrtf(ssq[3] * (1.f / 128.f) + EPS);
    const float snA = hi ? sn2 : sn0, snB = hi ? sn3 : sn1;
    float s[2];
    LAS const float* QR = (LAS const float*)(lds + DP_QR) + h * 64;
#pragma unroll
    for (int u = 0; u < 2; ++u) { const int key = 32 * (2 * hi + u) + l31; float sr = 0.f;
#pragma unroll
        for (int c = 0; c < 8; ++c) { const v4u w = *(LAS const v4u*)(lds + DP_KR + key * 144 + c * 16); const f32x4 q0 = *(LAS const f32x4*)(QR + 8 * c), q1 = *(LAS const f32x4*)(QR + 8 * c + 4);
            sr += lo16(w.x) * q0.x + hi16(w.x) * q0.y + lo16(w.y) * q0.z + hi16(w.y) * q0.w + lo16(w.z) * q1.x + hi16(w.z) * q1.y + lo16(w.w) * q1.z + hi16(w.w) * q1.w; }
        s[u] = ((u ? snB : snA) + sr) * MLA_SCALE; }
    const float mx = wave_max(fmaxf(s[0], s[1]));
    const float p0 = __expf(s[0] - mx), p1 = __expf(s[1] - mx);
    const float lsum = wave_sum(p0 + p1);
    *(LAS bf16*)(lds + DP_PT + h * 272 + (32 * (2 * hi) + l31) * 2) = (bf16)f2bf(p0);
    *(LAS bf16*)(lds + DP_PT + h * 272 + (32 * (2 * hi + 1) + l31) * 2) = (bf16)f2bf(p1);
    if (lane == 0) { float* ml = (float*)(ws + WS_DML) + ((size_t)unit * 8 + h) * 2; ml[0] = mx; ml[1] = lsum; }
    __syncthreads();
    float* DA = (float*)(ws + WS_DACC) + (size_t)unit * 8 * 512;
#pragma unroll 1
    for (int t = 0; t < 2; ++t) { const int cb = 64 * wave + 32 * t + l31;
        f32x16 acc2 = {};
#pragma unroll 2
        for (int ks = 0; ks < 8; ++ks) {
            bf16x8 a = {0, 0, 0, 0, 0, 0, 0, 0};
            if (l31 < 8) a = lds_ld8(lds + DP_PT + l31 * 272 + (16 * ks + 8 * hi) * 2);
            bf16x8 bb;
#pragma unroll
            for (int jj = 0; jj < 8; ++jj) bb[jj] = (short)*(LAS const bf16*)(lds + DP_CT + (16 * ks + 8 * hi + jj) * 1040 + cb * 2);
            acc2 = MFMA32(a, bb, acc2);
        }
#pragma unroll
        for (int r = 0; r < 4; ++r) DA[(size_t)(r + 4 * hi) * 512 + cb] = acc2[r];
    }
    __syncthreads();
}
__device__ __forceinline__ void dec_combine(const Args& A, LAS unsigned char* lds, int unit, int tid, int lane, int wave) {
    unsigned char* ws = A.ws;
    const int j = unit >> 3, h = unit & 7, row = MP + j;
    const bf16* Qrow = (const bf16*)(ws + WS_QP2) + (size_t)row * 1536 + h * 192;
    const bf16* Krow = (const bf16*)(ws + WS_KN) + (size_t)row * 1024 + h * 128;
    const bf16* KRrow = (const bf16*)(ws + WS_KR) + (size_t)row * 64;
    const float snew = wave_sum(bf2f(Qrow[lane]) * bf2f(Krow[lane]) + bf2f(Qrow[lane + 64]) * bf2f(Krow[lane + 64]) + bf2f(Qrow[128 + lane]) * bf2f(KRrow[lane])) * MLA_SCALE;
    const float* ML = (const float*)(ws + WS_DML) + ((size_t)j * NPAGE * 8 + h) * 2;
    const float m0 = ML[(size_t)lane * 16], m1 = ML[(size_t)(lane + 64) * 16], l0 = ML[(size_t)lane * 16 + 1], l1 = ML[(size_t)(lane + 64) * 16 + 1];
    const float M = fmaxf(wave_max(fmaxf(m0, m1)), snew);
    const float wn = __expf(snew - M);
    const float den = wave_sum(__expf(m0 - M) * l0 + __expf(m1 - M) * l1) + wn;
    const float* DA = (const float*)(ws + WS_DACC) + ((size_t)j * NPAGE * 8 + h) * 512 + tid;
    float num = wn * bf2f(((const bf16*)(ws + WS_C))[(size_t)row * 512 + tid]);
#pragma unroll 4
    for (int p = 0; p < NPAGE; ++p) num += __expf(ML[(size_t)p * 16] - M) * DA[(size_t)p * 4096];
    LAS float* lat = (LAS float*)lds; LAS float* red = lat + 512;
    lat[tid] = num / den;
    __syncthreads();
    const int d = tid & 127, qt = tid >> 7;
    const float* Wv = A.in[I_WUV] + (size_t)(qt * 128) * 1024 + h * 128 + d;
    float part = 0.f;
#pragma unroll 8
    for (int c = 0; c < 128; ++c) part += lat[qt * 128 + c] * Wv[(size_t)c * 1024];
    red[tid] = part;
    __syncthreads();
    if (tid < 128) ((bf16*)(ws + WS_YB))[(size_t)row * 1024 + h * 128 + tid] = (bf16)f2bf(red[tid] + red[128 + tid] + red[256 + tid] + red[384 + tid]);
    __syncthreads();
}
__device__ __forceinline__ f32x16 skinny_partial(const bf16* A, const bf16* Bt, int K, int n0, int wave, int lane) {
    const int l31 = lane & 31, hi = lane >> 5, kw = K >> 3, k0 = wave * kw;
    const bf16* ap = A + (size_t)l31 * K + k0 + 8 * hi; const bf16* bp = Bt + (size_t)(n0 + l31) * K + k0 + 8 * hi;
    f32x16 acc = {};
#pragma unroll 8
    for (int ks = 0; ks < (kw >> 4); ++ks) acc = MFMA32(gl_ld8(ap + 16 * ks), gl_ld8(bp + 16 * ks), acc);
    return acc;
}
__device__ __forceinline__ void skinny_put(LAS float* red, const f32x16& acc, int wave, int lane) {
    const int l31 = lane & 31, hi = lane >> 5;
#pragma unroll
    for (int r = 0; r < 16; ++r) red[(wave * 32 + crow(r, hi)) * 32 + l31] = acc[r];
}
__device__ __forceinline__ void skinny_get(LAS const float* red, int tid, float& v0, float& v1) {
    v0 = 0.f; v1 = 0.f;
#pragma unroll
    for (int w = 0; w < 8; ++w) { v0 += red[w * 1024 + tid * 2]; v1 += red[w * 1024 + tid * 2 + 1]; }
}
template <int MODE> __device__ __forceinline__ void skinny_tile(const Args& A, LAS unsigned char* lds, int tile, int tid, int lane, int wave) {
    unsigned char* ws = A.ws; const int n0 = tile * 32;
    LAS float* red = (LAS float*)lds; LAS float* red2 = red + 8192;
    if (MODE == 0) {
        skinny_put(red, skinny_partial((const bf16*)(ws + WS_YA) + (size_t)MP * 1024, (const bf16*)(ws + WS_WYA), 1024, n0, wave, lane), wave, lane);
        skinny_put(red2, skinny_partial((const bf16*)(ws + WS_YB) + (size_t)MP * 1024, (const bf16*)(ws + WS_WYB), 1024, n0, wave, lane), wave, lane);
    } else if (MODE == 1) skinny_put(red, skinny_partial((const bf16*)(ws + WS_T) + (size_t)MP * 1024, (const bf16*)(ws + WS_WO), 1024, n0, wave, lane), wave, lane);
    else if (MODE == 2) skinny_put(red, skinny_partial((const bf16*)(ws + WS_XN2) + (size_t)MP * 1024, (const bf16*)(ws + WS_WUP), 1024, n0, wave, lane), wave, lane);
    else skinny_put(red, skinny_partial((const bf16*)(ws + WS_H) + (size_t)MP * 4096, (const bf16*)(ws + WS_WDN), 4096, n0, wave, lane), wave, lane);
    __syncthreads();
    float v0, v1; skinny_get(red, tid, v0, v1);
    const int row = tid >> 4, col = n0 + 2 * (tid & 15); const size_t grow = (size_t)(MP + row);
    if (MODE == 0) {
        float u0, u1; skinny_get(red2, tid, u0, u1);
        const bf16* g = (const bf16*)(ws + WS_GATES) + grow * 2048 + col;
        const float t0 = bf2f(g[0]) * v0 + bf2f(g[1024]) * u0, t1 = bf2f(g[1]) * v1 + bf2f(g[1025]) * u1;
        *(unsigned*)((bf16*)(ws + WS_T) + grow * 1024 + col) = pk2(t0, t1);
    } else if (MODE == 1) {
        const float* x = A.in[I_XS] + (size_t)row * 1024 + col; float* o = (float*)(ws + WS_X1) + grow * 1024 + col;
        const float y0 = x[0] + v0, y1 = x[1] + v1;
        o[0] = y0; o[1] = y1;
        *(unsigned*)((bf16*)(ws + WS_XN2) + grow * 1024 + col) = pk2(y0, y1);
        float ss = y0 * y0 + y1 * y1; ss += __shfl_xor(ss, 1); ss += __shfl_xor(ss, 2); ss += __shfl_xor(ss, 4); ss += __shfl_xor(ss, 8);
        if ((tid & 15) == 0) atomicAdd((float*)(ws + WS_RX) + grow, ss);
    } else if (MODE == 2) {
        const float rr = __builtin_amdgcn_rsqf(((const float*)(ws + WS_RX))[grow] * (1.f / 1024.f) + EPS);
        const float a = fmaxf(v0 * rr, 0.f), b = fmaxf(v1 * rr, 0.f);
        *(unsigned*)((bf16*)(ws + WS_H) + grow * 4096 + col) = pk2(a * a, b * b);
    } else {
        const float* x = (const float*)(ws + WS_X1) + grow * 1024 + col; float* o = A.out + O_YS + (size_t)row * 1024 + col;
        o[0] = x[0] + v0; o[1] = x[1] + v1;
    }
    __syncthreads();
}
struct DecPk { v4u p[36]; };
#ifndef DEC_RD
#define DEC_RD 16
#endif
constexpr int RD = DEC_RD;
__device__ __forceinline__ void dec_load_sync(const Args& A, LAS unsigned char* lds, int unit, int tid) {
    const int phys = ((const int*)A.in[I_PT])[unit];
    const float* src = A.in[I_CACHE] + (size_t)phys * PAGE * LATW;
#pragma unroll 1
    for (int q0 = 0; q0 < 18; q0 += 6) {
        f32x4 va[6], vb[6];
#pragma unroll
        for (int q = 0; q < 6; ++q) { const int id = (q0 + q) * 512 + tid, row = id / 72, g = id % 72; const float* p = src + (size_t)row * LATW + 8 * g; va[q] = *(const f32x4*)p; vb[q] = *(const f32x4*)(p + 4); }
#pragma unroll
        for (int q = 0; q < 6; ++q) { const int id = (q0 + q) * 512 + tid, row = id / 72, g = id % 72;
            v4u o; o.x = pk2(va[q].x, va[q].y); o.y = pk2(va[q].z, va[q].w); o.z = pk2(vb[q].x, vb[q].y); o.w = pk2(vb[q].z, vb[q].w);
            if (g < 64) *(LAS v4u*)(lds + DP_CT + row * 1040 + g * 16) = o; else *(LAS v4u*)(lds + DP_KR + row * 144 + (g - 64) * 16) = o; }
    }
    __syncthreads();
}
__device__ __forceinline__ void dec_prefetch(const Args& A, int unit, int lt, DecPk& pk) {
    const int phys = __builtin_amdgcn_readfirstlane(((const int*)A.in[I_PT])[unit]);
    const char* src = (const char*)(A.in[I_CACHE] + (size_t)phys * PAGE * LATW);
    const unsigned lo = (unsigned)lt * 32u;
#pragma unroll
    for (int q0 = 0; q0 < 36; q0 += 12) {
        f32x4 va[12], vb[12];
#pragma unroll
        for (int q = 0; q < 12; ++q) { const char* p = src + (size_t)(q0 + q) * 8192 + lo; va[q] = __builtin_nontemporal_load((const f32x4*)p); vb[q] = __builtin_nontemporal_load((const f32x4*)(p + 16)); }
#pragma unroll
        for (int q = 0; q < 12; ++q) { v4u o; o.x = pg8::cvt_pk_bf16(va[q].x, va[q].y); o.y = pg8::cvt_pk_bf16(va[q].z, va[q].w); o.z = pg8::cvt_pk_bf16(vb[q].x, vb[q].y); o.w = pg8::cvt_pk_bf16(vb[q].z, vb[q].w); pk.p[q0 + q] = o; }
    }
}
__device__ __forceinline__ void dec_store(LAS unsigned char* lds, int lt, const DecPk& pk) {
    int ltx = lt; asm volatile("" : "+v"(ltx));
#pragma unroll
    for (int q = 0; q < 36; ++q) { const int id = q * 256 + ltx, row = id / 72, g = id - row * 72;
        const int off = g < 64 ? DP_CT + row * 1040 + g * 16 : DP_KR + row * 144 + (g - 64) * 16;
        *(LAS v4u*)(lds + off) = pk.p[q]; }
}
__device__ __forceinline__ void dec_ring_fill(const Args& A, int mw, int lane, bf16x8 (&a)[RD]) {
    const __amdgpu_buffer_rsrc_t rs = __builtin_amdgcn_make_buffer_rsrc((void*)(A.ws + WS_WKT), 0, 1024 * 512 * 2, 0x00020000);
    const unsigned voff = (unsigned)lane * 16u; const int so = 256 * mw * 1024;
#pragma unroll
    for (int d = 0; d < RD; ++d) a[d] = __builtin_bit_cast(bf16x8, __builtin_amdgcn_raw_buffer_load_b128(rs, voff, so + d * 1024, 0));
}
__device__ __forceinline__ void dec_mfma(const Args& A, LAS unsigned char* lds, int unit, int mw, int lane, bf16x8 (&a)[RD]) {
    const int l31_ = lane & 31, hi_ = lane >> 5;
    const __amdgpu_buffer_rsrc_t rs = __builtin_amdgcn_make_buffer_rsrc((void*)(A.ws + WS_WKT), 0, 1024 * 512 * 2, 0x00020000);
    const unsigned voff = (unsigned)lane * 16u; const int so = 256 * mw * 1024;
    LAS const unsigned char* Bb = lds + DP_CT + l31_ * 1040 + hi_ * 16;
    float ssq[4] = {0.f, 0.f, 0.f, 0.f}, dot[4] = {0.f, 0.f, 0.f, 0.f};
    bf16x8 bc0 = lds_ld8(Bb), bc1 = lds_ld8(Bb + 33280), bc2 = lds_ld8(Bb + 2 * 33280), bc3 = lds_ld8(Bb + 3 * 33280), bd0, bd1, bd2, bd3;
#pragma unroll 1
    for (int jb = 0; jb < 8; ++jb) {
        f32x16 acc[4];
#pragma unroll
        for (int nt = 0; nt < 4; ++nt) acc[nt] = f32x16{};
#pragma unroll 1
        for (int blk = 0; blk < 32 / RD; ++blk) {
            const int nj = (blk == 32 / RD - 1) ? ((jb + 1) & 7) : jb, nk = (blk == 32 / RD - 1) ? 0 : (blk + 1) * RD;
            const int nb = so + nj * 32 * 1024 + 1024 * nk;
            LAS const unsigned char* Bk = Bb + blk * (32 * RD);
            LAS const unsigned char* Bn = Bb + ((blk + 1) & (32 / RD - 1)) * (32 * RD);
#pragma unroll
            for (int d = 0; d < RD; d += 2) {
                {
                    LAS const unsigned char* Bx = Bk + (d + 1) * 32;
                    bd0 = lds_ld8(Bx); bd1 = lds_ld8(Bx + 33280); bd2 = lds_ld8(Bx + 2 * 33280); bd3 = lds_ld8(Bx + 3 * 33280);
                    __builtin_amdgcn_sched_barrier(0);
                    acc[0] = MFMA32(a[d], bc0, acc[0]); acc[1] = MFMA32(a[d], bc1, acc[1]); acc[2] = MFMA32(a[d], bc2, acc[2]); acc[3] = MFMA32(a[d], bc3, acc[3]);
                    a[d] = __builtin_bit_cast(bf16x8, __builtin_amdgcn_raw_buffer_load_b128(rs, voff, nb + d * 1024, 0));
                    __builtin_amdgcn_sched_barrier(0);
                }
                {
                    LAS const unsigned char* Bx = (d + 2 < RD) ? Bk + (d + 2) * 32 : Bn;
                    bc0 = lds_ld8(Bx); bc1 = lds_ld8(Bx + 33280); bc2 = lds_ld8(Bx + 2 * 33280); bc3 = lds_ld8(Bx + 3 * 33280);
                    __builtin_amdgcn_sched_barrier(0);
                    acc[0] = MFMA32(a[d + 1], bd0, acc[0]); acc[1] = MFMA32(a[d + 1], bd1, acc[1]); acc[2] = MFMA32(a[d + 1], bd2, acc[2]); acc[3] = MFMA32(a[d + 1], bd3, acc[3]);
                    a[d + 1] = __builtin_bit_cast(bf16x8, __builtin_amdgcn_raw_buffer_load_b128(rs, voff, nb + (d + 1) * 1024, 0));
                    __builtin_amdgcn_sched_barrier(0);
                }
            }
        }
        const int e4 = jb & 3, h = 2 * mw + (jb >> 2);
        int l31 = l31_, hi = hi_; asm volatile("" : "+v"(l31), "+v"(hi));
        LAS const float* QK = (LAS const float*)(lds + DP_QK) + h * 128 + 32 * e4 + 4 * hi;
#pragma unroll
        for (int g = 0; g < 4; ++g) { const f32x4 qv = *(LAS const f32x4*)(QK + 8 * g);
#pragma unroll
            for (int nt = 0; nt < 4; ++nt) {
                const float x0 = acc[nt][4 * g], x1 = acc[nt][4 * g + 1], x2 = acc[nt][4 * g + 2], x3 = acc[nt][4 * g + 3];
                ssq[nt] += x0 * x0 + x1 * x1 + x2 * x2 + x3 * x3; dot[nt] += x0 * qv.x + x1 * qv.y + x2 * qv.z + x3 * qv.w; } }
        if (e4 == 3) {
#pragma unroll
            for (int nt = 0; nt < 4; ++nt) { ssq[nt] += __shfl_xor(ssq[nt], 32); dot[nt] += __shfl_xor(dot[nt], 32); }
            const float sn0 = dot[0] / sqrtf(ssq[0] * (1.f / 128.f) + EPS), sn1 = dot[1] / sqrtf(ssq[1] * (1.f / 128.f) + EPS);
            const float sn2 = dot[2] / sqrtf(ssq[2] * (1.f / 128.f) + EPS), sn3 = dot[3] / sqrtf(ssq[3] * (1.f / 128.f) + EPS);
            const float snA = hi ? sn2 : sn0, snB = hi ? sn3 : sn1;
            float s[2];
            LAS const float* QR = (LAS const float*)(lds + DP_QR) + h * 64;
#pragma unroll
            for (int u = 0; u < 2; ++u) { const int key = 32 * (2 * hi + u) + l31; float sr = 0.f;
#pragma unroll
                for (int c = 0; c < 8; ++c) { const v4u w = *(LAS const v4u*)(lds + DP_KR + key * 144 + c * 16); const f32x4 q0 = *(LAS const f32x4*)(QR + 8 * c), q1 = *(LAS const f32x4*)(QR + 8 * c + 4);
                    sr += lo16(w.x) * q0.x + hi16(w.x) * q0.y + lo16(w.y) * q0.z + hi16(w.y) * q0.w + lo16(w.z) * q1.x + hi16(w.z) * q1.y + lo16(w.w) * q1.z + hi16(w.w) * q1.w; }
                s[u] = ((u ? snB : snA) + sr) * MLA_SCALE; }
            const float mx = wave_max(fmaxf(s[0], s[1]));
            const float p0 = __expf(s[0] - mx), p1 = __expf(s[1] - mx);
            const float lsum = wave_sum(p0 + p1);
            *(LAS bf16*)(lds + DP_PT + h * 272 + (32 * (2 * hi) + l31) * 2) = (bf16)f2bf(p0);
            *(LAS bf16*)(lds + DP_PT + h * 272 + (32 * (2 * hi + 1) + l31) * 2) = (bf16)f2bf(p1);
            if (l31 + hi == 0) { float* ml = (float*)(A.ws + WS_DML) + ((size_t)unit * 8 + h) * 2; ml[0] = mx; ml[1] = lsum; }
#pragma unroll
            for (int nt = 0; nt < 4; ++nt) { ssq[nt] = 0.f; dot[nt] = 0.f; }
        }
    }
}
__device__ __forceinline__ void dec_pv(const Args& A, LAS unsigned char* lds, int unit, int lane, int wave) {
    int l31 = lane & 31, hi = lane >> 5; asm volatile("" : "+v"(l31), "+v"(hi));
    float* DA = (float*)(A.ws + WS_DACC) + (size_t)unit * 8 * 512;
#pragma unroll 1
    for (int t = 0; t < 2; ++t) { const int cb = 64 * wave + 32 * t + l31;
        f32x16 acc2 = {};
#pragma unroll 2
        for (int ks = 0; ks < 8; ++ks) {
            bf16x8 a = {0, 0, 0, 0, 0, 0, 0, 0};
            if (l31 < 8) a = lds_ld8(lds + DP_PT + l31 * 272 + (16 * ks + 8 * hi) * 2);
            bf16x8 bb;
#pragma unroll
            for (int jj = 0; jj < 8; ++jj) bb[jj] = (short)*(LAS const bf16*)(lds + DP_CT + (16 * ks + 8 * hi + jj) * 1040 + cb * 2);
            acc2 = MFMA32(a, bb, acc2);
        }
#pragma unroll
        for (int r = 0; r < 4; ++r) DA[(size_t)(r + 4 * hi) * 512 + cb] = acc2[r];
    }
}
constexpr int NG4 = 640, NG2 = 512, NG1 = 512;
template <bool MF> __device__ __forceinline__ void dec_loop(const Args& A, LAS unsigned char* lds, volatile LAS unsigned* MISC, unsigned* qc, int g, int tid, int lane, int wave) {
    constexpr int NGRP = NG4 + NG2 + NG1; static_assert(4 * NG4 + 2 * NG2 + NG1 == 4096, "page count");
#define GFIRST(g_) ((g_) < NG4 ? 4 * (g_) : (g_) < NG4 + NG2 ? 4 * NG4 + 2 * ((g_) - NG4) : 4 * NG4 + 2 * NG2 + ((g_) - NG4 - NG2))
#define GCOUNT(g_) ((g_) < NG4 ? 4 : (g_) < NG4 + NG2 ? 2 : 1)
#define DPULL() ({ __syncthreads(); if (tid == 0) MISC[0] = atomicAdd(qc, 1u); __syncthreads(); (int)MISC[0]; })
    int jcur = -1;
#ifdef PROBE_K
#ifndef PROBE_B
#define PROBE_B 0
#endif
    unsigned long long pt0 = 0, pdt = 0;
#define DPS(k) do { if ((k) == PROBE_K) pt0 = __builtin_amdgcn_s_memrealtime(); } while (0)
#define DPE(k) do { if ((k) == PROBE_K) pdt += __builtin_amdgcn_s_memrealtime() - pt0; } while (0)
#else
#define DPS(k) do {} while (0)
#define DPE(k) do {} while (0)
#endif
    bf16x8 a[RD];
    if (MF) dec_ring_fill(A, wave, lane, a);
#pragma unroll 1
    while (g < NGRP) {
        const int gn = DPULL();
        const int j = GFIRST(g) >> 7, PG = GCOUNT(g), u0 = GFIRST(g);
        if (j != jcur) { dec_tables(A, lds, j, tid); jcur = j; __syncthreads(); }
#pragma unroll 1
        for (int p = 0; p < PG; ++p) {
            const int unit = u0 + p, np = (p + 1 < PG) ? unit + 1 : (gn < NGRP ? GFIRST(gn) : -1);
            DecPk pk;
            DPS(64); DPS(60); DPS(61);
#ifdef PROBE_K
            const unsigned long long ck0 = __builtin_readcyclecounter();
#endif
            if (MF) { dec_mfma(A, lds, unit, wave, lane, a); DPE(60);
#ifdef PROBE_K
                if (PROBE_K == 66) pdt += (__builtin_readcyclecounter() - ck0) / 24;
#endif
            }
            else if (np >= 0) { dec_prefetch(A, np, tid - 256, pk); DPE(61); }
            LBAR();
            DPS(62);
            dec_pv(A, lds, unit, lane, wave);
            LBAR();
            DPE(62); DPS(63);
            if (MF) { if (np >= 0) dec_ring_fill(A, wave, lane, a); }
            else if (np >= 0) dec_store(lds, tid - 256, pk);
            LBAR();
            DPE(63); DPE(64);
#ifdef PROBE_K
            if (PROBE_K == 65) pdt += 1000;
#endif
        }
        g = gn;
    }
#ifdef PROBE_K
    if (blockIdx.x == PROBE_B && PROBE_K >= 60) { const unsigned long long te = __builtin_amdgcn_s_memrealtime(); while (__builtin_amdgcn_s_memrealtime() - te < (unsigned long long)PROBE_MULT * pdt) __builtin_amdgcn_s_sleep(8); }
#endif
}
__device__ __forceinline__ void dec_run(const Args& A, LAS unsigned char* lds, volatile LAS unsigned* MISC, unsigned* qc, int tid, int lane, int wave) {
    const int g = DPULL();
    if (g >= NG4 + NG2 + NG1) return;
    dec_load_sync(A, lds, GFIRST(g), tid);
    if (wave < 4) dec_loop<true>(A, lds, MISC, qc, g, tid, lane, wave);
    else dec_loop<false>(A, lds, MISC, qc, g, tid, lane, wave);
#undef DPULL
#undef GFIRST
#undef GCOUNT
}
#ifndef MK_SINGLE
#define MK_SINGLE 1
#endif
constexpr int N_PHASES = 12;
__global__ void __launch_bounds__(512, 2) mk_fwd(Args args) {
    extern __shared__ __attribute__((aligned(16))) unsigned char lds_raw[];
    LAS unsigned char* lds = (LAS unsigned char*)lds_raw;
    const int tid = threadIdx.x, lane = tid & 63, wave = __builtin_amdgcn_readfirstlane(tid >> 6);
    const int G = gridDim.x, bid = blockIdx.x;
    const int gw = bid * 8 + wave, NGW = G * 8, gtid = bid * 512 + tid, NGT = G * 512;
    volatile LAS unsigned* MISC = (volatile LAS unsigned*)(lds + MISC_OFF);
    if (tid < 32) MISC[tid] = 0u;
    __syncthreads();
    unsigned char* ws = args.ws;
#if MK_SINGLE
    XcdBarrier bar = xcd_barrier_post((unsigned*)(ws + WS_CTL) + 4096, MISC + 8);
#define GRID_BAR() xcd_barrier(bar)
#else
#define GRID_BAR() do {} while (0)
#endif
    const int lo = args.ph_lo, hi = args.ph_hi;
#ifdef PROBE_K
#ifndef PROBE_B
#define PROBE_B 0
#endif
    unsigned long long pt0 = 0, pdt = 0;
#define PSTART(k) do { if ((k) == PROBE_K) pt0 = __builtin_amdgcn_s_memrealtime(); } while (0)
#define PEND(k) do { if ((k) == PROBE_K) pdt += __builtin_amdgcn_s_memrealtime() - pt0; } while (0)
#else
#define PSTART(k) do {} while (0)
#define PEND(k) do {} while (0)
#endif
#ifndef PHASE_MASK
#define PHASE_MASK 0xFFFF
#endif
#define IN(k) (((PHASE_MASK >> (k)) & 1) && lo <= (k) && (k) < hi)
#define SEAM(k) do { if (IN(k) && IN((k) + 1)) GRID_BAR(); } while (0)

    PSTART(0);
    if (IN(0)) {
        p0_prologue(args, lds, gw, NGW, wave, lane);
        for (int i = gtid; i < 32 * 2 * 3072; i += NGT) { const int c = i % 3072, r = (i / 3072) % 2, j = i / (2 * 3072);
            args.out[O_CSS + (size_t)(j * 3 + r) * 3072 + c] = args.in[I_SCONV][(size_t)(j * 3 + r + 1) * 3072 + c]; }
        __syncthreads();
    }
    SEAM(0);
    PEND(0);
    PSTART(1);
    if (IN(1)) {
        pg8::Gemm g{(const pg8::bf16_t*)(ws + WS_XN), (const pg8::bf16_t*)(ws + WS_WIN), MPAD, NIN, 1024};
        pg8::StaticOrder S; S.init(MPAD, NIN, G, bid);
        EpiG1 E{(bf16*)(ws + WS_QKV), (bf16*)(ws + WS_Z), (bf16*)(ws + WS_QD), (bf16*)(ws + WS_KVD), (bf16*)(ws + WS_GATES), (float*)(ws + WS_SM)};
        pg8::gemm_phase<EpiG1, pg8::StaticOrder, true, true>(lds, g, S, E);
        { const int nfull = (MPAD / 256) * (NIN / 256) - ((MPAD / 256) * (NIN / 256) / G) * G;
          if (bid >= nfull) cvt_weights<true>(args, lds, (bid - nfull) * 8 + wave, (G - nfull) * 8, wave, lane); }
    }
    SEAM(1);
    PEND(1);
    PSTART(2);
    if (IN(2)) {
        p2_rows(args, gw, NGW, lane);
        p2_conv_state(args, gtid, NGT);
    }
    SEAM(2);
    PEND(2);
    PSTART(3);
    if (IN(3)) {
        { pg8::Gemm g{(const pg8::bf16_t*)(ws + WS_QD), (const pg8::bf16_t*)(ws + WS_WQ), MPAD, 1536, 512};
          pg8::StaticOrder S; S.init(MPAD, 1536, G, bid);
          EpiStore<0> E{(bf16*)(ws + WS_QP), 1536, 6, (bf16*)(ws + WS_QP), 1536};
          pg8::gemm_phase<EpiStore<0>, pg8::StaticOrder, true, true>(lds, g, S, E); }
        { pg8::Gemm g{(const pg8::bf16_t*)(ws + WS_C), (const pg8::bf16_t*)(ws + WS_WKV), MPAD, 2048, 512};
          pg8::StaticOrder S; S.init(MPAD, 2048, G, G - 1 - bid);
          EpiStore<0> E{(bf16*)(ws + WS_KN), 1024, 4, (bf16*)(ws + WS_V), 1024};
          pg8::gemm_phase<EpiStore<0>, pg8::StaticOrder, true, true>(lds, g, S, E); }
        PSTART(31);
        for (int u = bid; u < 2048; u += G) gdn_a_unit(args, lds, u, tid, lane, wave);
        PEND(31); PSTART(32);
        for (int u = bid; u < 256; u += G) gdn_r_unit(args, lds, u, tid, lane, wave);
        PEND(32);
    }
    SEAM(3);
    PEND(3);
    PSTART(4);
    if (IN(4)) { p4_rows(args, gw, NGW, lane); }
    SEAM(4);
    PEND(4);
    PSTART(5);
    if (IN(5)) {
        unsigned* qctr = (unsigned*)(ws + WS_CTL) + 64;
#define PULL(k) ({ __syncthreads(); if (tid == 0) MISC[0] = atomicAdd(qctr + 64 * (k), 1u); __syncthreads(); (int)MISC[0]; })
        PSTART(50);
        for (int it = PULL(0); it < 64; it = PULL(0)) gdn_b_unit(args, lds, it, tid, lane, wave);
        PEND(50); PSTART(51);
        for (int u = PULL(1); u < 256; u = PULL(1)) {
            const int bh = u >> 2, pr = u & 3, b = bh >> 3, h = bh & 7;
#pragma unroll 1
            for (int s2 = 0; s2 < 2; ++s2) { const int qb = s2 ? pr : 7 - pr;
                att::attn_block((const bf16*)(ws + WS_QP2) + (size_t)(b * SEQ + 256 * qb) * 1536 + h * 192, (const bf16*)(ws + WS_KN) + (size_t)(b * SEQ) * 1024 + h * 128,
                                (const bf16*)(ws + WS_KR) + (size_t)(b * SEQ) * 64, (const bf16*)(ws + WS_V) + (size_t)(b * SEQ) * 1024 + h * 128,
                                (bf16*)(ws + WS_YB) + (size_t)(b * SEQ + 256 * qb) * 1024 + h * 128, 256 * qb, lds); }
        }
        PEND(51); PSTART(52);
        dec_run(args, lds, MISC, qctr + 128, tid, lane, wave);
        PEND(52); PSTART(53);
#undef PULL
    }
    SEAM(5);
    PEND(5); PEND(53);
    PSTART(6);
    if (IN(6)) { for (int u = bid; u < 256; u += G) dec_combine(args, lds, u, tid, lane, wave); }
    SEAM(6);
    PEND(6);
    PSTART(7);
    if (IN(7)) {
        for (int t = bid; t < 32; t += G) skinny_tile<0>(args, lds, t, tid, lane, wave);
        pg8::StaticOrder S; S.init(MP, 1024, G, bid);
        { pg8::Gemm g{(const pg8::bf16_t*)(ws + WS_YA), (const pg8::bf16_t*)(ws + WS_WYA), MP, 1024, 1024};
          EpiMerge<1> E{(const bf16*)(ws + WS_GATES), (float*)(ws + WS_TF), (bf16*)(ws + WS_T)};
          pg8::gemm_phase<EpiMerge<1>, pg8::StaticOrder, true, true>(lds, g, S, E); }
        { pg8::Gemm g{(const pg8::bf16_t*)(ws + WS_YB), (const pg8::bf16_t*)(ws + WS_WYB), MP, 1024, 1024};
          EpiMerge<2> E{(const bf16*)(ws + WS_GATES), (float*)(ws + WS_TF), (bf16*)(ws + WS_T)};
          pg8::gemm_phase<EpiMerge<2>, pg8::StaticOrder, true, true>(lds, g, S, E); }
    }
    SEAM(7);
    PEND(7);
    PSTART(8);
    if (IN(8)) {
        for (int t = bid; t < 32; t += G) skinny_tile<1>(args, lds, t, tid, lane, wave);
        pg8::Gemm g{(const pg8::bf16_t*)(ws + WS_T), (const pg8::bf16_t*)(ws + WS_WO), MP, 1024, 1024};
        pg8::StaticOrder S; S.init(MP, 1024, G, bid);
        EpiRes<0> E{args.in[I_XP], args.in[I_XS], (float*)(ws + WS_X1), args.out, (bf16*)(ws + WS_XN2), (float*)(ws + WS_RX)};
        pg8::gemm_phase<EpiRes<0>, pg8::StaticOrder, true, true>(lds, g, S, E);
    }
    SEAM(8);
    PEND(8);
    PSTART(10);
    if (IN(10)) {
        for (int t = bid; t < 128; t += G) skinny_tile<2>(args, lds, t, tid, lane, wave);
        pg8::Gemm g{(const pg8::bf16_t*)(ws + WS_XN2), (const pg8::bf16_t*)(ws + WS_WUP), MP, 4096, 1024};
        pg8::StaticOrder S; S.init(MP, 4096, G, bid);
        EpiUp E{(bf16*)(ws + WS_H), (const float*)(ws + WS_RX)};
        pg8::gemm_phase<EpiUp, pg8::StaticOrder, true, true>(lds, g, S, E);
    }
    SEAM(10);
    PEND(10);
    PSTART(11);
    if (IN(11)) {
        for (int t = bid; t < 32; t += G) skinny_tile<3>(args, lds, t, tid, lane, wave);
        pg8::Gemm g{(const pg8::bf16_t*)(ws + WS_H), (const pg8::bf16_t*)(ws + WS_WDN), MP, 1024, 4096};
        pg8::StaticOrder S; S.init(MP, 1024, G, bid);
        EpiRes<1> E{args.in[I_XP], args.in[I_XS], (float*)(ws + WS_X1), args.out, (bf16*)(ws + WS_XN2), (float*)(ws + WS_RX)};
        pg8::gemm_phase<EpiRes<1>, pg8::StaticOrder, true, true>(lds, g, S, E);
    }
    PEND(11);
#ifdef PROBE_K
    if (PROBE_K >= 80 && PROBE_K < 90) { __syncthreads(); pdt = MISC[16]; }
    if (bid == PROBE_B || (PROBE_K >= 80 && PROBE_K < 90)) { const unsigned long long te = __builtin_amdgcn_s_memrealtime(); while (__builtin_amdgcn_s_memrealtime() - te < (unsigned long long)PROBE_MULT * pdt) __builtin_amdgcn_s_sleep(8); }
#endif
#undef IN
#undef SEAM
}

extern "C" void kernel_launch(void* const* d_in, const int* in_sizes, int n_in, void* d_out, int out_size, void* d_ws, size_t ws_size, hipStream_t stream) {
    static int grid = 0;
    if (grid == 0) {
        if (n_in != 27 || ws_size < WS_END) { fprintf(stderr, "kernel_launch: unexpected n_in %d or ws_size %zu (need %zu)\n", n_in, ws_size, (size_t)WS_END); grid = -1; return; }
        int dev = 0, cus = 0, per_cu = 0;
        if (hipGetDevice(&dev) != hipSuccess || hipDeviceGetAttribute(&cus, hipDeviceAttributeMultiprocessorCount, dev) != hipSuccess) { grid = -1; return; }
        if (hipFuncSetAttribute((const void*)mk_fwd, hipFuncAttributeMaxDynamicSharedMemorySize, LDS_BYTES) != hipSuccess) { fprintf(stderr, "kernel_launch: hipFuncSetAttribute failed\n"); grid = -1; return; }
        if (hipOccupancyMaxActiveBlocksPerMultiprocessor(&per_cu, (const void*)mk_fwd, 512, LDS_BYTES) != hipSuccess || per_cu < 1) fprintf(stderr, "kernel_launch: occupancy query says %d\n", per_cu);
        (void)hipGetLastError();
        grid = cus;
    }
    if (grid < 0) return;
    (void)hipMemsetAsync((char*)d_ws + WS_CTL, 0, CTL_BYTES, stream);
    Args a{};
    for (int i = 0; i < 27; ++i) a.in[i] = (const float*)d_in[i];
    a.out = (float*)d_out; a.ws = (unsigned char*)d_ws;
#if MK_SINGLE
    a.ph_lo = 0; a.ph_hi = N_PHASES;
    hipLaunchKernelGGL(mk_fwd, dim3(grid), dim3(512), LDS_BYTES, stream, a);
#else
    for (int p = 0; p < N_PHASES; ++p) { a.ph_lo = p; a.ph_hi = p + 1; hipLaunchKernelGGL(mk_fwd, dim3(grid), dim3(512), LDS_BYTES, stream, a); }
#endif
    const hipError_t le = hipPeekAtLastError();
    if (le != hipSuccess) fprintf(stderr, "kernel_launch: launch failed: %s\n", hipGetErrorName(le));
}
```

```cpp
#include <hip/hip_runtime.h>
#include <cstdio>
#include <cstdint>
namespace pg8 {
#define PG8_LAS __attribute__((address_space(3)))
typedef unsigned short bf16_t;
typedef short bf16x8 __attribute__((ext_vector_type(8)));
typedef float f32x4 __attribute__((ext_vector_type(4)));
typedef unsigned u32x4 __attribute__((ext_vector_type(4)));
constexpr int BM = 256, BK = 64, HALF = 128, HTB = HALF * BK * 2  , STAGE_BYTES = 8 * HTB, NXCD = 8, WGM = 8;

__host__ __device__ __forceinline__ int lds_byte(int r, int c) { const int st = (r >> 4) * 2 + (c >> 5), rr = r & 15, cc = c & 31, ob = rr * 64 + cc * 2; return st * 1024 + (ob ^ (((ob >> 9) & 1) << 5)); }
__host__ __device__ __forceinline__ void stage_rc(int b, int& R, int& C) { const int st = b / 1024, sb = b % 1024, swz = sb ^ (((sb >> 9) & 1) << 5); R = (st >> 1) * 16 + swz / 64; C = (st & 1) * 32 + (swz % 64) / 2; }
__host__ __device__ __forceinline__ int perm32(int rho) { const int n = rho >> 4, i = rho & 15; return 8 * (i >> 2) + 4 * n + (i & 3); }

struct Unit { int pm, pn; };
struct Gemm { const bf16_t* A; const bf16_t* Bt; int M, N, K; };

struct StaticOrder {
    int nM, nN, nwg, G, c;
    __host__ __device__ void init(int M, int N, int G_, int c_) { nM = M / BM; nN = N / BM; nwg = nM * nN; G = G_; c = c_; }
    __host__ __device__ bool next(int i, Unit& u) const {
        const long L = (long)i * G + c; if (L >= nwg) return false;
        int wgid = (int)L; { const int q = nwg / NXCD, r = nwg % NXCD, xcd = wgid % NXCD, off = wgid / NXCD; wgid = (xcd < r ? xcd * (q + 1) : r * (q + 1) + (xcd - r) * q) + off; }
        const int nig = WGM * nN, gid = wgid / nig, fm = gid * WGM, gsz = (nM - fm) < WGM ? (nM - fm) : WGM;
        u.pm = fm + ((wgid % nig) % gsz); u.pn = (wgid % nig) / gsz; return true;
    }
    __device__ __forceinline__ void a_ready(const Unit&) const {}
    __device__ __forceinline__ void done(const Unit&) const {}
};

__device__ __forceinline__ unsigned cvt_pk_bf16(float lo, float hi) { unsigned r; asm volatile("v_cvt_pk_bf16_f32 %0, %1, %2" : "=v"(r) : "v"(lo), "v"(hi)); return r; }
template <class Epi, class Sched, bool ALIGN_EPI = false, bool SP2 = false>
__device__ __forceinline__ void gemm_phase(PG8_LAS unsigned char* lds, const Gemm g, const Sched& S, const Epi& E) {
    const int tid = threadIdx.x, wid = __builtin_amdgcn_readfirstlane(tid >> 6), lane = tid & 63, wr = wid >> 2, wc = wid & 3, fr = lane & 15, fq = lane >> 4;
    const int K = g.K, nt = K / BK;
    unsigned voffA[2], voffB[2];
#pragma unroll
    for (int i = 0; i < 2; ++i) { int R, C; stage_rc(tid * 16 + i * 8192, R, C); const int Rb = Epi::PERM ? ((R & ~31) + perm32(R & 31)) : R;
        voffA[i] = (unsigned)(R * K + C) * 2u; voffB[i] = (unsigned)(Rb * K + C) * 2u; }
    const size_t kstep = (size_t)(BK * 2);
    const size_t hstep = (size_t)HALF * K * 2;
    const size_t tstep = 2 * hstep;
    const unsigned ldsw = (unsigned)wid * 1024u;
    const int aoff = lds_byte(wr * 64 + fr, fq * 8), boff = lds_byte(wc * 32 + fr, fq * 8);
#define PG8_SA(b, h) (((b) * 2 + (h)) * HTB)
#define PG8_SB(b, h) ((4 + (b) * 2 + (h)) * HTB)
#define PG8_STAGE(bufoff, gbase, voff) do { _Pragma("unroll") for (int _i = 0; _i < 2; ++_i) \
        __builtin_amdgcn_global_load_lds((const unsigned*)((const char*)(gbase) + (voff)[_i]), (PG8_LAS unsigned*)(lds + (bufoff) + ldsw + _i * 8192), 16, 0, 0); } while (0)
#define PG8_LDA(dst, b, h) do { _Pragma("unroll") for (int m = 0; m < 4; ++m) _Pragma("unroll") for (int k = 0; k < 2; ++k) dst[m][k] = *(const PG8_LAS bf16x8*)(lds + PG8_SA(b, h) + aoff + m * 2048 + k * 1024); } while (0)
#define PG8_LDB(dst, b, h) do { _Pragma("unroll") for (int n = 0; n < 2; ++n) _Pragma("unroll") for (int k = 0; k < 2; ++k) dst[n][k] = *(const PG8_LAS bf16x8*)(lds + PG8_SB(b, h) + boff + n * 2048 + k * 1024); } while (0)
#define PG8_MMA(ai, bj, At, Bt) do { __builtin_amdgcn_s_setprio(1); _Pragma("unroll") for (int m = 0; m < 4; ++m) _Pragma("unroll") for (int n = 0; n < 2; ++n) _Pragma("unroll") for (int k = 0; k < 2; ++k) \
        acc[ai][bj][m][n] = __builtin_amdgcn_mfma_f32_16x16x32_bf16(Bt[n][k], At[m][k], acc[ai][bj][m][n], 0, 0, 0); __builtin_amdgcn_s_setprio(0); } while (0)
#define PG8_WAIT_V(n) asm volatile("s_waitcnt vmcnt(" #n ")" ::: "memory")
#define PG8_WAIT_L(n) asm volatile("s_waitcnt lgkmcnt(" #n ")" ::: "memory")
#define PG8_BAR __builtin_amdgcn_s_barrier()
#define PG8_SCHED __builtin_amdgcn_sched_barrier(0)
    Unit cur, nxt; int ui = 0;
    if (!S.next(0, cur)) return;
    f32x4 acc[2][2][4][2];
#pragma unroll
    for (int a = 0; a < 2; ++a)
#pragma unroll
        for (int b = 0; b < 2; ++b)
#pragma unroll
            for (int m = 0; m < 4; ++m)
#pragma unroll
                for (int n = 0; n < 2; ++n) acc[a][b][m][n] = (f32x4){0.f, 0.f, 0.f, 0.f};
    bf16x8 At[4][2], B0[2][2], B1[2][2];
    const char* cA = (const char*)g.A + (size_t)cur.pm * tstep; const char* cB = (const char*)g.Bt + (size_t)cur.pn * tstep;
    S.a_ready(cur);
    if constexpr (SP2) {
        PG8_STAGE(PG8_SB(0, 0), cB, voffB); PG8_STAGE(PG8_SB(0, 1), cB + hstep, voffB); PG8_STAGE(PG8_SA(0, 0), cA, voffA); PG8_STAGE(PG8_SA(0, 1), cA + hstep, voffA);
        if (wr == 1) PG8_BAR;
        PG8_WAIT_V(2); PG8_BAR;
        PG8_STAGE(PG8_SB(1, 0), cB + kstep, voffB); PG8_STAGE(PG8_SA(1, 0), cA + kstep, voffA); PG8_STAGE(PG8_SB(1, 1), cB + hstep + kstep, voffB);
        PG8_WAIT_V(6); PG8_BAR;
    } else {
        PG8_STAGE(PG8_SB(0, 0), cB, voffB); PG8_STAGE(PG8_SA(0, 0), cA, voffA); PG8_STAGE(PG8_SB(0, 1), cB + hstep, voffB); PG8_STAGE(PG8_SA(0, 1), cA + hstep, voffA);
        if (wr == 1) PG8_BAR;
        PG8_WAIT_V(4); PG8_BAR;
        PG8_STAGE(PG8_SB(1, 0), cB + kstep, voffB); PG8_STAGE(PG8_SA(1, 0), cA + kstep, voffA); PG8_STAGE(PG8_SB(1, 1), cB + hstep + kstep, voffB);
        PG8_WAIT_V(6); PG8_BAR;
    }
    for (;;) {
        const bool has_next = S.next(ui + 1, nxt);
        const char* nA = has_next ? (const char*)g.A + (size_t)nxt.pm * tstep : cA; const char* nB = has_next ? (const char*)g.Bt + (size_t)nxt.pn * tstep : cB;
        for (int t = 0; t < nt; t += 2) {
            const bool last = (t == nt - 2);
            const char* a1 = cA + (size_t)(t + 1) * kstep;
            const char* a2 = last ? nA : cA + (size_t)(t + 2) * kstep; const char* b2 = last ? nB : cB + (size_t)(t + 2) * kstep;
            const char* a3 = a2 + kstep; const char* b3 = b2 + kstep;
            if (last && has_next) S.a_ready(nxt);
            if constexpr (SP2) {
            PG8_LDB(B0, 0, 0); PG8_LDB(B1, 0, 1); PG8_SCHED; PG8_LDA(At, 0, 0); PG8_STAGE(PG8_SA(1, 1), a1 + hstep, voffA);
            PG8_WAIT_V(8); PG8_WAIT_L(0); PG8_BAR; PG8_MMA(0, 0, At, B0); PG8_MMA(0, 1, At, B1); PG8_BAR; PG8_SCHED;
            PG8_LDA(At, 0, 1); PG8_STAGE(PG8_SB(0, 0), b2, voffB); PG8_STAGE(PG8_SB(0, 1), b2 + hstep, voffB); PG8_STAGE(PG8_SA(0, 0), a2, voffA);
            PG8_WAIT_V(8); PG8_WAIT_L(0); PG8_BAR; PG8_MMA(1, 0, At, B0); PG8_MMA(1, 1, At, B1); PG8_BAR; PG8_SCHED;
            PG8_LDB(B0, 1, 0); PG8_LDB(B1, 1, 1); PG8_SCHED; PG8_LDA(At, 1, 0); PG8_STAGE(PG8_SA(0, 1), a2 + hstep, voffA);
            PG8_WAIT_V(8); PG8_WAIT_L(0); PG8_BAR; PG8_MMA(0, 0, At, B0); PG8_MMA(0, 1, At, B1); PG8_BAR; PG8_SCHED;
            PG8_LDA(At, 1, 1); PG8_STAGE(PG8_SB(1, 0), b3, voffB); PG8_STAGE(PG8_SB(1, 1), b3 + hstep, voffB); PG8_STAGE(PG8_SA(1, 0), a3, voffA);
            PG8_WAIT_V(8); PG8_WAIT_L(0); PG8_BAR; PG8_MMA(1, 0, At, B0); PG8_MMA(1, 1, At, B1); PG8_BAR; PG8_SCHED;
            } else {
            PG8_LDB(B0, 0, 0); PG8_SCHED; PG8_LDA(At, 0, 0); PG8_STAGE(PG8_SA(1, 1), a1 + hstep, voffA);
            PG8_WAIT_L(8); PG8_BAR; PG8_WAIT_L(0); PG8_MMA(0, 0, At, B0); PG8_BAR; PG8_SCHED;
            PG8_LDB(B1, 0, 1); PG8_STAGE(PG8_SB(0, 0), b2, voffB);
            PG8_BAR; PG8_WAIT_L(0); PG8_MMA(0, 1, At, B1); PG8_BAR;
            PG8_LDA(At, 0, 1); PG8_STAGE(PG8_SA(0, 0), a2, voffA);
            PG8_BAR; PG8_WAIT_L(0); PG8_MMA(1, 0, At, B0); PG8_BAR; PG8_SCHED;
            PG8_STAGE(PG8_SB(0, 1), b2 + hstep, voffB);
            PG8_WAIT_V(6); PG8_BAR; PG8_MMA(1, 1, At, B1); PG8_BAR;
            PG8_LDB(B0, 1, 0); PG8_SCHED; PG8_LDA(At, 1, 0); PG8_STAGE(PG8_SA(0, 1), a2 + hstep, voffA);
            PG8_WAIT_L(8); PG8_BAR; PG8_WAIT_L(0); PG8_MMA(0, 0, At, B0); PG8_BAR; PG8_SCHED;
            PG8_LDB(B1, 1, 1); PG8_STAGE(PG8_SB(1, 0), b3, voffB);
            PG8_BAR; PG8_WAIT_L(0); PG8_MMA(0, 1, At, B1); PG8_BAR;
            PG8_LDA(At, 1, 1); PG8_STAGE(PG8_SA(1, 0), a3, voffA);
            PG8_BAR; PG8_WAIT_L(0); PG8_MMA(1, 0, At, B0); PG8_BAR; PG8_SCHED;
            PG8_STAGE(PG8_SB(1, 1), b3 + hstep, voffB);
            PG8_WAIT_V(6); PG8_BAR; PG8_MMA(1, 1, At, B1); PG8_BAR;
            }
        }
        if constexpr (ALIGN_EPI) { if (wr == 0) PG8_BAR; }
        if constexpr (!Epi::AFTER_DRAIN) { E(acc, cur, wr, wc, fr, fq); S.done(cur); }
        if (!has_next) break;
#pragma unroll
        for (int a = 0; a < 2; ++a)
#pragma unroll
            for (int b = 0; b < 2; ++b)
#pragma unroll
                for (int m = 0; m < 4; ++m)
#pragma unroll
                    for (int n = 0; n < 2; ++n) acc[a][b][m][n] = (f32x4){0.f, 0.f, 0.f, 0.f};
        cur = nxt; cA = nA; cB = nB; ++ui;
        if constexpr (ALIGN_EPI) { if (wr == 1) PG8_BAR; }
    }
    PG8_WAIT_V(0);
    if constexpr (!ALIGN_EPI) { if (wr == 0) PG8_BAR; }
    PG8_BAR;
    if constexpr (Epi::AFTER_DRAIN) { E.fused(acc, cur, wr, wc, fr, fq, lds, wid, lane); S.done(cur); }
#undef PG8_SA
#undef PG8_SB
#undef PG8_STAGE
#undef PG8_LDA
#undef PG8_LDB
#undef PG8_MMA
#undef PG8_WAIT_V
#undef PG8_WAIT_L
#undef PG8_BAR
#undef PG8_SCHED
}
}
#define XB_TMO      128
#define XB_XCNT(j)  (256  + 64 * (j))
#define XB_XSUB(j)  (1280 + 64 * (j))
#define XB_XGEN(j)  (2304 + 64 * (j))
#define XB_TOP      3328
#define XB_TOPGEN   3392
#define XCD_BAR_WORDS 3456
#define XB_SPIN_CAP (1u << 18)
#define LAS __attribute__((address_space(3)))

__device__ __forceinline__ unsigned xb_ld(unsigned* p)              { return __hip_atomic_load(p, __ATOMIC_RELAXED, __HIP_MEMORY_SCOPE_AGENT); }
__device__ __forceinline__ unsigned xb_add(unsigned* p, unsigned v) { return __hip_atomic_fetch_add(p, v, __ATOMIC_RELAXED, __HIP_MEMORY_SCOPE_AGENT); }
__device__ __forceinline__ unsigned xb_xcc_id() { return (unsigned)__builtin_amdgcn_s_getreg((3 << 11) | 20) & 0xFu; }
#define XB_SPIN(cond, bar) do { unsigned _sp = 0; while (cond) { __builtin_amdgcn_s_sleep(1); \
    if ((++_sp & 255u) == 0u) { if (xb_ld(&(bar)[XB_TMO])) break; if (_sp > XB_SPIN_CAP) { atomicAdd(&(bar)[XB_TMO], 1u); break; } } } } while (0)

struct XcdBarrier {
    unsigned* bar; unsigned x;
    volatile LAS unsigned* st;
};

__device__ __forceinline__ XcdBarrier xcd_barrier_post(unsigned* bar, volatile LAS unsigned* st) {
    XcdBarrier b; b.bar = bar; b.x = xb_xcc_id(); b.st = st;
    if (threadIdx.x == 0) (void)xb_add(&bar[XB_XCNT(b.x)], 1u);
    return b;
}
__device__ __forceinline__ void xcd_barrier_complete(unsigned* bar, unsigned x, unsigned& nloc, unsigned& nx) {
    const unsigned G = gridDim.x * gridDim.y * gridDim.z;
    unsigned sum, cnt, mine, sp = 0u;
    for (;;) {
        sum = 0u; cnt = 0u; mine = 0u;
#pragma unroll
        for (unsigned j = 0; j < 16; ++j) { const unsigned c = xb_ld(&bar[XB_XCNT(j)]); sum += c; cnt += (c > 0u) ? 1u : 0u; mine = (j == x) ? c : mine; }
        if (sum == G) break;
        __builtin_amdgcn_s_sleep(1);
        if ((++sp & 255u) == 0u) { if (xb_ld(&bar[XB_TMO])) break; if (sp > XB_SPIN_CAP) { atomicAdd(&bar[XB_TMO], 1u); break; } }
    }
    nloc = mine > 0u ? mine : 1u; nx = cnt > 0u ? cnt : 1u;
}

__device__ __forceinline__ void xcd_barrier(const XcdBarrier& b) {
    asm volatile("s_waitcnt vmcnt(0)" ::: "memory");
    __syncthreads();
    if (threadIdx.x == 0) {
        unsigned* bar = b.bar;
        __builtin_amdgcn_s_waitcnt(0);
        unsigned nloc = b.st[0], nx = b.st[1];
        if (nloc == 0u) { xcd_barrier_complete(bar, b.x, nloc, nx); b.st[0] = nloc; b.st[1] = nx; }
        const unsigned old = xb_add(&bar[XB_XSUB(b.x)], 1u);
        const unsigned gen = old / nloc;
        if (old + 1u == (gen + 1u) * nloc) {
            __builtin_amdgcn_fence(__ATOMIC_RELEASE, "agent");
            asm volatile("s_waitcnt vmcnt(0)" ::: "memory");
            const unsigned og = xb_add(&bar[XB_TOP], 1u);
            const unsigned tg = og / nx;
            if (og + 1u == (tg + 1u) * nx) xb_add(&bar[XB_TOPGEN], 1u);
            else XB_SPIN(xb_ld(&bar[XB_TOPGEN]) == tg, bar);
            __builtin_amdgcn_fence(__ATOMIC_ACQUIRE, "agent");
            xb_add(&bar[XB_XGEN(b.x)], 1u);
            asm volatile("s_waitcnt vmcnt(0)" ::: "memory");
        } else {
            XB_SPIN(xb_ld(&bar[XB_XGEN(b.x)]) == gen, bar);
            __builtin_amdgcn_fence(__ATOMIC_ACQUIRE, "agent");
            asm volatile("s_waitcnt vmcnt(0)" ::: "memory");
        }
    }
    __syncthreads();
}
constexpr int MP = 16384, MS = 32, MR = MP + MS, MPAD = 16640;
constexpr int SEQ = 2048, NB = 8, NH = 8, DM = 1024;
constexpr int QKVW = 3072, NIN = 7424;
constexpr int PAST = 16384, NPAGE = 128, PAGE = 128, LATW = 576;
constexpr float EPS = 1e-6f;
constexpr float MLA_SCALE = 0.07216878364870322f;

constexpr size_t O_YP = 0, O_YS = O_YP + (size_t)MP * 1024, O_ROWSP = O_YS + 32 * 1024, O_GSP = O_ROWSP + (size_t)MP * 576,
                 O_CSP = O_GSP + 8 * 8 * 128 * 128, O_ROWSS = O_CSP + 8 * 3 * 3072, O_GSS = O_ROWSS + 32 * 576, O_CSS = O_GSS + (size_t)32 * 8 * 128 * 128;

constexpr size_t WS_CTL = 0, CTL_BYTES = 3u << 20;
constexpr size_t WS_WIN = CTL_BYTES;
constexpr size_t WS_WQ  = WS_WIN + (size_t)NIN * 1024 * 2;
constexpr size_t WS_WKV = WS_WQ + (size_t)1536 * 512 * 2;
constexpr size_t WS_WYA = WS_WKV + (size_t)2048 * 512 * 2;
constexpr size_t WS_WYB = WS_WYA + (size_t)1024 * 1024 * 2;
constexpr size_t WS_WO  = WS_WYB + (size_t)1024 * 1024 * 2;
constexpr size_t WS_WUP = WS_WO + (size_t)1024 * 1024 * 2;
constexpr size_t WS_WDN = WS_WUP + (size_t)4096 * 1024 * 2;
constexpr size_t WS_XN  = WS_WDN + (size_t)4096 * 1024 * 2;
constexpr size_t WS_QKV = WS_XN + (size_t)MPAD * 1024 * 2;
constexpr size_t WS_Z   = WS_QKV + (size_t)MPAD * 3072 * 2;
constexpr size_t WS_QD  = WS_Z + (size_t)MPAD * 1024 * 2;
constexpr size_t WS_KVD = WS_QD + (size_t)MPAD * 512 * 2;
constexpr size_t WS_SM  = WS_KVD + (size_t)MPAD * 512 * 2;
constexpr size_t WS_GATES = WS_SM + (size_t)MPAD * 128 * 4;
constexpr size_t WS_C   = WS_GATES + (size_t)MPAD * 2048 * 2;
constexpr size_t WS_KR  = WS_C + (size_t)MPAD * 512 * 2;
constexpr size_t WS_BETA = WS_KR + (size_t)MPAD * 64 * 2;
constexpr size_t WS_GLOG = WS_BETA + (size_t)MPAD * 8 * 4;
constexpr size_t WS_QP  = WS_GLOG + (size_t)MPAD * 8 * 4;
constexpr size_t WS_QP2 = WS_QP + (size_t)MPAD * 1536 * 2;
constexpr size_t WS_KN  = WS_QP2 + (size_t)MPAD * 1536 * 2;
constexpr size_t WS_V   = WS_KN + (size_t)MPAD * 1024 * 2;
constexpr size_t WS_YA  = WS_V + (size_t)MPAD * 1024 * 2;
constexpr size_t WS_YB  = WS_YA + (size_t)MPAD * 1024 * 2;
constexpr size_t WS_TF  = WS_YB + (size_t)MPAD * 1024 * 2;
constexpr size_t WS_T   = WS_TF + (size_t)MPAD * 1024 * 4;
constexpr size_t WS_X1  = WS_T + (size_t)MPAD * 1024 * 2;
constexpr size_t WS_XN2 = WS_X1 + (size_t)MPAD * 1024 * 4;
constexpr size_t WS_RX = WS_CTL + (256u << 10);
constexpr size_t WS_SQN = WS_CTL + (512u << 10);
constexpr size_t WS_SQR = WS_CTL + (1280u << 10);
constexpr size_t WS_SKN = WS_CTL + (2048u << 10);
constexpr size_t WS_H   = WS_XN2 + (size_t)MPAD * 1024 * 2;
constexpr size_t WS_GU0 = WS_H + (size_t)MPAD * 4096 * 2;
constexpr size_t WS_GW  = WS_GU0 + (size_t)2048 * 64 * 128 * 4;
constexpr size_t WS_GQG = WS_GW + (size_t)2048 * 64 * 128 * 2;
constexpr size_t WS_GKD = WS_GQG + (size_t)2048 * 64 * 128 * 2;
constexpr size_t WS_GAQK = WS_GKD + (size_t)2048 * 64 * 128 * 2;
constexpr size_t WS_GEND = WS_GAQK + (size_t)2048 * 64 * 64 * 2;
constexpr size_t WS_DML = WS_GEND + (size_t)2048 * 4 * 64;
constexpr size_t WS_DACC = WS_DML + (size_t)4096 * 8 * 2 * 4;
constexpr size_t WS_WKT = WS_DACC + (size_t)4096 * 8 * 512 * 4;
constexpr size_t WS_END = WS_WKT + (size_t)1024 * 512 * 2;

constexpr int LDS_BYTES = 163840;
constexpr int MISC_OFF = LDS_BYTES - 128;

#define GAS __attribute__((address_space(1)))
typedef unsigned short bf16;
typedef unsigned v4u __attribute__((ext_vector_type(4)));
typedef unsigned v2u __attribute__((ext_vector_type(2)));
typedef float f32x4 __attribute__((ext_vector_type(4)));
typedef float f32x16 __attribute__((ext_vector_type(16)));
typedef short bf16x8 __attribute__((ext_vector_type(8)));
#define LDS_WAIT() asm volatile("s_waitcnt lgkmcnt(0)" ::: "memory")
#define VM_WAIT() asm volatile("s_waitcnt vmcnt(0)" ::: "memory")
#define LBAR() asm volatile("s_waitcnt lgkmcnt(0)\n\ts_barrier" ::: "memory")
__device__ __forceinline__ float bf2f(unsigned b) { return __builtin_bit_cast(float, b << 16); }
typedef float f32x2_t __attribute__((ext_vector_type(2)));
typedef __bf16 bf16x2_t __attribute__((ext_vector_type(2)));
__device__ __forceinline__ unsigned pk2(float lo, float hi) { const f32x2_t v = {lo, hi}; const bf16x2_t b = __builtin_convertvector(v, bf16x2_t); return __builtin_bit_cast(unsigned, b); }
__device__ __forceinline__ unsigned f2bf(float f) { return pk2(f, 0.f) & 0xffffu; }
__device__ __forceinline__ float lo16(unsigned w) { return __builtin_bit_cast(float, w << 16); }
__device__ __forceinline__ float hi16(unsigned w) { return __builtin_bit_cast(float, w & 0xffff0000u); }
__device__ __forceinline__ float wave_sum(float v) {
#pragma unroll
    for (int o = 1; o < 64; o <<= 1) v += __shfl_xor(v, o);
    return v;
}
__device__ __forceinline__ float wave_max(float v) {
#pragma unroll
    for (int o = 1; o < 64; o <<= 1) v = fmaxf(v, __shfl_xor(v, o));
    return v;
}
__device__ __forceinline__ float sigmoidf_(float x) { return __builtin_amdgcn_rcpf(1.f + __expf(-x)); }
__device__ __forceinline__ float siluf_(float x) { return x * __builtin_amdgcn_rcpf(1.f + __expf(-x)); }

__constant__ float ROPE_INV[32] = {1.000000000e+00f,7.498942614e-01f,5.623413324e-01f,4.216965139e-01f,3.162277639e-01f,2.371373773e-01f,1.778279394e-01f,1.333521307e-01f,
    1.000000015e-01f,7.498941571e-02f,5.623413250e-02f,4.216965288e-02f,3.162277490e-02f,2.371373773e-02f,1.778279431e-02f,1.333521493e-02f,
    9.999999776e-03f,7.498941850e-03f,5.623413250e-03f,4.216964822e-03f,3.162277630e-03f,2.371373586e-03f,1.778279431e-03f,1.333521446e-03f,
    1.000000047e-03f,7.498942432e-04f,5.623413017e-04f,4.216965172e-04f,3.162277571e-04f,2.371373703e-04f,1.778279402e-04f,1.333521504e-04f};

struct Args { const float* in[27]; float* out; unsigned char* ws; int ph_lo, ph_hi; };
enum { I_XP = 0, I_XS, I_CACHE, I_SGDN, I_SCONV, I_PT, I_NMIX, I_WIN, I_CONVW, I_ALOG, I_DTB, I_GDNN, I_QAN, I_WUQ, I_KVAN, I_WUK, I_WUV,
       I_QNN, I_QNR, I_KNN, I_KNR, I_WYA, I_WYB, I_WO, I_NMLP, I_WUP, I_WDN };

__device__ __forceinline__ int src_col(int mode, int n) {
    if (mode == 0) {
        if (n < 4096) return n;
        if (n < 5184) return n + 16;
        if (n < 5200) return n - 5184 + 4096;
        if (n < 5376) return -1;
        return n - 5376 + 5200;
    }
    if (mode == 1) {
        if (n < 1024) return (n >> 7) * 192 + (n & 127);
        const int m = n - 1024; return (m >> 6) * 192 + 128 + (m & 63);
    }
    return n;
}
__device__ __forceinline__ void cvt_item(const float* W, int N, int K, bf16* WT, int row_off, int mode, LAS float* scr, int item, int nblk, int lane, const float* kscale = nullptr) {
    const int kb = item / nblk, nb = item % nblk, k0 = 64 * kb, n0 = 32 * nb;
    const int sc = src_col(mode, n0 + (lane & 31));
#pragma unroll
    for (int i = 0; i < 32; ++i) { const int kk = 2 * i + (lane >> 5); scr[kk * 33 + (lane & 31)] = sc >= 0 ? W[(size_t)(k0 + kk) * N + sc] * (kscale ? kscale[k0 + kk] : 1.f) : 0.f; }
    LDS_WAIT(); asm volatile("" ::: "memory");
    const int c = lane & 7;
#pragma unroll
    for (int j = 0; j < 4; ++j) { const int n = (lane >> 3) + 8 * j; const LAS float* s = scr + (8 * c) * 33 + n;
        v4u o; o.x = pk2(s[0 * 33], s[1 * 33]); o.y = pk2(s[2 * 33], s[3 * 33]); o.z = pk2(s[4 * 33], s[5 * 33]); o.w = pk2(s[6 * 33], s[7 * 33]);
        *(v4u*)(WT + (size_t)(row_off + n0 + n) * K + k0 + 8 * c) = o; }
    LDS_WAIT(); asm volatile("" ::: "memory");
}
__device__ __forceinline__ void rms_row_finish(const f32x4 (&v)[4], const float* gain, bf16* orow, int lane) {
    const f32x4* gr = (const f32x4*)gain + lane; float s = 0.f;
#pragma unroll
    for (int j = 0; j < 4; ++j) s += (v[j].x * v[j].x + v[j].y * v[j].y) + (v[j].z * v[j].z + v[j].w * v[j].w);
    const float r = 1.f / sqrtf(wave_sum(s) * (1.f / 1024.f) + EPS);
    unsigned long long* o8 = (unsigned long long*)orow + lane;
#pragma unroll
    for (int j = 0; j < 4; ++j) { const f32x4 g = gr[64 * j];
        o8[64 * j] = (unsigned long long)pk2(v[j].x * r * g.x, v[j].y * r * g.y) | ((unsigned long long)pk2(v[j].z * r * g.z, v[j].w * r * g.w) << 32); }
}
template <bool LATE> __device__ __forceinline__ void cvt_weights(const Args& A, LAS unsigned char* lds, int gw, int NGW, int wave, int lane) {
    LAS float* scr = (LAS float*)(lds + wave * 16384);
    unsigned char* ws = A.ws;
    constexpr int I0 = 16 * (NIN / 32), I1 = 8 * (1536 / 32), I2 = 8 * 32, I3 = 8 * 32, I4 = 16 * 32, I5 = I4, I6 = I4, I7 = 16 * 128, I8 = 64 * 32;
    if (!LATE) {
        for (int it = gw; it < I0 + I1 + I2 + I3; it += NGW) {
            int r = it;
            if (r < I0) { cvt_item(A.in[I_WIN], 7248, 1024, (bf16*)(ws + WS_WIN), 0, 0, scr, r, NIN / 32, lane); continue; } r -= I0;
            if (r < I1) { cvt_item(A.in[I_WUQ], 1536, 512, (bf16*)(ws + WS_WQ), 0, 1, scr, r, 1536 / 32, lane); continue; } r -= I1;
            if (r < I2) { cvt_item(A.in[I_WUK], 1024, 512, (bf16*)(ws + WS_WKV), 0, 2, scr, r, 32, lane); continue; } r -= I2;
            cvt_item(A.in[I_WUV], 1024, 512, (bf16*)(ws + WS_WKV), 1024, 2, scr, r, 32, lane);
        }
    } else {
        for (int it = gw; it < I4 + I5 + I6 + I7 + I8; it += NGW) {
            int r = it;
            if (r < I4) { cvt_item(A.in[I_WYA], 1024, 1024, (bf16*)(ws + WS_WYA), 0, 2, scr, r, 32, lane); continue; } r -= I4;
            if (r < I5) { cvt_item(A.in[I_WYB], 1024, 1024, (bf16*)(ws + WS_WYB), 0, 2, scr, r, 32, lane); continue; } r -= I5;
            if (r < I6) { cvt_item(A.in[I_WO], 1024, 1024, (bf16*)(ws + WS_WO), 0, 2, scr, r, 32, lane); continue; } r -= I6;
            if (r < I7) { cvt_item(A.in[I_WUP], 4096, 1024, (bf16*)(ws + WS_WUP), 0, 2, scr, r, 128, lane, A.in[I_NMLP]); continue; } r -= I7;
            cvt_item(A.in[I_WDN], 1024, 4096, (bf16*)(ws + WS_WDN), 0, 2, scr, r, 32, lane);
        }
    }
}
__device__ __forceinline__ void p0_prologue(const Args& A, LAS unsigned char* lds, int gw, int NGW, int wave, int lane) {
    unsigned char* ws = A.ws;
    cvt_weights<false>(A, lds, gw, NGW, wave, lane);
    bf16* XN = (bf16*)(ws + WS_XN);
#define XROW(m_) ((m_) < MP ? A.in[I_XP] + (size_t)(m_) * 1024 : A.in[I_XS] + (size_t)((m_) - MP) * 1024)
    f32x4 v[4], vn[4];
    if (gw < MR) {
#pragma unroll
        for (int j = 0; j < 4; ++j) v[j] = ((const f32x4*)XROW(gw) + lane)[64 * j]; }
    for (int m = gw; m < MPAD; m += NGW) {
        const int mn = m + NGW;
        if (mn < MR) {
#pragma unroll
            for (int j = 0; j < 4; ++j) vn[j] = ((const f32x4*)XROW(mn) + lane)[64 * j]; }
        if (m < MR) rms_row_finish(v, A.in[I_NMIX], XN + (size_t)m * 1024, lane);
        else { v4u z = {0u, 0u, 0u, 0u}; *((v4u*)(XN + (size_t)m * 1024) + lane) = z; *((v4u*)(XN + (size_t)m * 1024) + 64 + lane) = z; }
#pragma unroll
        for (int j = 0; j < 4; ++j) v[j] = vn[j];
    }
#undef XROW
}

struct EpiG1 {
    static constexpr bool PERM = true, AFTER_DRAIN = false;
    bf16 *QKV, *Z, *QD, *KVD, *GATES; float* SM;
    __device__ __forceinline__ void operator()(const pg8::f32x4 (&acc)[2][2][4][2], const pg8::Unit& u, int wr, int wc, int fr, int fq) const {
        const int row0 = u.pm * 256 + wr * 64 + fr, pn = u.pn, cl = wc * 32 + 8 * fq;
        if (pn == 20) {
#pragma unroll
            for (int ai = 0; ai < 2; ++ai)
#pragma unroll
                for (int m = 0; m < 4; ++m) { float* rowp = SM + (size_t)(row0 + ai * 128 + m * 16) * 128 + cl;
                    *(pg8::f32x4*)rowp = acc[ai][0][m][0]; *(pg8::f32x4*)(rowp + 4) = acc[ai][0][m][1]; }
            return;
        }
        bf16* base; int ld; bool sg = false;
        if (pn < 12) { base = QKV + pn * 256; ld = 3072; }
        else if (pn < 16) { base = Z + (pn - 12) * 256; ld = 1024; }
        else if (pn < 18) { base = QD + (pn - 16) * 256; ld = 512; }
        else if (pn < 20) { base = KVD + (pn - 18) * 256; ld = 512; }
        else { base = GATES + (pn - 21) * 256; ld = 2048; sg = true; }
#pragma unroll
        for (int ai = 0; ai < 2; ++ai)
#pragma unroll
            for (int m = 0; m < 4; ++m) { bf16* rowp = base + (size_t)(row0 + ai * 128 + m * 16) * ld + cl;
#pragma unroll
                for (int bj = 0; bj < 2; ++bj) { pg8::f32x4 v0 = acc[ai][bj][m][0], v1 = acc[ai][bj][m][1];
                    if (sg) { v0 = (pg8::f32x4){sigmoidf_(v0[0]), sigmoidf_(v0[1]), sigmoidf_(v0[2]), sigmoidf_(v0[3])}; v1 = (pg8::f32x4){sigmoidf_(v1[0]), sigmoidf_(v1[1]), sigmoidf_(v1[2]), sigmoidf_(v1[3])}; }
                    pg8::u32x4 w; w.x = pk2(v0[0], v0[1]); w.y = pk2(v0[2], v0[3]); w.z = pk2(v1[0], v1[1]); w.w = pk2(v1[2], v1[3]);
                    *(pg8::u32x4*)(rowp + bj * 128) = w; } }
    }
};

__device__ __forceinline__ void p2_rows(const Args& A, int gw, int NGW, int lane) {
    unsigned char* ws = A.ws;
    bf16* QD = (bf16*)(ws + WS_QD); const bf16* KVD = (const bf16*)(ws + WS_KVD); const float* SM = (const float*)(ws + WS_SM);
    bf16* C = (bf16*)(ws + WS_C); bf16* KR = (bf16*)(ws + WS_KR); float* BETA = (float*)(ws + WS_BETA); float* GLOG = (float*)(ws + WS_GLOG);
    v4u wq = {0u, 0u, 0u, 0u}, wk = wq, wqn = wq, wkn = wq; float xs = 0.f, xb = 0.f, xa = 0.f, xsn = 0.f, xbn = 0.f, xan = 0.f;
    if (gw < MR) { wq = *((const v4u*)(QD + (size_t)gw * 512) + lane); wk = *((const v4u*)(KVD + (size_t)gw * 512) + lane); xs = SM[(size_t)gw * 128 + lane];
        if (lane < 8) { xb = SM[(size_t)gw * 128 + 64 + lane]; xa = SM[(size_t)gw * 128 + 72 + lane]; } }
    for (int m = gw; m < MR; m += NGW) {
        const int mn = m + NGW;
        if (mn < MR) { wqn = *((const v4u*)(QD + (size_t)mn * 512) + lane); wkn = *((const v4u*)(KVD + (size_t)mn * 512) + lane); xsn = SM[(size_t)mn * 128 + lane];
            if (lane < 8) { xbn = SM[(size_t)mn * 128 + 64 + lane]; xan = SM[(size_t)mn * 128 + 72 + lane]; } }
        const int pos = m < MP ? (m & (SEQ - 1)) : PAST;
        float* lat = m < MP ? A.out + O_ROWSP + (size_t)m * LATW : A.out + O_ROWSS + (size_t)(m - MP) * LATW;
        {
            v4u w = wq;
            float v[8] = {lo16(w.x), hi16(w.x), lo16(w.y), hi16(w.y), lo16(w.z), hi16(w.z), lo16(w.w), hi16(w.w)};
            float s = 0.f;
#pragma unroll
            for (int i = 0; i < 8; ++i) s += v[i] * v[i];
            const float r = 1.f / sqrtf(wave_sum(s) * (1.f / 512.f) + EPS);
            const f32x4 g0 = *((const f32x4*)A.in[I_QAN] + 2 * lane), g1 = *((const f32x4*)A.in[I_QAN] + 2 * lane + 1);
            v4u o; o.x = pk2(v[0] * r * g0.x, v[1] * r * g0.y); o.y = pk2(v[2] * r * g0.z, v[3] * r * g0.w); o.z = pk2(v[4] * r * g1.x, v[5] * r * g1.y); o.w = pk2(v[6] * r * g1.z, v[7] * r * g1.w);
            *((v4u*)(QD + (size_t)m * 512) + lane) = o;
        }
        {
            v4u w = wk;
            float v[8] = {lo16(w.x), hi16(w.x), lo16(w.y), hi16(w.y), lo16(w.z), hi16(w.z), lo16(w.w), hi16(w.w)};
            float s = 0.f;
#pragma unroll
            for (int i = 0; i < 8; ++i) s += v[i] * v[i];
            const float r = 1.f / sqrtf(wave_sum(s) * (1.f / 512.f) + EPS);
            const f32x4 g0 = *((const f32x4*)A.in[I_KVAN] + 2 * lane), g1 = *((const f32x4*)A.in[I_KVAN] + 2 * lane + 1);
            f32x4 c0 = {v[0] * r * g0.x, v[1] * r * g0.y, v[2] * r * g0.z, v[3] * r * g0.w}, c1 = {v[4] * r * g1.x, v[5] * r * g1.y, v[6] * r * g1.z, v[7] * r * g1.w};
            *((f32x4*)lat + 2 * lane) = c0; *((f32x4*)lat + 2 * lane + 1) = c1;
            v4u o; o.x = pk2(c0.x, c0.y); o.y = pk2(c0.z, c0.w); o.z = pk2(c1.x, c1.y); o.w = pk2(c1.z, c1.w);
            *((v4u*)(C + (size_t)m * 512) + lane) = o;
        }
        {
            const float x = xs;
            const float r = 1.f / sqrtf(wave_sum(x * x) * (1.f / 64.f) + EPS);
            const float xr = x * r * A.in[I_KNR][lane];
            const float other = __shfl_xor(xr, 32);
            const float ang = (float)pos * ROPE_INV[lane & 31];
            const float cs = cosf(ang), sn = sinf(ang);
            const float o = lane < 32 ? xr * cs - other * sn : other * sn + xr * cs;
            lat[512 + lane] = o;
            KR[(size_t)m * 64 + lane] = (bf16)f2bf(o);
        }
        if (lane < 8) {
            const float b = xb, a = xa;
            BETA[(size_t)m * 8 + lane] = 1.f / (1.f + expf(-b));
            const float xx = a + A.in[I_DTB][lane];
            const float sp = fmaxf(xx, 0.f) + log1pf(expf(-fabsf(xx)));
            GLOG[(size_t)m * 8 + lane] = -expf(A.in[I_ALOG][lane]) * sp;
        }
        wq = wqn; wk = wkn; xs = xsn; xb = xbn; xa = xan;
    }
}
__device__ __forceinline__ void p2_conv_state(const Args& A, int gtid, int NGT) {
    const bf16* QKV = (const bf16*)(A.ws + WS_QKV);
    {
        const bf16* WKV = (const bf16*)(A.ws + WS_WKV); bf16* WKT = (bf16*)(A.ws + WS_WKT);
        for (int c = gtid; c < 65536; c += NGT) { const int blk = c >> 6, l = c & 63, rt = blk >> 5, ks = blk & 31;
            *(v4u*)(WKT + (size_t)c * 8) = *(const v4u*)(WKV + (size_t)(rt * 32 + (l & 31)) * 512 + 16 * ks + 8 * (l >> 5)); }
    }
    for (int i = gtid; i < 8 * 3 * 3072; i += NGT) { const int c = i % 3072, r = (i / 3072) % 3, b = i / (3 * 3072);
        A.out[O_CSP + i] = bf2f(QKV[(size_t)(b * SEQ + SEQ - 3 + r) * 3072 + c]); }
    for (int i = gtid; i < 32 * 3 * 3072; i += NGT) { const int c = i % 3072, r = (i / 3072) % 3, j = i / (3 * 3072);
        A.out[O_CSS + i] = r < 2 ? A.in[I_SCONV][(size_t)(j * 3 + r + 1) * 3072 + c] : bf2f(QKV[(size_t)(MP + j) * 3072 + c]); }
}
__device__ __forceinline__ pg8::u32x4 pack8(const pg8::f32x4& v0, const pg8::f32x4& v1) {
    pg8::u32x4 w; w.x = pk2(v0[0], v0[1]); w.y = pk2(v0[2], v0[3]); w.z = pk2(v1[0], v1[1]); w.w = pk2(v1[2], v1[3]); return w;
}
template <int ACT> struct EpiStore {
    static constexpr bool PERM = true, AFTER_DRAIN = false;
    bf16* O0; int ld0; int split; bf16* O1; int ld1;
    __device__ __forceinline__ void operator()(const pg8::f32x4 (&acc)[2][2][4][2], const pg8::Unit& u, int wr, int wc, int fr, int fq) const {
        const int row0 = u.pm * 256 + wr * 64 + fr, cl = wc * 32 + 8 * fq;
        bf16* base; int ld;
        if (u.pn < split) { base = O0 + u.pn * 256; ld = ld0; } else { base = O1 + (u.pn - split) * 256; ld = ld1; }
#pragma unroll
        for (int ai = 0; ai < 2; ++ai)
#pragma unroll
            for (int m = 0; m < 4; ++m) { bf16* rowp = base + (size_t)(row0 + ai * 128 + m * 16) * ld + cl;
#pragma unroll
                for (int bj = 0; bj < 2; ++bj) { pg8::f32x4 v0 = acc[ai][bj][m][0], v1 = acc[ai][bj][m][1];
                    if (ACT == 1) {
#pragma unroll
                        for (int e = 0; e < 4; ++e) { const float a = fmaxf(v0[e], 0.f), b = fmaxf(v1[e], 0.f); v0[e] = a * a; v1[e] = b * b; } }
                    *(pg8::u32x4*)(rowp + bj * 128) = pack8(v0, v1); } }
    }
};
struct EpiUp {
    static constexpr bool PERM = true, AFTER_DRAIN = false;
    bf16* H; const float* RX;
    __device__ __forceinline__ void operator()(const pg8::f32x4 (&acc)[2][2][4][2], const pg8::Unit& u, int wr, int wc, int fr, int fq) const {
        const int row0 = u.pm * 256 + wr * 64 + fr, cl = u.pn * 256 + wc * 32 + 8 * fq;
#pragma unroll
        for (int ai = 0; ai < 2; ++ai)
#pragma unroll
            for (int m = 0; m < 4; ++m) { const int row = row0 + ai * 128 + m * 16; const float r = __builtin_amdgcn_rsqf(RX[row] * (1.f / 1024.f) + EPS);
                bf16* rowp = H + (size_t)row * 4096 + cl;
#pragma unroll
                for (int bj = 0; bj < 2; ++bj) { pg8::f32x4 v0 = acc[ai][bj][m][0], v1 = acc[ai][bj][m][1];
#pragma unroll
                    for (int e = 0; e < 4; ++e) { const float a = fmaxf(v0[e] * r, 0.f), b = fmaxf(v1[e] * r, 0.f); v0[e] = a * a; v1[e] = b * b; }
                    *(pg8::u32x4*)(rowp + bj * 128) = pack8(v0, v1); } }
    }
};
constexpr int EPI_S_OFF = 131072;
template <int KIND> struct EpiHeads {
    static constexpr bool PERM = true, AFTER_DRAIN = false;
    bf16* O0; int ld0; int split; bf16* O1; int ld1; float* SB; const float* gain; LAS float* S;
    __device__ __forceinline__ void operator()(const pg8::f32x4 (&acc)[2][2][4][2], const pg8::Unit& u, int wr, int wc, int fr, int fq) const {
        const int rl0 = wr * 64 + fr, row0 = u.pm * 256 + rl0, cl = wc * 32 + 8 * fq;
        bf16* base; int ld;
        if (u.pn < split) { base = O0 + u.pn * 256; ld = ld0; } else { base = O1 + (u.pn - split) * 256; ld = ld1; }
        if (KIND == 1 && u.pn >= 4) {
#pragma unroll
            for (int ai = 0; ai < 2; ++ai)
#pragma unroll
                for (int m = 0; m < 4; ++m) { bf16* rowp = base + (size_t)(row0 + ai * 128 + m * 16) * ld + cl;
#pragma unroll
                    for (int bj = 0; bj < 2; ++bj) *(pg8::u32x4*)(rowp + bj * 128) = pack8(acc[ai][bj][m][0], acc[ai][bj][m][1]); }
            return;
        }
        const bool rope = (KIND == 0) && (u.pn >= 4);
        if (wc == 0) {
#pragma unroll
            for (int ai = 0; ai < 2; ++ai)
#pragma unroll
                for (int m = 0; m < 4; ++m) S[(rl0 + ai * 128 + m * 16) * 4 + fq] = 0.f; }
        LBAR();
#pragma unroll
        for (int ai = 0; ai < 2; ++ai)
#pragma unroll
            for (int m = 0; m < 4; ++m)
#pragma unroll
                for (int bj = 0; bj < 2; ++bj) { const pg8::f32x4 v0 = acc[ai][bj][m][0], v1 = acc[ai][bj][m][1];
                    float s = (v0[0] * v0[0] + v0[1] * v0[1]) + (v0[2] * v0[2] + v0[3] * v0[3]) + (v1[0] * v1[0] + v1[1] * v1[1]) + (v1[2] * v1[2] + v1[3] * v1[3]);
                    s += __shfl_xor(s, 16); s += __shfl_xor(s, 32);
                    if (fq == 0) (void)__hip_atomic_fetch_add(S + (rl0 + ai * 128 + m * 16) * 4 + (rope ? 2 * bj + (wc >> 1) : bj), s, __ATOMIC_RELAXED, __HIP_MEMORY_SCOPE_WORKGROUP); }
        LBAR();
#pragma unroll
        for (int ai = 0; ai < 2; ++ai)
#pragma unroll
            for (int m = 0; m < 4; ++m) { const int rl = rl0 + ai * 128 + m * 16, row = row0 + ai * 128 + m * 16; bf16* rowp = base + (size_t)row * ld + cl;
#pragma unroll
                for (int bj = 0; bj < 2; ++bj) { pg8::f32x4 v0 = acc[ai][bj][m][0], v1 = acc[ai][bj][m][1];
                    if (!rope) { const float r = __builtin_amdgcn_rsqf(S[rl * 4 + bj] * (1.f / 128.f) + EPS); const f32x4 g0 = *(const f32x4*)(gain + cl), g1 = *(const f32x4*)(gain + cl + 4);
                        v0[0] *= r * g0.x; v0[1] *= r * g0.y; v0[2] *= r * g0.z; v0[3] *= r * g0.w; v1[0] *= r * g1.x; v1[1] *= r * g1.y; v1[2] *= r * g1.z; v1[3] *= r * g1.w; }
                    else if (fq == 0 && (wc & 1) == 0 && row < MR) SB[(size_t)row * 8 + 4 * (u.pn - 4) + 2 * bj + (wc >> 1)] = S[rl * 4 + 2 * bj + (wc >> 1)];
                    *(pg8::u32x4*)(rowp + bj * 128) = pack8(v0, v1); } }
    }
};
template <int STEP> struct EpiMerge {
    static constexpr bool PERM = true, AFTER_DRAIN = false;
    const bf16* GATES; float* TF; bf16* T;
    __device__ __forceinline__ void operator()(const pg8::f32x4 (&acc)[2][2][4][2], const pg8::Unit& u, int wr, int wc, int fr, int fq) const {
        const int row0 = u.pm * 256 + wr * 64 + fr, c0 = u.pn * 256 + wc * 32 + 8 * fq;
#pragma unroll
        for (int ai = 0; ai < 2; ++ai)
#pragma unroll
            for (int m = 0; m < 4; ++m) { const size_t row = (size_t)(row0 + ai * 128 + m * 16);
#pragma unroll
                for (int bj = 0; bj < 2; ++bj) { const int col = c0 + bj * 128;
                    const v4u gw = *(const v4u*)(GATES + row * 2048 + (STEP == 1 ? 0 : 1024) + col);
                    const float g[8] = {lo16(gw.x), hi16(gw.x), lo16(gw.y), hi16(gw.y), lo16(gw.z), hi16(gw.z), lo16(gw.w), hi16(gw.w)};
                    pg8::f32x4 v0 = acc[ai][bj][m][0], v1 = acc[ai][bj][m][1];
#pragma unroll
                    for (int e = 0; e < 4; ++e) { v0[e] *= g[e]; v1[e] *= g[4 + e]; }
                    bf16* tp = T + row * 1024 + col;
                    if (STEP == 1) *(pg8::u32x4*)tp = pack8(v0, v1);
                    else { const v4u pw = *(const v4u*)tp;
                        v0[0] += lo16(pw.x); v0[1] += hi16(pw.x); v0[2] += lo16(pw.y); v0[3] += hi16(pw.y); v1[0] += lo16(pw.z); v1[1] += hi16(pw.z); v1[2] += lo16(pw.w); v1[3] += hi16(pw.w);
                        *(pg8::u32x4*)tp = pack8(v0, v1); } } }
    }
};
template <int MODE> struct EpiRes {
    static constexpr bool PERM = true, AFTER_DRAIN = false;
    const float *XPp, *XSp; float* X1; float* out; bf16* XB; float* RX; LAS unsigned char* lds_epi;
    __device__ __forceinline__ void operator()(const pg8::f32x4 (&acc)[2][2][4][2], const pg8::Unit& u, int wr, int wc, int fr, int fq) const {
        const int row0 = u.pm * 256 + wr * 64 + fr, c0 = u.pn * 256 + wc * 32 + 8 * fq;
        float ss[2][4] = {{0.f, 0.f, 0.f, 0.f}, {0.f, 0.f, 0.f, 0.f}};
#pragma unroll
        for (int ai = 0; ai < 2; ++ai)
#pragma unroll
            for (int m = 0; m < 4; ++m) { const int row = row0 + ai * 128 + m * 16;
                if (row >= MR) continue;
#pragma unroll
                for (int bj = 0; bj < 2; ++bj) { const int col = c0 + bj * 128;
                    if (MODE == 0) {
                        const float* src = row < MP ? XPp + (size_t)row * 1024 + col : XSp + (size_t)(row - MP) * 1024 + col;
                        const pg8::f32x4 y0 = acc[ai][bj][m][0] + *(const pg8::f32x4*)src, y1 = acc[ai][bj][m][1] + *(const pg8::f32x4*)(src + 4);
                        *(pg8::u32x4*)(XB + (size_t)row * 1024 + col) = pack8(y0, y1);
                        ss[ai][m] += (y0[0] * y0[0] + y0[1] * y0[1]) + (y0[2] * y0[2] + y0[3] * y0[3]) + (y1[0] * y1[0] + y1[1] * y1[1]) + (y1[2] * y1[2] + y1[3] * y1[3]);
                    } else {
                        const v4u pw = *(const v4u*)(XB + (size_t)row * 1024 + col);
                        float* dst = row < MP ? out + O_YP + (size_t)row * 1024 + col : out + O_YS + (size_t)(row - MP) * 1024 + col;
                        pg8::f32x4 y0 = acc[ai][bj][m][0], y1 = acc[ai][bj][m][1];
                        y0[0] += lo16(pw.x); y0[1] += hi16(pw.x); y0[2] += lo16(pw.y); y0[3] += hi16(pw.y); y1[0] += lo16(pw.z); y1[1] += hi16(pw.z); y1[2] += lo16(pw.w); y1[3] += hi16(pw.w);
                        *(pg8::f32x4*)dst = y0; *(pg8::f32x4*)(dst + 4) = y1; } } }
        if (MODE == 0) {
            LAS float* S = (LAS float*)(lds_epi + EPI_S_OFF); const int rl0 = wr * 64 + fr;
            if (wc == 0 && fq == 0) {
#pragma unroll
                for (int ai = 0; ai < 2; ++ai)
#pragma unroll
                    for (int m = 0; m < 4; ++m) S[rl0 + ai * 128 + m * 16] = 0.f; }
            LBAR();
#pragma unroll
            for (int ai = 0; ai < 2; ++ai)
#pragma unroll
                for (int m = 0; m < 4; ++m) { float v = ss[ai][m]; v += __shfl_xor(v, 16); v += __shfl_xor(v, 32);
                    if (fq == 0) (void)__hip_atomic_fetch_add(S + rl0 + ai * 128 + m * 16, v, __ATOMIC_RELAXED, __HIP_MEMORY_SCOPE_WORKGROUP); }
            LBAR();
            const int t = threadIdx.x;
            if (t < 256 && u.pm * 256 + t < MR) atomicAdd(RX + u.pm * 256 + t, S[t]);
            LBAR();
        }
    }
};

#define MFMA32(a, b, c) __builtin_amdgcn_mfma_f32_32x32x16_bf16((a), (b), (c), 0, 0, 0)
__device__ __forceinline__ int crow(int r, int hi) { return (r & 3) + 8 * (r >> 2) + 4 * hi; }
__device__ __forceinline__ bf16x8 lds_ld8(LAS const unsigned char* p) { return *(LAS const bf16x8*)p; }
__device__ __forceinline__ bf16x8 gl_ld8(const bf16* p) { return *(const bf16x8*)p; }

constexpr int GA_QH = 0, GA_KH = 17408, GA_KBH = 34816, GA_VBT = 52224, GA_KBGT = 70656, GA_KDT = 89088, GA_LF = 107520, GA_TB = 123904, GA_GS = 133120, GA_BS = 133376, GA_T32 = 133632, GA_X32 = 141824;
__device__ __forceinline__ void gdn_a_unit(const Args& A, LAS unsigned char* lds, int unit, int tid, int lane, int wave) {
    unsigned char* ws = A.ws;
    const int b = unit >> 8, h = (unit >> 5) & 7, n = unit & 31;
    const int row0 = b * SEQ + n * 64;
#ifdef PROBE_K
    unsigned long long pt0 = 0, pdt = 0;
#define GPS(k) do { if ((k) == PROBE_K) pt0 = __builtin_amdgcn_s_memrealtime(); } while (0)
#define GPE(k) do { if ((k) == PROBE_K) pdt += __builtin_amdgcn_s_memrealtime() - pt0; } while (0)
#else
#define GPS(k) do {} while (0)
#define GPE(k) do {} while (0)
#endif
    GPS(74); GPS(70);
    const bf16* QKV = (const bf16*)(ws + WS_QKV);
    LAS float* Gs = (LAS float*)(lds + GA_GS); LAS float* Bs = (LAS float*)(lds + GA_BS);
    float Gend;
    {
        const int cg = tid & 15, rr = tid >> 4;
        v4u xw[3][2][4];
#pragma unroll
        for (int part = 0; part < 3; ++part)
#pragma unroll
            for (int ri = 0; ri < 2; ++ri)
#pragma unroll
                for (int tap = 0; tap < 4; ++tap) { const int tt = n * 64 + rr + 32 * ri - 3 + tap;
                    xw[part][ri][tap] = tt >= 0 ? *(const v4u*)(QKV + (size_t)(b * SEQ + tt) * 3072 + part * 1024 + h * 128 + 8 * cg) : (v4u){0u, 0u, 0u, 0u}; }
        float gx = ((const float*)(ws + WS_GLOG))[(size_t)(row0 + lane) * 8 + h];
        const float be0 = ((const float*)(ws + WS_BETA))[(size_t)(row0 + rr) * 8 + h], be1 = ((const float*)(ws + WS_BETA))[(size_t)(row0 + rr + 32) * 8 + h];
#pragma unroll
        for (int o = 1; o < 64; o <<= 1) { const float y = __shfl_up(gx, o); if (lane >= o) gx += y; }
        if (wave == 0) { Gs[lane] = gx; Bs[lane] = ((const float*)(ws + WS_BETA))[(size_t)(row0 + lane) * 8 + h]; }
        Gend = __shfl(gx, 63);
        const float Gr0 = __shfl(gx, rr), Gr1 = __shfl(gx, rr + 32);
        bf16* GQG = (bf16*)(ws + WS_GQG) + (size_t)unit * 8192;
#pragma unroll
        for (int part = 0; part < 3; ++part) {
            const int colb = part * 1024 + h * 128 + 8 * cg;
            float wgt[4][8];
#pragma unroll
            for (int tap = 0; tap < 4; ++tap) { const f32x4 w0 = *(const f32x4*)(A.in[I_CONVW] + tap * 3072 + colb), w1 = *(const f32x4*)(A.in[I_CONVW] + tap * 3072 + colb + 4);
                wgt[tap][0] = w0.x; wgt[tap][1] = w0.y; wgt[tap][2] = w0.z; wgt[tap][3] = w0.w; wgt[tap][4] = w1.x; wgt[tap][5] = w1.y; wgt[tap][6] = w1.z; wgt[tap][7] = w1.w; }
#pragma unroll
            for (int ri = 0; ri < 2; ++ri) {
                const int i = rr + 32 * ri;
                float y[8];
#pragma unroll
                for (int e = 0; e < 8; ++e) y[e] = 0.f;
#pragma unroll
                for (int tap = 0; tap < 4; ++tap) { const v4u w = xw[part][ri][tap];
                    const float x[8] = {lo16(w.x), hi16(w.x), lo16(w.y), hi16(w.y), lo16(w.z), hi16(w.z), lo16(w.w), hi16(w.w)};
#pragma unroll
                    for (int e = 0; e < 8; ++e) y[e] += wgt[tap][e] * x[e]; }
                float ss = 0.f;
#pragma unroll
                for (int e = 0; e < 8; ++e) { y[e] = siluf_(y[e]); ss += y[e] * y[e]; }
                ss += __shfl_xor(ss, 1); ss += __shfl_xor(ss, 2); ss += __shfl_xor(ss, 4); ss += __shfl_xor(ss, 8);
                const float Gi = ri ? Gr1 : Gr0;
                const float rs = 1.f / sqrtf(ss + EPS), beta = ri ? be1 : be0, eg = __expf(Gi), ed = __expf(Gend - Gi);
                if (part == 0) {
                    float q[8];
#pragma unroll
                    for (int e = 0; e < 8; ++e) q[e] = y[e] * rs * 0.08838834764831845f;
                    v4u o; o.x = pk2(q[0], q[1]); o.y = pk2(q[2], q[3]); o.z = pk2(q[4], q[5]); o.w = pk2(q[6], q[7]);
                    *(LAS v4u*)(lds + GA_QH + i * 272 + cg * 16) = o;
                    v4u g; g.x = pk2(q[0] * eg, q[1] * eg); g.y = pk2(q[2] * eg, q[3] * eg); g.z = pk2(q[4] * eg, q[5] * eg); g.w = pk2(q[6] * eg, q[7] * eg);
                    *(v4u*)(GQG + i * 128 + 8 * cg) = g;
                } else if (part == 1) {
                    float k[8];
#pragma unroll
                    for (int e = 0; e < 8; ++e) k[e] = y[e] * rs;
                    v4u o; o.x = pk2(k[0], k[1]); o.y = pk2(k[2], k[3]); o.z = pk2(k[4], k[5]); o.w = pk2(k[6], k[7]);
                    *(LAS v4u*)(lds + GA_KH + i * 272 + cg * 16) = o;
                    v4u kb; kb.x = pk2(k[0] * beta, k[1] * beta); kb.y = pk2(k[2] * beta, k[3] * beta); kb.z = pk2(k[4] * beta, k[5] * beta); kb.w = pk2(k[6] * beta, k[7] * beta);
                    *(LAS v4u*)(lds + GA_KBH + i * 272 + cg * 16) = kb;
#pragma unroll
                    for (int e = 0; e < 8; ++e) { *(LAS bf16*)(lds + GA_KBGT + (8 * cg + e) * 144 + i * 2) = (bf16)f2bf(k[e] * beta * eg);
                        *(LAS bf16*)(lds + GA_KDT + (8 * cg + e) * 144 + i * 2) = (bf16)f2bf(k[e] * ed); }
                } else {
#pragma unroll
                    for (int e = 0; e < 8; ++e) *(LAS bf16*)(lds + GA_VBT + (8 * cg + e) * 144 + i * 2) = (bf16)f2bf(y[e] * beta);
                }
            }
            __builtin_amdgcn_sched_barrier(0);
        }
    }
    __syncthreads();
    GPE(70); GPS(71);
    int l31 = lane & 31, hi = lane >> 5; asm volatile("" : "+v"(l31), "+v"(hi));
    {
        const int it = (wave >> 1) & 1, jt = wave & 1; const bool isL = wave < 4;
        f32x16 acc = {};
        if (it >= jt) {
            LAS const unsigned char* Ab = lds + (isL ? GA_KBH : GA_QH) + (32 * it + l31) * 272 + hi * 16;
            LAS const unsigned char* Bb = lds + GA_KH + (32 * jt + l31) * 272 + hi * 16;
#pragma unroll
            for (int ks = 0; ks < 8; ++ks) acc = MFMA32(lds_ld8(Ab + ks * 32), lds_ld8(Bb + ks * 32), acc);
        }
        const int j = 32 * jt + l31; const float Gj = Gs[j];
        bf16* AQ = (bf16*)(ws + WS_GAQK) + (size_t)unit * 4096;
#pragma unroll
        for (int r = 0; r < 16; ++r) { const int i = 32 * it + crow(r, hi);
            const float d = __expf(fminf(Gs[i] - Gj, 0.f));
            if (isL) ((LAS float*)(lds + GA_LF))[i * 64 + j] = (i > j) ? acc[r] * d : 0.f;
            else AQ[i * 64 + j] = (bf16)f2bf((i >= j) ? acc[r] * d : 0.f); }
    }
    __syncthreads();
    GPE(71); GPS(72);
    {
        LAS const float* Lf = (LAS const float*)(lds + GA_LF);
        LAS float* T32 = (LAS float*)(lds + GA_T32); LAS float* X32 = (LAS float*)(lds + GA_X32);
        if (wave == 0) {
            int lx = lane; asm volatile("" : "+v"(lx));
            const int hb = lx >> 5, c = lx & 31;
            LAS const float* Lb = Lf + (32 * hb) * 64 + 32 * hb;
            float T[32];
#pragma unroll
            for (int i = 0; i < 32; ++i) {
                float a0 = (i == c) ? 1.f : 0.f, a1 = 0.f;
#pragma unroll
                for (int j4 = 0; j4 < (i + 3) / 4; ++j4) { const f32x4 l4 = *(LAS const f32x4*)(Lb + i * 64 + 4 * j4);
                    if (4 * j4 + 0 < i) a0 -= l4.x * T[4 * j4 + 0];
                    if (4 * j4 + 1 < i) a1 -= l4.y * T[4 * j4 + 1];
                    if (4 * j4 + 2 < i) a0 -= l4.z * T[4 * j4 + 2];
                    if (4 * j4 + 3 < i) a1 -= l4.w * T[4 * j4 + 3]; }
                T[i] = a0 + a1;
                T32[hb * 1024 + i * 32 + c] = T[i];
                *(LAS bf16*)(lds + GA_TB + (32 * hb + i) * 144 + (32 * hb + c) * 2) = (bf16)f2bf(T[i]);
                if (hb == 0) *(LAS bf16*)(lds + GA_TB + i * 144 + (32 + c) * 2) = (bf16)0;
            }
        } else {
            bf16* GKD = (bf16*)(ws + WS_GKD) + (size_t)unit * 8192;
            int t0 = tid; asm volatile("" : "+v"(t0));
            for (int id = t0 - 64; id < 1024; id += 448) { const int row = id >> 3, ch = id & 7;
                *(v4u*)(GKD + row * 64 + ch * 8) = *(LAS const v4u*)(lds + GA_KDT + row * 144 + ch * 16); }
        }
        __syncthreads();
        int tidx = tid; asm volatile("" : "+v"(tidx));
        const int r = tidx >> 4, c2 = (tidx & 15) * 2;
        {
            float x0 = 0.f, x1 = 0.f;
#pragma unroll 8
            for (int k = 0; k < 32; ++k) { const float l = Lf[(32 + r) * 64 + k]; x0 += l * T32[k * 32 + c2]; x1 += l * T32[k * 32 + c2 + 1]; }
            X32[r * 32 + c2] = x0; X32[r * 32 + c2 + 1] = x1;
        }
        __syncthreads();
        {
            float x0 = 0.f, x1 = 0.f;
#pragma unroll 8
            for (int k = 0; k < 32; ++k) { const float t = T32[1024 + r * 32 + k]; x0 += t * X32[k * 32 + c2]; x1 += t * X32[k * 32 + c2 + 1]; }
            *(LAS unsigned*)(lds + GA_TB + (32 + r) * 144 + c2 * 2) = pk2(-x0, -x1);
        }
    }
    __syncthreads();
    GPE(72); GPS(73);
    {
        const int nt = wave; LAS const unsigned char* Bb = lds + (nt < 4 ? GA_VBT : GA_KBGT) + (32 * (nt & 3) + l31) * 144 + hi * 16;
        float* GU0 = (float*)(ws + WS_GU0) + (size_t)unit * 8192; bf16* GW = (bf16*)(ws + WS_GW) + (size_t)unit * 8192;
#pragma unroll
        for (int it = 0; it < 2; ++it) {
            f32x16 acc = {};
            LAS const unsigned char* Ab = lds + GA_TB + (32 * it + l31) * 144 + hi * 16;
#pragma unroll
            for (int ks = 0; ks < 4; ++ks) if (ks < 2 * (it + 1)) acc = MFMA32(lds_ld8(Ab + ks * 32), lds_ld8(Bb + ks * 32), acc);
            const int col = 32 * (nt & 3) + l31;
#pragma unroll
            for (int r = 0; r < 16; ++r) { const int i = 32 * it + crow(r, hi);
                if (nt < 4) GU0[i * 128 + col] = acc[r]; else GW[i * 128 + col] = (bf16)f2bf(acc[r]); }
        }
        if (tid == 0) ((float*)(ws + WS_GEND))[unit] = __expf(Gend);
    }
    __syncthreads();
    GPE(73); GPE(74);
#ifdef PROBE_K
    if (blockIdx.x == PROBE_B && PROBE_K >= 70 && PROBE_K < 80) { const unsigned long long te = __builtin_amdgcn_s_memrealtime(); while (__builtin_amdgcn_s_memrealtime() - te < (unsigned long long)PROBE_MULT * pdt) __builtin_amdgcn_s_sleep(8); }
#endif
}

constexpr int GB_ST = 0, GB_UT = 34816, GB_OF = 53248;
__device__ __forceinline__ void gdn_b_unit(const Args& A, LAS unsigned char* lds, int bh, int tid, int lane, int wave) {
    unsigned char* ws = A.ws;
    const int b = bh >> 3, h = bh & 7, l31 = lane & 31, hi = lane >> 5;
    const int it = wave >> 2, vt = wave & 3;
    for (int i = tid; i < 34816 / 16; i += 512) *(LAS v4u*)(lds + GB_ST + i * 16) = (v4u){0u, 0u, 0u, 0u};
    f32x16 Sacc[2] = {};
    __syncthreads();
    const bf16* Zb = (const bf16*)(ws + WS_Z); bf16* YA = (bf16*)(ws + WS_YA);
    LAS const unsigned char* Sb = lds + GB_ST + (32 * vt + l31) * 272 + hi * 16;
    LAS const unsigned char* Ub = lds + GB_UT + (32 * vt + l31) * 144 + hi * 16;
    const int di = tid >> 3, dc0 = (tid & 7) * 16;
    bf16x8 wA[8], qA[8], cA[4], kA[2][4]; float u0[16]; v4u zz[2]; float gend;
#define BL8(rs_, vo_, so_) __builtin_bit_cast(bf16x8, __builtin_amdgcn_raw_buffer_load_b128((rs_), (vo_), (so_), 0))
#define MKRS(p_, bytes_) __builtin_amdgcn_make_buffer_rsrc((void*)(p_), 0, (bytes_), 0x00020000)
    const unsigned voW = (unsigned)((32 * it + l31) * 128 + 8 * hi) * 2u, voA = (unsigned)((32 * it + l31) * 64 + 8 * hi) * 2u, voK = (unsigned)((64 * it + l31) * 64 + 8 * hi) * 2u;
    const unsigned voU = (unsigned)((32 * it + 4 * hi) * 128 + 32 * vt + l31) * 4u, voZ = (unsigned)(di * 1024 + h * 128 + dc0) * 2u;
#define GB_LD_W(n_) do { const int cu_ = bh * 32 + (n_); const __amdgpu_buffer_rsrc_t rW_ = MKRS((const bf16*)(ws + WS_GW) + (size_t)cu_ * 8192, 16384), rU_ = MKRS((const float*)(ws + WS_GU0) + (size_t)cu_ * 8192, 32768); \
        _Pragma("unroll") for (int ks = 0; ks < 8; ++ks) wA[ks] = BL8(rW_, voW, ks * 32); \
        _Pragma("unroll") for (int r = 0; r < 16; ++r) u0[r] = __builtin_bit_cast(float, __builtin_amdgcn_raw_buffer_load_b32(rU_, voU, ((r & 3) + 8 * (r >> 2)) * 512, 0)); } while (0)
#define GB_LD_Q(n_) do { const int cu_ = bh * 32 + (n_); const __amdgpu_buffer_rsrc_t rQ_ = MKRS((const bf16*)(ws + WS_GQG) + (size_t)cu_ * 8192, 16384), rA_ = MKRS((const bf16*)(ws + WS_GAQK) + (size_t)cu_ * 4096, 8192); \
        _Pragma("unroll") for (int ks = 0; ks < 8; ++ks) qA[ks] = BL8(rQ_, voW, ks * 32); \
        _Pragma("unroll") for (int ks = 0; ks < 4; ++ks) cA[ks] = BL8(rA_, voA, ks * 32); } while (0)
#define GB_LD_K(n_) do { const int cu_ = bh * 32 + (n_); const __amdgpu_buffer_rsrc_t rK_ = MKRS((const bf16*)(ws + WS_GKD) + (size_t)cu_ * 8192, 16384), rZ_ = MKRS(Zb + (size_t)(b * SEQ + 64 * (n_)) * 1024, 64 * 1024 * 2); \
        _Pragma("unroll") for (int ks = 0; ks < 4; ++ks) { kA[0][ks] = BL8(rK_, voK, ks * 32); kA[1][ks] = BL8(rK_, voK, 32 * 64 * 2 + ks * 32); } \
        zz[0] = __builtin_amdgcn_raw_buffer_load_b128(rZ_, voZ, 0, 0); zz[1] = __builtin_amdgcn_raw_buffer_load_b128(rZ_, voZ, 16, 0); \
        gend = ((const float*)(ws + WS_GEND))[cu_]; } while (0)
#ifdef PROBE_K
    unsigned long long pt0 = 0, pdt = 0;
#endif
    GB_LD_W(0); GB_LD_Q(0);
#pragma unroll 1
    for (int n = 0; n < 32; ++n) {
        const int r0 = b * SEQ + 64 * n;
        GPS(80); GPS(84);
        GB_LD_K(n);
        {
            f32x16 acc = {};
#pragma unroll
            for (int ks = 0; ks < 8; ++ks) acc = MFMA32(wA[ks], lds_ld8(Sb + ks * 32), acc);
            float u[16];
#pragma unroll
            for (int r = 0; r < 16; ++r) u[r] = u0[r] - acc[r];
#pragma unroll
            for (int g = 0; g < 4; ++g) { v2u w; w.x = pk2(u[4 * g], u[4 * g + 1]); w.y = pk2(u[4 * g + 2], u[4 * g + 3]);
                *(LAS v2u*)(lds + GB_UT + (32 * vt + l31) * 144 + (32 * it + 8 * g + 4 * hi) * 2) = w; }
        }
        LBAR();
        GPE(80); GPS(81);
        if (n + 1 < 32) GB_LD_W(n + 1);
        {
            f32x16 acc = {};
#pragma unroll
            for (int ks = 0; ks < 8; ++ks) acc = MFMA32(qA[ks], lds_ld8(Sb + ks * 32), acc);
#pragma unroll
            for (int ks = 0; ks < 4; ++ks) if (ks < 2 * (it + 1)) acc = MFMA32(cA[ks], lds_ld8(Ub + ks * 32), acc);
#pragma unroll
            for (int r = 0; r < 16; ++r) ((LAS float*)(lds + GB_OF))[(32 * it + crow(r, hi)) * 132 + 32 * vt + l31] = acc[r];
        }
        LBAR();
        GPE(81); GPS(82);
        if (n + 1 < 32) GB_LD_Q(n + 1);
        {
#pragma unroll
            for (int t = 0; t < 2; ++t) { const int kt = 2 * (wave >> 2) + t;
                Sacc[t] = Sacc[t] * gend;
#pragma unroll
                for (int ks = 0; ks < 4; ++ks) Sacc[t] = MFMA32(kA[t][ks], lds_ld8(Ub + ks * 32), Sacc[t]);
#pragma unroll
                for (int g = 0; g < 4; ++g) { v2u w; w.x = pk2(Sacc[t][4 * g], Sacc[t][4 * g + 1]); w.y = pk2(Sacc[t][4 * g + 2], Sacc[t][4 * g + 3]);
                    *(LAS v2u*)(lds + GB_ST + (32 * vt + l31) * 272 + (32 * kt + 8 * g + 4 * hi) * 2) = w; }
            }
        }
        {
            LAS const float* orow = (LAS const float*)(lds + GB_OF) + di * 132 + dc0;
            float o[16]; float ss = 0.f;
#pragma unroll
            for (int q = 0; q < 4; ++q) { const f32x4 v = *(LAS const f32x4*)(orow + 4 * q); o[4 * q] = v.x; o[4 * q + 1] = v.y; o[4 * q + 2] = v.z; o[4 * q + 3] = v.w; }
#pragma unroll
            for (int e = 0; e < 16; ++e) ss += o[e] * o[e];
            ss += __shfl_xor(ss, 1); ss += __shfl_xor(ss, 2); ss += __shfl_xor(ss, 4);
            const float r = 1.f / sqrtf(ss * (1.f / 128.f) + EPS);
            const size_t off = (size_t)(r0 + di) * 1024 + h * 128 + dc0;
            const v4u z0 = zz[0], z1 = zz[1];
            const float z[16] = {lo16(z0.x), hi16(z0.x), lo16(z0.y), hi16(z0.y), lo16(z0.z), hi16(z0.z), lo16(z0.w), hi16(z0.w),
                                 lo16(z1.x), hi16(z1.x), lo16(z1.y), hi16(z1.y), lo16(z1.z), hi16(z1.z), lo16(z1.w), hi16(z1.w)};
            float y[16];
#pragma unroll
            for (int e = 0; e < 16; ++e) y[e] = o[e] * r * A.in[I_GDNN][dc0 + e] * siluf_(z[e]);
            v4u o0, o1; o0.x = pk2(y[0], y[1]); o0.y = pk2(y[2], y[3]); o0.z = pk2(y[4], y[5]); o0.w = pk2(y[6], y[7]);
            o1.x = pk2(y[8], y[9]); o1.y = pk2(y[10], y[11]); o1.z = pk2(y[12], y[13]); o1.w = pk2(y[14], y[15]);
            *(v4u*)(YA + off) = o0; *(v4u*)(YA + off + 8) = o1;
        }
        GPE(82); GPS(83);
        LBAR();
        GPE(83); GPE(84);
    }
#undef GB_LD_W
#undef GB_LD_Q
#undef GB_LD_K
#undef BL8
#undef MKRS
#ifdef PROBE_K
    if (bh == 0 && tid == 0 && PROBE_K >= 80 && PROBE_K < 90) ((volatile LAS unsigned*)(lds + MISC_OFF))[16] = (unsigned)pdt;
#endif
    float* So = A.out + O_GSP + (size_t)bh * 16384;
#pragma unroll
    for (int t = 0; t < 2; ++t) { const int kt = 2 * (wave >> 2) + t;
#pragma unroll
        for (int r = 0; r < 16; ++r) So[(32 * kt + crow(r, hi)) * 128 + 32 * vt + l31] = Sacc[t][r]; }
    __syncthreads();
}

__device__ __forceinline__ void gdn_r_unit(const Args& A, LAS unsigned char* lds, int unit, int tid, int lane, int wave) {
    unsigned char* ws = A.ws;
    const int j = unit >> 3, h = unit & 7, row = MP + j;
    LAS float* qs = (LAS float*)lds; LAS float* ks = qs + 128; LAS float* vs = qs + 256; LAS float* red = qs + 384;
    LAS float* os = qs + 896;
    if (tid < 384) {
        const int part = tid >> 7, d = tid & 127, col = part * 1024 + h * 128 + d;
        const float* cw = A.in[I_CONVW]; const float* sc = A.in[I_SCONV] + (size_t)j * 3 * 3072;
        const float xn = bf2f(((const bf16*)(ws + WS_QKV))[(size_t)row * 3072 + col]);
        const float y = cw[col] * sc[col] + cw[3072 + col] * sc[3072 + col] + cw[2 * 3072 + col] * sc[2 * 3072 + col] + cw[3 * 3072 + col] * xn;
        qs[tid] = siluf_(y);
    }
    __syncthreads();
    const float rq = 1.f / sqrtf(wave_sum(qs[lane] * qs[lane] + qs[lane + 64] * qs[lane + 64]) + EPS) * 0.08838834764831845f;
    const float rk = 1.f / sqrtf(wave_sum(ks[lane] * ks[lane] + ks[lane + 64] * ks[lane + 64]) + EPS);
    const float beta = ((const float*)(ws + WS_BETA))[(size_t)row * 8 + h], eg = __expf(((const float*)(ws + WS_GLOG))[(size_t)row * 8 + h]);
    const int v = tid & 127, kq = tid >> 7;
    const float* S0 = A.in[I_SGDN] + (size_t)unit * 16384;
    float s[32]; float kv = 0.f;
#pragma unroll
    for (int i = 0; i < 32; ++i) { const int k = 32 * kq + i; s[i] = eg * S0[k * 128 + v]; kv += ks[k] * rk * s[i]; }
    red[kq * 128 + v] = kv;
    __syncthreads();
    const float u = beta * (vs[v] - (red[v] + red[128 + v] + red[256 + v] + red[384 + v]));
    __syncthreads();
    float* So = A.out + O_GSS + (size_t)unit * 16384; float po = 0.f;
#pragma unroll
    for (int i = 0; i < 32; ++i) { const int k = 32 * kq + i; s[i] += ks[k] * rk * u; So[k * 128 + v] = s[i]; po += qs[k] * rq * s[i]; }
    red[kq * 128 + v] = po;
    __syncthreads();
    if (tid < 128) os[tid] = red[tid] + red[128 + tid] + red[256 + tid] + red[384 + tid];
    __syncthreads();
    const float rn = 1.f / sqrtf(wave_sum(os[lane] * os[lane] + os[lane + 64] * os[lane + 64]) * (1.f / 128.f) + EPS);
    if (tid < 128) { const size_t off = (size_t)row * 1024 + h * 128 + tid;
        ((bf16*)(ws + WS_YA))[off] = (bf16)f2bf(os[tid] * rn * A.in[I_GDNN][tid] * siluf_(bf2f(((const bf16*)(ws + WS_Z))[off]))); }
    __syncthreads();
}

namespace att {
using s16x4 = __attribute__((ext_vector_type(4))) short;
using u32x4 = __attribute__((ext_vector_type(4))) unsigned;
constexpr int SHM_V = 16384, SHM_K = 16384, SHM_KR = 8192;
constexpr int OFF_V = 0, OFF_K = 2 * SHM_V, OFF_KR = OFF_K + 2 * SHM_K, OFF_WS = OFF_KR + 2 * SHM_KR, OFF_QR = OFF_WS + 2048;
constexpr float THR = 8.f;
#define KSWZ(row, colB) ((row) * 256 + ((colB) ^ (((row) & 7) << 4)))
#define KRSWZ(row, colB) ((row) * 128 + ((colB) ^ (((row) & 7) << 4)))
#define SBAR() __builtin_amdgcn_sched_barrier(0)
__device__ __forceinline__ unsigned cvtpk(float lo, float hi) { unsigned r; asm volatile("v_cvt_pk_bf16_f32 %0, %1, %2" : "=v"(r) : "v"(lo), "v"(hi)); return r; }
__device__ __forceinline__ void partialSM(f32x16& p0, f32x16& p1, float& m_reg, float& mn, float& alpha) {
    constexpr float C = MLA_SCALE * 1.4426950408889634f;
    float pmax = p0[0];
#pragma unroll
    for (int r = 1; r < 16; ++r) pmax = fmaxf(pmax, p0[r]);
#pragma unroll
    for (int r = 0; r < 16; ++r) pmax = fmaxf(pmax, p1[r]);
    { auto rr = __builtin_amdgcn_permlane32_swap(__float_as_uint(pmax), __float_as_uint(pmax), false, false);
      pmax = fmaxf(__uint_as_float(rr[0]), __uint_as_float(rr[1])); }
    if (__builtin_expect(__all(pmax - m_reg <= THR / MLA_SCALE), 1)) { mn = m_reg; alpha = 1.f; }
    else { mn = fmaxf(m_reg, pmax); alpha = __builtin_amdgcn_exp2f((m_reg - mn) * C); m_reg = mn; }
    const float mnC = -mn * C;
#pragma unroll
    for (int r = 0; r < 16; ++r) p0[r] = fmaf(p0[r], C, mnC);
#pragma unroll
    for (int r = 0; r < 16; ++r) p1[r] = fmaf(p1[r], C, mnC);
#pragma unroll
    for (int r = 0; r < 16; ++r) p0[r] = __builtin_amdgcn_exp2f(p0[r]);
}
__device__ __forceinline__ void finishSM(f32x16& p0, f32x16& p1, float alpha, float& l_reg, bf16x8& pa0, bf16x8& pa1, bf16x8& pa2, bf16x8& pa3) {
#pragma unroll
    for (int r = 0; r < 16; ++r) p1[r] = __builtin_amdgcn_exp2f(p1[r]);
    float ps = 0;
#pragma unroll
    for (int r = 0; r < 16; ++r) ps += p0[r];
#pragma unroll
    for (int r = 0; r < 16; ++r) ps += p1[r];
    { auto rr = __builtin_amdgcn_permlane32_swap(__float_as_uint(ps), __float_as_uint(ps), false, false);
      ps = __uint_as_float(rr[0]) + __uint_as_float(rr[1]); }
    l_reg = l_reg * alpha + ps;
#define PK4(P, BASE, OUT) do { unsigned a0 = cvtpk(P[BASE + 0], P[BASE + 1]), a1 = cvtpk(P[BASE + 2], P[BASE + 3]);   \
    unsigned b0 = cvtpk(P[BASE + 4], P[BASE + 5]), b1 = cvtpk(P[BASE + 6], P[BASE + 7]);                              \
    auto r0 = __builtin_amdgcn_permlane32_swap(a0, b0, false, false); auto r1 = __builtin_amdgcn_permlane32_swap(a1, b1, false, false); \
    u32x4 w = {r0[0], r1[0], r0[1], r1[1]}; OUT = *reinterpret_cast<bf16x8*>(&w); } while (0)
    PK4(p0, 0, pa0); PK4(p0, 8, pa1); PK4(p1, 0, pa2); PK4(p1, 8, pa3);
#undef PK4
}
__device__ __forceinline__ void qkt(f32x16& p0, f32x16& p1, LAS const unsigned char* Ks, LAS const unsigned char* KRs, const bf16x8* qr, LAS const unsigned char* qrl, int r32, int hi) {
    p0 = f32x16{}; p1 = f32x16{};
#pragma unroll
    for (int d0 = 0; d0 < 8; ++d0) { const int cb = (d0 * 16 + hi * 8) * 2;
        const bf16x8 b0 = *(LAS const bf16x8*)(Ks + KSWZ(r32, cb)), b1 = *(LAS const bf16x8*)(Ks + KSWZ(32 + r32, cb));
        p0 = MFMA32(b0, qr[d0], p0); p1 = MFMA32(b1, qr[d0], p1); if (d0 == 3 || d0 == 7) SBAR(); }
#pragma unroll
    for (int d0 = 0; d0 < 4; ++d0) { const int cb = (d0 * 16 + hi * 8) * 2;
        const bf16x8 b0 = *(LAS const bf16x8*)(KRs + KRSWZ(r32, cb)), b1 = *(LAS const bf16x8*)(KRs + KRSWZ(32 + r32, cb));
        const bf16x8 qq = *(LAS const bf16x8*)(qrl + d0 * 1024);
        p0 = MFMA32(b0, qq, p0); p1 = MFMA32(b1, qq, p1); }
}
__device__ __forceinline__ void cmask(f32x16& p0, f32x16& p1, int key0, int qpos, int hi) {
#pragma unroll
    for (int r = 0; r < 16; ++r) { const int k = key0 + crow(r, hi); if (k > qpos) p0[r] = -1e30f; if (k + 32 > qpos) p1[r] = -1e30f; }
}
__device__ __forceinline__ int v_st(int k, int c) { const int kk = (k & ~0xC) | ((k & 4) << 1) | ((k & 8) >> 1); return ((kk >> 3) * 4 + (c >> 5)) * 512 + ((kk & 7) * 32 + (c & 31)) * 2; }
__device__ __forceinline__ int v_rd_base(int lane) { return ((lane & 3) << 3) | (((lane >> 2) & 3) << 6) | (((lane >> 4) & 1) << 5) | (((lane >> 5) & 1) << 8); }
constexpr int v_rd_off(int d0, int ks, int half) { return d0 * 512 + ks * 4096 + half * 2048; }
template <int OFF> __device__ __forceinline__ s16x4 tr_read(int vb) {
    s16x4 r; asm volatile("ds_read_b64_tr_b16 %0, %1 offset:%2" : "=&v"(r) : "v"(vb), "i"(OFF) : "memory"); return r;
}
template <int D0> __device__ __forceinline__ void pv_one(f32x16& od, int vb, bf16x8 pa0, bf16x8 pa1, bf16x8 pa2, bf16x8 pa3) {
    const s16x4 l0 = tr_read<v_rd_off(D0, 0, 0)>(vb), h0 = tr_read<v_rd_off(D0, 0, 1)>(vb), l1 = tr_read<v_rd_off(D0, 1, 0)>(vb), h1 = tr_read<v_rd_off(D0, 1, 1)>(vb);
    const s16x4 l2 = tr_read<v_rd_off(D0, 2, 0)>(vb), h2 = tr_read<v_rd_off(D0, 2, 1)>(vb), l3 = tr_read<v_rd_off(D0, 3, 0)>(vb), h3 = tr_read<v_rd_off(D0, 3, 1)>(vb);
    asm volatile("s_waitcnt lgkmcnt(0)" ::: "memory"); SBAR();
#define PKV(L, H) (bf16x8){L[0], L[1], L[2], L[3], H[0], H[1], H[2], H[3]}
    od = MFMA32(pa0, PKV(l0, h0), od); od = MFMA32(pa1, PKV(l1, h1), od); od = MFMA32(pa2, PKV(l2, h2), od); od = MFMA32(pa3, PKV(l3, h3), od);
#undef PKV
}
__device__ __forceinline__ void pv_d0(f32x16* o, int vb, bf16x8 pa0, bf16x8 pa1, bf16x8 pa2, bf16x8 pa3) {
    pv_one<0>(o[0], vb, pa0, pa1, pa2, pa3); pv_one<1>(o[1], vb, pa0, pa1, pa2, pa3); pv_one<2>(o[2], vb, pa0, pa1, pa2, pa3); pv_one<3>(o[3], vb, pa0, pa1, pa2, pa3);
}
__device__ __forceinline__ void attn_block(const bf16* __restrict__ Qn, const bf16* __restrict__ Qr, const float* __restrict__ sqn, const float* __restrict__ sqr,
                                           const bf16* __restrict__ Kh, const float* __restrict__ skn, const bf16* __restrict__ KRb, const bf16* __restrict__ Vh,
                                           const float* __restrict__ gqn, const float* __restrict__ gqr, const float* __restrict__ gkn,
                                           bf16* __restrict__ Ob, int q0, LAS unsigned char* lds) {
    const int tid = threadIdx.x, wid = __builtin_amdgcn_readfirstlane(tid >> 6), lane = tid & 63, r32 = lane & 31, hi = lane >> 5; const int r32_o = r32, hi_o = hi;
    LAS unsigned char* V_lds = lds + OFF_V; LAS unsigned char* K_lds = lds + OFF_K; LAS unsigned char* KR_lds = lds + OFF_KR;
    LAS float* wsf = (LAS float*)(lds + OFF_WS) + wid * 64; LAS float* li_l = wsf; LAS float* al_l = wsf + 32;
    float m_reg = -1e30f, l_reg = 0; f32x16 o[4] = {}; bf16x8 qr[8];
    LAS unsigned char* qrl = lds + OFF_QR + wid * 4096 + lane * 16;
    const int qpos = q0 + wid * 32 + r32;
    {
        int hi = hi_o, r32 = r32_o; asm volatile("" : "+v"(hi), "+v"(r32));
        const char* Qw = (const char*)Qn + (size_t)wid * (32 * 1536 * 2); const char* Qx = (const char*)Qr + (size_t)wid * (32 * 1536 * 2);
        const unsigned qoff = (unsigned)(r32 * 1536 + hi * 8) * 2u;
        const float rr = __builtin_amdgcn_rsqf(sqr[(size_t)(wid * 32 + r32) * 8] * (1.f / 64.f) + EPS);
#pragma unroll
        for (int d0 = 0; d0 < 8; ++d0) qr[d0] = *(const bf16x8*)(Qw + qoff + d0 * 32);
#pragma unroll
        for (int d0 = 0; d0 < 2; ++d0) {
            const v4u w1 = *(const v4u*)(Qx + qoff + d0 * 32), w2 = *(const v4u*)(Qx + qoff + (d0 + 2) * 32);
            const float x1[8] = {lo16(w1.x), hi16(w1.x), lo16(w1.y), hi16(w1.y), lo16(w1.z), hi16(w1.z), lo16(w1.w), hi16(w1.w)};
            const float x2[8] = {lo16(w2.x), hi16(w2.x), lo16(w2.y), hi16(w2.y), lo16(w2.z), hi16(w2.z), lo16(w2.w), hi16(w2.w)};
            float o1[8], o2[8];
#pragma unroll
            for (int j = 0; j < 8; ++j) { const int e = 16 * d0 + 8 * hi + j; const float a = x1[j] * rr * gqr[e], b = x2[j] * rr * gqr[e + 32];
                const float rev = (float)qpos * ROPE_INV[e] * 0.15915494309189535f; const float fr_ = rev - floorf(rev);
                const float cs = __builtin_amdgcn_cosf(fr_), sn = __builtin_amdgcn_sinf(fr_);
                o1[j] = a * cs - b * sn; o2[j] = a * sn + b * cs; }
            v4u p1, p2; p1.x = pk2(o1[0], o1[1]); p1.y = pk2(o1[2], o1[3]); p1.z = pk2(o1[4], o1[5]); p1.w = pk2(o1[6], o1[7]);
            p2.x = pk2(o2[0], o2[1]); p2.y = pk2(o2[2], o2[3]); p2.z = pk2(o2[4], o2[5]); p2.w = pk2(o2[6], o2[7]);
            *(LAS v4u*)(qrl + d0 * 1024) = p1; *(LAS v4u*)(qrl + (d0 + 2) * 1024) = p2; }
    }
    const int sr = tid >> 4, sc = (tid & 15) * 8, vst0 = v_st(sr, sc), vst1 = v_st(32 + sr, sc);
    const int krr = tid >> 3, krc = (tid & 7) * 8;
    const unsigned voff = (unsigned)(sr * 1024 + sc) * 2u, voffr = (unsigned)(krr * 64 + krc) * 2u;
    const int vb0 = (int)(uintptr_t)V_lds + v_rd_base(lane);
    bf16x8 vs0, vs1, ks0, ks1, krs;
#define KSCALE(x_, r_) do { const v4u w_ = __builtin_bit_cast(v4u, x_); const float s_ = __builtin_amdgcn_rsqf((r_) * (1.f / 128.f) + EPS); v4u o_; \
    int sc_ = sc; asm volatile("" : "+v"(sc_)); const f32x4 ga_ = *(const f32x4*)(gkn + sc_), gb_ = *(const f32x4*)(gkn + sc_ + 4);     \
    o_.x = pk2(lo16(w_.x) * s_ * ga_.x, hi16(w_.x) * s_ * ga_.y); o_.y = pk2(lo16(w_.y) * s_ * ga_.z, hi16(w_.y) * s_ * ga_.w); \
    o_.z = pk2(lo16(w_.z) * s_ * gb_.x, hi16(w_.z) * s_ * gb_.y); o_.w = pk2(lo16(w_.w) * s_ * gb_.z, hi16(w_.w) * s_ * gb_.w); x_ = __builtin_bit_cast(bf16x8, o_); } while (0)
#define SLOAD(k0) do { do { const char* kb_ = (const char*)Kh + (size_t)(k0) * 2048; const char* vb_ = (const char*)Vh + (size_t)(k0) * 2048; const char* rb_ = (const char*)KRb + (size_t)(k0) * 128; \
    vs0 = *(const bf16x8*)(vb_ + voff); vs1 = *(const bf16x8*)(vb_ + 65536 + voff); ks0 = *(const bf16x8*)(kb_ + voff); ks1 = *(const bf16x8*)(kb_ + 65536 + voff); \
    krs = *(const bf16x8*)(rb_ + voffr); } while (0); } while (0)
#define SWRITE(b) do { *(LAS bf16x8*)(V_lds + (b) * SHM_V + vst0) = vs0; *(LAS bf16x8*)(V_lds + (b) * SHM_V + vst1) = vs1; const int kc = sc * 2; \
    *(LAS bf16x8*)(K_lds + (b) * SHM_K + KSWZ(sr, kc)) = ks0; *(LAS bf16x8*)(K_lds + (b) * SHM_K + KSWZ(32 + sr, kc)) = ks1; \
    *(LAS bf16x8*)(KR_lds + (b) * SHM_KR + KRSWZ(krr, krc * 2)) = krs; } while (0)
#define SWAIT() asm volatile("s_waitcnt vmcnt(0)" ::: "memory")
#define RESC(a) do { if (__any((a) < 1.f)) { if (hi == 0) al_l[r32] = (a); asm volatile("s_waitcnt lgkmcnt(0)" ::: "memory"); \
    _Pragma("unroll") for (int d = 0; d < 4; ++d) _Pragma("unroll") for (int r = 0; r < 16; ++r) o[d][r] *= al_l[crow(r, hi)]; } } while (0)
    f32x16 p0, p1; float mn, al; bf16x8 pa0, pa1, pa2, pa3;
    const int NT = (q0 + 256) / 64, NM = q0 / 64;
    SLOAD(0); SWAIT(); SWRITE(0); SLOAD(64); __syncthreads();
#pragma unroll 1
    for (int j = 0; j < NT; ++j) {
        const int bf = j & 1;
        const bool act = 64 * j <= q0 + wid * 32 + 31;
        if (act) {
            SBAR(); qkt(p0, p1, K_lds + bf * SHM_K, KR_lds + bf * SHM_KR, qr, qrl, r32, hi); if (j >= NM) cmask(p0, p1, 64 * j, qpos, hi);
            partialSM(p0, p1, m_reg, mn, al); RESC(al);
            finishSM(p0, p1, al, l_reg, pa0, pa1, pa2, pa3); SBAR();
        }
        if (j + 1 < NT) { SWAIT(); SWRITE(bf ^ 1); }
        if (j + 2 < NT) SLOAD((j + 2) * 64);
        SBAR();
        if (act) pv_d0(o, vb0 + bf * SHM_V, pa0, pa1, pa2, pa3);
        __syncthreads();
    }
    if (hi == 0) li_l[r32] = l_reg; asm volatile("s_waitcnt lgkmcnt(0)" ::: "memory");
    char* Ow = (char*)Ob + (size_t)wid * (32 * 1024 * 2);
    unsigned lofs = (unsigned)(4 * hi * 1024 + r32) * 2u; asm volatile("" : "+v"(lofs));
#pragma unroll
    for (int r = 0; r < 16; ++r) { const float rl = __builtin_amdgcn_rcpf(li_l[crow(r, hi)]);
#pragma unroll
        for (int d0 = 0; d0 < 4; ++d0) *(bf16*)(Ow + lofs + (unsigned)(((r & 3) + 8 * (r >> 2)) * 1024 + d0 * 32) * 2u) = (bf16)f2bf(o[d0][r] * rl); }
    __syncthreads();
#undef SLOAD
#undef KSCALE
#undef SWRITE
#undef SWAIT
#undef RESC
}
}

constexpr int DP_CT = 0, DP_KR = 133120, DP_PT = 151552, DP_QK = 153728, DP_QR = 157824;
__device__ __forceinline__ float dec_qn(const Args& A, int j, int h, int d) {
    const int row = MP + j;
    return bf2f(((const bf16*)(A.ws + WS_QP))[(size_t)row * 1536 + h * 128 + d]);
}
__device__ __forceinline__ float dec_qr(const Args& A, int j, int h, int e) {
    const int row = MP + j, e1 = e & 31;
    const bf16* q = (const bf16*)(A.ws + WS_QP) + (size_t)row * 1536 + 1024 + h * 64;
    const float rs = __builtin_amdgcn_rsqf(((const float*)(A.ws + WS_SQR))[(size_t)row * 8 + h] * (1.f / 64.f) + EPS);
    const float a = bf2f(q[e1]) * rs * A.in[I_QNR][e1], b = bf2f(q[e1 + 32]) * rs * A.in[I_QNR][e1 + 32];
    const float ang = (float)PAST * ROPE_INV[e1]; const float cs = cosf(ang), sn = sinf(ang);
    return e < 32 ? a * cs - b * sn : a * sn + b * cs;
}
__device__ __forceinline__ void dec_tables(const Args& A, LAS unsigned char* lds, int j, int tid_) {
    int tid = tid_; asm volatile("" : "+v"(tid));
#pragma unroll
    for (int q = 0; q < 2; ++q) { const int idx = tid + 512 * q, h = idx >> 7, d = idx & 127; ((LAS float*)(lds + DP_QK))[idx] = dec_qn(A, j, h, d) * A.in[I_KNN][d]; }
    { const int h = tid >> 6, e = tid & 63; ((LAS float*)(lds + DP_QR))[tid] = dec_qr(A, j, h, e); }
}
__device__ __forceinline__ void dec_page(const Args& A, LAS unsigned char* lds, int unit, int tid, int lane, int wave) {
    unsigned char* ws = A.ws;
    const int phys = ((const int*)A.in[I_PT])[unit];
    const float* src = A.in[I_CACHE] + (size_t)phys * PAGE * LATW;
#pragma unroll 1
    for (int q0 = 0; q0 < 18; q0 += 6) {
        f32x4 va[6], vb[6];
#pragma unroll
        for (int q = 0; q < 6; ++q) { const int id = (q0 + q) * 512 + tid, row = id / 72, g = id % 72; const float* p = src + (size_t)row * LATW + 8 * g; va[q] = *(const f32x4*)p; vb[q] = *(const f32x4*)(p + 4); }
#pragma unroll
        for (int q = 0; q < 6; ++q) { const int id = (q0 + q) * 512 + tid, row = id / 72, g = id % 72;
            v4u o; o.x = pk2(va[q].x, va[q].y); o.y = pk2(va[q].z, va[q].w); o.z = pk2(vb[q].x, vb[q].y); o.w = pk2(vb[q].z, vb[q].w);
            if (g < 64) *(LAS v4u*)(lds + DP_CT + row * 1040 + g * 16) = o; else *(LAS v4u*)(lds + DP_KR + row * 144 + (g - 64) * 16) = o; }
    }
    __syncthreads();
    const int l31 = lane & 31, hi = lane >> 5, h = wave;
    float ssq[4] = {0.f, 0.f, 0.f, 0.f}, dot[4] = {0.f, 0.f, 0.f, 0.f};
    const bf16* WK = (const bf16*)(ws + WS_WKV);
    LAS const float* QK = (LAS const float*)(lds + DP_QK) + h * 128;
#pragma unroll 1
    for (int e = 0; e < 2; ++e) {
        f32x16 acc[2][4];
#pragma unroll
        for (int mt = 0; mt < 2; ++mt)
#pragma unroll
            for (int nt = 0; nt < 4; ++nt) acc[mt][nt] = f32x16{};
        const bf16* Ab = WK + (size_t)(h * 128 + 64 * e + l31) * 512 + 8 * hi;
        LAS const unsigned char* Bb = lds + DP_CT + l31 * 1040 + hi * 16;
#pragma unroll 2
        for (int ks = 0; ks < 32; ++ks) {
            const bf16x8 a0 = gl_ld8(Ab + 16 * ks), a1 = gl_ld8(Ab + 32 * 512 + 16 * ks);
            bf16x8 bq[4];
#pragma unroll
            for (int nt = 0; nt < 4; ++nt) bq[nt] = lds_ld8(Bb + nt * 32 * 1040 + ks * 32);
#pragma unroll
            for (int nt = 0; nt < 4; ++nt) { acc[0][nt] = MFMA32(a0, bq[nt], acc[0][nt]); acc[1][nt] = MFMA32(a1, bq[nt], acc[1][nt]); }
        }
#pragma unroll
        for (int mt = 0; mt < 2; ++mt)
#pragma unroll
            for (int g = 0; g < 4; ++g) { const f32x4 qv = *(LAS const f32x4*)(QK + 64 * e + 32 * mt + 8 * g + 4 * hi);
#pragma unroll
                for (int nt = 0; nt < 4; ++nt) {
                    const float x0 = acc[mt][nt][4 * g], x1 = acc[mt][nt][4 * g + 1], x2 = acc[mt][nt][4 * g + 2], x3 = acc[mt][nt][4 * g + 3];
                    ssq[nt] += x0 * x0 + x1 * x1 + x2 * x2 + x3 * x3; dot[nt] += x0 * qv.x + x1 * qv.y + x2 * qv.z + x3 * qv.w; } }
    }
#pragma unroll
    for (int nt = 0; nt < 4; ++nt) { ssq[nt] += __shfl_xor(ssq[nt], 32); dot[nt] += __shfl_xor(dot[nt], 32); }
    const float sn0 = dot[0] / sqrtf(ssq[0] * (1.f / 128.f) + EPS), sn1 = dot[1] / sqrtf(ssq[1] * (1.f / 128.f) + EPS);
    const float sn2 = dot[2] / sqrtf(ssq[2] * (1.f / 128.f) + EPS), sn3 = dot[3] / sqrtf(ssq[3] * (1.f / 128.f) + EPS);
    const float snA = hi ? sn2 : sn0, snB = hi ? sn3 : sn1;
    float s[2];
    LAS const float* QR = (LAS const float*)(lds + DP_QR) + h * 64;
#pragma unroll
    for (int u = 0; u < 2; ++u) { const int key = 32 * (2 * hi + u) + l31; float sr = 0.f;
#pragma unroll
        for (int c = 0; c < 8; ++c) { const v4u w = *(LAS const v4u*)(lds + DP_KR + key * 144 + c * 16); const f32x4 q0 = *(LAS const f32x4*)(QR + 8 * c), q1 = *(LAS const f32x4*)(QR + 8 * c + 4);
            sr += lo16(w.x) * q0.x + hi16(w.x) * q0.y + lo16(w.y) * q0.z + hi16(w.y) * q0.w + lo16(w.z) * q1.x + hi16(w.z) * q1.y + lo16(w.w) * q1.z + hi16(w.w) * q1.w; }
        s[u] = ((u ? snB : snA) + sr) * MLA_SCALE; }
    const float mx = wave_max(fmaxf(s[0], s[1]));
    const float p0 = __expf(s[0] - mx), p1 = __expf(s[1] - mx);
    const float lsum = wave_sum(p0 + p1);
    *(LAS bf16*)(lds + DP_PT + h * 272 + (32 * (2 * hi) + l31) * 2) = (bf16)f2bf(p0);
    *(LAS bf16*)(lds + DP_PT + h * 272 + (32 * (2 * hi + 1) + l31) * 2) = (bf16)f2bf(p1);
    if (lane == 0) { float* ml = (float*)(ws + WS_DML) + ((size_t)unit * 8 + h) * 2; ml[0] = mx; ml[1] = lsum; }
    __syncthreads();
    float* DA = (float*)(ws + WS_DACC) + (size_t)unit * 8 * 512;
#pragma unroll 1
    for (int t = 0; t < 2; ++t) { const int cb = 64 * wave + 32 * t + l31;
        f32x16 acc2 = {};
#pragma unroll 2
        for (int ks = 0; ks < 8; ++ks) {
            bf16x8 a = {0, 0, 0, 0, 0, 0, 0, 0};
            if (l31 < 8) a = lds_ld8(lds + DP_PT + l31 * 272 + (16 * ks + 8 * hi) * 2);
            bf16x8 bb;
#pragma unroll
            for (int jj = 0; jj < 8; ++jj) bb[jj] = (short)*(LAS const bf16*)(lds + DP_CT + (16 * ks + 8 * hi + jj) * 1040 + cb * 2);
            acc2 = MFMA32(a, bb, acc2);
        }
#pragma unroll
        for (int r = 0; r < 4; ++r) DA[(size_t)(r + 4 * hi) * 512 + cb] = acc2[r];
    }
    __syncthreads();
}
__device__ __forceinline__ void dec_combine(const Args& A, LAS unsigned char* lds, int unit, int tid, int lane, int wave) {
    unsigned char* ws = A.ws;
    const int j = unit >> 3, h = unit & 7, row = MP + j;
    const bf16* Krow = (const bf16*)(ws + WS_KN) + (size_t)row * 1024 + h * 128;
    const bf16* KRrow = (const bf16*)(ws + WS_KR) + (size_t)row * 64;
    const float snew = wave_sum(dec_qn(A, j, h, lane) * bf2f(Krow[lane]) + dec_qn(A, j, h, lane + 64) * bf2f(Krow[lane + 64])
                                + dec_qr(A, j, h, lane) * bf2f(KRrow[lane])) * MLA_SCALE;
    const float* ML = (const float*)(ws + WS_DML) + ((size_t)j * NPAGE * 8 + h) * 2;
    const float m0 = ML[(size_t)lane * 16], m1 = ML[(size_t)(lane + 64) * 16], l0 = ML[(size_t)lane * 16 + 1], l1 = ML[(size_t)(lane + 64) * 16 + 1];
    const float M = fmaxf(wave_max(fmaxf(m0, m1)), snew);
    const float wn = __expf(snew - M);
    const float den = wave_sum(__expf(m0 - M) * l0 + __expf(m1 - M) * l1) + wn;
    const float* DA = (const float*)(ws + WS_DACC) + ((size_t)j * NPAGE * 8 + h) * 512 + tid;
    float num = wn * bf2f(((const bf16*)(ws + WS_C))[(size_t)row * 512 + tid]);
#pragma unroll 16
    for (int p = 0; p < NPAGE; ++p) num += __expf(ML[(size_t)p * 16] - M) * DA[(size_t)p * 4096];
    LAS float* lat = (LAS float*)lds; LAS float* red = lat + 512;
    lat[tid] = num / den;
    __syncthreads();
    const int d = tid & 127, qt = tid >> 7;
    const float* Wv = A.in[I_WUV] + (size_t)(qt * 128) * 1024 + h * 128 + d;
    float part = 0.f;
#pragma unroll 32
    for (int c = 0; c < 128; ++c) part += lat[qt * 128 + c] * Wv[(size_t)c * 1024];
    red[tid] = part;
    __syncthreads();
    if (tid < 128) ((bf16*)(ws + WS_YB))[(size_t)row * 1024 + h * 128 + tid] = (bf16)f2bf(red[tid] + red[128 + tid] + red[256 + tid] + red[384 + tid]);
    __syncthreads();
}
__device__ __forceinline__ f32x16 skinny_partial(const bf16* A, const bf16* Bt, int K, int n0, int wave, int lane) {
    const int l31 = lane & 31, hi = lane >> 5, kw = K >> 3, k0 = wave * kw;
    const bf16* ap = A + (size_t)l31 * K + k0 + 8 * hi; const bf16* bp = Bt + (size_t)(n0 + l31) * K + k0 + 8 * hi;
    f32x16 acc = {};
#pragma unroll 8
    for (int ks = 0; ks < (kw >> 4); ++ks) acc = MFMA32(gl_ld8(ap + 16 * ks), gl_ld8(bp + 16 * ks), acc);
    return acc;
}
__device__ __forceinline__ void skinny_put(LAS float* red, const f32x16& acc, int wave, int lane) {
    const int l31 = lane & 31, hi = lane >> 5;
#pragma unroll
    for (int r = 0; r < 16; ++r) red[(wave * 32 + crow(r, hi)) * 32 + l31] = acc[r];
}
__device__ __forceinline__ void skinny_get(LAS const float* red, int tid, float& v0, float& v1) {
    v0 = 0.f; v1 = 0.f;
#pragma unroll
    for (int w = 0; w < 8; ++w) { v0 += red[w * 1024 + tid * 2]; v1 += red[w * 1024 + tid * 2 + 1]; }
}
template <int MODE> __device__ __forceinline__ void skinny_tile(const Args& A, LAS unsigned char* lds, int tile, int tid, int lane, int wave) {
    unsigned char* ws = A.ws; const int n0 = tile * 32;
    LAS float* red = (LAS float*)lds; LAS float* red2 = red + 8192;
    if (MODE == 0) {
        skinny_put(red, skinny_partial((const bf16*)(ws + WS_YA) + (size_t)MP * 1024, (const bf16*)(ws + WS_WYA), 1024, n0, wave, lane), wave, lane);
        skinny_put(red2, skinny_partial((const bf16*)(ws + WS_YB) + (size_t)MP * 1024, (const bf16*)(ws + WS_WYB), 1024, n0, wave, lane), wave, lane);
    } else if (MODE == 1) skinny_put(red, skinny_partial((const bf16*)(ws + WS_T) + (size_t)MP * 1024, (const bf16*)(ws + WS_WO), 1024, n0, wave, lane), wave, lane);
    else if (MODE == 2) skinny_put(red, skinny_partial((const bf16*)(ws + WS_XN2) + (size_t)MP * 1024, (const bf16*)(ws + WS_WUP), 1024, n0, wave, lane), wave, lane);
    else skinny_put(red, skinny_partial((const bf16*)(ws + WS_H) + (size_t)MP * 4096, (const bf16*)(ws + WS_WDN), 4096, n0, wave, lane), wave, lane);
    __syncthreads();
    float v0, v1; skinny_get(red, tid, v0, v1);
    const int row = tid >> 4, col = n0 + 2 * (tid & 15); const size_t grow = (size_t)(MP + row);
    if (MODE == 0) {
        float u0, u1; skinny_get(red2, tid, u0, u1);
        const bf16* g = (const bf16*)(ws + WS_GATES) + grow * 2048 + col;
        const float t0 = bf2f(g[0]) * v0 + bf2f(g[1024]) * u0, t1 = bf2f(g[1]) * v1 + bf2f(g[1025]) * u1;
        *(unsigned*)((bf16*)(ws + WS_T) + grow * 1024 + col) = pk2(t0, t1);
    } else if (MODE == 1) {
        const float* x = A.in[I_XS] + (size_t)row * 1024 + col;
        const float y0 = x[0] + v0, y1 = x[1] + v1;
        *(unsigned*)((bf16*)(ws + WS_XN2) + grow * 1024 + col) = pk2(y0, y1);
        float ss = y0 * y0 + y1 * y1; ss += __shfl_xor(ss, 1); ss += __shfl_xor(ss, 2); ss += __shfl_xor(ss, 4); ss += __shfl_xor(ss, 8);
        if ((tid & 15) == 0) atomicAdd((float*)(ws + WS_RX) + grow, ss);
    } else if (MODE == 2) {
        const float rr = __builtin_amdgcn_rsqf(((const float*)(ws + WS_RX))[grow] * (1.f / 1024.f) + EPS);
        const float a = fmaxf(v0 * rr, 0.f), b = fmaxf(v1 * rr, 0.f);
        *(unsigned*)((bf16*)(ws + WS_H) + grow * 4096 + col) = pk2(a * a, b * b);
    } else {
        const unsigned xw = *(const unsigned*)((const bf16*)(ws + WS_XN2) + grow * 1024 + col); float* o = A.out + O_YS + (size_t)row * 1024 + col;
        o[0] = lo16(xw) + v0; o[1] = hi16(xw) + v1;
    }
    __syncthreads();
}
struct DecPk { v4u p[36]; };
#ifndef DEC_RD
#define DEC_RD 16
#endif
constexpr int RD = DEC_RD;
__device__ __forceinline__ void dec_load_sync(const Args& A, LAS unsigned char* lds, int unit, int tid) {
    const int phys = ((const int*)A.in[I_PT])[unit];
    const float* src = A.in[I_CACHE] + (size_t)phys * PAGE * LATW;
#pragma unroll 1
    for (int q0 = 0; q0 < 18; q0 += 6) {
        f32x4 va[6], vb[6];
#pragma unroll
        for (int q = 0; q < 6; ++q) { const int id = (q0 + q) * 512 + tid, row = id / 72, g = id % 72; const float* p = src + (size_t)row * LATW + 8 * g; va[q] = *(const f32x4*)p; vb[q] = *(const f32x4*)(p + 4); }
#pragma unroll
        for (int q = 0; q < 6; ++q) { const int id = (q0 + q) * 512 + tid, row = id / 72, g = id % 72;
            v4u o; o.x = pk2(va[q].x, va[q].y); o.y = pk2(va[q].z, va[q].w); o.z = pk2(vb[q].x, vb[q].y); o.w = pk2(vb[q].z, vb[q].w);
            if (g < 64) *(LAS v4u*)(lds + DP_CT + row * 1040 + g * 16) = o; else *(LAS v4u*)(lds + DP_KR + row * 144 + (g - 64) * 16) = o; }
    }
    __syncthreads();
}
__device__ __forceinline__ void dec_prefetch(const Args& A, int unit, int lt, DecPk& pk) {
    const int phys = __builtin_amdgcn_readfirstlane(((const int*)A.in[I_PT])[unit]);
    const char* src = (const char*)(A.in[I_CACHE] + (size_t)phys * PAGE * LATW);
    const unsigned lo = (unsigned)lt * 32u;
#pragma unroll
    for (int q0 = 0; q0 < 36; q0 += 12) {
        f32x4 va[12], vb[12];
#pragma unroll
        for (int q = 0; q < 12; ++q) { const char* p = src + (size_t)(q0 + q) * 8192 + lo; va[q] = __builtin_nontemporal_load((const f32x4*)p); vb[q] = __builtin_nontemporal_load((const f32x4*)(p + 16)); }
#pragma unroll
        for (int q = 0; q < 12; ++q) { v4u o; o.x = pk2(va[q].x, va[q].y); o.y = pk2(va[q].z, va[q].w); o.z = pk2(vb[q].x, vb[q].y); o.w = pk2(vb[q].z, vb[q].w); pk.p[q0 + q] = o; }
    }
}
__device__ __forceinline__ void dec_store(LAS unsigned char* lds, int lt, const DecPk& pk) {
    int ltx = lt; asm volatile("" : "+v"(ltx));
#pragma unroll
    for (int q = 0; q < 36; ++q) { const int id = q * 256 + ltx, row = id / 72, g = id - row * 72;
        const int off = g < 64 ? DP_CT + row * 1040 + g * 16 : DP_KR + row * 144 + (g - 64) * 16;
        *(LAS v4u*)(lds + off) = pk.p[q]; }
}
__device__ __forceinline__ void dec_ring_fill(const Args& A, int mw, int lane, bf16x8 (&a)[RD]) {
    const __amdgpu_buffer_rsrc_t rs = __builtin_amdgcn_make_buffer_rsrc((void*)(A.ws + WS_WKT), 0, 1024 * 512 * 2, 0x00020000);
    const unsigned voff = (unsigned)lane * 16u; const int so = 256 * mw * 1024;
#pragma unroll
    for (int d = 0; d < RD; ++d) a[d] = __builtin_bit_cast(bf16x8, __builtin_amdgcn_raw_buffer_load_b128(rs, voff, so + d * 1024, 0));
}
__device__ __forceinline__ void dec_mfma(const Args& A, LAS unsigned char* lds, int unit, int mw, int lane, bf16x8 (&a)[RD]) {
    const int l31_ = lane & 31, hi_ = lane >> 5;
    const __amdgpu_buffer_rsrc_t rs = __builtin_amdgcn_make_buffer_rsrc((void*)(A.ws + WS_WKT), 0, 1024 * 512 * 2, 0x00020000);
    const unsigned voff = (unsigned)lane * 16u; const int so = 256 * mw * 1024;
    LAS const unsigned char* Bb = lds + DP_CT + l31_ * 1040 + hi_ * 16;
    float ssq[4] = {0.f, 0.f, 0.f, 0.f}, dot[4] = {0.f, 0.f, 0.f, 0.f};
    bf16x8 bc0 = lds_ld8(Bb), bc1 = lds_ld8(Bb + 33280), bc2 = lds_ld8(Bb + 2 * 33280), bc3 = lds_ld8(Bb + 3 * 33280), bd0, bd1, bd2, bd3;
#pragma unroll 1
    for (int jb = 0; jb < 8; ++jb) {
        f32x16 acc[4];
#pragma unroll
        for (int nt = 0; nt < 4; ++nt) acc[nt] = f32x16{};
#pragma unroll 1
        for (int blk = 0; blk < 32 / RD; ++blk) {
            const int nj = (blk == 32 / RD - 1) ? ((jb + 1) & 7) : jb, nk = (blk == 32 / RD - 1) ? 0 : (blk + 1) * RD;
            const int nb = so + nj * 32 * 1024 + 1024 * nk;
            LAS const unsigned char* Bk = Bb + blk * (32 * RD);
            LAS const unsigned char* Bn = Bb + ((blk + 1) & (32 / RD - 1)) * (32 * RD);
#pragma unroll
            for (int d = 0; d < RD; d += 2) {
                {
                    LAS const unsigned char* Bx = Bk + (d + 1) * 32;
                    bd0 = lds_ld8(Bx); bd1 = lds_ld8(Bx + 33280); bd2 = lds_ld8(Bx + 2 * 33280); bd3 = lds_ld8(Bx + 3 * 33280);
                    __builtin_amdgcn_sched_barrier(0);
                    acc[0] = MFMA32(a[d], bc0, acc[0]); acc[1] = MFMA32(a[d], bc1, acc[1]); acc[2] = MFMA32(a[d], bc2, acc[2]); acc[3] = MFMA32(a[d], bc3, acc[3]);
                    a[d] = __builtin_bit_cast(bf16x8, __builtin_amdgcn_raw_buffer_load_b128(rs, voff, nb + d * 1024, 0));
                    __builtin_amdgcn_sched_barrier(0);
                }
                {
                    LAS const unsigned char* Bx = (d + 2 < RD) ? Bk + (d + 2) * 32 : Bn;
                    bc0 = lds_ld8(Bx); bc1 = lds_ld8(Bx + 33280); bc2 = lds_ld8(Bx + 2 * 33280); bc3 = lds_ld8(Bx + 3 * 33280);
                    __builtin_amdgcn_sched_barrier(0);
                    acc[0] = MFMA32(a[d + 1], bd0, acc[0]); acc[1] = MFMA32(a[d + 1], bd1, acc[1]); acc[2] = MFMA32(a[d + 1], bd2, acc[2]); acc[3] = MFMA32(a[d + 1], bd3, acc[3]);
                    a[d + 1] = __builtin_bit_cast(bf16x8, __builtin_amdgcn_raw_buffer_load_b128(rs, voff, nb + (d + 1) * 1024, 0));
                    __builtin_amdgcn_sched_barrier(0);
                }
            }
        }
        const int e4 = jb & 3, h = 2 * mw + (jb >> 2);
#ifdef PROBE_K
        const unsigned long long fz0 = __builtin_amdgcn_s_memrealtime();
#endif
        int l31 = l31_, hi = hi_; asm volatile("" : "+v"(l31), "+v"(hi));
        LAS const float* QK = (LAS const float*)(lds + DP_QK) + h * 128 + 32 * e4 + 4 * hi;
#pragma unroll
        for (int g = 0; g < 4; ++g) { const f32x4 qv = *(LAS const f32x4*)(QK + 8 * g);
#pragma unroll
            for (int nt = 0; nt < 4; ++nt) {
                const float x0 = acc[nt][4 * g], x1 = acc[nt][4 * g + 1], x2 = acc[nt][4 * g + 2], x3 = acc[nt][4 * g + 3];
                ssq[nt] += x0 * x0 + x1 * x1 + x2 * x2 + x3 * x3; dot[nt] += x0 * qv.x + x1 * qv.y + x2 * qv.z + x3 * qv.w; } }
        if (e4 == 3) {
#pragma unroll
            for (int nt = 0; nt < 4; ++nt) { ssq[nt] += __shfl_xor(ssq[nt], 32); dot[nt] += __shfl_xor(dot[nt], 32); }
            const float sn0 = dot[0] / sqrtf(ssq[0] * (1.f / 128.f) + EPS), sn1 = dot[1] / sqrtf(ssq[1] * (1.f / 128.f) + EPS);
            const float sn2 = dot[2] / sqrtf(ssq[2] * (1.f / 128.f) + EPS), sn3 = dot[3] / sqrtf(ssq[3] * (1.f / 128.f) + EPS);
            const float snA = hi ? sn2 : sn0, snB = hi ? sn3 : sn1;
            float s[2];
            LAS const float* QR = (LAS const float*)(lds + DP_QR) + h * 64;
#pragma unroll
            for (int u = 0; u < 2; ++u) { const int key = 32 * (2 * hi + u) + l31; float sr = 0.f;
#pragma unroll
                for (int c = 0; c < 8; ++c) { const v4u w = *(LAS const v4u*)(lds + DP_KR + key * 144 + c * 16); const f32x4 q0 = *(LAS const f32x4*)(QR + 8 * c), q1 = *(LAS const f32x4*)(QR + 8 * c + 4);
                    sr += lo16(w.x) * q0.x + hi16(w.x) * q0.y + lo16(w.y) * q0.z + hi16(w.y) * q0.w + lo16(w.z) * q1.x + hi16(w.z) * q1.y + lo16(w.w) * q1.z + hi16(w.w) * q1.w; }
                s[u] = ((u ? snB : snA) + sr) * MLA_SCALE; }
            const float mx = wave_max(fmaxf(s[0], s[1]));
            const float p0 = __expf(s[0] - mx), p1 = __expf(s[1] - mx);
            const float lsum = wave_sum(p0 + p1);
            *(LAS bf16*)(lds + DP_PT + h * 272 + (32 * (2 * hi) + l31) * 2) = (bf16)f2bf(p0);
            *(LAS bf16*)(lds + DP_PT + h * 272 + (32 * (2 * hi + 1) + l31) * 2) = (bf16)f2bf(p1);
            if (l31 + hi == 0) { float* ml = (float*)(A.ws + WS_DML) + ((size_t)unit * 8 + h) * 2; ml[0] = mx; ml[1] = lsum; }
#pragma unroll
            for (int nt = 0; nt < 4; ++nt) { ssq[nt] = 0.f; dot[nt] = 0.f; }
        }
#ifdef PROBE_K
        if (PROBE_K == 67 && mw == 0 && lane == 0) ((volatile LAS unsigned*)(lds + MISC_OFF))[20] += (unsigned)(__builtin_amdgcn_s_memrealtime() - fz0);
#endif
    }
}
__device__ __forceinline__ void dec_pv(const Args& A, LAS unsigned char* lds, int unit, int lane, int wave) {
    int l31 = lane & 31, hi = lane >> 5; asm volatile("" : "+v"(l31), "+v"(hi));
    float* DA = (float*)(A.ws + WS_DACC) + (size_t)unit * 8 * 512;
#pragma unroll 1
    for (int t = 0; t < 2; ++t) { const int cb = 64 * wave + 32 * t + l31;
        f32x16 acc2 = {};
#pragma unroll 2
        for (int ks = 0; ks < 8; ++ks) {
            bf16x8 a = {0, 0, 0, 0, 0, 0, 0, 0};
            if (l31 < 8) a = lds_ld8(lds + DP_PT + l31 * 272 + (16 * ks + 8 * hi) * 2);
            bf16x8 bb;
#pragma unroll
            for (int jj = 0; jj < 8; ++jj) bb[jj] = (short)*(LAS const bf16*)(lds + DP_CT + (16 * ks + 8 * hi + jj) * 1040 + cb * 2);
            acc2 = MFMA32(a, bb, acc2);
        }
#pragma unroll
        for (int r = 0; r < 4; ++r) DA[(size_t)(r + 4 * hi) * 512 + cb] = acc2[r];
    }
}
constexpr int NG4 = 640, NG2 = 512, NG1 = 512;
template <bool MF> __device__ __forceinline__ void dec_loop(const Args& A, LAS unsigned char* lds, volatile LAS unsigned* MISC, unsigned* qc, int g, int tid, int lane, int wave) {
    constexpr int NGRP = NG4 + NG2 + NG1; static_assert(4 * NG4 + 2 * NG2 + NG1 == 4096, "page count");
#define GFIRST(g_) ((g_) < NG4 ? 4 * (g_) : (g_) < NG4 + NG2 ? 4 * NG4 + 2 * ((g_) - NG4) : 4 * NG4 + 2 * NG2 + ((g_) - NG4 - NG2))
#define GCOUNT(g_) ((g_) < NG4 ? 4 : (g_) < NG4 + NG2 ? 2 : 1)
#define DPULL() ({ __syncthreads(); if (tid == 0) MISC[0] = atomicAdd(qc, 1u); __syncthreads(); (int)MISC[0]; })
    int jcur = -1;
#ifdef PROBE_K
#ifndef PROBE_B
#define PROBE_B 0
#endif
    unsigned long long pt0 = 0, pdt = 0;
#define DPS(k) do { if ((k) == PROBE_K) pt0 = __builtin_amdgcn_s_memrealtime(); } while (0)
#define DPE(k) do { if ((k) == PROBE_K) pdt += __builtin_amdgcn_s_memrealtime() - pt0; } while (0)
#else
#define DPS(k) do {} while (0)
#define DPE(k) do {} while (0)
#endif
    bf16x8 a[RD];
    if (MF) dec_ring_fill(A, wave, lane, a);
#pragma unroll 1
    while (g < NGRP) {
        const int gn = DPULL();
        const int j = GFIRST(g) >> 7, PG = GCOUNT(g), u0 = GFIRST(g);
        if (j != jcur) { dec_tables(A, lds, j, tid); jcur = j; __syncthreads(); }
#pragma unroll 1
        for (int p = 0; p < PG; ++p) {
            const int unit = u0 + p, np = (p + 1 < PG) ? unit + 1 : (gn < NGRP ? GFIRST(gn) : -1);
            DecPk pk;
            DPS(64); DPS(60); DPS(61);
#ifdef PROBE_K
            const unsigned long long ck0 = __builtin_readcyclecounter();
#endif
            if (MF) { dec_mfma(A, lds, unit, wave, lane, a); DPE(60);
#ifdef PROBE_K
                if (PROBE_K == 66) pdt += (__builtin_readcyclecounter() - ck0) / 24;
#endif
            }
            else if (np >= 0) { dec_prefetch(A, np, tid - 256, pk); DPE(61); }
            LBAR();
            DPS(62);
            dec_pv(A, lds, unit, lane, wave);
            LBAR();
            DPE(62); DPS(63);
            if (MF) { if (np >= 0) dec_ring_fill(A, wave, lane, a); }
            else if (np >= 0) dec_store(lds, tid - 256, pk);
            LBAR();
            DPE(63); DPE(64);
#ifdef PROBE_K
            if (PROBE_K == 67) pdt = ((volatile LAS unsigned*)(lds + MISC_OFF))[20];
#endif
#ifdef PROBE_K
            if (PROBE_K == 65) pdt += 1000;
#endif
        }
        g = gn;
    }
#ifdef PROBE_K
    if (blockIdx.x == PROBE_B && PROBE_K >= 60) { const unsigned long long te = __builtin_amdgcn_s_memrealtime(); while (__builtin_amdgcn_s_memrealtime() - te < (unsigned long long)PROBE_MULT * pdt) __builtin_amdgcn_s_sleep(8); }
#endif
}
__device__ __forceinline__ void dec_run(const Args& A, LAS unsigned char* lds, volatile LAS unsigned* MISC, unsigned* qc, int tid, int lane, int wave) {
    const int g = DPULL();
    if (g >= NG4 + NG2 + NG1) return;
    dec_load_sync(A, lds, GFIRST(g), tid);
    if (wave < 4) dec_loop<true>(A, lds, MISC, qc, g, tid, lane, wave);
    else dec_loop<false>(A, lds, MISC, qc, g, tid, lane, wave);
#undef DPULL
#undef GFIRST
#undef GCOUNT
}
#ifndef MK_SINGLE
#define MK_SINGLE 1
#endif
constexpr int N_PHASES = 12;
__global__ void __launch_bounds__(512, 2) mk_fwd(Args args) {
    extern __shared__ __attribute__((aligned(16))) unsigned char lds_raw[];
    LAS unsigned char* lds = (LAS unsigned char*)lds_raw;
    const int tid = threadIdx.x, lane = tid & 63, wave = __builtin_amdgcn_readfirstlane(tid >> 6);
    const int G = gridDim.x, bid = blockIdx.x;
    const int gw = bid * 8 + wave, NGW = G * 8, gtid = bid * 512 + tid, NGT = G * 512;
    volatile LAS unsigned* MISC = (volatile LAS unsigned*)(lds + MISC_OFF);
    if (tid < 32) MISC[tid] = 0u;
    __syncthreads();
    unsigned char* ws = args.ws;
#if MK_SINGLE
    XcdBarrier bar = xcd_barrier_post((unsigned*)(ws + WS_CTL) + 4096, MISC + 8);
#define GRID_BAR() xcd_barrier(bar)
#else
#define GRID_BAR() do {} while (0)
#endif
    const int lo = args.ph_lo, hi = args.ph_hi;
#ifdef PROBE_K
#ifndef PROBE_B
#define PROBE_B 0
#endif
    unsigned long long pt0 = 0, pdt = 0;
#define PSTART(k) do { if ((k) == PROBE_K) pt0 = __builtin_amdgcn_s_memrealtime(); } while (0)
#define PEND(k) do { if ((k) == PROBE_K) pdt += __builtin_amdgcn_s_memrealtime() - pt0; } while (0)
#else
#define PSTART(k) do {} while (0)
#define PEND(k) do {} while (0)
#endif
#ifndef PHASE_MASK
#define PHASE_MASK 0xFFFF
#endif
#define IN(k) (((PHASE_MASK >> (k)) & 1) && lo <= (k) && (k) < hi)
#define SEAM(k) do { if (IN(k) && IN((k) + 1)) GRID_BAR(); } while (0)

    PSTART(0);
    if (IN(0)) {
        p0_prologue(args, lds, gw, NGW, wave, lane);
        for (int i = gtid; i < 32 * 2 * 3072; i += NGT) { const int c = i % 3072, r = (i / 3072) % 2, j = i / (2 * 3072);
            args.out[O_CSS + (size_t)(j * 3 + r) * 3072 + c] = args.in[I_SCONV][(size_t)(j * 3 + r + 1) * 3072 + c]; }
        __syncthreads();
    }
    SEAM(0);
    PEND(0);
    PSTART(1);
    if (IN(1)) {
        pg8::Gemm g{(const pg8::bf16_t*)(ws + WS_XN), (const pg8::bf16_t*)(ws + WS_WIN), MPAD, NIN, 1024};
        pg8::StaticOrder S; S.init(MPAD, NIN, G, bid);
        EpiG1 E{(bf16*)(ws + WS_QKV), (bf16*)(ws + WS_Z), (bf16*)(ws + WS_QD), (bf16*)(ws + WS_KVD), (bf16*)(ws + WS_GATES), (float*)(ws + WS_SM)};
        pg8::gemm_phase<EpiG1, pg8::StaticOrder, true, true>(lds, g, S, E);
        { const int nfull = (MPAD / 256) * (NIN / 256) - ((MPAD / 256) * (NIN / 256) / G) * G;
          if (bid >= nfull) cvt_weights<true>(args, lds, (bid - nfull) * 8 + wave, (G - nfull) * 8, wave, lane); }
    }
    SEAM(1);
    PEND(1);
    PSTART(2);
    if (IN(2)) {
        p2_rows(args, gw, NGW, lane);
        p2_conv_state(args, gtid, NGT);
    }
    SEAM(2);
    PEND(2);
    PSTART(3);
    if (IN(3)) {
        { pg8::Gemm g{(const pg8::bf16_t*)(ws + WS_QD), (const pg8::bf16_t*)(ws + WS_WQ), MPAD, 1536, 512};
          pg8::StaticOrder S; S.init(MPAD, 1536, G, bid);
          EpiHeads<0> E{(bf16*)(ws + WS_QP), 1536, 6, (bf16*)(ws + WS_QP), 1536, (float*)(ws + WS_SQR), args.in[I_QNN], (LAS float*)(lds + EPI_S_OFF)};
          pg8::gemm_phase<EpiHeads<0>, pg8::StaticOrder, true, true>(lds, g, S, E); }
        { pg8::Gemm g{(const pg8::bf16_t*)(ws + WS_C), (const pg8::bf16_t*)(ws + WS_WKV), MPAD, 2048, 512};
          pg8::StaticOrder S; S.init(MPAD, 2048, G, G - 1 - bid);
          EpiHeads<1> E{(bf16*)(ws + WS_KN), 1024, 4, (bf16*)(ws + WS_V), 1024, (float*)(ws + WS_SQR), args.in[I_KNN], (LAS float*)(lds + EPI_S_OFF)};
          pg8::gemm_phase<EpiHeads<1>, pg8::StaticOrder, true, true>(lds, g, S, E); }
        PSTART(31);
        for (int u = bid; u < 2048; u += G) gdn_a_unit(args, lds, u, tid, lane, wave);
        PEND(31); PSTART(32);
        for (int u = bid; u < 256; u += G) gdn_r_unit(args, lds, u, tid, lane, wave);
        PEND(32);
    }
    SEAM(3);
    PEND(3);
    PSTART(5);
    if (IN(5)) {
        unsigned* qctr = (unsigned*)(ws + WS_CTL) + 64;
#define PULL(k) ({ __syncthreads(); if (tid == 0) MISC[0] = atomicAdd(qctr + 64 * (k), 1u); __syncthreads(); (int)MISC[0]; })
        PSTART(50);
        for (int it = PULL(0); it < 64; it = PULL(0)) gdn_b_unit(args, lds, it, tid, lane, wave);
        PEND(50); PSTART(51);
        for (int u = PULL(1); u < 256; u = PULL(1)) {
            const int bh = u >> 2, pr = u & 3, b = bh >> 3, h = bh & 7;
#pragma unroll 1
            for (int s2 = 0; s2 < 2; ++s2) { const int qb = s2 ? pr : 7 - pr;
                att::attn_block((const bf16*)(ws + WS_QP) + (size_t)(b * SEQ + 256 * qb) * 1536 + h * 128, (const bf16*)(ws + WS_QP) + (size_t)(b * SEQ + 256 * qb) * 1536 + 1024 + h * 64,
                                (const float*)(ws + WS_SQN) + (size_t)(b * SEQ + 256 * qb) * 8 + h, (const float*)(ws + WS_SQR) + (size_t)(b * SEQ + 256 * qb) * 8 + h,
                                (const bf16*)(ws + WS_KN) + (size_t)(b * SEQ) * 1024 + h * 128, (const float*)(ws + WS_SKN) + (size_t)(b * SEQ) * 8 + h,
                                (const bf16*)(ws + WS_KR) + (size_t)(b * SEQ) * 64, (const bf16*)(ws + WS_V) + (size_t)(b * SEQ) * 1024 + h * 128,
                                args.in[I_QNN], args.in[I_QNR], args.in[I_KNN],
                                (bf16*)(ws + WS_YB) + (size_t)(b * SEQ + 256 * qb) * 1024 + h * 128, 256 * qb, lds); }
        }
        PEND(51); PSTART(52);
        dec_run(args, lds, MISC, qctr + 128, tid, lane, wave);
        PEND(52); PSTART(53);
#undef PULL
    }
    SEAM(5);
    PEND(5); PEND(53);
    PSTART(6);
    if (IN(6)) { for (int u = bid; u < 256; u += G) dec_combine(args, lds, u, tid, lane, wave); }
    SEAM(6);
    PEND(6);
    PSTART(7);
    if (IN(7)) {
        for (int t = bid; t < 32; t += G) skinny_tile<0>(args, lds, t, tid, lane, wave);
        pg8::StaticOrder S; S.init(MP, 1024, G, bid);
        { pg8::Gemm g{(const pg8::bf16_t*)(ws + WS_YA), (const pg8::bf16_t*)(ws + WS_WYA), MP, 1024, 1024};
          EpiMerge<1> E{(const bf16*)(ws + WS_GATES), (float*)(ws + WS_TF), (bf16*)(ws + WS_T)};
          pg8::gemm_phase<EpiMerge<1>, pg8::StaticOrder, true, true>(lds, g, S, E); }
        { pg8::Gemm g{(const pg8::bf16_t*)(ws + WS_YB), (const pg8::bf16_t*)(ws + WS_WYB), MP, 1024, 1024};
          EpiMerge<2> E{(const bf16*)(ws + WS_GATES), (float*)(ws + WS_TF), (bf16*)(ws + WS_T)};
          pg8::gemm_phase<EpiMerge<2>, pg8::StaticOrder, true, true>(lds, g, S, E); }
    }
    SEAM(7);
    PEND(7);
    PSTART(8);
    if (IN(8)) {
        for (int t = bid; t < 32; t += G) skinny_tile<1>(args, lds, t, tid, lane, wave);
        pg8::Gemm g{(const pg8::bf16_t*)(ws + WS_T), (const pg8::bf16_t*)(ws + WS_WO), MP, 1024, 1024};
        pg8::StaticOrder S; S.init(MP, 1024, G, bid);
        EpiRes<0> E{args.in[I_XP], args.in[I_XS], (float*)(ws + WS_X1), args.out, (bf16*)(ws + WS_XN2), (float*)(ws + WS_RX), lds};
        pg8::gemm_phase<EpiRes<0>, pg8::StaticOrder, true, true>(lds, g, S, E);
    }
    SEAM(8);
    PEND(8);
    PSTART(10);
    if (IN(10)) {
        for (int t = bid; t < 128; t += G) skinny_tile<2>(args, lds, t, tid, lane, wave);
        pg8::Gemm g{(const pg8::bf16_t*)(ws + WS_XN2), (const pg8::bf16_t*)(ws + WS_WUP), MP, 4096, 1024};
        pg8::StaticOrder S; S.init(MP, 4096, G, bid);
        EpiUp E{(bf16*)(ws + WS_H), (const float*)(ws + WS_RX)};
        pg8::gemm_phase<EpiUp, pg8::StaticOrder, true, true>(lds, g, S, E);
    }
    SEAM(10);
    PEND(10);
    PSTART(11);
    if (IN(11)) {
        for (int t = bid; t < 32; t += G) skinny_tile<3>(args, lds, t, tid, lane, wave);
        pg8::Gemm g{(const pg8::bf16_t*)(ws + WS_H), (const pg8::bf16_t*)(ws + WS_WDN), MP, 1024, 4096};
        pg8::StaticOrder S; S.init(MP, 1024, G, bid);
        EpiRes<1> E{args.in[I_XP], args.in[I_XS], (float*)(ws + WS_X1), args.out, (bf16*)(ws + WS_XN2), (float*)(ws + WS_RX), lds};
        pg8::gemm_phase<EpiRes<1>, pg8::StaticOrder, true, true>(lds, g, S, E);
    }
    PEND(11);
#ifdef PROBE_K
    if (PROBE_K >= 80 && PROBE_K < 90) { __syncthreads(); pdt = MISC[16]; }
    if (bid == PROBE_B || (PROBE_K >= 80 && PROBE_K < 90)) { const unsigned long long te = __builtin_amdgcn_s_memrealtime(); while (__builtin_amdgcn_s_memrealtime() - te < (unsigned long long)PROBE_MULT * pdt) __builtin_amdgcn_s_sleep(8); }
#endif
#undef IN
#undef SEAM
}

extern "C" void kernel_launch(void* const* d_in, const int* in_sizes, int n_in, void* d_out, int out_size, void* d_ws, size_t ws_size, hipStream_t stream) {
    static int grid = 0;
    if (grid == 0) {
        if (n_in != 27 || ws_size < WS_END) { fprintf(stderr, "kernel_launch: unexpected n_in %d or ws_size %zu (need %zu)\n", n_in, ws_size, (size_t)WS_END); grid = -1; return; }
        int dev = 0, cus = 0, per_cu = 0;
        if (hipGetDevice(&dev) != hipSuccess || hipDeviceGetAttribute(&cus, hipDeviceAttributeMultiprocessorCount, dev) != hipSuccess) { grid = -1; return; }
        if (hipFuncSetAttribute((const void*)mk_fwd, hipFuncAttributeMaxDynamicSharedMemorySize, LDS_BYTES) != hipSuccess) { fprintf(stderr, "kernel_launch: hipFuncSetAttribute failed\n"); grid = -1; return; }
        if (hipOccupancyMaxActiveBlocksPerMultiprocessor(&per_cu, (const void*)mk_fwd, 512, LDS_BYTES) != hipSuccess || per_cu < 1) fprintf(stderr, "kernel_launch: occupancy query says %d\n", per_cu);
        (void)hipGetLastError();
        grid = cus;
    }
    if (grid < 0) return;
    (void)hipMemsetAsync((char*)d_ws + WS_CTL, 0, CTL_BYTES, stream);
    Args a{};
    for (int i = 0; i < 27; ++i) a.in[i] = (const float*)d_in[i];
    a.out = (float*)d_out; a.ws = (unsigned char*)d_ws;
#if MK_SINGLE
    a.ph_lo = 0; a.ph_hi = N_PHASES;
    hipLaunchKernelGGL(mk_fwd, dim3(grid), dim3(512), LDS_BYTES, stream, a);
#else
    for (int p = 0; p < N_PHASES; ++p) { a.ph_lo = p; a.ph_hi = p + 1; hipLaunchKernelGGL(mk_fwd, dim3(grid), dim3(512), LDS_BYTES, stream, a); }
#endif
    const hipError_t le = hipPeekAtLastError();
    if (le != hipSuccess) fprintf(stderr, "kernel_launch: launch failed: %s\n", hipGetErrorName(le));
}
```

```cpp
#include <hip/hip_runtime.h>
#include <cstdio>
#include <cstdint>
namespace pg8 {
#define PG8_LAS __attribute__((address_space(3)))
typedef unsigned short bf16_t;
typedef short bf16x8 __attribute__((ext_vector_type(8)));
typedef float f32x4 __attribute__((ext_vector_type(4)));
typedef unsigned u32x4 __attribute__((ext_vector_type(4)));
constexpr int BM = 256, BK = 64, HALF = 128, HTB = HALF * BK * 2  , STAGE_BYTES = 8 * HTB, NXCD = 8, WGM = 8;

__host__ __device__ __forceinline__ int lds_byte(int r, int c) { const int st = (r >> 4) * 2 + (c >> 5), rr = r & 15, cc = c & 31, ob = rr * 64 + cc * 2; return st * 1024 + (ob ^ (((ob >> 9) & 1) << 5)); }
__host__ __device__ __forceinline__ void stage_rc(int b, int& R, int& C) { const int st = b / 1024, sb = b % 1024, swz = sb ^ (((sb >> 9) & 1) << 5); R = (st >> 1) * 16 + swz / 64; C = (st & 1) * 32 + (swz % 64) / 2; }
__host__ __device__ __forceinline__ int perm32(int rho) { const int n = rho >> 4, i = rho & 15; return 8 * (i >> 2) + 4 * n + (i & 3); }

struct Unit { int pm, pn; };
struct Gemm { const bf16_t* A; const bf16_t* Bt; int M, N, K; };

struct StaticOrder {
    int nM, nN, nwg, G, c;
    __host__ __device__ void init(int M, int N, int G_, int c_) { nM = M / BM; nN = N / BM; nwg = nM * nN; G = G_; c = c_; }
    __host__ __device__ bool next(int i, Unit& u) const {
        const long L = (long)i * G + c; if (L >= nwg) return false;
        int wgid = (int)L; { const int q = nwg / NXCD, r = nwg % NXCD, xcd = wgid % NXCD, off = wgid / NXCD; wgid = (xcd < r ? xcd * (q + 1) : r * (q + 1) + (xcd - r) * q) + off; }
        const int nig = WGM * nN, gid = wgid / nig, fm = gid * WGM, gsz = (nM - fm) < WGM ? (nM - fm) : WGM;
        u.pm = fm + ((wgid % nig) % gsz); u.pn = (wgid % nig) / gsz; return true;
    }
    __device__ __forceinline__ void a_ready(const Unit&) const {}
    __device__ __forceinline__ void done(const Unit&) const {}
};

__device__ __forceinline__ unsigned cvt_pk_bf16(float lo, float hi) { unsigned r; asm volatile("v_cvt_pk_bf16_f32 %0, %1, %2" : "=v"(r) : "v"(lo), "v"(hi)); return r; }
template <class Epi, class Sched, bool ALIGN_EPI = false, bool SP2 = false>
__device__ __forceinline__ void gemm_phase(PG8_LAS unsigned char* lds, const Gemm g, const Sched& S, const Epi& E) {
    const int tid = threadIdx.x, wid = __builtin_amdgcn_readfirstlane(tid >> 6), lane = tid & 63, wr = wid >> 2, wc = wid & 3, fr = lane & 15, fq = lane >> 4;
    const int K = g.K, nt = K / BK;
    unsigned voffA[2], voffB[2];
#pragma unroll
    for (int i = 0; i < 2; ++i) { int R, C; stage_rc(tid * 16 + i * 8192, R, C); const int Rb = Epi::PERM ? ((R & ~31) + perm32(R & 31)) : R;
        voffA[i] = (unsigned)(R * K + C) * 2u; voffB[i] = (unsigned)(Rb * K + C) * 2u; }
    const size_t kstep = (size_t)(BK * 2);
    const size_t hstep = (size_t)HALF * K * 2;
    const size_t tstep = 2 * hstep;
    const unsigned ldsw = (unsigned)wid * 1024u;
    const int aoff = lds_byte(wr * 64 + fr, fq * 8), boff = lds_byte(wc * 32 + fr, fq * 8);
#define PG8_SA(b, h) (((b) * 2 + (h)) * HTB)
#define PG8_SB(b, h) ((4 + (b) * 2 + (h)) * HTB)
#define PG8_STAGE(bufoff, gbase, voff) do { _Pragma("unroll") for (int _i = 0; _i < 2; ++_i) \
        __builtin_amdgcn_global_load_lds((const unsigned*)((const char*)(gbase) + (voff)[_i]), (PG8_LAS unsigned*)(lds + (bufoff) + ldsw + _i * 8192), 16, 0, 0); } while (0)
#define PG8_LDA(dst, b, h) do { _Pragma("unroll") for (int m = 0; m < 4; ++m) _Pragma("unroll") for (int k = 0; k < 2; ++k) dst[m][k] = *(const PG8_LAS bf16x8*)(lds + PG8_SA(b, h) + aoff + m * 2048 + k * 1024); } while (0)
#define PG8_LDB(dst, b, h) do { _Pragma("unroll") for (int n = 0; n < 2; ++n) _Pragma("unroll") for (int k = 0; k < 2; ++k) dst[n][k] = *(const PG8_LAS bf16x8*)(lds + PG8_SB(b, h) + boff + n * 2048 + k * 1024); } while (0)
#define PG8_MMA(ai, bj, At, Bt) do { __builtin_amdgcn_s_setprio(1); _Pragma("unroll") for (int m = 0; m < 4; ++m) _Pragma("unroll") for (int n = 0; n < 2; ++n) _Pragma("unroll") for (int k = 0; k < 2; ++k) \
        acc[ai][bj][m][n] = __builtin_amdgcn_mfma_f32_16x16x32_bf16(Bt[n][k], At[m][k], acc[ai][bj][m][n], 0, 0, 0); __builtin_amdgcn_s_setprio(0); } while (0)
#define PG8_WAIT_V(n) asm volatile("s_waitcnt vmcnt(" #n ")" ::: "memory")
#define PG8_WAIT_L(n) asm volatile("s_waitcnt lgkmcnt(" #n ")" ::: "memory")
#define PG8_BAR __builtin_amdgcn_s_barrier()
#define PG8_SCHED __builtin_amdgcn_sched_barrier(0)
    Unit cur, nxt; int ui = 0;
    if (!S.next(0, cur)) return;
    f32x4 acc[2][2][4][2];
#pragma unroll
    for (int a = 0; a < 2; ++a)
#pragma unroll
        for (int b = 0; b < 2; ++b)
#pragma unroll
            for (int m = 0; m < 4; ++m)
#pragma unroll
                for (int n = 0; n < 2; ++n) acc[a][b][m][n] = (f32x4){0.f, 0.f, 0.f, 0.f};
    bf16x8 At[4][2], B0[2][2], B1[2][2];
    const char* cA = (const char*)g.A + (size_t)cur.pm * tstep; const char* cB = (const char*)g.Bt + (size_t)cur.pn * tstep;
    S.a_ready(cur);
    if constexpr (SP2) {
        PG8_STAGE(PG8_SB(0, 0), cB, voffB); PG8_STAGE(PG8_SB(0, 1), cB + hstep, voffB); PG8_STAGE(PG8_SA(0, 0), cA, voffA); PG8_STAGE(PG8_SA(0, 1), cA + hstep, voffA);
        if (wr == 1) PG8_BAR;
        PG8_WAIT_V(2); PG8_BAR;
        PG8_STAGE(PG8_SB(1, 0), cB + kstep, voffB); PG8_STAGE(PG8_SA(1, 0), cA + kstep, voffA); PG8_STAGE(PG8_SB(1, 1), cB + hstep + kstep, voffB);
        PG8_WAIT_V(6); PG8_BAR;
    } else {
        PG8_STAGE(PG8_SB(0, 0), cB, voffB); PG8_STAGE(PG8_SA(0, 0), cA, voffA); PG8_STAGE(PG8_SB(0, 1), cB + hstep, voffB); PG8_STAGE(PG8_SA(0, 1), cA + hstep, voffA);
        if (wr == 1) PG8_BAR;
        PG8_WAIT_V(4); PG8_BAR;
        PG8_STAGE(PG8_SB(1, 0), cB + kstep, voffB); PG8_STAGE(PG8_SA(1, 0), cA + kstep, voffA); PG8_STAGE(PG8_SB(1, 1), cB + hstep + kstep, voffB);
        PG8_WAIT_V(6); PG8_BAR;
    }
    for (;;) {
        const bool has_next = S.next(ui + 1, nxt);
        const char* nA = has_next ? (const char*)g.A + (size_t)nxt.pm * tstep : cA; const char* nB = has_next ? (const char*)g.Bt + (size_t)nxt.pn * tstep : cB;
        for (int t = 0; t < nt; t += 2) {
            const bool last = (t == nt - 2);
            const char* a1 = cA + (size_t)(t + 1) * kstep;
            const char* a2 = last ? nA : cA + (size_t)(t + 2) * kstep; const char* b2 = last ? nB : cB + (size_t)(t + 2) * kstep;
            const char* a3 = a2 + kstep; const char* b3 = b2 + kstep;
            if (last && has_next) S.a_ready(nxt);
            if constexpr (SP2) {
            PG8_LDB(B0, 0, 0); PG8_LDB(B1, 0, 1); PG8_SCHED; PG8_LDA(At, 0, 0); PG8_STAGE(PG8_SA(1, 1), a1 + hstep, voffA);
            PG8_WAIT_V(8); PG8_WAIT_L(0); PG8_BAR; PG8_MMA(0, 0, At, B0); PG8_MMA(0, 1, At, B1); PG8_BAR; PG8_SCHED;
            PG8_LDA(At, 0, 1); PG8_STAGE(PG8_SB(0, 0), b2, voffB); PG8_STAGE(PG8_SB(0, 1), b2 + hstep, voffB); PG8_STAGE(PG8_SA(0, 0), a2, voffA);
            PG8_WAIT_V(8); PG8_WAIT_L(0); PG8_BAR; PG8_MMA(1, 0, At, B0); PG8_MMA(1, 1, At, B1); PG8_BAR; PG8_SCHED;
            PG8_LDB(B0, 1, 0); PG8_LDB(B1, 1, 1); PG8_SCHED; PG8_LDA(At, 1, 0); PG8_STAGE(PG8_SA(0, 1), a2 + hstep, voffA);
            PG8_WAIT_V(8); PG8_WAIT_L(0); PG8_BAR; PG8_MMA(0, 0, At, B0); PG8_MMA(0, 1, At, B1); PG8_BAR; PG8_SCHED;
            PG8_LDA(At, 1, 1); PG8_STAGE(PG8_SB(1, 0), b3, voffB); PG8_STAGE(PG8_SB(1, 1), b3 + hstep, voffB); PG8_STAGE(PG8_SA(1, 0), a3, voffA);
            PG8_WAIT_V(8); PG8_WAIT_L(0); PG8_BAR; PG8_MMA(1, 0, At, B0); PG8_MMA(1, 1, At, B1); PG8_BAR; PG8_SCHED;
            } else {
            PG8_LDB(B0, 0, 0); PG8_SCHED; PG8_LDA(At, 0, 0); PG8_STAGE(PG8_SA(1, 1), a1 + hstep, voffA);
            PG8_WAIT_L(8); PG8_BAR; PG8_WAIT_L(0); PG8_MMA(0, 0, At, B0); PG8_BAR; PG8_SCHED;
            PG8_LDB(B1, 0, 1); PG8_STAGE(PG8_SB(0, 0), b2, voffB);
            PG8_BAR; PG8_WAIT_L(0); PG8_MMA(0, 1, At, B1); PG8_BAR;
            PG8_LDA(At, 0, 1); PG8_STAGE(PG8_SA(0, 0), a2, voffA);
            PG8_BAR; PG8_WAIT_L(0); PG8_MMA(1, 0, At, B0); PG8_BAR; PG8_SCHED;
            PG8_STAGE(PG8_SB(0, 1), b2 + hstep, voffB);
            PG8_WAIT_V(6); PG8_BAR; PG8_MMA(1, 1, At, B1); PG8_BAR;
            PG8_LDB(B0, 1, 0); PG8_SCHED; PG8_LDA(At, 1, 0); PG8_STAGE(PG8_SA(0, 1), a2 + hstep, voffA);
            PG8_WAIT_L(8); PG8_BAR; PG8_WAIT_L(0); PG8_MMA(0, 0, At, B0); PG8_BAR; PG8_SCHED;
            PG8_LDB(B1, 1, 1); PG8_STAGE(PG8_SB(1, 0), b3, voffB);
            PG8_BAR; PG8_WAIT_L(0); PG8_MMA(0, 1, At, B1); PG8_BAR;
            PG8_LDA(At, 1, 1); PG8_STAGE(PG8_SA(1, 0), a3, voffA);
            PG8_BAR; PG8_WAIT_L(0); PG8_MMA(1, 0, At, B0); PG8_BAR; PG8_SCHED;
            PG8_STAGE(PG8_SB(1, 1), b3 + hstep, voffB);
            PG8_WAIT_V(6); PG8_BAR; PG8_MMA(1, 1, At, B1); PG8_BAR;
            }
        }
        if constexpr (ALIGN_EPI) { if (wr == 0) PG8_BAR; }
        if constexpr (!Epi::AFTER_DRAIN) { E(acc, cur, wr, wc, fr, fq); S.done(cur); }
        if (!has_next) break;
#pragma unroll
        for (int a = 0; a < 2; ++a)
#pragma unroll
            for (int b = 0; b < 2; ++b)
#pragma unroll
                for (int m = 0; m < 4; ++m)
#pragma unroll
                    for (int n = 0; n < 2; ++n) acc[a][b][m][n] = (f32x4){0.f, 0.f, 0.f, 0.f};
        cur = nxt; cA = nA; cB = nB; ++ui;
        if constexpr (ALIGN_EPI) { if (wr == 1) PG8_BAR; }
    }
    PG8_WAIT_V(0);
    if constexpr (!ALIGN_EPI) { if (wr == 0) PG8_BAR; }
    PG8_BAR;
    if constexpr (Epi::AFTER_DRAIN) { E.fused(acc, cur, wr, wc, fr, fq, lds, wid, lane); S.done(cur); }
#undef PG8_SA
#undef PG8_SB
#undef PG8_STAGE
#undef PG8_LDA
#undef PG8_LDB
#undef PG8_MMA
#undef PG8_WAIT_V
#undef PG8_WAIT_L
#undef PG8_BAR
#undef PG8_SCHED
}
}
#define XB_TMO      128
#define XB_XCNT(j)  (256  + 64 * (j))
#define XB_XSUB(j)  (1280 + 64 * (j))
#define XB_XGEN(j)  (2304 + 64 * (j))
#define XB_TOP      3328
#define XB_TOPGEN   3392
#define XCD_BAR_WORDS 3456
#define XB_SPIN_CAP (1u << 18)
#define LAS __attribute__((address_space(3)))

__device__ __forceinline__ unsigned xb_ld(unsigned* p)              { return __hip_atomic_load(p, __ATOMIC_RELAXED, __HIP_MEMORY_SCOPE_AGENT); }
__device__ __forceinline__ unsigned xb_add(unsigned* p, unsigned v) { return __hip_atomic_fetch_add(p, v, __ATOMIC_RELAXED, __HIP_MEMORY_SCOPE_AGENT); }
__device__ __forceinline__ unsigned xb_xcc_id() { return (unsigned)__builtin_amdgcn_s_getreg((3 << 11) | 20) & 0xFu; }
#define XB_SPIN(cond, bar) do { unsigned _sp = 0; while (cond) { __builtin_amdgcn_s_sleep(1); \
    if ((++_sp & 255u) == 0u) { if (xb_ld(&(bar)[XB_TMO])) break; if (_sp > XB_SPIN_CAP) { atomicAdd(&(bar)[XB_TMO], 1u); break; } } } } while (0)

struct XcdBarrier {
    unsigned* bar; unsigned x;
    volatile LAS unsigned* st;
};

__device__ __forceinline__ XcdBarrier xcd_barrier_post(unsigned* bar, volatile LAS unsigned* st) {
    XcdBarrier b; b.bar = bar; b.x = xb_xcc_id(); b.st = st;
    if (threadIdx.x == 0) (void)xb_add(&bar[XB_XCNT(b.x)], 1u);
    return b;
}
__device__ __forceinline__ void xcd_barrier_complete(unsigned* bar, unsigned x, unsigned& nloc, unsigned& nx) {
    const unsigned G = gridDim.x * gridDim.y * gridDim.z;
    unsigned sum, cnt, mine, sp = 0u;
    for (;;) {
        sum = 0u; cnt = 0u; mine = 0u;
#pragma unroll
        for (unsigned j = 0; j < 16; ++j) { const unsigned c = xb_ld(&bar[XB_XCNT(j)]); sum += c; cnt += (c > 0u) ? 1u : 0u; mine = (j == x) ? c : mine; }
        if (sum == G) break;
        __builtin_amdgcn_s_sleep(1);
        if ((++sp & 255u) == 0u) { if (xb_ld(&bar[XB_TMO])) break; if (sp > XB_SPIN_CAP) { atomicAdd(&bar[XB_TMO], 1u); break; } }
    }
    nloc = mine > 0u ? mine : 1u; nx = cnt > 0u ? cnt : 1u;
}

__device__ __forceinline__ void xcd_barrier(const XcdBarrier& b) {
    asm volatile("s_waitcnt vmcnt(0)" ::: "memory");
    __syncthreads();
    if (threadIdx.x == 0) {
        unsigned* bar = b.bar;
        __builtin_amdgcn_s_waitcnt(0);
        unsigned nloc = b.st[0], nx = b.st[1];
        if (nloc == 0u) { xcd_barrier_complete(bar, b.x, nloc, nx); b.st[0] = nloc; b.st[1] = nx; }
        const unsigned old = xb_add(&bar[XB_XSUB(b.x)], 1u);
        const unsigned gen = old / nloc;
        if (old + 1u == (gen + 1u) * nloc) {
            __builtin_amdgcn_fence(__ATOMIC_RELEASE, "agent");
            asm volatile("s_waitcnt vmcnt(0)" ::: "memory");
            const unsigned og = xb_add(&bar[XB_TOP], 1u);
            const unsigned tg = og / nx;
            if (og + 1u == (tg + 1u) * nx) xb_add(&bar[XB_TOPGEN], 1u);
            else XB_SPIN(xb_ld(&bar[XB_TOPGEN]) == tg, bar);
            __builtin_amdgcn_fence(__ATOMIC_ACQUIRE, "agent");
            xb_add(&bar[XB_XGEN(b.x)], 1u);
            asm volatile("s_waitcnt vmcnt(0)" ::: "memory");
        } else {
            XB_SPIN(xb_ld(&bar[XB_XGEN(b.x)]) == gen, bar);
            __builtin_amdgcn_fence(__ATOMIC_ACQUIRE, "agent");
            asm volatile("s_waitcnt vmcnt(0)" ::: "memory");
        }
    }
    __syncthreads();
}
constexpr int MP = 16384, MS = 32, MR = MP + MS, MPAD = 16640;
constexpr int SEQ = 2048, NB = 8, NH = 8, DM = 1024;
constexpr int QKVW = 3072, NIN = 7424;
constexpr int PAST = 16384, NPAGE = 128, PAGE = 128, LATW = 576;
constexpr float EPS = 1e-6f;
constexpr float MLA_SCALE = 0.07216878364870322f;

constexpr size_t O_YP = 0, O_YS = O_YP + (size_t)MP * 1024, O_ROWSP = O_YS + 32 * 1024, O_GSP = O_ROWSP + (size_t)MP * 576,
                 O_CSP = O_GSP + 8 * 8 * 128 * 128, O_ROWSS = O_CSP + 8 * 3 * 3072, O_GSS = O_ROWSS + 32 * 576, O_CSS = O_GSS + (size_t)32 * 8 * 128 * 128;

constexpr size_t WS_CTL = 0, CTL_BYTES = 3u << 20;
constexpr size_t WS_WIN = CTL_BYTES;
constexpr size_t WS_WQ  = WS_WIN + (size_t)NIN * 1024 * 2;
constexpr size_t WS_WKV = WS_WQ + (size_t)1536 * 512 * 2;
constexpr size_t WS_WYA = WS_WKV + (size_t)2048 * 512 * 2;
constexpr size_t WS_WYB = WS_WYA + (size_t)1024 * 1024 * 2;
constexpr size_t WS_WO  = WS_WYB + (size_t)1024 * 1024 * 2;
constexpr size_t WS_WUP = WS_WO + (size_t)1024 * 1024 * 2;
constexpr size_t WS_WDN = WS_WUP + (size_t)4096 * 1024 * 2;
constexpr size_t WS_XN  = WS_WDN + (size_t)4096 * 1024 * 2;
constexpr size_t WS_QKV = WS_XN + (size_t)MPAD * 1024 * 2;
constexpr size_t WS_Z   = WS_QKV + (size_t)MPAD * 3072 * 2;
constexpr size_t WS_QD  = WS_Z + (size_t)MPAD * 1024 * 2;
constexpr size_t WS_KVD = WS_QD + (size_t)MPAD * 512 * 2;
constexpr size_t WS_SM  = WS_KVD + (size_t)MPAD * 512 * 2;
constexpr size_t WS_GATES = WS_SM + (size_t)MPAD * 128 * 4;
constexpr size_t WS_C   = WS_GATES + (size_t)MPAD * 2048 * 2;
constexpr size_t WS_KR  = WS_C + (size_t)MPAD * 512 * 2;
constexpr size_t WS_BETA = WS_KR + (size_t)MPAD * 64 * 2;
constexpr size_t WS_GLOG = WS_BETA + (size_t)MPAD * 8 * 4;
constexpr size_t WS_QP  = WS_GLOG + (size_t)MPAD * 8 * 4;
constexpr size_t WS_QP2 = WS_QP + (size_t)MPAD * 1536 * 2;
constexpr size_t WS_KN  = WS_QP2 + (size_t)MPAD * 1536 * 2;
constexpr size_t WS_V   = WS_KN + (size_t)MPAD * 1024 * 2;
constexpr size_t WS_YA  = WS_V + (size_t)MPAD * 1024 * 2;
constexpr size_t WS_YB  = WS_YA + (size_t)MPAD * 1024 * 2;
constexpr size_t WS_TF  = WS_YB + (size_t)MPAD * 1024 * 2;
constexpr size_t WS_T   = WS_TF + (size_t)MPAD * 1024 * 4;
constexpr size_t WS_X1  = WS_T + (size_t)MPAD * 1024 * 2;
constexpr size_t WS_XN2 = WS_X1 + (size_t)MPAD * 1024 * 4;
constexpr size_t WS_RX = WS_CTL + (256u << 10);
constexpr size_t WS_SQN = WS_CTL + (512u << 10);
constexpr size_t WS_SQR = WS_CTL + (1280u << 10);
constexpr size_t WS_SKN = WS_CTL + (2048u << 10);
constexpr size_t WS_H   = WS_XN2 + (size_t)MPAD * 1024 * 2;
constexpr size_t WS_GU0 = WS_H + (size_t)MPAD * 4096 * 2;
constexpr size_t WS_GW  = WS_GU0 + (size_t)2048 * 64 * 128 * 4;
constexpr size_t WS_GQG = WS_GW + (size_t)2048 * 64 * 128 * 2;
constexpr size_t WS_GKD = WS_GQG + (size_t)2048 * 64 * 128 * 2;
constexpr size_t WS_GAQK = WS_GKD + (size_t)2048 * 64 * 128 * 2;
constexpr size_t WS_GEND = WS_GAQK + (size_t)2048 * 64 * 64 * 2;
constexpr size_t WS_DML = WS_GEND + (size_t)2048 * 4 * 64;
constexpr size_t WS_DACC = WS_DML + (size_t)4096 * 8 * 2 * 4;
constexpr size_t WS_WKT = WS_DACC + (size_t)4096 * 8 * 512 * 4;
constexpr size_t WS_END = WS_WKT + (size_t)1024 * 512 * 2;

constexpr int LDS_BYTES = 163840;
constexpr int MISC_OFF = LDS_BYTES - 128;

#define GAS __attribute__((address_space(1)))
typedef unsigned short bf16;
typedef unsigned v4u __attribute__((ext_vector_type(4)));
typedef unsigned v2u __attribute__((ext_vector_type(2)));
typedef float f32x4 __attribute__((ext_vector_type(4)));
typedef float f32x16 __attribute__((ext_vector_type(16)));
typedef short bf16x8 __attribute__((ext_vector_type(8)));
#define LDS_WAIT() asm volatile("s_waitcnt lgkmcnt(0)" ::: "memory")
#define VM_WAIT() asm volatile("s_waitcnt vmcnt(0)" ::: "memory")
#define LBAR() asm volatile("s_waitcnt lgkmcnt(0)\n\ts_barrier" ::: "memory")
__device__ __forceinline__ float bf2f(unsigned b) { return __builtin_bit_cast(float, b << 16); }
typedef float f32x2_t __attribute__((ext_vector_type(2)));
typedef __bf16 bf16x2_t __attribute__((ext_vector_type(2)));
__device__ __forceinline__ unsigned pk2(float lo, float hi) { const f32x2_t v = {lo, hi}; const bf16x2_t b = __builtin_convertvector(v, bf16x2_t); return __builtin_bit_cast(unsigned, b); }
__device__ __forceinline__ unsigned f2bf(float f) { return pk2(f, 0.f) & 0xffffu; }
__device__ __forceinline__ float lo16(unsigned w) { return __builtin_bit_cast(float, w << 16); }
__device__ __forceinline__ float hi16(unsigned w) { return __builtin_bit_cast(float, w & 0xffff0000u); }
__device__ __forceinline__ float wave_sum(float v) {
#pragma unroll
    for (int o = 1; o < 64; o <<= 1) v += __shfl_xor(v, o);
    return v;
}
__device__ __forceinline__ float wave_max(float v) {
#pragma unroll
    for (int o = 1; o < 64; o <<= 1) v = fmaxf(v, __shfl_xor(v, o));
    return v;
}
__device__ __forceinline__ float sigmoidf_(float x) { return __builtin_amdgcn_rcpf(1.f + __expf(-x)); }
__device__ __forceinline__ float siluf_(float x) { return x * __builtin_amdgcn_rcpf(1.f + __expf(-x)); }

__constant__ float ROPE_INV[32] = {1.000000000e+00f,7.498942614e-01f,5.623413324e-01f,4.216965139e-01f,3.162277639e-01f,2.371373773e-01f,1.778279394e-01f,1.333521307e-01f,
    1.000000015e-01f,7.498941571e-02f,5.623413250e-02f,4.216965288e-02f,3.162277490e-02f,2.371373773e-02f,1.778279431e-02f,1.333521493e-02f,
    9.999999776e-03f,7.498941850e-03f,5.623413250e-03f,4.216964822e-03f,3.162277630e-03f,2.371373586e-03f,1.778279431e-03f,1.333521446e-03f,
    1.000000047e-03f,7.498942432e-04f,5.623413017e-04f,4.216965172e-04f,3.162277571e-04f,2.371373703e-04f,1.778279402e-04f,1.333521504e-04f};

struct Args { const float* in[27]; float* out; unsigned char* ws; int ph_lo, ph_hi; };
enum { I_XP = 0, I_XS, I_CACHE, I_SGDN, I_SCONV, I_PT, I_NMIX, I_WIN, I_CONVW, I_ALOG, I_DTB, I_GDNN, I_QAN, I_WUQ, I_KVAN, I_WUK, I_WUV,
       I_QNN, I_QNR, I_KNN, I_KNR, I_WYA, I_WYB, I_WO, I_NMLP, I_WUP, I_WDN };

__device__ __forceinline__ int src_col(int mode, int n) {
    if (mode == 0) {
        if (n < 4096) return n;
        if (n < 5184) return n + 16;
        if (n < 5200) return n - 5184 + 4096;
        if (n < 5376) return -1;
        return n - 5376 + 5200;
    }
    if (mode == 1) {
        if (n < 1024) return (n >> 7) * 192 + (n & 127);
        const int m = n - 1024; return (m >> 6) * 192 + 128 + (m & 63);
    }
    return n;
}
__device__ __forceinline__ void cvt_item(const float* W, int N, int K, bf16* WT, int row_off, int mode, LAS float* scr, int item, int nblk, int lane, const float* kscale = nullptr) {
    const int kb = item / nblk, nb = item % nblk, k0 = 64 * kb, n0 = 32 * nb;
    const int sc = src_col(mode, n0 + (lane & 31));
#pragma unroll
    for (int i = 0; i < 32; ++i) { const int kk = 2 * i + (lane >> 5); scr[kk * 33 + (lane & 31)] = sc >= 0 ? W[(size_t)(k0 + kk) * N + sc] * (kscale ? kscale[k0 + kk] : 1.f) : 0.f; }
    LDS_WAIT(); asm volatile("" ::: "memory");
    const int c = lane & 7;
#pragma unroll
    for (int j = 0; j < 4; ++j) { const int n = (lane >> 3) + 8 * j; const LAS float* s = scr + (8 * c) * 33 + n;
        v4u o; o.x = pk2(s[0 * 33], s[1 * 33]); o.y = pk2(s[2 * 33], s[3 * 33]); o.z = pk2(s[4 * 33], s[5 * 33]); o.w = pk2(s[6 * 33], s[7 * 33]);
        *(v4u*)(WT + (size_t)(row_off + n0 + n) * K + k0 + 8 * c) = o; }
    LDS_WAIT(); asm volatile("" ::: "memory");
}
__device__ __forceinline__ void rms_row_finish(const f32x4 (&v)[4], const float* gain, bf16* orow, int lane) {
    const f32x4* gr = (const f32x4*)gain + lane; float s = 0.f;
#pragma unroll
    for (int j = 0; j < 4; ++j) s += (v[j].x * v[j].x + v[j].y * v[j].y) + (v[j].z * v[j].z + v[j].w * v[j].w);
    const float r = 1.f / sqrtf(wave_sum(s) * (1.f / 1024.f) + EPS);
    unsigned long long* o8 = (unsigned long long*)orow + lane;
#pragma unroll
    for (int j = 0; j < 4; ++j) { const f32x4 g = gr[64 * j];
        o8[64 * j] = (unsigned long long)pk2(v[j].x * r * g.x, v[j].y * r * g.y) | ((unsigned long long)pk2(v[j].z * r * g.z, v[j].w * r * g.w) << 32); }
}
template <bool LATE> __device__ __forceinline__ void cvt_weights(const Args& A, LAS unsigned char* lds, int gw, int NGW, int wave, int lane) {
    LAS float* scr = (LAS float*)(lds + wave * 16384);
    unsigned char* ws = A.ws;
    constexpr int I0 = 16 * (NIN / 32), I1 = 8 * (1536 / 32), I2 = 8 * 32, I3 = 8 * 32, I4 = 16 * 32, I5 = I4, I6 = I4, I7 = 16 * 128, I8 = 64 * 32;
    if (!LATE) {
        for (int it = gw; it < I0 + I1 + I2 + I3; it += NGW) {
            int r = it;
            if (r < I0) { cvt_item(A.in[I_WIN], 7248, 1024, (bf16*)(ws + WS_WIN), 0, 0, scr, r, NIN / 32, lane); continue; } r -= I0;
            if (r < I1) { cvt_item(A.in[I_WUQ], 1536, 512, (bf16*)(ws + WS_WQ), 0, 1, scr, r, 1536 / 32, lane); continue; } r -= I1;
            if (r < I2) { cvt_item(A.in[I_WUK], 1024, 512, (bf16*)(ws + WS_WKV), 0, 2, scr, r, 32, lane); continue; } r -= I2;
            cvt_item(A.in[I_WUV], 1024, 512, (bf16*)(ws + WS_WKV), 1024, 2, scr, r, 32, lane);
        }
    } else {
        for (int it = gw; it < I4 + I5 + I6 + I7 + I8; it += NGW) {
            int r = it;
            if (r < I4) { cvt_item(A.in[I_WYA], 1024, 1024, (bf16*)(ws + WS_WYA), 0, 2, scr, r, 32, lane); continue; } r -= I4;
            if (r < I5) { cvt_item(A.in[I_WYB], 1024, 1024, (bf16*)(ws + WS_WYB), 0, 2, scr, r, 32, lane); continue; } r -= I5;
            if (r < I6) { cvt_item(A.in[I_WO], 1024, 1024, (bf16*)(ws + WS_WO), 0, 2, scr, r, 32, lane); continue; } r -= I6;
            if (r < I7) { cvt_item(A.in[I_WUP], 4096, 1024, (bf16*)(ws + WS_WUP), 0, 2, scr, r, 128, lane, A.in[I_NMLP]); continue; } r -= I7;
            cvt_item(A.in[I_WDN], 1024, 4096, (bf16*)(ws + WS_WDN), 0, 2, scr, r, 32, lane);
        }
    }
}
__device__ __forceinline__ void p0_prologue(const Args& A, LAS unsigned char* lds, int gw, int NGW, int wave, int lane) {
    unsigned char* ws = A.ws;
    cvt_weights<false>(A, lds, gw, NGW, wave, lane);
    bf16* XN = (bf16*)(ws + WS_XN);
#define XROW(m_) ((m_) < MP ? A.in[I_XP] + (size_t)(m_) * 1024 : A.in[I_XS] + (size_t)((m_) - MP) * 1024)
    f32x4 v[4], vn[4];
    if (gw < MR) {
#pragma unroll
        for (int j = 0; j < 4; ++j) v[j] = ((const f32x4*)XROW(gw) + lane)[64 * j]; }
    for (int m = gw; m < MPAD; m += NGW) {
        const int mn = m + NGW;
        if (mn < MR) {
#pragma unroll
            for (int j = 0; j < 4; ++j) vn[j] = ((const f32x4*)XROW(mn) + lane)[64 * j]; }
        if (m < MR) rms_row_finish(v, A.in[I_NMIX], XN + (size_t)m * 1024, lane);
        else { v4u z = {0u, 0u, 0u, 0u}; *((v4u*)(XN + (size_t)m * 1024) + lane) = z; *((v4u*)(XN + (size_t)m * 1024) + 64 + lane) = z; }
#pragma unroll
        for (int j = 0; j < 4; ++j) v[j] = vn[j];
    }
#undef XROW
}

struct EpiG1 {
    static constexpr bool PERM = true, AFTER_DRAIN = false;
    bf16 *QKV, *Z, *QD, *KVD, *GATES; float* SM;
    __device__ __forceinline__ void operator()(const pg8::f32x4 (&acc)[2][2][4][2], const pg8::Unit& u, int wr, int wc, int fr, int fq) const {
        const int row0 = u.pm * 256 + wr * 64 + fr, pn = u.pn, cl = wc * 32 + 8 * fq;
        if (pn == 20) {
#pragma unroll
            for (int ai = 0; ai < 2; ++ai)
#pragma unroll
                for (int m = 0; m < 4; ++m) { float* rowp = SM + (size_t)(row0 + ai * 128 + m * 16) * 128 + cl;
                    *(pg8::f32x4*)rowp = acc[ai][0][m][0]; *(pg8::f32x4*)(rowp + 4) = acc[ai][0][m][1]; }
            return;
        }
        bf16* base; int ld; bool sg = false;
        if (pn < 12) { base = QKV + pn * 256; ld = 3072; }
        else if (pn < 16) { base = Z + (pn - 12) * 256; ld = 1024; }
        else if (pn < 18) { base = QD + (pn - 16) * 256; ld = 512; }
        else if (pn < 20) { base = KVD + (pn - 18) * 256; ld = 512; }
        else { base = GATES + (pn - 21) * 256; ld = 2048; sg = true; }
#pragma unroll
        for (int ai = 0; ai < 2; ++ai)
#pragma unroll
            for (int m = 0; m < 4; ++m) { bf16* rowp = base + (size_t)(row0 + ai * 128 + m * 16) * ld + cl;
#pragma unroll
                for (int bj = 0; bj < 2; ++bj) { pg8::f32x4 v0 = acc[ai][bj][m][0], v1 = acc[ai][bj][m][1];
                    if (sg) { v0 = (pg8::f32x4){sigmoidf_(v0[0]), sigmoidf_(v0[1]), sigmoidf_(v0[2]), sigmoidf_(v0[3])}; v1 = (pg8::f32x4){sigmoidf_(v1[0]), sigmoidf_(v1[1]), sigmoidf_(v1[2]), sigmoidf_(v1[3])}; }
                    pg8::u32x4 w; w.x = pk2(v0[0], v0[1]); w.y = pk2(v0[2], v0[3]); w.z = pk2(v1[0], v1[1]); w.w = pk2(v1[2], v1[3]);
                    *(pg8::u32x4*)(rowp + bj * 128) = w; } }
    }
};

__device__ __forceinline__ void p2_rows(const Args& A, int gw, int NGW, int lane) {
    unsigned char* ws = A.ws;
    bf16* QD = (bf16*)(ws + WS_QD); const bf16* KVD = (const bf16*)(ws + WS_KVD); const float* SM = (const float*)(ws + WS_SM);
    bf16* C = (bf16*)(ws + WS_C); bf16* KR = (bf16*)(ws + WS_KR); float* BETA = (float*)(ws + WS_BETA); float* GLOG = (float*)(ws + WS_GLOG);
    v4u wq = {0u, 0u, 0u, 0u}, wk = wq, wqn = wq, wkn = wq; float xs = 0.f, xb = 0.f, xa = 0.f, xsn = 0.f, xbn = 0.f, xan = 0.f;
    if (gw < MR) { wq = *((const v4u*)(QD + (size_t)gw * 512) + lane); wk = *((const v4u*)(KVD + (size_t)gw * 512) + lane); xs = SM[(size_t)gw * 128 + lane];
        if (lane < 8) { xb = SM[(size_t)gw * 128 + 64 + lane]; xa = SM[(size_t)gw * 128 + 72 + lane]; } }
    for (int m = gw; m < MR; m += NGW) {
        const int mn = m + NGW;
        if (mn < MR) { wqn = *((const v4u*)(QD + (size_t)mn * 512) + lane); wkn = *((const v4u*)(KVD + (size_t)mn * 512) + lane); xsn = SM[(size_t)mn * 128 + lane];
            if (lane < 8) { xbn = SM[(size_t)mn * 128 + 64 + lane]; xan = SM[(size_t)mn * 128 + 72 + lane]; } }
        const int pos = m < MP ? (m & (SEQ - 1)) : PAST;
        float* lat = m < MP ? A.out + O_ROWSP + (size_t)m * LATW : A.out + O_ROWSS + (size_t)(m - MP) * LATW;
        {
            v4u w = wq;
            float v[8] = {lo16(w.x), hi16(w.x), lo16(w.y), hi16(w.y), lo16(w.z), hi16(w.z), lo16(w.w), hi16(w.w)};
            float s = 0.f;
#pragma unroll
            for (int i = 0; i < 8; ++i) s += v[i] * v[i];
            const float r = 1.f / sqrtf(wave_sum(s) * (1.f / 512.f) + EPS);
            const f32x4 g0 = *((const f32x4*)A.in[I_QAN] + 2 * lane), g1 = *((const f32x4*)A.in[I_QAN] + 2 * lane + 1);
            v4u o; o.x = pk2(v[0] * r * g0.x, v[1] * r * g0.y); o.y = pk2(v[2] * r * g0.z, v[3] * r * g0.w); o.z = pk2(v[4] * r * g1.x, v[5] * r * g1.y); o.w = pk2(v[6] * r * g1.z, v[7] * r * g1.w);
            *((v4u*)(QD + (size_t)m * 512) + lane) = o;
        }
        {
            v4u w = wk;
            float v[8] = {lo16(w.x), hi16(w.x), lo16(w.y), hi16(w.y), lo16(w.z), hi16(w.z), lo16(w.w), hi16(w.w)};
            float s = 0.f;
#pragma unroll
            for (int i = 0; i < 8; ++i) s += v[i] * v[i];
            const float r = 1.f / sqrtf(wave_sum(s) * (1.f / 512.f) + EPS);
            const f32x4 g0 = *((const f32x4*)A.in[I_KVAN] + 2 * lane), g1 = *((const f32x4*)A.in[I_KVAN] + 2 * lane + 1);
            f32x4 c0 = {v[0] * r * g0.x, v[1] * r * g0.y, v[2] * r * g0.z, v[3] * r * g0.w}, c1 = {v[4] * r * g1.x, v[5] * r * g1.y, v[6] * r * g1.z, v[7] * r * g1.w};
            *((f32x4*)lat + 2 * lane) = c0; *((f32x4*)lat + 2 * lane + 1) = c1;
            v4u o; o.x = pk2(c0.x, c0.y); o.y = pk2(c0.z, c0.w); o.z = pk2(c1.x, c1.y); o.w = pk2(c1.z, c1.w);
            *((v4u*)(C + (size_t)m * 512) + lane) = o;
        }
        {
            const float x = xs;
            const float r = 1.f / sqrtf(wave_sum(x * x) * (1.f / 64.f) + EPS);
            const float xr = x * r * A.in[I_KNR][lane];
            const float other = __shfl_xor(xr, 32);
            const float ang = (float)pos * ROPE_INV[lane & 31];
            const float cs = cosf(ang), sn = sinf(ang);
            const float o = lane < 32 ? xr * cs - other * sn : other * sn + xr * cs;
            lat[512 + lane] = o;
            KR[(size_t)m * 64 + lane] = (bf16)f2bf(o);
        }
        if (lane < 8) {
            const float b = xb, a = xa;
            BETA[(size_t)m * 8 + lane] = 1.f / (1.f + expf(-b));
            const float xx = a + A.in[I_DTB][lane];
            const float sp = fmaxf(xx, 0.f) + log1pf(expf(-fabsf(xx)));
            GLOG[(size_t)m * 8 + lane] = -expf(A.in[I_ALOG][lane]) * sp;
        }
        wq = wqn; wk = wkn; xs = xsn; xb = xbn; xa = xan;
    }
}
__device__ __forceinline__ void p2_conv_state(const Args& A, int gtid, int NGT) {
    const bf16* QKV = (const bf16*)(A.ws + WS_QKV);
    {
        const bf16* WKV = (const bf16*)(A.ws + WS_WKV); bf16* WKT = (bf16*)(A.ws + WS_WKT);
        for (int c = gtid; c < 65536; c += NGT) { const int blk = c >> 6, l = c & 63, rt = blk >> 5, ks = blk & 31;
            *(v4u*)(WKT + (size_t)c * 8) = *(const v4u*)(WKV + (size_t)(rt * 32 + (l & 31)) * 512 + 16 * ks + 8 * (l >> 5)); }
    }
    for (int i = gtid; i < 8 * 3 * 3072; i += NGT) { const int c = i % 3072, r = (i / 3072) % 3, b = i / (3 * 3072);
        A.out[O_CSP + i] = bf2f(QKV[(size_t)(b * SEQ + SEQ - 3 + r) * 3072 + c]); }
    for (int i = gtid; i < 32 * 3 * 3072; i += NGT) { const int c = i % 3072, r = (i / 3072) % 3, j = i / (3 * 3072);
        A.out[O_CSS + i] = r < 2 ? A.in[I_SCONV][(size_t)(j * 3 + r + 1) * 3072 + c] : bf2f(QKV[(size_t)(MP + j) * 3072 + c]); }
}
__device__ __forceinline__ pg8::u32x4 pack8(const pg8::f32x4& v0, const pg8::f32x4& v1) {
    pg8::u32x4 w; w.x = pk2(v0[0], v0[1]); w.y = pk2(v0[2], v0[3]); w.z = pk2(v1[0], v1[1]); w.w = pk2(v1[2], v1[3]); return w;
}
template <int ACT> struct EpiStore {
    static constexpr bool PERM = true, AFTER_DRAIN = false;
    bf16* O0; int ld0; int split; bf16* O1; int ld1;
    __device__ __forceinline__ void operator()(const pg8::f32x4 (&acc)[2][2][4][2], const pg8::Unit& u, int wr, int wc, int fr, int fq) const {
        const int row0 = u.pm * 256 + wr * 64 + fr, cl = wc * 32 + 8 * fq;
        bf16* base; int ld;
        if (u.pn < split) { base = O0 + u.pn * 256; ld = ld0; } else { base = O1 + (u.pn - split) * 256; ld = ld1; }
#pragma unroll
        for (int ai = 0; ai < 2; ++ai)
#pragma unroll
            for (int m = 0; m < 4; ++m) { bf16* rowp = base + (size_t)(row0 + ai * 128 + m * 16) * ld + cl;
#pragma unroll
                for (int bj = 0; bj < 2; ++bj) { pg8::f32x4 v0 = acc[ai][bj][m][0], v1 = acc[ai][bj][m][1];
                    if (ACT == 1) {
#pragma unroll
                        for (int e = 0; e < 4; ++e) { const float a = fmaxf(v0[e], 0.f), b = fmaxf(v1[e], 0.f); v0[e] = a * a; v1[e] = b * b; } }
                    *(pg8::u32x4*)(rowp + bj * 128) = pack8(v0, v1); } }
    }
};
struct EpiUp {
    static constexpr bool PERM = true, AFTER_DRAIN = false;
    bf16* H; const float* RX;
    __device__ __forceinline__ void operator()(const pg8::f32x4 (&acc)[2][2][4][2], const pg8::Unit& u, int wr, int wc, int fr, int fq) const {
        const int row0 = u.pm * 256 + wr * 64 + fr, cl = u.pn * 256 + wc * 32 + 8 * fq;
#pragma unroll
        for (int ai = 0; ai < 2; ++ai)
#pragma unroll
            for (int m = 0; m < 4; ++m) { const int row = row0 + ai * 128 + m * 16; const float r = __builtin_amdgcn_rsqf(RX[row] * (1.f / 1024.f) + EPS);
                bf16* rowp = H + (size_t)row * 4096 + cl;
#pragma unroll
                for (int bj = 0; bj < 2; ++bj) { pg8::f32x4 v0 = acc[ai][bj][m][0], v1 = acc[ai][bj][m][1];
#pragma unroll
                    for (int e = 0; e < 4; ++e) { const float a = fmaxf(v0[e] * r, 0.f), b = fmaxf(v1[e] * r, 0.f); v0[e] = a * a; v1[e] = b * b; }
                    *(pg8::u32x4*)(rowp + bj * 128) = pack8(v0, v1); } }
    }
};
constexpr int EPI_S_OFF = 131072;
template <int KIND> struct EpiHeads {
    static constexpr bool PERM = true, AFTER_DRAIN = false;
    bf16* O0; int ld0; int split; bf16* O1; int ld1; float* SB; const float* gain; LAS float* S;
    __device__ __forceinline__ void operator()(const pg8::f32x4 (&acc)[2][2][4][2], const pg8::Unit& u, int wr, int wc, int fr, int fq) const {
        const int rl0 = wr * 64 + fr, row0 = u.pm * 256 + rl0, cl = wc * 32 + 8 * fq;
        bf16* base; int ld;
        if (u.pn < split) { base = O0 + u.pn * 256; ld = ld0; } else { base = O1 + (u.pn - split) * 256; ld = ld1; }
        if (KIND == 1 && u.pn >= 4) {
#pragma unroll
            for (int ai = 0; ai < 2; ++ai)
#pragma unroll
                for (int m = 0; m < 4; ++m) { bf16* rowp = base + (size_t)(row0 + ai * 128 + m * 16) * ld + cl;
#pragma unroll
                    for (int bj = 0; bj < 2; ++bj) *(pg8::u32x4*)(rowp + bj * 128) = pack8(acc[ai][bj][m][0], acc[ai][bj][m][1]); }
            return;
        }
        const bool rope = (KIND == 0) && (u.pn >= 4);
        if (wc == 0) {
#pragma unroll
            for (int ai = 0; ai < 2; ++ai)
#pragma unroll
                for (int m = 0; m < 4; ++m) S[(rl0 + ai * 128 + m * 16) * 4 + fq] = 0.f; }
        LBAR();
#pragma unroll
        for (int ai = 0; ai < 2; ++ai)
#pragma unroll
            for (int m = 0; m < 4; ++m)
#pragma unroll
                for (int bj = 0; bj < 2; ++bj) { const pg8::f32x4 v0 = acc[ai][bj][m][0], v1 = acc[ai][bj][m][1];
                    float s = (v0[0] * v0[0] + v0[1] * v0[1]) + (v0[2] * v0[2] + v0[3] * v0[3]) + (v1[0] * v1[0] + v1[1] * v1[1]) + (v1[2] * v1[2] + v1[3] * v1[3]);
                    s += __shfl_xor(s, 16); s += __shfl_xor(s, 32);
                    if (fq == 0) (void)__hip_atomic_fetch_add(S + (rl0 + ai * 128 + m * 16) * 4 + (rope ? 2 * bj + (wc >> 1) : bj), s, __ATOMIC_RELAXED, __HIP_MEMORY_SCOPE_WORKGROUP); }
        LBAR();
#pragma unroll
        for (int ai = 0; ai < 2; ++ai)
#pragma unroll
            for (int m = 0; m < 4; ++m) { const int rl = rl0 + ai * 128 + m * 16, row = row0 + ai * 128 + m * 16; bf16* rowp = base + (size_t)row * ld + cl;
#pragma unroll
                for (int bj = 0; bj < 2; ++bj) { pg8::f32x4 v0 = acc[ai][bj][m][0], v1 = acc[ai][bj][m][1];
                    if (!rope) { const float r = __builtin_amdgcn_rsqf(S[rl * 4 + bj] * (1.f / 128.f) + EPS); const f32x4 g0 = *(const f32x4*)(gain + cl), g1 = *(const f32x4*)(gain + cl + 4);
                        v0[0] *= r * g0.x; v0[1] *= r * g0.y; v0[2] *= r * g0.z; v0[3] *= r * g0.w; v1[0] *= r * g1.x; v1[1] *= r * g1.y; v1[2] *= r * g1.z; v1[3] *= r * g1.w; }
                    else if (fq == 0 && (wc & 1) == 0 && row < MR) SB[(size_t)row * 8 + 4 * (u.pn - 4) + 2 * bj + (wc >> 1)] = S[rl * 4 + 2 * bj + (wc >> 1)];
                    *(pg8::u32x4*)(rowp + bj * 128) = pack8(v0, v1); } }
    }
};
template <int STEP> struct EpiMerge {
    static constexpr bool PERM = true, AFTER_DRAIN = false;
    const bf16* GATES; float* TF; bf16* T;
    __device__ __forceinline__ void operator()(const pg8::f32x4 (&acc)[2][2][4][2], const pg8::Unit& u, int wr, int wc, int fr, int fq) const {
        const int row0 = u.pm * 256 + wr * 64 + fr, c0 = u.pn * 256 + wc * 32 + 8 * fq;
#pragma unroll
        for (int ai = 0; ai < 2; ++ai)
#pragma unroll
            for (int m = 0; m < 4; ++m) { const size_t row = (size_t)(row0 + ai * 128 + m * 16);
#pragma unroll
                for (int bj = 0; bj < 2; ++bj) { const int col = c0 + bj * 128;
                    const v4u gw = *(const v4u*)(GATES + row * 2048 + (STEP == 1 ? 0 : 1024) + col);
                    const float g[8] = {lo16(gw.x), hi16(gw.x), lo16(gw.y), hi16(gw.y), lo16(gw.z), hi16(gw.z), lo16(gw.w), hi16(gw.w)};
                    pg8::f32x4 v0 = acc[ai][bj][m][0], v1 = acc[ai][bj][m][1];
#pragma unroll
                    for (int e = 0; e < 4; ++e) { v0[e] *= g[e]; v1[e] *= g[4 + e]; }
                    bf16* tp = T + row * 1024 + col;
                    if (STEP == 1) *(pg8::u32x4*)tp = pack8(v0, v1);
                    else { const v4u pw = *(const v4u*)tp;
                        v0[0] += lo16(pw.x); v0[1] += hi16(pw.x); v0[2] += lo16(pw.y); v0[3] += hi16(pw.y); v1[0] += lo16(pw.z); v1[1] += hi16(pw.z); v1[2] += lo16(pw.w); v1[3] += hi16(pw.w);
                        *(pg8::u32x4*)tp = pack8(v0, v1); } } }
    }
};
template <int MODE> struct EpiRes {
    static constexpr bool PERM = true, AFTER_DRAIN = false;
    const float *XPp, *XSp; float* X1; float* out; bf16* XB; float* RX; LAS unsigned char* lds_epi;
    __device__ __forceinline__ void operator()(const pg8::f32x4 (&acc)[2][2][4][2], const pg8::Unit& u, int wr, int wc, int fr, int fq) const {
        const int row0 = u.pm * 256 + wr * 64 + fr, c0 = u.pn * 256 + wc * 32 + 8 * fq;
        float ss[2][4] = {{0.f, 0.f, 0.f, 0.f}, {0.f, 0.f, 0.f, 0.f}};
#pragma unroll
        for (int ai = 0; ai < 2; ++ai)
#pragma unroll
            for (int m = 0; m < 4; ++m) { const int row = row0 + ai * 128 + m * 16;
                if (row >= MR) continue;
#pragma unroll
                for (int bj = 0; bj < 2; ++bj) { const int col = c0 + bj * 128;
                    if (MODE == 0) {
                        const float* src = row < MP ? XPp + (size_t)row * 1024 + col : XSp + (size_t)(row - MP) * 1024 + col;
                        const pg8::f32x4 y0 = acc[ai][bj][m][0] + *(const pg8::f32x4*)src, y1 = acc[ai][bj][m][1] + *(const pg8::f32x4*)(src + 4);
                        *(pg8::u32x4*)(XB + (size_t)row * 1024 + col) = pack8(y0, y1);
                        ss[ai][m] += (y0[0] * y0[0] + y0[1] * y0[1]) + (y0[2] * y0[2] + y0[3] * y0[3]) + (y1[0] * y1[0] + y1[1] * y1[1]) + (y1[2] * y1[2] + y1[3] * y1[3]);
                    } else {
                        const v4u pw = *(const v4u*)(XB + (size_t)row * 1024 + col);
                        float* dst = row < MP ? out + O_YP + (size_t)row * 1024 + col : out + O_YS + (size_t)(row - MP) * 1024 + col;
                        pg8::f32x4 y0 = acc[ai][bj][m][0], y1 = acc[ai][bj][m][1];
                        y0[0] += lo16(pw.x); y0[1] += hi16(pw.x); y0[2] += lo16(pw.y); y0[3] += hi16(pw.y); y1[0] += lo16(pw.z); y1[1] += hi16(pw.z); y1[2] += lo16(pw.w); y1[3] += hi16(pw.w);
                        *(pg8::f32x4*)dst = y0; *(pg8::f32x4*)(dst + 4) = y1; } } }
        if (MODE == 0) {
            LAS float* S = (LAS float*)(lds_epi + EPI_S_OFF); const int rl0 = wr * 64 + fr;
            if (wc == 0 && fq == 0) {
#pragma unroll
                for (int ai = 0; ai < 2; ++ai)
#pragma unroll
                    for (int m = 0; m < 4; ++m) S[rl0 + ai * 128 + m * 16] = 0.f; }
            LBAR();
#pragma unroll
            for (int ai = 0; ai < 2; ++ai)
#pragma unroll
                for (int m = 0; m < 4; ++m) { float v = ss[ai][m]; v += __shfl_xor(v, 16); v += __shfl_xor(v, 32);
                    if (fq == 0) (void)__hip_atomic_fetch_add(S + rl0 + ai * 128 + m * 16, v, __ATOMIC_RELAXED, __HIP_MEMORY_SCOPE_WORKGROUP); }
            LBAR();
            const int t = threadIdx.x;
            if (t < 256 && u.pm * 256 + t < MR) atomicAdd(RX + u.pm * 256 + t, S[t]);
            LBAR();
        }
    }
};

#define MFMA32(a, b, c) __builtin_amdgcn_mfma_f32_32x32x16_bf16((a), (b), (c), 0, 0, 0)
__device__ __forceinline__ int crow(int r, int hi) { return (r & 3) + 8 * (r >> 2) + 4 * hi; }
__device__ __forceinline__ bf16x8 lds_ld8(LAS const unsigned char* p) { return *(LAS const bf16x8*)p; }
__device__ __forceinline__ bf16x8 gl_ld8(const bf16* p) { return *(const bf16x8*)p; }

constexpr int GA_QH = 0, GA_KH = 17408, GA_KBH = 34816, GA_VBT = 52224, GA_KBGT = 70656, GA_KDT = 89088, GA_LF = 107520, GA_TB = 123904, GA_GS = 133120, GA_BS = 133376, GA_T32 = 133632, GA_X32 = 141824;
__device__ __forceinline__ void gdn_a_unit(const Args& A, LAS unsigned char* lds, int unit, int tid, int lane, int wave) {
    unsigned char* ws = A.ws;
    const int b = unit >> 8, h = (unit >> 5) & 7, n = unit & 31;
    const int row0 = b * SEQ + n * 64;
#ifdef PROBE_K
    unsigned long long pt0 = 0, pdt = 0;
#define GPS(k) do { if ((k) == PROBE_K) pt0 = __builtin_amdgcn_s_memrealtime(); } while (0)
#define GPE(k) do { if ((k) == PROBE_K) pdt += __builtin_amdgcn_s_memrealtime() - pt0; } while (0)
#else
#define GPS(k) do {} while (0)
#define GPE(k) do {} while (0)
#endif
    GPS(74); GPS(70);
    const bf16* QKV = (const bf16*)(ws + WS_QKV);
    LAS float* Gs = (LAS float*)(lds + GA_GS); LAS float* Bs = (LAS float*)(lds + GA_BS);
    float Gend;
    {
        const int cg = tid & 15, rr = tid >> 4;
        v4u xw[3][2][4];
#pragma unroll
        for (int part = 0; part < 3; ++part)
#pragma unroll
            for (int ri = 0; ri < 2; ++ri)
#pragma unroll
                for (int tap = 0; tap < 4; ++tap) { const int tt = n * 64 + rr + 32 * ri - 3 + tap;
                    xw[part][ri][tap] = tt >= 0 ? *(const v4u*)(QKV + (size_t)(b * SEQ + tt) * 3072 + part * 1024 + h * 128 + 8 * cg) : (v4u){0u, 0u, 0u, 0u}; }
        float gx = ((const float*)(ws + WS_GLOG))[(size_t)(row0 + lane) * 8 + h];
        const float be0 = ((const float*)(ws + WS_BETA))[(size_t)(row0 + rr) * 8 + h], be1 = ((const float*)(ws + WS_BETA))[(size_t)(row0 + rr + 32) * 8 + h];
#pragma unroll
        for (int o = 1; o < 64; o <<= 1) { const float y = __shfl_up(gx, o); if (lane >= o) gx += y; }
        if (wave == 0) { Gs[lane] = gx; Bs[lane] = ((const float*)(ws + WS_BETA))[(size_t)(row0 + lane) * 8 + h]; }
        Gend = __shfl(gx, 63);
        const float Gr0 = __shfl(gx, rr), Gr1 = __shfl(gx, rr + 32);
        bf16* GQG = (bf16*)(ws + WS_GQG) + (size_t)unit * 8192;
#pragma unroll
        for (int part = 0; part < 3; ++part) {
            const int colb = part * 1024 + h * 128 + 8 * cg;
            float wgt[4][8];
#pragma unroll
            for (int tap = 0; tap < 4; ++tap) { const f32x4 w0 = *(const f32x4*)(A.in[I_CONVW] + tap * 3072 + colb), w1 = *(const f32x4*)(A.in[I_CONVW] + tap * 3072 + colb + 4);
                wgt[tap][0] = w0.x; wgt[tap][1] = w0.y; wgt[tap][2] = w0.z; wgt[tap][3] = w0.w; wgt[tap][4] = w1.x; wgt[tap][5] = w1.y; wgt[tap][6] = w1.z; wgt[tap][7] = w1.w; }
#pragma unroll
            for (int ri = 0; ri < 2; ++ri) {
                const int i = rr + 32 * ri;
                float y[8];
#pragma unroll
                for (int e = 0; e < 8; ++e) y[e] = 0.f;
#pragma unroll
                for (int tap = 0; tap < 4; ++tap) { const v4u w = xw[part][ri][tap];
                    const float x[8] = {lo16(w.x), hi16(w.x), lo16(w.y), hi16(w.y), lo16(w.z), hi16(w.z), lo16(w.w), hi16(w.w)};
#pragma unroll
                    for (int e = 0; e < 8; ++e) y[e] += wgt[tap][e] * x[e]; }
                float ss = 0.f;
#pragma unroll
                for (int e = 0; e < 8; ++e) { y[e] = siluf_(y[e]); ss += y[e] * y[e]; }
                ss += __shfl_xor(ss, 1); ss += __shfl_xor(ss, 2); ss += __shfl_xor(ss, 4); ss += __shfl_xor(ss, 8);
                const float Gi = ri ? Gr1 : Gr0;
                const float rs = 1.f / sqrtf(ss + EPS), beta = ri ? be1 : be0, eg = __expf(Gi), ed = __expf(Gend - Gi);
                if (part == 0) {
                    float q[8];
#pragma unroll
                    for (int e = 0; e < 8; ++e) q[e] = y[e] * rs * 0.08838834764831845f;
                    v4u o; o.x = pk2(q[0], q[1]); o.y = pk2(q[2], q[3]); o.z = pk2(q[4], q[5]); o.w = pk2(q[6], q[7]);
                    *(LAS v4u*)(lds + GA_QH + i * 272 + cg * 16) = o;
                    v4u g; g.x = pk2(q[0] * eg, q[1] * eg); g.y = pk2(q[2] * eg, q[3] * eg); g.z = pk2(q[4] * eg, q[5] * eg); g.w = pk2(q[6] * eg, q[7] * eg);
                    *(v4u*)(GQG + i * 128 + 8 * cg) = g;
                } else if (part == 1) {
                    float k[8];
#pragma unroll
                    for (int e = 0; e < 8; ++e) k[e] = y[e] * rs;
                    v4u o; o.x = pk2(k[0], k[1]); o.y = pk2(k[2], k[3]); o.z = pk2(k[4], k[5]); o.w = pk2(k[6], k[7]);
                    *(LAS v4u*)(lds + GA_KH + i * 272 + cg * 16) = o;
                    v4u kb; kb.x = pk2(k[0] * beta, k[1] * beta); kb.y = pk2(k[2] * beta, k[3] * beta); kb.z = pk2(k[4] * beta, k[5] * beta); kb.w = pk2(k[6] * beta, k[7] * beta);
                    *(LAS v4u*)(lds + GA_KBH + i * 272 + cg * 16) = kb;
#pragma unroll
                    for (int e = 0; e < 8; ++e) { *(LAS bf16*)(lds + GA_KBGT + (8 * cg + e) * 144 + i * 2) = (bf16)f2bf(k[e] * beta * eg);
                        *(LAS bf16*)(lds + GA_KDT + (8 * cg + e) * 144 + i * 2) = (bf16)f2bf(k[e] * ed); }
                } else {
#pragma unroll
                    for (int e = 0; e < 8; ++e) *(LAS bf16*)(lds + GA_VBT + (8 * cg + e) * 144 + i * 2) = (bf16)f2bf(y[e] * beta);
                }
            }
            __builtin_amdgcn_sched_barrier(0);
        }
    }
    __syncthreads();
    GPE(70); GPS(71);
    int l31 = lane & 31, hi = lane >> 5; asm volatile("" : "+v"(l31), "+v"(hi));
    {
        const int it = (wave >> 1) & 1, jt = wave & 1; const bool isL = wave < 4;
        f32x16 acc = {};
        if (it >= jt) {
            LAS const unsigned char* Ab = lds + (isL ? GA_KBH : GA_QH) + (32 * it + l31) * 272 + hi * 16;
            LAS const unsigned char* Bb = lds + GA_KH + (32 * jt + l31) * 272 + hi * 16;
#pragma unroll
            for (int ks = 0; ks < 8; ++ks) acc = MFMA32(lds_ld8(Ab + ks * 32), lds_ld8(Bb + ks * 32), acc);
        }
        const int j = 32 * jt + l31; const float Gj = Gs[j];
        bf16* AQ = (bf16*)(ws + WS_GAQK) + (size_t)unit * 4096;
#pragma unroll
        for (int r = 0; r < 16; ++r) { const int i = 32 * it + crow(r, hi);
            const float d = __expf(fminf(Gs[i] - Gj, 0.f));
            if (isL) ((LAS float*)(lds + GA_LF))[i * 64 + j] = (i > j) ? acc[r] * d : 0.f;
            else AQ[i * 64 + j] = (bf16)f2bf((i >= j) ? acc[r] * d : 0.f); }
    }
    __syncthreads();
    GPE(71); GPS(72);
    {
        LAS const float* Lf = (LAS const float*)(lds + GA_LF);
        LAS float* T32 = (LAS float*)(lds + GA_T32); LAS float* X32 = (LAS float*)(lds + GA_X32);
        if (wave == 0) {
            int lx = lane; asm volatile("" : "+v"(lx));
            const int hb = lx >> 5, c = lx & 31;
            LAS const float* Lb = Lf + (32 * hb) * 64 + 32 * hb;
            float T[32];
#pragma unroll
            for (int i = 0; i < 32; ++i) {
                float a0 = (i == c) ? 1.f : 0.f, a1 = 0.f;
#pragma unroll
                for (int j4 = 0; j4 < (i + 3) / 4; ++j4) { const f32x4 l4 = *(LAS const f32x4*)(Lb + i * 64 + 4 * j4);
                    if (4 * j4 + 0 < i) a0 -= l4.x * T[4 * j4 + 0];
                    if (4 * j4 + 1 < i) a1 -= l4.y * T[4 * j4 + 1];
                    if (4 * j4 + 2 < i) a0 -= l4.z * T[4 * j4 + 2];
                    if (4 * j4 + 3 < i) a1 -= l4.w * T[4 * j4 + 3]; }
                T[i] = a0 + a1;
                T32[hb * 1024 + i * 32 + c] = T[i];
                *(LAS bf16*)(lds + GA_TB + (32 * hb + i) * 144 + (32 * hb + c) * 2) = (bf16)f2bf(T[i]);
                if (hb == 0) *(LAS bf16*)(lds + GA_TB + i * 144 + (32 + c) * 2) = (bf16)0;
            }
        } else {
            bf16* GKD = (bf16*)(ws + WS_GKD) + (size_t)unit * 8192;
            int t0 = tid; asm volatile("" : "+v"(t0));
            for (int id = t0 - 64; id < 1024; id += 448) { const int row = id >> 3, ch = id & 7;
                *(v4u*)(GKD + row * 64 + ch * 8) = *(LAS const v4u*)(lds + GA_KDT + row * 144 + ch * 16); }
        }
        __syncthreads();
        int tidx = tid; asm volatile("" : "+v"(tidx));
        const int r = tidx >> 4, c2 = (tidx & 15) * 2;
        {
            float x0 = 0.f, x1 = 0.f;
#pragma unroll 8
            for (int k = 0; k < 32; ++k) { const float l = Lf[(32 + r) * 64 + k]; x0 += l * T32[k * 32 + c2]; x1 += l * T32[k * 32 + c2 + 1]; }
            X32[r * 32 + c2] = x0; X32[r * 32 + c2 + 1] = x1;
        }
        __syncthreads();
        {
            float x0 = 0.f, x1 = 0.f;
#pragma unroll 8
            for (int k = 0; k < 32; ++k) { const float t = T32[1024 + r * 32 + k]; x0 += t * X32[k * 32 + c2]; x1 += t * X32[k * 32 + c2 + 1]; }
            *(LAS unsigned*)(lds + GA_TB + (32 + r) * 144 + c2 * 2) = pk2(-x0, -x1);
        }
    }
    __syncthreads();
    GPE(72); GPS(73);
    {
        const int nt = wave; LAS const unsigned char* Bb = lds + (nt < 4 ? GA_VBT : GA_KBGT) + (32 * (nt & 3) + l31) * 144 + hi * 16;
        float* GU0 = (float*)(ws + WS_GU0) + (size_t)unit * 8192; bf16* GW = (bf16*)(ws + WS_GW) + (size_t)unit * 8192;
#pragma unroll
        for (int it = 0; it < 2; ++it) {
            f32x16 acc = {};
            LAS const unsigned char* Ab = lds + GA_TB + (32 * it + l31) * 144 + hi * 16;
#pragma unroll
            for (int ks = 0; ks < 4; ++ks) if (ks < 2 * (it + 1)) acc = MFMA32(lds_ld8(Ab + ks * 32), lds_ld8(Bb + ks * 32), acc);
            const int col = 32 * (nt & 3) + l31;
#pragma unroll
            for (int r = 0; r < 16; ++r) { const int i = 32 * it + crow(r, hi);
                if (nt < 4) GU0[i * 128 + col] = acc[r]; else GW[i * 128 + col] = (bf16)f2bf(acc[r]); }
        }
        if (tid == 0) ((float*)(ws + WS_GEND))[unit] = __expf(Gend);
    }
    __syncthreads();
    GPE(73); GPE(74);
#ifdef PROBE_K
    if (blockIdx.x == PROBE_B && PROBE_K >= 70 && PROBE_K < 80) { const unsigned long long te = __builtin_amdgcn_s_memrealtime(); while (__builtin_amdgcn_s_memrealtime() - te < (unsigned long long)PROBE_MULT * pdt) __builtin_amdgcn_s_sleep(8); }
#endif
}

constexpr int GB_ST = 0, GB_UT = 34816, GB_OF = 53248;
__device__ __forceinline__ void gdn_b_unit(const Args& A, LAS unsigned char* lds, int bh, int tid, int lane, int wave) {
    unsigned char* ws = A.ws;
    const int b = bh >> 3, h = bh & 7, l31 = lane & 31, hi = lane >> 5;
    const int it = wave >> 2, vt = wave & 3;
    for (int i = tid; i < 34816 / 16; i += 512) *(LAS v4u*)(lds + GB_ST + i * 16) = (v4u){0u, 0u, 0u, 0u};
    f32x16 Sacc[2] = {};
    __syncthreads();
    const bf16* Zb = (const bf16*)(ws + WS_Z); bf16* YA = (bf16*)(ws + WS_YA);
    LAS const unsigned char* Sb = lds + GB_ST + (32 * vt + l31) * 272 + hi * 16;
    LAS const unsigned char* Ub = lds + GB_UT + (32 * vt + l31) * 144 + hi * 16;
    const int di = tid >> 3, dc0 = (tid & 7) * 16;
    bf16x8 wA[8], qA[8], cA[4], kA[2][4]; float u0[16]; v4u zz[2]; float gend;
#define BL8(rs_, vo_, so_) __builtin_bit_cast(bf16x8, __builtin_amdgcn_raw_buffer_load_b128((rs_), (vo_), (so_), 0))
#define MKRS(p_, bytes_) __builtin_amdgcn_make_buffer_rsrc((void*)(p_), 0, (bytes_), 0x00020000)
    const unsigned voW = (unsigned)((32 * it + l31) * 128 + 8 * hi) * 2u, voA = (unsigned)((32 * it + l31) * 64 + 8 * hi) * 2u, voK = (unsigned)((64 * it + l31) * 64 + 8 * hi) * 2u;
    const unsigned voU = (unsigned)((32 * it + 4 * hi) * 128 + 32 * vt + l31) * 4u, voZ = (unsigned)(di * 1024 + h * 128 + dc0) * 2u;
#define GB_LD_W(n_) do { const int cu_ = bh * 32 + (n_); const __amdgpu_buffer_rsrc_t rW_ = MKRS((const bf16*)(ws + WS_GW) + (size_t)cu_ * 8192, 16384), rU_ = MKRS((const float*)(ws + WS_GU0) + (size_t)cu_ * 8192, 32768); \
        _Pragma("unroll") for (int ks = 0; ks < 8; ++ks) wA[ks] = BL8(rW_, voW, ks * 32); \
        _Pragma("unroll") for (int r = 0; r < 16; ++r) u0[r] = __builtin_bit_cast(float, __builtin_amdgcn_raw_buffer_load_b32(rU_, voU, ((r & 3) + 8 * (r >> 2)) * 512, 0)); } while (0)
#define GB_LD_Q(n_) do { const int cu_ = bh * 32 + (n_); const __amdgpu_buffer_rsrc_t rQ_ = MKRS((const bf16*)(ws + WS_GQG) + (size_t)cu_ * 8192, 16384), rA_ = MKRS((const bf16*)(ws + WS_GAQK) + (size_t)cu_ * 4096, 8192); \
        _Pragma("unroll") for (int ks = 0; ks < 8; ++ks) qA[ks] = BL8(rQ_, voW, ks * 32); \
        _Pragma("unroll") for (int ks = 0; ks < 4; ++ks) cA[ks] = BL8(rA_, voA, ks * 32); } while (0)
#define GB_LD_K(n_) do { const int cu_ = bh * 32 + (n_); const __amdgpu_buffer_rsrc_t rK_ = MKRS((const bf16*)(ws + WS_GKD) + (size_t)cu_ * 8192, 16384), rZ_ = MKRS(Zb + (size_t)(b * SEQ + 64 * (n_)) * 1024, 64 * 1024 * 2); \
        _Pragma("unroll") for (int ks = 0; ks < 4; ++ks) { kA[0][ks] = BL8(rK_, voK, ks * 32); kA[1][ks] = BL8(rK_, voK, 32 * 64 * 2 + ks * 32); } \
        zz[0] = __builtin_amdgcn_raw_buffer_load_b128(rZ_, voZ, 0, 0); zz[1] = __builtin_amdgcn_raw_buffer_load_b128(rZ_, voZ, 16, 0); \
        gend = ((const float*)(ws + WS_GEND))[cu_]; } while (0)
#ifdef PROBE_K
    unsigned long long pt0 = 0, pdt = 0;
#endif
    float gn[16];
#pragma unroll
    for (int e = 0; e < 16; ++e) gn[e] = A.in[I_GDNN][dc0 + e];
    GB_LD_W(0); GB_LD_Q(0);
#pragma unroll 1
    for (int n = 0; n < 32; ++n) {
        const int r0 = b * SEQ + 64 * n;
        GPS(80); GPS(84);
        GB_LD_K(n);
        {
            f32x16 acc = {};
#pragma unroll
            for (int ks = 0; ks < 8; ++ks) acc = MFMA32(wA[ks], lds_ld8(Sb + ks * 32), acc);
            float u[16];
#pragma unroll
            for (int r = 0; r < 16; ++r) u[r] = u0[r] - acc[r];
#pragma unroll
            for (int g = 0; g < 4; ++g) { v2u w; w.x = pk2(u[4 * g], u[4 * g + 1]); w.y = pk2(u[4 * g + 2], u[4 * g + 3]);
                *(LAS v2u*)(lds + GB_UT + (32 * vt + l31) * 144 + (32 * it + 8 * g + 4 * hi) * 2) = w; }
        }
        LBAR();
        GPE(80); GPS(81);
        GB_LD_W(n + 1 < 32 ? n + 1 : 31);
        {
            f32x16 acc = {};
#pragma unroll
            for (int ks = 0; ks < 8; ++ks) acc = MFMA32(qA[ks], lds_ld8(Sb + ks * 32), acc);
#pragma unroll
            for (int ks = 0; ks < 4; ++ks) if (ks < 2 * (it + 1)) acc = MFMA32(cA[ks], lds_ld8(Ub + ks * 32), acc);
#pragma unroll
            for (int r = 0; r < 16; ++r) ((LAS float*)(lds + GB_OF))[(32 * it + crow(r, hi)) * 132 + 32 * vt + l31] = acc[r];
        }
        LBAR();
        GPE(81); GPS(82);
        GB_LD_Q(n + 1 < 32 ? n + 1 : 31);
        {
#pragma unroll
            for (int t = 0; t < 2; ++t) { const int kt = 2 * (wave >> 2) + t;
                Sacc[t] = Sacc[t] * gend;
#pragma unroll
                for (int ks = 0; ks < 4; ++ks) Sacc[t] = MFMA32(kA[t][ks], lds_ld8(Ub + ks * 32), Sacc[t]);
#pragma unroll
                for (int g = 0; g < 4; ++g) { v2u w; w.x = pk2(Sacc[t][4 * g], Sacc[t][4 * g + 1]); w.y = pk2(Sacc[t][4 * g + 2], Sacc[t][4 * g + 3]);
                    *(LAS v2u*)(lds + GB_ST + (32 * vt + l31) * 272 + (32 * kt + 8 * g + 4 * hi) * 2) = w; }
            }
        }
        {
            LAS const float* orow = (LAS const float*)(lds + GB_OF) + di * 132 + dc0;
            float o[16]; float ss = 0.f;
#pragma unroll
            for (int q = 0; q < 4; ++q) { const f32x4 v = *(LAS const f32x4*)(orow + 4 * q); o[4 * q] = v.x; o[4 * q + 1] = v.y; o[4 * q + 2] = v.z; o[4 * q + 3] = v.w; }
#pragma unroll
            for (int e = 0; e < 16; ++e) ss += o[e] * o[e];
            ss += __shfl_xor(ss, 1); ss += __shfl_xor(ss, 2); ss += __shfl_xor(ss, 4);
            const float r = 1.f / sqrtf(ss * (1.f / 128.f) + EPS);
            const size_t off = (size_t)(r0 + di) * 1024 + h * 128 + dc0;
            const v4u z0 = zz[0], z1 = zz[1];
            const float z[16] = {lo16(z0.x), hi16(z0.x), lo16(z0.y), hi16(z0.y), lo16(z0.z), hi16(z0.z), lo16(z0.w), hi16(z0.w),
                                 lo16(z1.x), hi16(z1.x), lo16(z1.y), hi16(z1.y), lo16(z1.z), hi16(z1.z), lo16(z1.w), hi16(z1.w)};
            float y[16];
#pragma unroll
            for (int e = 0; e < 16; ++e) y[e] = o[e] * r * gn[e] * siluf_(z[e]);
            v4u o0, o1; o0.x = pk2(y[0], y[1]); o0.y = pk2(y[2], y[3]); o0.z = pk2(y[4], y[5]); o0.w = pk2(y[6], y[7]);
            o1.x = pk2(y[8], y[9]); o1.y = pk2(y[10], y[11]); o1.z = pk2(y[12], y[13]); o1.w = pk2(y[14], y[15]);
            *(v4u*)(YA + off) = o0; *(v4u*)(YA + off + 8) = o1;
        }
        GPE(82); GPS(83);
        LBAR();
        GPE(83); GPE(84);
    }
#undef GB_LD_W
#undef GB_LD_Q
#undef GB_LD_K
#undef BL8
#undef MKRS
#ifdef PROBE_K
    if (bh == 0 && tid == 0 && PROBE_K >= 80 && PROBE_K < 90) ((volatile LAS unsigned*)(lds + MISC_OFF))[16] = (unsigned)pdt;
#endif
    float* So = A.out + O_GSP + (size_t)bh * 16384;
#pragma unroll
    for (int t = 0; t < 2; ++t) { const int kt = 2 * (wave >> 2) + t;
#pragma unroll
        for (int r = 0; r < 16; ++r) So[(32 * kt + crow(r, hi)) * 128 + 32 * vt + l31] = Sacc[t][r]; }
    __syncthreads();
}

__device__ __forceinline__ void gdn_r_unit(const Args& A, LAS unsigned char* lds, int unit, int tid, int lane, int wave) {
    unsigned char* ws = A.ws;
    const int j = unit >> 3, h = unit & 7, row = MP + j;
    LAS float* qs = (LAS float*)lds; LAS float* ks = qs + 128; LAS float* vs = qs + 256; LAS float* red = qs + 384;
    LAS float* os = qs + 896;
    if (tid < 384) {
        const int part = tid >> 7, d = tid & 127, col = part * 1024 + h * 128 + d;
        const float* cw = A.in[I_CONVW]; const float* sc = A.in[I_SCONV] + (size_t)j * 3 * 3072;
        const float xn = bf2f(((const bf16*)(ws + WS_QKV))[(size_t)row * 3072 + col]);
        const float y = cw[col] * sc[col] + cw[3072 + col] * sc[3072 + col] + cw[2 * 3072 + col] * sc[2 * 3072 + col] + cw[3 * 3072 + col] * xn;
        qs[tid] = siluf_(y);
    }
    __syncthreads();
    const float rq = 1.f / sqrtf(wave_sum(qs[lane] * qs[lane] + qs[lane + 64] * qs[lane + 64]) + EPS) * 0.08838834764831845f;
    const float rk = 1.f / sqrtf(wave_sum(ks[lane] * ks[lane] + ks[lane + 64] * ks[lane + 64]) + EPS);
    const float beta = ((const float*)(ws + WS_BETA))[(size_t)row * 8 + h], eg = __expf(((const float*)(ws + WS_GLOG))[(size_t)row * 8 + h]);
    const int v = tid & 127, kq = tid >> 7;
    const float* S0 = A.in[I_SGDN] + (size_t)unit * 16384;
    float s[32]; float kv = 0.f;
#pragma unroll
    for (int i = 0; i < 32; ++i) { const int k = 32 * kq + i; s[i] = eg * S0[k * 128 + v]; kv += ks[k] * rk * s[i]; }
    red[kq * 128 + v] = kv;
    __syncthreads();
    const float u = beta * (vs[v] - (red[v] + red[128 + v] + red[256 + v] + red[384 + v]));
    __syncthreads();
    float* So = A.out + O_GSS + (size_t)unit * 16384; float po = 0.f;
#pragma unroll
    for (int i = 0; i < 32; ++i) { const int k = 32 * kq + i; s[i] += ks[k] * rk * u; So[k * 128 + v] = s[i]; po += qs[k] * rq * s[i]; }
    red[kq * 128 + v] = po;
    __syncthreads();
    if (tid < 128) os[tid] = red[tid] + red[128 + tid] + red[256 + tid] + red[384 + tid];
    __syncthreads();
    const float rn = 1.f / sqrtf(wave_sum(os[lane] * os[lane] + os[lane + 64] * os[lane + 64]) * (1.f / 128.f) + EPS);
    if (tid < 128) { const size_t off = (size_t)row * 1024 + h * 128 + tid;
        ((bf16*)(ws + WS_YA))[off] = (bf16)f2bf(os[tid] * rn * A.in[I_GDNN][tid] * siluf_(bf2f(((const bf16*)(ws + WS_Z))[off]))); }
    __syncthreads();
}

namespace att {
using s16x4 = __attribute__((ext_vector_type(4))) short;
using u32x4 = __attribute__((ext_vector_type(4))) unsigned;
constexpr int SHM_V = 16384, SHM_K = 16384, SHM_KR = 8192;
constexpr int OFF_V = 0, OFF_K = 2 * SHM_V, OFF_KR = OFF_K + 2 * SHM_K, OFF_WS = OFF_KR + 2 * SHM_KR, OFF_QR = OFF_WS + 2048;
constexpr float THR = 8.f;
#define KSWZ(row, colB) ((row) * 256 + ((colB) ^ (((row) & 7) << 4)))
#define KRSWZ(row, colB) ((row) * 128 + ((colB) ^ (((row) & 7) << 4)))
#define SBAR() __builtin_amdgcn_sched_barrier(0)
__device__ __forceinline__ unsigned cvtpk(float lo, float hi) { unsigned r; asm volatile("v_cvt_pk_bf16_f32 %0, %1, %2" : "=v"(r) : "v"(lo), "v"(hi)); return r; }
__device__ __forceinline__ void partialSM(f32x16& p0, f32x16& p1, float& m_reg, float& mn, float& alpha) {
    constexpr float C = MLA_SCALE * 1.4426950408889634f;
    float pmax = p0[0];
#pragma unroll
    for (int r = 1; r < 16; ++r) pmax = fmaxf(pmax, p0[r]);
#pragma unroll
    for (int r = 0; r < 16; ++r) pmax = fmaxf(pmax, p1[r]);
    { auto rr = __builtin_amdgcn_permlane32_swap(__float_as_uint(pmax), __float_as_uint(pmax), false, false);
      pmax = fmaxf(__uint_as_float(rr[0]), __uint_as_float(rr[1])); }
    if (__builtin_expect(__all(pmax - m_reg <= THR / MLA_SCALE), 1)) { mn = m_reg; alpha = 1.f; }
    else { mn = fmaxf(m_reg, pmax); alpha = __builtin_amdgcn_exp2f((m_reg - mn) * C); m_reg = mn; }
    const float mnC = -mn * C;
#pragma unroll
    for (int r = 0; r < 16; ++r) p0[r] = fmaf(p0[r], C, mnC);
#pragma unroll
    for (int r = 0; r < 16; ++r) p1[r] = fmaf(p1[r], C, mnC);
#pragma unroll
    for (int r = 0; r < 16; ++r) p0[r] = __builtin_amdgcn_exp2f(p0[r]);
}
__device__ __forceinline__ void finishSM(f32x16& p0, f32x16& p1, float alpha, float& l_reg, bf16x8& pa0, bf16x8& pa1, bf16x8& pa2, bf16x8& pa3) {
#pragma unroll
    for (int r = 0; r < 16; ++r) p1[r] = __builtin_amdgcn_exp2f(p1[r]);
    float ps = 0;
#pragma unroll
    for (int r = 0; r < 16; ++r) ps += p0[r];
#pragma unroll
    for (int r = 0; r < 16; ++r) ps += p1[r];
    { auto rr = __builtin_amdgcn_permlane32_swap(__float_as_uint(ps), __float_as_uint(ps), false, false);
      ps = __uint_as_float(rr[0]) + __uint_as_float(rr[1]); }
    l_reg = l_reg * alpha + ps;
#define PK4(P, BASE, OUT) do { unsigned a0 = cvtpk(P[BASE + 0], P[BASE + 1]), a1 = cvtpk(P[BASE + 2], P[BASE + 3]);   \
    unsigned b0 = cvtpk(P[BASE + 4], P[BASE + 5]), b1 = cvtpk(P[BASE + 6], P[BASE + 7]);                              \
    auto r0 = __builtin_amdgcn_permlane32_swap(a0, b0, false, false); auto r1 = __builtin_amdgcn_permlane32_swap(a1, b1, false, false); \
    u32x4 w = {r0[0], r1[0], r0[1], r1[1]}; OUT = *reinterpret_cast<bf16x8*>(&w); } while (0)
    PK4(p0, 0, pa0); PK4(p0, 8, pa1); PK4(p1, 0, pa2); PK4(p1, 8, pa3);
#undef PK4
}
__device__ __forceinline__ void qkt(f32x16& p0, f32x16& p1, LAS const unsigned char* Ks, LAS const unsigned char* KRs, const bf16x8* qr, LAS const unsigned char* qrl, int r32, int hi) {
    p0 = f32x16{}; p1 = f32x16{};
#pragma unroll
    for (int d0 = 0; d0 < 8; ++d0) { const int cb = (d0 * 16 + hi * 8) * 2;
        const bf16x8 b0 = *(LAS const bf16x8*)(Ks + KSWZ(r32, cb)), b1 = *(LAS const bf16x8*)(Ks + KSWZ(32 + r32, cb));
        p0 = MFMA32(b0, qr[d0], p0); p1 = MFMA32(b1, qr[d0], p1); if (d0 == 3 || d0 == 7) SBAR(); }
#pragma unroll
    for (int d0 = 0; d0 < 4; ++d0) { const int cb = (d0 * 16 + hi * 8) * 2;
        const bf16x8 b0 = *(LAS const bf16x8*)(KRs + KRSWZ(r32, cb)), b1 = *(LAS const bf16x8*)(KRs + KRSWZ(32 + r32, cb));
        const bf16x8 qq = *(LAS const bf16x8*)(qrl + d0 * 1024);
        p0 = MFMA32(b0, qq, p0); p1 = MFMA32(b1, qq, p1); }
}
__device__ __forceinline__ void cmask(f32x16& p0, f32x16& p1, int key0, int qpos, int hi) {
#pragma unroll
    for (int r = 0; r < 16; ++r) { const int k = key0 + crow(r, hi); if (k > qpos) p0[r] = -1e30f; if (k + 32 > qpos) p1[r] = -1e30f; }
}
__device__ __forceinline__ int v_st(int k, int c) { const int kk = (k & ~0xC) | ((k & 4) << 1) | ((k & 8) >> 1); return ((kk >> 3) * 4 + (c >> 5)) * 512 + ((kk & 7) * 32 + (c & 31)) * 2; }
__device__ __forceinline__ int v_rd_base(int lane) { return ((lane & 3) << 3) | (((lane >> 2) & 3) << 6) | (((lane >> 4) & 1) << 5) | (((lane >> 5) & 1) << 8); }
constexpr int v_rd_off(int d0, int ks, int half) { return d0 * 512 + ks * 4096 + half * 2048; }
template <int OFF> __device__ __forceinline__ s16x4 tr_read(int vb) {
    s16x4 r; asm volatile("ds_read_b64_tr_b16 %0, %1 offset:%2" : "=&v"(r) : "v"(vb), "i"(OFF) : "memory"); return r;
}
template <int D0> __device__ __forceinline__ void pv_one(f32x16& od, int vb, bf16x8 pa0, bf16x8 pa1, bf16x8 pa2, bf16x8 pa3) {
    const s16x4 l0 = tr_read<v_rd_off(D0, 0, 0)>(vb), h0 = tr_read<v_rd_off(D0, 0, 1)>(vb), l1 = tr_read<v_rd_off(D0, 1, 0)>(vb), h1 = tr_read<v_rd_off(D0, 1, 1)>(vb);
    const s16x4 l2 = tr_read<v_rd_off(D0, 2, 0)>(vb), h2 = tr_read<v_rd_off(D0, 2, 1)>(vb), l3 = tr_read<v_rd_off(D0, 3, 0)>(vb), h3 = tr_read<v_rd_off(D0, 3, 1)>(vb);
    asm volatile("s_waitcnt lgkmcnt(0)" ::: "memory"); SBAR();
#define PKV(L, H) (bf16x8){L[0], L[1], L[2], L[3], H[0], H[1], H[2], H[3]}
    od = MFMA32(pa0, PKV(l0, h0), od); od = MFMA32(pa1, PKV(l1, h1), od); od = MFMA32(pa2, PKV(l2, h2), od); od = MFMA32(pa3, PKV(l3, h3), od);
#undef PKV
}
__device__ __forceinline__ void pv_d0(f32x16* o, int vb, bf16x8 pa0, bf16x8 pa1, bf16x8 pa2, bf16x8 pa3) {
    pv_one<0>(o[0], vb, pa0, pa1, pa2, pa3); pv_one<1>(o[1], vb, pa0, pa1, pa2, pa3); pv_one<2>(o[2], vb, pa0, pa1, pa2, pa3); pv_one<3>(o[3], vb, pa0, pa1, pa2, pa3);
}
__device__ __forceinline__ void attn_block(const bf16* __restrict__ Qn, const bf16* __restrict__ Qr, const float* __restrict__ sqn, const float* __restrict__ sqr,
                                           const bf16* __restrict__ Kh, const float* __restrict__ skn, const bf16* __restrict__ KRb, const bf16* __restrict__ Vh,
                                           const float* __restrict__ gqn, const float* __restrict__ gqr, const float* __restrict__ gkn,
                                           bf16* __restrict__ Ob, int q0, LAS unsigned char* lds) {
    const int tid = threadIdx.x, wid = __builtin_amdgcn_readfirstlane(tid >> 6), lane = tid & 63, r32 = lane & 31, hi = lane >> 5; const int r32_o = r32, hi_o = hi;
    LAS unsigned char* V_lds = lds + OFF_V; LAS unsigned char* K_lds = lds + OFF_K; LAS unsigned char* KR_lds = lds + OFF_KR;
    LAS float* wsf = (LAS float*)(lds + OFF_WS) + wid * 64; LAS float* li_l = wsf; LAS float* al_l = wsf + 32;
    float m_reg = -1e30f, l_reg = 0; f32x16 o[4] = {}; bf16x8 qr[8];
    LAS unsigned char* qrl = lds + OFF_QR + wid * 4096 + lane * 16;
    const int qpos = q0 + wid * 32 + r32;
    {
        int hi = hi_o, r32 = r32_o; asm volatile("" : "+v"(hi), "+v"(r32));
        const char* Qw = (const char*)Qn + (size_t)wid * (32 * 1536 * 2); const char* Qx = (const char*)Qr + (size_t)wid * (32 * 1536 * 2);
        const unsigned qoff = (unsigned)(r32 * 1536 + hi * 8) * 2u;
        const float rr = __builtin_amdgcn_rsqf(sqr[(size_t)(wid * 32 + r32) * 8] * (1.f / 64.f) + EPS);
#pragma unroll
        for (int d0 = 0; d0 < 8; ++d0) qr[d0] = *(const bf16x8*)(Qw + qoff + d0 * 32);
#pragma unroll
        for (int d0 = 0; d0 < 2; ++d0) {
            const v4u w1 = *(const v4u*)(Qx + qoff + d0 * 32), w2 = *(const v4u*)(Qx + qoff + (d0 + 2) * 32);
            const float x1[8] = {lo16(w1.x), hi16(w1.x), lo16(w1.y), hi16(w1.y), lo16(w1.z), hi16(w1.z), lo16(w1.w), hi16(w1.w)};
            const float x2[8] = {lo16(w2.x), hi16(w2.x), lo16(w2.y), hi16(w2.y), lo16(w2.z), hi16(w2.z), lo16(w2.w), hi16(w2.w)};
            float o1[8], o2[8];
#pragma unroll
            for (int j = 0; j < 8; ++j) { const int e = 16 * d0 + 8 * hi + j; const float a = x1[j] * rr * gqr[e], b = x2[j] * rr * gqr[e + 32];
                const float rev = (float)qpos * ROPE_INV[e] * 0.15915494309189535f; const float fr_ = rev - floorf(rev);
                const float cs = __builtin_amdgcn_cosf(fr_), sn = __builtin_amdgcn_sinf(fr_);
                o1[j] = a * cs - b * sn; o2[j] = a * sn + b * cs; }
            v4u p1, p2; p1.x = pk2(o1[0], o1[1]); p1.y = pk2(o1[2], o1[3]); p1.z = pk2(o1[4], o1[5]); p1.w = pk2(o1[6], o1[7]);
            p2.x = pk2(o2[0], o2[1]); p2.y = pk2(o2[2], o2[3]); p2.z = pk2(o2[4], o2[5]); p2.w = pk2(o2[6], o2[7]);
            *(LAS v4u*)(qrl + d0 * 1024) = p1; *(LAS v4u*)(qrl + (d0 + 2) * 1024) = p2; }
    }
    const int sr = tid >> 4, sc = (tid & 15) * 8, vst0 = v_st(sr, sc), vst1 = v_st(32 + sr, sc);
    const int krr = tid >> 3, krc = (tid & 7) * 8;
    const unsigned voff = (unsigned)(sr * 1024 + sc) * 2u, voffr = (unsigned)(krr * 64 + krc) * 2u;
    const int vb0 = (int)(uintptr_t)V_lds + v_rd_base(lane);
    bf16x8 vs0, vs1, ks0, ks1, krs;
#define KSCALE(x_, r_) do { const v4u w_ = __builtin_bit_cast(v4u, x_); const float s_ = __builtin_amdgcn_rsqf((r_) * (1.f / 128.f) + EPS); v4u o_; \
    int sc_ = sc; asm volatile("" : "+v"(sc_)); const f32x4 ga_ = *(const f32x4*)(gkn + sc_), gb_ = *(const f32x4*)(gkn + sc_ + 4);     \
    o_.x = pk2(lo16(w_.x) * s_ * ga_.x, hi16(w_.x) * s_ * ga_.y); o_.y = pk2(lo16(w_.y) * s_ * ga_.z, hi16(w_.y) * s_ * ga_.w); \
    o_.z = pk2(lo16(w_.z) * s_ * gb_.x, hi16(w_.z) * s_ * gb_.y); o_.w = pk2(lo16(w_.w) * s_ * gb_.z, hi16(w_.w) * s_ * gb_.w); x_ = __builtin_bit_cast(bf16x8, o_); } while (0)
#define SLOAD(k0) do { do { const char* kb_ = (const char*)Kh + (size_t)(k0) * 2048; const char* vb_ = (const char*)Vh + (size_t)(k0) * 2048; const char* rb_ = (const char*)KRb + (size_t)(k0) * 128; \
    vs0 = *(const bf16x8*)(vb_ + voff); vs1 = *(const bf16x8*)(vb_ + 65536 + voff); ks0 = *(const bf16x8*)(kb_ + voff); ks1 = *(const bf16x8*)(kb_ + 65536 + voff); \
    krs = *(const bf16x8*)(rb_ + voffr); } while (0); } while (0)
#define SWRITE(b) do { *(LAS bf16x8*)(V_lds + (b) * SHM_V + vst0) = vs0; *(LAS bf16x8*)(V_lds + (b) * SHM_V + vst1) = vs1; const int kc = sc * 2; \
    *(LAS bf16x8*)(K_lds + (b) * SHM_K + KSWZ(sr, kc)) = ks0; *(LAS bf16x8*)(K_lds + (b) * SHM_K + KSWZ(32 + sr, kc)) = ks1; \
    *(LAS bf16x8*)(KR_lds + (b) * SHM_KR + KRSWZ(krr, krc * 2)) = krs; } while (0)
#define SWAIT() asm volatile("s_waitcnt vmcnt(0)" ::: "memory")
#define RESC(a) do { if (__any((a) < 1.f)) { if (hi == 0) al_l[r32] = (a); asm volatile("s_waitcnt lgkmcnt(0)" ::: "memory"); \
    _Pragma("unroll") for (int d = 0; d < 4; ++d) _Pragma("unroll") for (int r = 0; r < 16; ++r) o[d][r] *= al_l[crow(r, hi)]; } } while (0)
    f32x16 p0, p1; float mn, al; bf16x8 pa0, pa1, pa2, pa3;
    const int NT = (q0 + 256) / 64, NM = q0 / 64;
    SLOAD(0); SWAIT(); SWRITE(0); SLOAD(64); __syncthreads();
#pragma unroll 1
    for (int j = 0; j < NT; ++j) {
        const int bf = j & 1;
        const bool act = 64 * j <= q0 + wid * 32 + 31;
        if (act) {
            SBAR(); qkt(p0, p1, K_lds + bf * SHM_K, KR_lds + bf * SHM_KR, qr, qrl, r32, hi); if (j >= NM) cmask(p0, p1, 64 * j, qpos, hi);
            partialSM(p0, p1, m_reg, mn, al); RESC(al);
            finishSM(p0, p1, al, l_reg, pa0, pa1, pa2, pa3); SBAR();
        }
        if (j + 1 < NT) { SWAIT(); SWRITE(bf ^ 1); }
        if (j + 2 < NT) SLOAD((j + 2) * 64);
        SBAR();
        if (act) pv_d0(o, vb0 + bf * SHM_V, pa0, pa1, pa2, pa3);
        __syncthreads();
    }
    if (hi == 0) li_l[r32] = l_reg; asm volatile("s_waitcnt lgkmcnt(0)" ::: "memory");
    char* Ow = (char*)Ob + (size_t)wid * (32 * 1024 * 2);
    unsigned lofs = (unsigned)(4 * hi * 1024 + r32) * 2u; asm volatile("" : "+v"(lofs));
#pragma unroll
    for (int r = 0; r < 16; ++r) { const float rl = __builtin_amdgcn_rcpf(li_l[crow(r, hi)]);
#pragma unroll
        for (int d0 = 0; d0 < 4; ++d0) *(bf16*)(Ow + lofs + (unsigned)(((r & 3) + 8 * (r >> 2)) * 1024 + d0 * 32) * 2u) = (bf16)f2bf(o[d0][r] * rl); }
    __syncthreads();
#undef SLOAD
#undef KSCALE
#undef SWRITE
#undef SWAIT
#undef RESC
}
}

constexpr int DP_CT = 0, DP_KR = 133120, DP_PT = 151552, DP_QK = 153728, DP_QR = 157824, DP_ROPE = 159872;
__device__ __forceinline__ float dec_qn(const Args& A, int j, int h, int d) {
    const int row = MP + j;
    return bf2f(((const bf16*)(A.ws + WS_QP))[(size_t)row * 1536 + h * 128 + d]);
}
__device__ __forceinline__ float dec_qr(const Args& A, int j, int h, int e) {
    const int row = MP + j, e1 = e & 31;
    const bf16* q = (const bf16*)(A.ws + WS_QP) + (size_t)row * 1536 + 1024 + h * 64;
    const float rs = __builtin_amdgcn_rsqf(((const float*)(A.ws + WS_SQR))[(size_t)row * 8 + h] * (1.f / 64.f) + EPS);
    const float a = bf2f(q[e1]) * rs * A.in[I_QNR][e1], b = bf2f(q[e1 + 32]) * rs * A.in[I_QNR][e1 + 32];
    const float ang = (float)PAST * ROPE_INV[e1]; const float cs = cosf(ang), sn = sinf(ang);
    return e < 32 ? a * cs - b * sn : a * sn + b * cs;
}
__device__ __forceinline__ void dec_tables(const Args& A, LAS unsigned char* lds, int j, int tid_) {
    int tid = tid_; asm volatile("" : "+v"(tid));
#pragma unroll
    for (int q = 0; q < 2; ++q) { const int idx = tid + 512 * q, h = idx >> 7, d = idx & 127; ((LAS float*)(lds + DP_QK))[idx] = dec_qn(A, j, h, d) * A.in[I_KNN][d]; }
    { const int h = tid >> 6, e = tid & 63; ((LAS float*)(lds + DP_QR))[tid] = dec_qr(A, j, h, e); }
}
__device__ __forceinline__ void dec_page(const Args& A, LAS unsigned char* lds, int unit, int tid, int lane, int wave) {
    unsigned char* ws = A.ws;
    const int phys = ((const int*)A.in[I_PT])[unit];
    const float* src = A.in[I_CACHE] + (size_t)phys * PAGE * LATW;
#pragma unroll 1
    for (int q0 = 0; q0 < 18; q0 += 6) {
        f32x4 va[6], vb[6];
#pragma unroll
        for (int q = 0; q < 6; ++q) { const int id = (q0 + q) * 512 + tid, row = id / 72, g = id % 72; const float* p = src + (size_t)row * LATW + 8 * g; va[q] = *(const f32x4*)p; vb[q] = *(const f32x4*)(p + 4); }
#pragma unroll
        for (int q = 0; q < 6; ++q) { const int id = (q0 + q) * 512 + tid, row = id / 72, g = id % 72;
            v4u o; o.x = pk2(va[q].x, va[q].y); o.y = pk2(va[q].z, va[q].w); o.z = pk2(vb[q].x, vb[q].y); o.w = pk2(vb[q].z, vb[q].w);
            if (g < 64) *(LAS v4u*)(lds + DP_CT + row * 1040 + g * 16) = o; else *(LAS v4u*)(lds + DP_KR + row * 144 + (g - 64) * 16) = o; }
    }
    __syncthreads();
    const int l31 = lane & 31, hi = lane >> 5, h = wave;
    float ssq[4] = {0.f, 0.f, 0.f, 0.f}, dot[4] = {0.f, 0.f, 0.f, 0.f};
    const bf16* WK = (const bf16*)(ws + WS_WKV);
    LAS const float* QK = (LAS const float*)(lds + DP_QK) + h * 128;
#pragma unroll 1
    for (int e = 0; e < 2; ++e) {
        f32x16 acc[2][4];
#pragma unroll
        for (int mt = 0; mt < 2; ++mt)
#pragma unroll
            for (int nt = 0; nt < 4; ++nt) acc[mt][nt] = f32x16{};
        const bf16* Ab = WK + (size_t)(h * 128 + 64 * e + l31) * 512 + 8 * hi;
        LAS const unsigned char* Bb = lds + DP_CT + l31 * 1040 + hi * 16;
#pragma unroll 2
        for (int ks = 0; ks < 32; ++ks) {
            const bf16x8 a0 = gl_ld8(Ab + 16 * ks), a1 = gl_ld8(Ab + 32 * 512 + 16 * ks);
            bf16x8 bq[4];
#pragma unroll
            for (int nt = 0; nt < 4; ++nt) bq[nt] = lds_ld8(Bb + nt * 32 * 1040 + ks * 32);
#pragma unroll
            for (int nt = 0; nt < 4; ++nt) { acc[0][nt] = MFMA32(a0, bq[nt], acc[0][nt]); acc[1][nt] = MFMA32(a1, bq[nt], acc[1][nt]); }
        }
#pragma unroll
        for (int mt = 0; mt < 2; ++mt)
#pragma unroll
            for (int g = 0; g < 4; ++g) { const f32x4 qv = *(LAS const f32x4*)(QK + 64 * e + 32 * mt + 8 * g + 4 * hi);
#pragma unroll
                for (int nt = 0; nt < 4; ++nt) {
                    const float x0 = acc[mt][nt][4 * g], x1 = acc[mt][nt][4 * g + 1], x2 = acc[mt][nt][4 * g + 2], x3 = acc[mt][nt][4 * g + 3];
                    ssq[nt] += x0 * x0 + x1 * x1 + x2 * x2 + x3 * x3; dot[nt] += x0 * qv.x + x1 * qv.y + x2 * qv.z + x3 * qv.w; } }
    }
#pragma unroll
    for (int nt = 0; nt < 4; ++nt) { ssq[nt] += __shfl_xor(ssq[nt], 32); dot[nt] += __shfl_xor(dot[nt], 32); }
    const float sn0 = dot[0] / sqrtf(ssq[0] * (1.f / 128.f) + EPS), sn1 = dot[1] / sqrtf(ssq[1] * (1.f / 128.f) + EPS);
    const float sn2 = dot[2] / sqrtf(ssq[2] * (1.f / 128.f) + EPS), sn3 = dot[3] / sqrtf(ssq[3] * (1.f / 128.f) + EPS);
    const float snA = hi ? sn2 : sn0, snB = hi ? sn3 : sn1;
    float s[2];
    LAS const float* QR = (LAS const float*)(lds + DP_QR) + h * 64;
#pragma unroll
    for (int u = 0; u < 2; ++u) { const int key = 32 * (2 * hi + u) + l31; float sr = 0.f;
#pragma unroll
        for (int c = 0; c < 8; ++c) { const v4u w = *(LAS const v4u*)(lds + DP_KR + key * 144 + c * 16); const f32x4 q0 = *(LAS const f32x4*)(QR + 8 * c), q1 = *(LAS const f32x4*)(QR + 8 * c + 4);
            sr += lo16(w.x) * q0.x + hi16(w.x) * q0.y + lo16(w.y) * q0.z + hi16(w.y) * q0.w + lo16(w.z) * q1.x + hi16(w.z) * q1.y + lo16(w.w) * q1.z + hi16(w.w) * q1.w; }
        s[u] = ((u ? snB : snA) + sr) * MLA_SCALE; }
    const float mx = wave_max(fmaxf(s[0], s[1]));
    const float p0 = __expf(s[0] - mx), p1 = __expf(s[1] - mx);
    const float lsum = wave_sum(p0 + p1);
    *(LAS bf16*)(lds + DP_PT + h * 272 + (32 * (2 * hi) + l31) * 2) = (bf16)f2bf(p0);
    *(LAS bf16*)(lds + DP_PT + h * 272 + (32 * (2 * hi + 1) + l31) * 2) = (bf16)f2bf(p1);
    if (lane == 0) { float* ml = (float*)(ws + WS_DML) + ((size_t)unit * 8 + h) * 2; ml[0] = mx; ml[1] = lsum; }
    __syncthreads();
    float* DA = (float*)(ws + WS_DACC) + (size_t)unit * 8 * 512;
#pragma unroll 1
    for (int t = 0; t < 2; ++t) { const int cb = 64 * wave + 32 * t + l31;
        f32x16 acc2 = {};
#pragma unroll 2
        for (int ks = 0; ks < 8; ++ks) {
            bf16x8 a = {0, 0, 0, 0, 0, 0, 0, 0};
            if (l31 < 8) a = lds_ld8(lds + DP_PT + l31 * 272 + (16 * ks + 8 * hi) * 2);
            bf16x8 bb;
#pragma unroll
            for (int jj = 0; jj < 8; ++jj) bb[jj] = (short)*(LAS const bf16*)(lds + DP_CT + (16 * ks + 8 * hi + jj) * 1040 + cb * 2);
            acc2 = MFMA32(a, bb, acc2);
        }
#pragma unroll
        for (int r = 0; r < 4; ++r) DA[(size_t)(r + 4 * hi) * 512 + cb] = acc2[r];
    }
    __syncthreads();
}
__device__ __forceinline__ void dec_combine(const Args& A, LAS unsigned char* lds, int unit, int tid, int lane, int wave) {
    unsigned char* ws = A.ws;
    const int j = unit >> 3, h = unit & 7, row = MP + j;
    const bf16* Krow = (const bf16*)(ws + WS_KN) + (size_t)row * 1024 + h * 128;
    const bf16* KRrow = (const bf16*)(ws + WS_KR) + (size_t)row * 64;
    const float snew = wave_sum(dec_qn(A, j, h, lane) * bf2f(Krow[lane]) + dec_qn(A, j, h, lane + 64) * bf2f(Krow[lane + 64])
                                + dec_qr(A, j, h, lane) * bf2f(KRrow[lane])) * MLA_SCALE;
    const float* ML = (const float*)(ws + WS_DML) + ((size_t)j * NPAGE * 8 + h) * 2;
    const float m0 = ML[(size_t)lane * 16], m1 = ML[(size_t)(lane + 64) * 16], l0 = ML[(size_t)lane * 16 + 1], l1 = ML[(size_t)(lane + 64) * 16 + 1];
    const float M = fmaxf(wave_max(fmaxf(m0, m1)), snew);
    const float wn = __expf(snew - M);
    const float den = wave_sum(__expf(m0 - M) * l0 + __expf(m1 - M) * l1) + wn;
    const float* DA = (const float*)(ws + WS_DACC) + ((size_t)j * NPAGE * 8 + h) * 512 + tid;
    float num = wn * bf2f(((const bf16*)(ws + WS_C))[(size_t)row * 512 + tid]);
#pragma unroll 16
    for (int p = 0; p < NPAGE; ++p) num += __expf(ML[(size_t)p * 16] - M) * DA[(size_t)p * 4096];
    LAS float* lat = (LAS float*)lds; LAS float* red = lat + 512;
    lat[tid] = num / den;
    __syncthreads();
    const int d = tid & 127, qt = tid >> 7;
    const float* Wv = A.in[I_WUV] + (size_t)(qt * 128) * 1024 + h * 128 + d;
    float part = 0.f;
#pragma unroll 32
    for (int c = 0; c < 128; ++c) part += lat[qt * 128 + c] * Wv[(size_t)c * 1024];
    red[tid] = part;
    __syncthreads();
    if (tid < 128) ((bf16*)(ws + WS_YB))[(size_t)row * 1024 + h * 128 + tid] = (bf16)f2bf(red[tid] + red[128 + tid] + red[256 + tid] + red[384 + tid]);
    __syncthreads();
}
__device__ __forceinline__ f32x16 skinny_partial(const bf16* A, const bf16* Bt, int K, int n0, int wave, int lane) {
    const int l31 = lane & 31, hi = lane >> 5, kw = K >> 3, k0 = wave * kw;
    const bf16* ap = A + (size_t)l31 * K + k0 + 8 * hi; const bf16* bp = Bt + (size_t)(n0 + l31) * K + k0 + 8 * hi;
    f32x16 acc = {};
#pragma unroll 8
    for (int ks = 0; ks < (kw >> 4); ++ks) acc = MFMA32(gl_ld8(ap + 16 * ks), gl_ld8(bp + 16 * ks), acc);
    return acc;
}
__device__ __forceinline__ void skinny_put(LAS float* red, const f32x16& acc, int wave, int lane) {
    const int l31 = lane & 31, hi = lane >> 5;
#pragma unroll
    for (int r = 0; r < 16; ++r) red[(wave * 32 + crow(r, hi)) * 32 + l31] = acc[r];
}
__device__ __forceinline__ void skinny_get(LAS const float* red, int tid, float& v0, float& v1) {
    v0 = 0.f; v1 = 0.f;
#pragma unroll
    for (int w = 0; w < 8; ++w) { v0 += red[w * 1024 + tid * 2]; v1 += red[w * 1024 + tid * 2 + 1]; }
}
template <int MODE> __device__ __forceinline__ void skinny_tile(const Args& A, LAS unsigned char* lds, int tile, int tid, int lane, int wave) {
    unsigned char* ws = A.ws; const int n0 = tile * 32;
    LAS float* red = (LAS float*)lds; LAS float* red2 = red + 8192;
    if (MODE == 0) {
        skinny_put(red, skinny_partial((const bf16*)(ws + WS_YA) + (size_t)MP * 1024, (const bf16*)(ws + WS_WYA), 1024, n0, wave, lane), wave, lane);
        skinny_put(red2, skinny_partial((const bf16*)(ws + WS_YB) + (size_t)MP * 1024, (const bf16*)(ws + WS_WYB), 1024, n0, wave, lane), wave, lane);
    } else if (MODE == 1) skinny_put(red, skinny_partial((const bf16*)(ws + WS_T) + (size_t)MP * 1024, (const bf16*)(ws + WS_WO), 1024, n0, wave, lane), wave, lane);
    else if (MODE == 2) skinny_put(red, skinny_partial((const bf16*)(ws + WS_XN2) + (size_t)MP * 1024, (const bf16*)(ws + WS_WUP), 1024, n0, wave, lane), wave, lane);
    else skinny_put(red, skinny_partial((const bf16*)(ws + WS_H) + (size_t)MP * 4096, (const bf16*)(ws + WS_WDN), 4096, n0, wave, lane), wave, lane);
    __syncthreads();
    float v0, v1; skinny_get(red, tid, v0, v1);
    const int row = tid >> 4, col = n0 + 2 * (tid & 15); const size_t grow = (size_t)(MP + row);
    if (MODE == 0) {
        float u0, u1; skinny_get(red2, tid, u0, u1);
        const bf16* g = (const bf16*)(ws + WS_GATES) + grow * 2048 + col;
        const float t0 = bf2f(g[0]) * v0 + bf2f(g[1024]) * u0, t1 = bf2f(g[1]) * v1 + bf2f(g[1025]) * u1;
        *(unsigned*)((bf16*)(ws + WS_T) + grow * 1024 + col) = pk2(t0, t1);
    } else if (MODE == 1) {
        const float* x = A.in[I_XS] + (size_t)row * 1024 + col;
        const float y0 = x[0] + v0, y1 = x[1] + v1;
        *(unsigned*)((bf16*)(ws + WS_XN2) + grow * 1024 + col) = pk2(y0, y1);
        float ss = y0 * y0 + y1 * y1; ss += __shfl_xor(ss, 1); ss += __shfl_xor(ss, 2); ss += __shfl_xor(ss, 4); ss += __shfl_xor(ss, 8);
        if ((tid & 15) == 0) atomicAdd((float*)(ws + WS_RX) + grow, ss);
    } else if (MODE == 2) {
        const float rr = __builtin_amdgcn_rsqf(((const float*)(ws + WS_RX))[grow] * (1.f / 1024.f) + EPS);
        const float a = fmaxf(v0 * rr, 0.f), b = fmaxf(v1 * rr, 0.f);
        *(unsigned*)((bf16*)(ws + WS_H) + grow * 4096 + col) = pk2(a * a, b * b);
    } else {
        const unsigned xw = *(const unsigned*)((const bf16*)(ws + WS_XN2) + grow * 1024 + col); float* o = A.out + O_YS + (size_t)row * 1024 + col;
        o[0] = lo16(xw) + v0; o[1] = hi16(xw) + v1;
    }
    __syncthreads();
}
struct DecPk { v4u p[36]; };
#ifndef DEC_RD
#define DEC_RD 16
#endif
constexpr int RD = DEC_RD;
__device__ __forceinline__ void dec_load_sync(const Args& A, LAS unsigned char* lds, int unit, int tid) {
    const int phys = ((const int*)A.in[I_PT])[unit];
    const float* src = A.in[I_CACHE] + (size_t)phys * PAGE * LATW;
#pragma unroll 1
    for (int q0 = 0; q0 < 18; q0 += 6) {
        f32x4 va[6], vb[6];
#pragma unroll
        for (int q = 0; q < 6; ++q) { const int id = (q0 + q) * 512 + tid, row = id / 72, g = id % 72; const float* p = src + (size_t)row * LATW + 8 * g; va[q] = *(const f32x4*)p; vb[q] = *(const f32x4*)(p + 4); }
#pragma unroll
        for (int q = 0; q < 6; ++q) { const int id = (q0 + q) * 512 + tid, row = id / 72, g = id % 72;
            v4u o; o.x = pk2(va[q].x, va[q].y); o.y = pk2(va[q].z, va[q].w); o.z = pk2(vb[q].x, vb[q].y); o.w = pk2(vb[q].z, vb[q].w);
            if (g < 64) *(LAS v4u*)(lds + DP_CT + row * 1040 + g * 16) = o; else *(LAS v4u*)(lds + DP_KR + row * 144 + (g - 64) * 16) = o; }
    }
    __syncthreads();
}
__device__ __forceinline__ void dec_prefetch(const Args& A, int unit, int lt, DecPk& pk) {
    const int phys = __builtin_amdgcn_readfirstlane(((const int*)A.in[I_PT])[unit]);
    const char* src = (const char*)(A.in[I_CACHE] + (size_t)phys * PAGE * LATW);
    const unsigned lo = (unsigned)lt * 32u;
#pragma unroll
    for (int q0 = 0; q0 < 36; q0 += 12) {
        f32x4 va[12], vb[12];
#pragma unroll
        for (int q = 0; q < 12; ++q) { const char* p = src + (size_t)(q0 + q) * 8192 + lo; va[q] = __builtin_nontemporal_load((const f32x4*)p); vb[q] = __builtin_nontemporal_load((const f32x4*)(p + 16)); }
#pragma unroll
        for (int q = 0; q < 12; ++q) { v4u o; o.x = pk2(va[q].x, va[q].y); o.y = pk2(va[q].z, va[q].w); o.z = pk2(vb[q].x, vb[q].y); o.w = pk2(vb[q].z, vb[q].w); pk.p[q0 + q] = o; }
    }
}
__device__ __forceinline__ void dec_store(LAS unsigned char* lds, int lt, const DecPk& pk) {
    int ltx = lt; asm volatile("" : "+v"(ltx));
#pragma unroll
    for (int q = 0; q < 36; ++q) { const int id = q * 256 + ltx, row = id / 72, g = id - row * 72;
        const int off = g < 64 ? DP_CT + row * 1040 + g * 16 : DP_KR + row * 144 + (g - 64) * 16;
        *(LAS v4u*)(lds + off) = pk.p[q]; }
}
__device__ __forceinline__ void dec_ring_fill(const Args& A, int mw, int lane, bf16x8 (&a)[RD]) {
    const __amdgpu_buffer_rsrc_t rs = __builtin_amdgcn_make_buffer_rsrc((void*)(A.ws + WS_WKT), 0, 1024 * 512 * 2, 0x00020000);
    const unsigned voff = (unsigned)lane * 16u; const int so = 256 * mw * 1024;
#pragma unroll
    for (int d = 0; d < RD; ++d) a[d] = __builtin_bit_cast(bf16x8, __builtin_amdgcn_raw_buffer_load_b128(rs, voff, so + d * 1024, 0));
}
__device__ __forceinline__ void dec_mfma(const Args& A, LAS unsigned char* lds, int unit, int mw, int lane, bf16x8 (&a)[RD]) {
    const int l31_ = lane & 31, hi_ = lane >> 5;
    const __amdgpu_buffer_rsrc_t rs = __builtin_amdgcn_make_buffer_rsrc((void*)(A.ws + WS_WKT), 0, 1024 * 512 * 2, 0x00020000);
    const unsigned voff = (unsigned)lane * 16u; const int so = 256 * mw * 1024;
    LAS const unsigned char* Bb = lds + DP_CT + l31_ * 1040 + hi_ * 16;
    float ssq[4] = {0.f, 0.f, 0.f, 0.f}, dot[4] = {0.f, 0.f, 0.f, 0.f};
    bf16x8 bc0 = lds_ld8(Bb), bc1 = lds_ld8(Bb + 33280), bc2 = lds_ld8(Bb + 2 * 33280), bc3 = lds_ld8(Bb + 3 * 33280), bd0, bd1, bd2, bd3;
#pragma unroll 1
    for (int jb = 0; jb < 8; ++jb) {
        f32x16 acc[4];
#pragma unroll
        for (int nt = 0; nt < 4; ++nt) acc[nt] = f32x16{};
#pragma unroll 1
        for (int blk = 0; blk < 32 / RD; ++blk) {
            const int nj = (blk == 32 / RD - 1) ? ((jb + 1) & 7) : jb, nk = (blk == 32 / RD - 1) ? 0 : (blk + 1) * RD;
            const int nb = so + nj * 32 * 1024 + 1024 * nk;
            LAS const unsigned char* Bk = Bb + blk * (32 * RD);
            LAS const unsigned char* Bn = Bb + ((blk + 1) & (32 / RD - 1)) * (32 * RD);
#pragma unroll
            for (int d = 0; d < RD; d += 2) {
                {
                    LAS const unsigned char* Bx = Bk + (d + 1) * 32;
                    bd0 = lds_ld8(Bx); bd1 = lds_ld8(Bx + 33280); bd2 = lds_ld8(Bx + 2 * 33280); bd3 = lds_ld8(Bx + 3 * 33280);
                    __builtin_amdgcn_sched_barrier(0);
                    acc[0] = MFMA32(a[d], bc0, acc[0]); acc[1] = MFMA32(a[d], bc1, acc[1]); acc[2] = MFMA32(a[d], bc2, acc[2]); acc[3] = MFMA32(a[d], bc3, acc[3]);
                    a[d] = __builtin_bit_cast(bf16x8, __builtin_amdgcn_raw_buffer_load_b128(rs, voff, nb + d * 1024, 0));
                    __builtin_amdgcn_sched_barrier(0);
                }
                {
                    LAS const unsigned char* Bx = (d + 2 < RD) ? Bk + (d + 2) * 32 : Bn;
                    bc0 = lds_ld8(Bx); bc1 = lds_ld8(Bx + 33280); bc2 = lds_ld8(Bx + 2 * 33280); bc3 = lds_ld8(Bx + 3 * 33280);
                    __builtin_amdgcn_sched_barrier(0);
                    acc[0] = MFMA32(a[d + 1], bd0, acc[0]); acc[1] = MFMA32(a[d + 1], bd1, acc[1]); acc[2] = MFMA32(a[d + 1], bd2, acc[2]); acc[3] = MFMA32(a[d + 1], bd3, acc[3]);
                    a[d + 1] = __builtin_bit_cast(bf16x8, __builtin_amdgcn_raw_buffer_load_b128(rs, voff, nb + (d + 1) * 1024, 0));
                    __builtin_amdgcn_sched_barrier(0);
                }
            }
        }
        const int e4 = jb & 3, h = 2 * mw + (jb >> 2);
#ifdef PROBE_K
        const unsigned long long fz0 = __builtin_amdgcn_s_memrealtime();
#endif
        int l31 = l31_, hi = hi_; asm volatile("" : "+v"(l31), "+v"(hi));
        LAS const float* QK = (LAS const float*)(lds + DP_QK) + h * 128 + 32 * e4 + 4 * hi;
#pragma unroll
        for (int g = 0; g < 4; ++g) { const f32x4 qv = *(LAS const f32x4*)(QK + 8 * g);
#pragma unroll
            for (int nt = 0; nt < 4; ++nt) {
                const float x0 = acc[nt][4 * g], x1 = acc[nt][4 * g + 1], x2 = acc[nt][4 * g + 2], x3 = acc[nt][4 * g + 3];
                ssq[nt] += x0 * x0 + x1 * x1 + x2 * x2 + x3 * x3; dot[nt] += x0 * qv.x + x1 * qv.y + x2 * qv.z + x3 * qv.w; } }
        if (e4 == 3) {
#pragma unroll
            for (int nt = 0; nt < 4; ++nt) { ssq[nt] += __shfl_xor(ssq[nt], 32); dot[nt] += __shfl_xor(dot[nt], 32); }
            const float sn0 = dot[0] / sqrtf(ssq[0] * (1.f / 128.f) + EPS), sn1 = dot[1] / sqrtf(ssq[1] * (1.f / 128.f) + EPS);
            const float sn2 = dot[2] / sqrtf(ssq[2] * (1.f / 128.f) + EPS), sn3 = dot[3] / sqrtf(ssq[3] * (1.f / 128.f) + EPS);
            const float snA = hi ? sn2 : sn0, snB = hi ? sn3 : sn1;
            float s[2];
            LAS const float* QR = (LAS const float*)(lds + DP_QR) + h * 64;
#pragma unroll
            for (int u = 0; u < 2; ++u) { const int key = 32 * (2 * hi + u) + l31; float sr = 0.f;
#pragma unroll
                for (int c = 0; c < 8; ++c) { const v4u w = *(LAS const v4u*)(lds + DP_KR + key * 144 + c * 16); const f32x4 q0 = *(LAS const f32x4*)(QR + 8 * c), q1 = *(LAS const f32x4*)(QR + 8 * c + 4);
                    sr += lo16(w.x) * q0.x + hi16(w.x) * q0.y + lo16(w.y) * q0.z + hi16(w.y) * q0.w + lo16(w.z) * q1.x + hi16(w.z) * q1.y + lo16(w.w) * q1.z + hi16(w.w) * q1.w; }
                s[u] = ((u ? snB : snA) + sr) * MLA_SCALE; }
            const float mx = wave_max(fmaxf(s[0], s[1]));
            const float p0 = __expf(s[0] - mx), p1 = __expf(s[1] - mx);
            const float lsum = wave_sum(p0 + p1);
            *(LAS bf16*)(lds + DP_PT + h * 272 + (32 * (2 * hi) + l31) * 2) = (bf16)f2bf(p0);
            *(LAS bf16*)(lds + DP_PT + h * 272 + (32 * (2 * hi + 1) + l31) * 2) = (bf16)f2bf(p1);
            if (l31 + hi == 0) { float* ml = (float*)(A.ws + WS_DML) + ((size_t)unit * 8 + h) * 2; ml[0] = mx; ml[1] = lsum; }
#pragma unroll
            for (int nt = 0; nt < 4; ++nt) { ssq[nt] = 0.f; dot[nt] = 0.f; }
        }
#ifdef PROBE_K
        if (PROBE_K == 67 && mw == 0 && lane == 0) ((volatile LAS unsigned*)(lds + MISC_OFF))[20] += (unsigned)(__builtin_amdgcn_s_memrealtime() - fz0);
#endif
    }
}
__device__ __forceinline__ void dec_pv(const Args& A, LAS unsigned char* lds, int unit, int lane, int wave) {
    int l31 = lane & 31, hi = lane >> 5; asm volatile("" : "+v"(l31), "+v"(hi));
    float* DA = (float*)(A.ws + WS_DACC) + (size_t)unit * 8 * 512;
#pragma unroll 1
    for (int t = 0; t < 2; ++t) { const int cb = 64 * wave + 32 * t + l31;
        f32x16 acc2 = {};
#pragma unroll 2
        for (int ks = 0; ks < 8; ++ks) {
            bf16x8 a = {0, 0, 0, 0, 0, 0, 0, 0};
            if (l31 < 8) a = lds_ld8(lds + DP_PT + l31 * 272 + (16 * ks + 8 * hi) * 2);
            bf16x8 bb;
#pragma unroll
            for (int jj = 0; jj < 8; ++jj) bb[jj] = (short)*(LAS const bf16*)(lds + DP_CT + (16 * ks + 8 * hi + jj) * 1040 + cb * 2);
            acc2 = MFMA32(a, bb, acc2);
        }
#pragma unroll
        for (int r = 0; r < 4; ++r) DA[(size_t)(r + 4 * hi) * 512 + cb] = acc2[r];
    }
}
constexpr int NG4 = 640, NG2 = 512, NG1 = 512;
__device__ __forceinline__ void dec_rope(LAS unsigned char* lds, int lt_) {
    int lt = lt_; asm volatile("" : "+v"(lt));
#pragma unroll 1
    for (int i = 0; i < 4; ++i) { const int idx = lt + 256 * i, h = idx >> 7, key = idx & 127;
        LAS const float* QR = (LAS const float*)(lds + DP_QR) + h * 64; float sr = 0.f;
#pragma unroll
        for (int c = 0; c < 8; ++c) { const v4u w = *(LAS const v4u*)(lds + DP_KR + key * 144 + c * 16); const f32x4 q0 = *(LAS const f32x4*)(QR + 8 * c), q1 = *(LAS const f32x4*)(QR + 8 * c + 4);
            sr += lo16(w.x) * q0.x + hi16(w.x) * q0.y + lo16(w.y) * q0.z + hi16(w.y) * q0.w + lo16(w.z) * q1.x + hi16(w.z) * q1.y + lo16(w.w) * q1.z + hi16(w.w) * q1.w; }
        *(LAS _Float16*)(lds + DP_ROPE + idx * 2) = (_Float16)sr; }
}
template <bool MF> __device__ __forceinline__ void dec_loop(const Args& A, LAS unsigned char* lds, volatile LAS unsigned* MISC, unsigned* qc, int g, int tid, int lane, int wave) {
    constexpr int NGRP = NG4 + NG2 + NG1; static_assert(4 * NG4 + 2 * NG2 + NG1 == 4096, "page count");
#define GFIRST(g_) ((g_) < NG4 ? 4 * (g_) : (g_) < NG4 + NG2 ? 4 * NG4 + 2 * ((g_) - NG4) : 4 * NG4 + 2 * NG2 + ((g_) - NG4 - NG2))
#define GCOUNT(g_) ((g_) < NG4 ? 4 : (g_) < NG4 + NG2 ? 2 : 1)
#define DPULL() ({ __syncthreads(); if (tid == 0) MISC[0] = atomicAdd(qc, 1u); __syncthreads(); (int)MISC[0]; })
    int jcur = -1;
#ifdef PROBE_K
#ifndef PROBE_B
#define PROBE_B 0
#endif
    unsigned long long pt0 = 0, pdt = 0;
#define DPS(k) do { if ((k) == PROBE_K) pt0 = __builtin_amdgcn_s_memrealtime(); } while (0)
#define DPE(k) do { if ((k) == PROBE_K) pdt += __builtin_amdgcn_s_memrealtime() - pt0; } while (0)
#else
#define DPS(k) do {} while (0)
#define DPE(k) do {} while (0)
#endif
    bf16x8 a[RD];
    if (MF) dec_ring_fill(A, wave, lane, a);
#pragma unroll 1
    while (g < NGRP) {
        const int gn = DPULL();
        const int j = GFIRST(g) >> 7, PG = GCOUNT(g), u0 = GFIRST(g);
        if (j != jcur) { dec_tables(A, lds, j, tid); jcur = j; __syncthreads(); }
#pragma unroll 1
        for (int p = 0; p < PG; ++p) {
            const int unit = u0 + p, np = (p + 1 < PG) ? unit + 1 : (gn < NGRP ? GFIRST(gn) : -1);
            DecPk pk;
            DPS(64); DPS(60); DPS(61);
#ifdef PROBE_K
            const unsigned long long ck0 = __builtin_readcyclecounter();
#endif
            if (MF) { dec_mfma(A, lds, unit, wave, lane, a); DPE(60);
#ifdef PROBE_K
                if (PROBE_K == 66) pdt += (__builtin_readcyclecounter() - ck0) / 24;
#endif
            }
            else if (np >= 0) { dec_prefetch(A, np, tid - 256, pk); DPE(61); }
            LBAR();
            DPS(62);
            dec_pv(A, lds, unit, lane, wave);
            LBAR();
            DPE(62); DPS(63);
            if (MF) { if (np >= 0) dec_ring_fill(A, wave, lane, a); }
            else if (np >= 0) dec_store(lds, tid - 256, pk);
            LBAR();
            DPE(63); DPE(64);
#ifdef PROBE_K
            if (PROBE_K == 67) pdt = ((volatile LAS unsigned*)(lds + MISC_OFF))[20];
#endif
#ifdef PROBE_K
            if (PROBE_K == 65) pdt += 1000;
#endif
        }
        g = gn;
    }
#ifdef PROBE_K
    if (blockIdx.x == PROBE_B && PROBE_K >= 60) { const unsigned long long te = __builtin_amdgcn_s_memrealtime(); while (__builtin_amdgcn_s_memrealtime() - te < (unsigned long long)PROBE_MULT * pdt) __builtin_amdgcn_s_sleep(8); }
#endif
}
__device__ __forceinline__ void dec_run(const Args& A, LAS unsigned char* lds, volatile LAS unsigned* MISC, unsigned* qc, int tid, int lane, int wave) {
    const int g = DPULL();
    if (g >= NG4 + NG2 + NG1) return;
    dec_load_sync(A, lds, GFIRST(g), tid);
    if (wave < 4) dec_loop<true>(A, lds, MISC, qc, g, tid, lane, wave);
    else dec_loop<false>(A, lds, MISC, qc, g, tid, lane, wave);
#undef DPULL
#undef GFIRST
#undef GCOUNT
}
#ifndef MK_SINGLE
#define MK_SINGLE 1
#endif
constexpr int N_PHASES = 12;
__global__ void __launch_bounds__(512, 2) mk_fwd(Args args) {
    extern __shared__ __attribute__((aligned(16))) unsigned char lds_raw[];
    LAS unsigned char* lds = (LAS unsigned char*)lds_raw;
    const int tid = threadIdx.x, lane = tid & 63, wave = __builtin_amdgcn_readfirstlane(tid >> 6);
    const int G = gridDim.x, bid = blockIdx.x;
    const int gw = bid * 8 + wave, NGW = G * 8, gtid = bid * 512 + tid, NGT = G * 512;
    volatile LAS unsigned* MISC = (volatile LAS unsigned*)(lds + MISC_OFF);
    if (tid < 32) MISC[tid] = 0u;
    __syncthreads();
    unsigned char* ws = args.ws;
#if MK_SINGLE
    XcdBarrier bar = xcd_barrier_post((unsigned*)(ws + WS_CTL) + 4096, MISC + 8);
#define GRID_BAR() xcd_barrier(bar)
#else
#define GRID_BAR() do {} while (0)
#endif
    const int lo = args.ph_lo, hi = args.ph_hi;
#ifdef PROBE_K
#ifndef PROBE_B
#define PROBE_B 0
#endif
    unsigned long long pt0 = 0, pdt = 0;
#define PSTART(k) do { if ((k) == PROBE_K) pt0 = __builtin_amdgcn_s_memrealtime(); } while (0)
#define PEND(k) do { if ((k) == PROBE_K) pdt += __builtin_amdgcn_s_memrealtime() - pt0; } while (0)
#else
#define PSTART(k) do {} while (0)
#define PEND(k) do {} while (0)
#endif
#ifndef PHASE_MASK
#define PHASE_MASK 0xFFFF
#endif
#define IN(k) (((PHASE_MASK >> (k)) & 1) && lo <= (k) && (k) < hi)
#define SEAM(k) do { if (IN(k) && IN((k) + 1)) GRID_BAR(); } while (0)

    PSTART(0);
    if (IN(0)) {
        p0_prologue(args, lds, gw, NGW, wave, lane);
        for (int i = gtid; i < 32 * 2 * 3072; i += NGT) { const int c = i % 3072, r = (i / 3072) % 2, j = i / (2 * 3072);
            args.out[O_CSS + (size_t)(j * 3 + r) * 3072 + c] = args.in[I_SCONV][(size_t)(j * 3 + r + 1) * 3072 + c]; }
        __syncthreads();
    }
    SEAM(0);
    PEND(0);
    PSTART(1);
    if (IN(1)) {
        pg8::Gemm g{(const pg8::bf16_t*)(ws + WS_XN), (const pg8::bf16_t*)(ws + WS_WIN), MPAD, NIN, 1024};
        pg8::StaticOrder S; S.init(MPAD, NIN, G, bid);
        EpiG1 E{(bf16*)(ws + WS_QKV), (bf16*)(ws + WS_Z), (bf16*)(ws + WS_QD), (bf16*)(ws + WS_KVD), (bf16*)(ws + WS_GATES), (float*)(ws + WS_SM)};
        pg8::gemm_phase<EpiG1, pg8::StaticOrder, true, true>(lds, g, S, E);
        { const int nfull = (MPAD / 256) * (NIN / 256) - ((MPAD / 256) * (NIN / 256) / G) * G;
          if (bid >= nfull) cvt_weights<true>(args, lds, (bid - nfull) * 8 + wave, (G - nfull) * 8, wave, lane); }
    }
    SEAM(1);
    PEND(1);
    PSTART(2);
    if (IN(2)) {
        p2_rows(args, gw, NGW, lane);
        p2_conv_state(args, gtid, NGT);
    }
    SEAM(2);
    PEND(2);
    PSTART(3);
    if (IN(3)) {
        { pg8::Gemm g{(const pg8::bf16_t*)(ws + WS_QD), (const pg8::bf16_t*)(ws + WS_WQ), MPAD, 1536, 512};
          pg8::StaticOrder S; S.init(MPAD, 1536, G, bid);
          EpiHeads<0> E{(bf16*)(ws + WS_QP), 1536, 6, (bf16*)(ws + WS_QP), 1536, (float*)(ws + WS_SQR), args.in[I_QNN], (LAS float*)(lds + EPI_S_OFF)};
          pg8::gemm_phase<EpiHeads<0>, pg8::StaticOrder, true, true>(lds, g, S, E); }
        { pg8::Gemm g{(const pg8::bf16_t*)(ws + WS_C), (const pg8::bf16_t*)(ws + WS_WKV), MPAD, 2048, 512};
          pg8::StaticOrder S; S.init(MPAD, 2048, G, G - 1 - bid);
          EpiHeads<1> E{(bf16*)(ws + WS_KN), 1024, 4, (bf16*)(ws + WS_V), 1024, (float*)(ws + WS_SQR), args.in[I_KNN], (LAS float*)(lds + EPI_S_OFF)};
          pg8::gemm_phase<EpiHeads<1>, pg8::StaticOrder, true, true>(lds, g, S, E); }
        PSTART(31);
        for (int u = bid; u < 2048; u += G) gdn_a_unit(args, lds, u, tid, lane, wave);
        PEND(31); PSTART(32);
        for (int u = bid; u < 256; u += G) gdn_r_unit(args, lds, u, tid, lane, wave);
        PEND(32);
    }
    SEAM(3);
    PEND(3);
    PSTART(5);
    if (IN(5)) {
        unsigned* qctr = (unsigned*)(ws + WS_CTL) + 64;
#define PULL(k) ({ __syncthreads(); if (tid == 0) MISC[0] = atomicAdd(qctr + 64 * (k), 1u); __syncthreads(); (int)MISC[0]; })
        PSTART(50);
        for (int it = PULL(0); it < 64; it = PULL(0)) gdn_b_unit(args, lds, it, tid, lane, wave);
        PEND(50); PSTART(51);
        for (int u = PULL(1); u < 256; u = PULL(1)) {
            const int bh = u >> 2, pr = u & 3, b = bh >> 3, h = bh & 7;
#pragma unroll 1
            for (int s2 = 0; s2 < 2; ++s2) { const int qb = s2 ? pr : 7 - pr;
                att::attn_block((const bf16*)(ws + WS_QP) + (size_t)(b * SEQ + 256 * qb) * 1536 + h * 128, (const bf16*)(ws + WS_QP) + (size_t)(b * SEQ + 256 * qb) * 1536 + 1024 + h * 64,
                                (const float*)(ws + WS_SQN) + (size_t)(b * SEQ + 256 * qb) * 8 + h, (const float*)(ws + WS_SQR) + (size_t)(b * SEQ + 256 * qb) * 8 + h,
                                (const bf16*)(ws + WS_KN) + (size_t)(b * SEQ) * 1024 + h * 128, (const float*)(ws + WS_SKN) + (size_t)(b * SEQ) * 8 + h,
                                (const bf16*)(ws + WS_KR) + (size_t)(b * SEQ) * 64, (const bf16*)(ws + WS_V) + (size_t)(b * SEQ) * 1024 + h * 128,
                                args.in[I_QNN], args.in[I_QNR], args.in[I_KNN],
                                (bf16*)(ws + WS_YB) + (size_t)(b * SEQ + 256 * qb) * 1024 + h * 128, 256 * qb, lds); }
        }
        PEND(51); PSTART(52);
        dec_run(args, lds, MISC, qctr + 128, tid, lane, wave);
        PEND(52); PSTART(53);
#undef PULL
    }
    SEAM(5);
    PEND(5); PEND(53);
    PSTART(6);
    if (IN(6)) { for (int u = bid; u < 256; u += G) dec_combine(args, lds, u, tid, lane, wave); }
    SEAM(6);
    PEND(6);
    PSTART(7);
    if (IN(7)) {
        for (int t = bid; t < 32; t += G) skinny_tile<0>(args, lds, t, tid, lane, wave);
        pg8::StaticOrder S; S.init(MP, 1024, G, bid);
        { pg8::Gemm g{(const pg8::bf16_t*)(ws + WS_YA), (const pg8::bf16_t*)(ws + WS_WYA), MP, 1024, 1024};
          EpiMerge<1> E{(const bf16*)(ws + WS_GATES), (float*)(ws + WS_TF), (bf16*)(ws + WS_T)};
          pg8::gemm_phase<EpiMerge<1>, pg8::StaticOrder, true, true>(lds, g, S, E); }
        { pg8::Gemm g{(const pg8::bf16_t*)(ws + WS_YB), (const pg8::bf16_t*)(ws + WS_WYB), MP, 1024, 1024};
          EpiMerge<2> E{(const bf16*)(ws + WS_GATES), (float*)(ws + WS_TF), (bf16*)(ws + WS_T)};
          pg8::gemm_phase<EpiMerge<2>, pg8::StaticOrder, true, true>(lds, g, S, E); }
    }
    SEAM(7);
    PEND(7);
    PSTART(8);
    if (IN(8)) {
        for (int t = bid; t < 32; t += G) skinny_tile<1>(args, lds, t, tid, lane, wave);
        pg8::Gemm g{(const pg8::bf16_t*)(ws + WS_T), (const pg8::bf16_t*)(ws + WS_WO), MP, 1024, 1024};
        pg8::StaticOrder S; S.init(MP, 1024, G, bid);
        EpiRes<0> E{args.in[I_XP], args.in[I_XS], (float*)(ws + WS_X1), args.out, (bf16*)(ws + WS_XN2), (float*)(ws + WS_RX), lds};
        pg8::gemm_phase<EpiRes<0>, pg8::StaticOrder, true, true>(lds, g, S, E);
    }
    SEAM(8);
    PEND(8);
    PSTART(10);
    if (IN(10)) {
        for (int t = bid; t < 128; t += G) skinny_tile<2>(args, lds, t, tid, lane, wave);
        pg8::Gemm g{(const pg8::bf16_t*)(ws + WS_XN2), (const pg8::bf16_t*)(ws + WS_WUP), MP, 4096, 1024};
        pg8::StaticOrder S; S.init(MP, 4096, G, bid);
        EpiUp E{(bf16*)(ws + WS_H), (const float*)(ws + WS_RX)};
        pg8::gemm_phase<EpiUp, pg8::StaticOrder, true, true>(lds, g, S, E);
    }
    SEAM(10);
    PEND(10);
    PSTART(11);
    if (IN(11)) {
        for (int t = bid; t < 32; t += G) skinny_tile<3>(args, lds, t, tid, lane, wave);
        pg8::Gemm g{(const pg8::bf16_t*)(ws + WS_H), (const pg8::bf16_t*)(ws + WS_WDN), MP, 1024, 4096};
        pg8::StaticOrder S; S.init(MP, 1024, G, bid);
        EpiRes<1> E{args.in[I_XP], args.in[I_XS], (float*)(ws + WS_X1), args.out, (bf16*)(ws + WS_XN2), (float*)(ws + WS_RX), lds};
        pg8::gemm_phase<EpiRes<1>, pg8::StaticOrder, true, true>(lds, g, S, E);
    }
    PEND(11);
#ifdef PROBE_K
    if (PROBE_K >= 80 && PROBE_K < 90) { __syncthreads(); pdt = MISC[16]; }
    if (bid == PROBE_B || (PROBE_K >= 80 && PROBE_K < 90)) { const unsigned long long te = __builtin_amdgcn_s_memrealtime(); while (__builtin_amdgcn_s_memrealtime() - te < (unsigned long long)PROBE_MULT * pdt) __builtin_amdgcn_s_sleep(8); }
#endif
#undef IN
#undef SEAM
}

extern "C" void kernel_launch(void* const* d_in, const int* in_sizes, int n_in, void* d_out, int out_size, void* d_ws, size_t ws_size, hipStream_t stream) {
    static int grid = 0;
    if (grid == 0) {
        if (n_in != 27 || ws_size < WS_END) { fprintf(stderr, "kernel_launch: unexpected n_in %d or ws_size %zu (need %zu)\n", n_in, ws_size, (size_t)WS_END); grid = -1; return; }
        int dev = 0, cus = 0, per_cu = 0;
        if (hipGetDevice(&dev) != hipSuccess || hipDeviceGetAttribute(&cus, hipDeviceAttributeMultiprocessorCount, dev) != hipSuccess) { grid = -1; return; }
        if (hipFuncSetAttribute((const void*)mk_fwd, hipFuncAttributeMaxDynamicSharedMemorySize, LDS_BYTES) != hipSuccess) { fprintf(stderr, "kernel_launch: hipFuncSetAttribute failed\n"); grid = -1; return; }
        if (hipOccupancyMaxActiveBlocksPerMultiprocessor(&per_cu, (const void*)mk_fwd, 512, LDS_BYTES) != hipSuccess || per_cu < 1) fprintf(stderr, "kernel_launch: occupancy query says %d\n", per_cu);
        (void)hipGetLastError();
        grid = cus;
    }
    if (grid < 0) return;
    (void)hipMemsetAsync((char*)d_ws + WS_CTL, 0, CTL_BYTES, stream);
    Args a{};
    for (int i = 0; i < 27; ++i) a.in[i] = (const float*)d_in[i];
    a.out = (float*)d_out; a.ws = (unsigned char*)d_ws;
#if MK_SINGLE
    a.ph_lo = 0; a.ph_hi = N_PHASES;
    hipLaunchKernelGGL(mk_fwd, dim3(grid), dim3(512), LDS_BYTES, stream, a);
#else
    for (int p = 0; p < N_PHASES; ++p) { a.ph_lo = p; a.ph_hi = p + 1; hipLaunchKernelGGL(mk_fwd, dim3(grid), dim3(512), LDS_BYTES, stream, a); }
#endif
    const hipError_t le = hipPeekAtLastError();
    if (le != hipSuccess) fprintf(stderr, "kernel_launch: launch failed: %s\n", hipGetErrorName(le));
}
```

```cpp
#include <hip/hip_runtime.h>
#include <cstdio>
#include <cstdint>
namespace pg8 {
#define PG8_LAS __attribute__((address_space(3)))
typedef unsigned short bf16_t;
typedef short bf16x8 __attribute__((ext_vector_type(8)));
typedef float f32x4 __attribute__((ext_vector_type(4)));
typedef unsigned u32x4 __attribute__((ext_vector_type(4)));
constexpr int BM = 256, BK = 64, HALF = 128, HTB = HALF * BK * 2  , STAGE_BYTES = 8 * HTB, NXCD = 8, WGM = 8;

__host__ __device__ __forceinline__ int lds_byte(int r, int c) { const int st = (r >> 4) * 2 + (c >> 5), rr = r & 15, cc = c & 31, ob = rr * 64 + cc * 2; return st * 1024 + (ob ^ (((ob >> 9) & 1) << 5)); }
__host__ __device__ __forceinline__ void stage_rc(int b, int& R, int& C) { const int st = b / 1024, sb = b % 1024, swz = sb ^ (((sb >> 9) & 1) << 5); R = (st >> 1) * 16 + swz / 64; C = (st & 1) * 32 + (swz % 64) / 2; }
__host__ __device__ __forceinline__ int perm32(int rho) { const int n = rho >> 4, i = rho & 15; return 8 * (i >> 2) + 4 * n + (i & 3); }

struct Unit { int pm, pn; };
struct Gemm { const bf16_t* A; const bf16_t* Bt; int M, N, K; };

struct StaticOrder {
    int nM, nN, nwg, G, c;
    __host__ __device__ void init(int M, int N, int G_, int c_) { nM = M / BM; nN = N / BM; nwg = nM * nN; G = G_; c = c_; }
    __host__ __device__ bool next(int i, Unit& u) const {
        const long L = (long)i * G + c; if (L >= nwg) return false;
        int wgid = (int)L; { const int q = nwg / NXCD, r = nwg % NXCD, xcd = wgid % NXCD, off = wgid / NXCD; wgid = (xcd < r ? xcd * (q + 1) : r * (q + 1) + (xcd - r) * q) + off; }
        const int nig = WGM * nN, gid = wgid / nig, fm = gid * WGM, gsz = (nM - fm) < WGM ? (nM - fm) : WGM;
        u.pm = fm + ((wgid % nig) % gsz); u.pn = (wgid % nig) / gsz; return true;
    }
    __device__ __forceinline__ void a_ready(const Unit&) const {}
    __device__ __forceinline__ void done(const Unit&) const {}
};

__device__ __forceinline__ unsigned cvt_pk_bf16(float lo, float hi) { unsigned r; asm volatile("v_cvt_pk_bf16_f32 %0, %1, %2" : "=v"(r) : "v"(lo), "v"(hi)); return r; }
template <class Epi, class Sched, bool ALIGN_EPI = false, bool SP2 = false>
__device__ __forceinline__ void gemm_phase(PG8_LAS unsigned char* lds, const Gemm g, const Sched& S, const Epi& E) {
    const int tid = threadIdx.x, wid = __builtin_amdgcn_readfirstlane(tid >> 6), lane = tid & 63, wr = wid >> 2, wc = wid & 3, fr = lane & 15, fq = lane >> 4;
    const int K = g.K, nt = K / BK;
    unsigned voffA[2], voffB[2];
#pragma unroll
    for (int i = 0; i < 2; ++i) { int R, C; stage_rc(tid * 16 + i * 8192, R, C); const int Rb = Epi::PERM ? ((R & ~31) + perm32(R & 31)) : R;
        voffA[i] = (unsigned)(R * K + C) * 2u; voffB[i] = (unsigned)(Rb * K + C) * 2u; }
    const size_t kstep = (size_t)(BK * 2);
    const size_t hstep = (size_t)HALF * K * 2;
    const size_t tstep = 2 * hstep;
    const unsigned ldsw = (unsigned)wid * 1024u;
    const int aoff = lds_byte(wr * 64 + fr, fq * 8), boff = lds_byte(wc * 32 + fr, fq * 8);
#define PG8_SA(b, h) (((b) * 2 + (h)) * HTB)
#define PG8_SB(b, h) ((4 + (b) * 2 + (h)) * HTB)
#define PG8_STAGE(bufoff, gbase, voff) do { _Pragma("unroll") for (int _i = 0; _i < 2; ++_i) \
        __builtin_amdgcn_global_load_lds((const unsigned*)((const char*)(gbase) + (voff)[_i]), (PG8_LAS unsigned*)(lds + (bufoff) + ldsw + _i * 8192), 16, 0, 0); } while (0)
#define PG8_LDA(dst, b, h) do { _Pragma("unroll") for (int m = 0; m < 4; ++m) _Pragma("unroll") for (int k = 0; k < 2; ++k) dst[m][k] = *(const PG8_LAS bf16x8*)(lds + PG8_SA(b, h) + aoff + m * 2048 + k * 1024); } while (0)
#define PG8_LDB(dst, b, h) do { _Pragma("unroll") for (int n = 0; n < 2; ++n) _Pragma("unroll") for (int k = 0; k < 2; ++k) dst[n][k] = *(const PG8_LAS bf16x8*)(lds + PG8_SB(b, h) + boff + n * 2048 + k * 1024); } while (0)
#define PG8_MMA(ai, bj, At, Bt) do { __builtin_amdgcn_s_setprio(1); _Pragma("unroll") for (int m = 0; m < 4; ++m) _Pragma("unroll") for (int n = 0; n < 2; ++n) _Pragma("unroll") for (int k = 0; k < 2; ++k) \
        acc[ai][bj][m][n] = __builtin_amdgcn_mfma_f32_16x16x32_bf16(Bt[n][k], At[m][k], acc[ai][bj][m][n], 0, 0, 0); __builtin_amdgcn_s_setprio(0); } while (0)
#define PG8_WAIT_V(n) asm volatile("s_waitcnt vmcnt(" #n ")" ::: "memory")
#define PG8_WAIT_L(n) asm volatile("s_waitcnt lgkmcnt(" #n ")" ::: "memory")
#define PG8_BAR __builtin_amdgcn_s_barrier()
#define PG8_SCHED __builtin_amdgcn_sched_barrier(0)
    Unit cur, nxt; int ui = 0;
    if (!S.next(0, cur)) return;
    f32x4 acc[2][2][4][2];
#pragma unroll
    for (int a = 0; a < 2; ++a)
#pragma unroll
        for (int b = 0; b < 2; ++b)
#pragma unroll
            for (int m = 0; m < 4; ++m)
#pragma unroll
                for (int n = 0; n < 2; ++n) acc[a][b][m][n] = (f32x4){0.f, 0.f, 0.f, 0.f};
    bf16x8 At[4][2], B0[2][2], B1[2][2];
    const char* cA = (const char*)g.A + (size_t)cur.pm * tstep; const char* cB = (const char*)g.Bt + (size_t)cur.pn * tstep;
    S.a_ready(cur);
    if constexpr (SP2) {
        PG8_STAGE(PG8_SB(0, 0), cB, voffB); PG8_STAGE(PG8_SB(0, 1), cB + hstep, voffB); PG8_STAGE(PG8_SA(0, 0), cA, voffA); PG8_STAGE(PG8_SA(0, 1), cA + hstep, voffA);
        if (wr == 1) PG8_BAR;
        PG8_WAIT_V(2); PG8_BAR;
        PG8_STAGE(PG8_SB(1, 0), cB + kstep, voffB); PG8_STAGE(PG8_SA(1, 0), cA + kstep, voffA); PG8_STAGE(PG8_SB(1, 1), cB + hstep + kstep, voffB);
        PG8_WAIT_V(6); PG8_BAR;
    } else {
        PG8_STAGE(PG8_SB(0, 0), cB, voffB); PG8_STAGE(PG8_SA(0, 0), cA, voffA); PG8_STAGE(PG8_SB(0, 1), cB + hstep, voffB); PG8_STAGE(PG8_SA(0, 1), cA + hstep, voffA);
        if (wr == 1) PG8_BAR;
        PG8_WAIT_V(4); PG8_BAR;
        PG8_STAGE(PG8_SB(1, 0), cB + kstep, voffB); PG8_STAGE(PG8_SA(1, 0), cA + kstep, voffA); PG8_STAGE(PG8_SB(1, 1), cB + hstep + kstep, voffB);
        PG8_WAIT_V(6); PG8_BAR;
    }
    for (;;) {
        const bool has_next = S.next(ui + 1, nxt);
        const char* nA = has_next ? (const char*)g.A + (size_t)nxt.pm * tstep : cA; const char* nB = has_next ? (const char*)g.Bt + (size_t)nxt.pn * tstep : cB;
        for (int t = 0; t < nt; t += 2) {
            const bool last = (t == nt - 2);
            const char* a1 = cA + (size_t)(t + 1) * kstep;
            const char* a2 = last ? nA : cA + (size_t)(t + 2) * kstep; const char* b2 = last ? nB : cB + (size_t)(t + 2) * kstep;
            const char* a3 = a2 + kstep; const char* b3 = b2 + kstep;
            if (last && has_next) S.a_ready(nxt);
            if constexpr (SP2) {
            PG8_LDB(B0, 0, 0); PG8_LDB(B1, 0, 1); PG8_SCHED; PG8_LDA(At, 0, 0); PG8_STAGE(PG8_SA(1, 1), a1 + hstep, voffA);
            PG8_WAIT_V(8); PG8_WAIT_L(0); PG8_BAR; PG8_MMA(0, 0, At, B0); PG8_MMA(0, 1, At, B1); PG8_BAR; PG8_SCHED;
            PG8_LDA(At, 0, 1); PG8_STAGE(PG8_SB(0, 0), b2, voffB); PG8_STAGE(PG8_SB(0, 1), b2 + hstep, voffB); PG8_STAGE(PG8_SA(0, 0), a2, voffA);
            PG8_WAIT_V(8); PG8_WAIT_L(0); PG8_BAR; PG8_MMA(1, 0, At, B0); PG8_MMA(1, 1, At, B1); PG8_BAR; PG8_SCHED;
            PG8_LDB(B0, 1, 0); PG8_LDB(B1, 1, 1); PG8_SCHED; PG8_LDA(At, 1, 0); PG8_STAGE(PG8_SA(0, 1), a2 + hstep, voffA);
            PG8_WAIT_V(8); PG8_WAIT_L(0); PG8_BAR; PG8_MMA(0, 0, At, B0); PG8_MMA(0, 1, At, B1); PG8_BAR; PG8_SCHED;
            PG8_LDA(At, 1, 1); PG8_STAGE(PG8_SB(1, 0), b3, voffB); PG8_STAGE(PG8_SB(1, 1), b3 + hstep, voffB); PG8_STAGE(PG8_SA(1, 0), a3, voffA);
            PG8_WAIT_V(8); PG8_WAIT_L(0); PG8_BAR; PG8_MMA(1, 0, At, B0); PG8_MMA(1, 1, At, B1); PG8_BAR; PG8_SCHED;
            } else {
            PG8_LDB(B0, 0, 0); PG8_SCHED; PG8_LDA(At, 0, 0); PG8_STAGE(PG8_SA(1, 1), a1 + hstep, voffA);
            PG8_WAIT_L(8); PG8_BAR; PG8_WAIT_L(0); PG8_MMA(0, 0, At, B0); PG8_BAR; PG8_SCHED;
            PG8_LDB(B1, 0, 1); PG8_STAGE(PG8_SB(0, 0), b2, voffB);
            PG8_BAR; PG8_WAIT_L(0); PG8_MMA(0, 1, At, B1); PG8_BAR;
            PG8_LDA(At, 0, 1); PG8_STAGE(PG8_SA(0, 0), a2, voffA);
            PG8_BAR; PG8_WAIT_L(0); PG8_MMA(1, 0, At, B0); PG8_BAR; PG8_SCHED;
            PG8_STAGE(PG8_SB(0, 1), b2 + hstep, voffB);
            PG8_WAIT_V(6); PG8_BAR; PG8_MMA(1, 1, At, B1); PG8_BAR;
            PG8_LDB(B0, 1, 0); PG8_SCHED; PG8_LDA(At, 1, 0); PG8_STAGE(PG8_SA(0, 1), a2 + hstep, voffA);
            PG8_WAIT_L(8); PG8_BAR; PG8_WAIT_L(0); PG8_MMA(0, 0, At, B0); PG8_BAR; PG8_SCHED;
            PG8_LDB(B1, 1, 1); PG8_STAGE(PG8_SB(1, 0), b3, voffB);
            PG8_BAR; PG8_WAIT_L(0); PG8_MMA(0, 1, At, B1); PG8_BAR;
            PG8_LDA(At, 1, 1); PG8_STAGE(PG8_SA(1, 0), a3, voffA);
            PG8_BAR; PG8_WAIT_L(0); PG8_MMA(1, 0, At, B0); PG8_BAR; PG8_SCHED;
            PG8_STAGE(PG8_SB(1, 1), b3 + hstep, voffB);
            PG8_WAIT_V(6); PG8_BAR; PG8_MMA(1, 1, At, B1); PG8_BAR;
            }
        }
        if constexpr (ALIGN_EPI) { if (wr == 0) PG8_BAR; }
        if constexpr (!Epi::AFTER_DRAIN) { E(acc, cur, wr, wc, fr, fq); S.done(cur); }
        if (!has_next) break;
#pragma unroll
        for (int a = 0; a < 2; ++a)
#pragma unroll
            for (int b = 0; b < 2; ++b)
#pragma unroll
                for (int m = 0; m < 4; ++m)
#pragma unroll
                    for (int n = 0; n < 2; ++n) acc[a][b][m][n] = (f32x4){0.f, 0.f, 0.f, 0.f};
        cur = nxt; cA = nA; cB = nB; ++ui;
        if constexpr (ALIGN_EPI) { if (wr == 1) PG8_BAR; }
    }
    PG8_WAIT_V(0);
    if constexpr (!ALIGN_EPI) { if (wr == 0) PG8_BAR; }
    PG8_BAR;
    if constexpr (Epi::AFTER_DRAIN) { E.fused(acc, cur, wr, wc, fr, fq, lds, wid, lane); S.done(cur); }
#undef PG8_SA
#undef PG8_SB
#undef PG8_STAGE
#undef PG8_LDA
#undef PG8_LDB
#undef PG8_MMA
#undef PG8_WAIT_V
#undef PG8_WAIT_L
#undef PG8_BAR
#undef PG8_SCHED
}
}
#define XB_TMO      128
#define XB_XCNT(j)  (256  + 64 * (j))
#define XB_XSUB(j)  (1280 + 64 * (j))
#define XB_XGEN(j)  (2304 + 64 * (j))
#define XB_TOP      3328
#define XB_TOPGEN   3392
#define XCD_BAR_WORDS 3456
#define XB_SPIN_CAP (1u << 18)
#define LAS __attribute__((address_space(3)))

__device__ __forceinline__ unsigned xb_ld(unsigned* p)              { return __hip_atomic_load(p, __ATOMIC_RELAXED, __HIP_MEMORY_SCOPE_AGENT); }
__device__ __forceinline__ unsigned xb_add(unsigned* p, unsigned v) { return __hip_atomic_fetch_add(p, v, __ATOMIC_RELAXED, __HIP_MEMORY_SCOPE_AGENT); }
__device__ __forceinline__ unsigned xb_xcc_id() { return (unsigned)__builtin_amdgcn_s_getreg((3 << 11) | 20) & 0xFu; }
#define XB_SPIN(cond, bar) do { unsigned _sp = 0; while (cond) { __builtin_amdgcn_s_sleep(1); \
    if ((++_sp & 255u) == 0u) { if (xb_ld(&(bar)[XB_TMO])) break; if (_sp > XB_SPIN_CAP) { atomicAdd(&(bar)[XB_TMO], 1u); break; } } } } while (0)

struct XcdBarrier {
    unsigned* bar; unsigned x;
    volatile LAS unsigned* st;
};

__device__ __forceinline__ XcdBarrier xcd_barrier_post(unsigned* bar, volatile LAS unsigned* st) {
    XcdBarrier b; b.bar = bar; b.x = xb_xcc_id(); b.st = st;
    if (threadIdx.x == 0) (void)xb_add(&bar[XB_XCNT(b.x)], 1u);
    return b;
}
__device__ __forceinline__ void xcd_barrier_complete(unsigned* bar, unsigned x, unsigned& nloc, unsigned& nx) {
    const unsigned G = gridDim.x * gridDim.y * gridDim.z;
    unsigned sum, cnt, mine, sp = 0u;
    for (;;) {
        sum = 0u; cnt = 0u; mine = 0u;
#pragma unroll
        for (unsigned j = 0; j < 16; ++j) { const unsigned c = xb_ld(&bar[XB_XCNT(j)]); sum += c; cnt += (c > 0u) ? 1u : 0u; mine = (j == x) ? c : mine; }
        if (sum == G) break;
        __builtin_amdgcn_s_sleep(1);
        if ((++sp & 255u) == 0u) { if (xb_ld(&bar[XB_TMO])) break; if (sp > XB_SPIN_CAP) { atomicAdd(&bar[XB_TMO], 1u); break; } }
    }
    nloc = mine > 0u ? mine : 1u; nx = cnt > 0u ? cnt : 1u;
}

__device__ __forceinline__ void xcd_barrier(const XcdBarrier& b) {
    asm volatile("s_waitcnt vmcnt(0)" ::: "memory");
    __syncthreads();
    if (threadIdx.x == 0) {
        unsigned* bar = b.bar;
        __builtin_amdgcn_s_waitcnt(0);
        unsigned nloc = b.st[0], nx = b.st[1];
        if (nloc == 0u) { xcd_barrier_complete(bar, b.x, nloc, nx); b.st[0] = nloc; b.st[1] = nx; }
        const unsigned old = xb_add(&bar[XB_XSUB(b.x)], 1u);
        const unsigned gen = old / nloc;
        if (old + 1u == (gen + 1u) * nloc) {
            __builtin_amdgcn_fence(__ATOMIC_RELEASE, "agent");
            asm volatile("s_waitcnt vmcnt(0)" ::: "memory");
            const unsigned og = xb_add(&bar[XB_TOP], 1u);
            const unsigned tg = og / nx;
            if (og + 1u == (tg + 1u) * nx) xb_add(&bar[XB_TOPGEN], 1u);
            else XB_SPIN(xb_ld(&bar[XB_TOPGEN]) == tg, bar);
            __builtin_amdgcn_fence(__ATOMIC_ACQUIRE, "agent");
            xb_add(&bar[XB_XGEN(b.x)], 1u);
            asm volatile("s_waitcnt vmcnt(0)" ::: "memory");
        } else {
            XB_SPIN(xb_ld(&bar[XB_XGEN(b.x)]) == gen, bar);
            __builtin_amdgcn_fence(__ATOMIC_ACQUIRE, "agent");
            asm volatile("s_waitcnt vmcnt(0)" ::: "memory");
        }
    }
    __syncthreads();
}
constexpr int MP = 16384, MS = 32, MR = MP + MS, MPAD = 16640;
constexpr int SEQ = 2048, NB = 8, NH = 8, DM = 1024;
constexpr int QKVW = 3072, NIN = 7424;
constexpr int PAST = 16384, NPAGE = 128, PAGE = 128, LATW = 576;
constexpr float EPS = 1e-6f;
constexpr float MLA_SCALE = 0.07216878364870322f;

constexpr size_t O_YP = 0, O_YS = O_YP + (size_t)MP * 1024, O_ROWSP = O_YS + 32 * 1024, O_GSP = O_ROWSP + (size_t)MP * 576,
                 O_CSP = O_GSP + 8 * 8 * 128 * 128, O_ROWSS = O_CSP + 8 * 3 * 3072, O_GSS = O_ROWSS + 32 * 576, O_CSS = O_GSS + (size_t)32 * 8 * 128 * 128;

constexpr size_t WS_CTL = 0, CTL_BYTES = 3u << 20;
constexpr size_t WS_WIN = CTL_BYTES;
constexpr size_t WS_WQ  = WS_WIN + (size_t)NIN * 1024 * 2;
constexpr size_t WS_WKV = WS_WQ + (size_t)1536 * 512 * 2;
constexpr size_t WS_WYA = WS_WKV + (size_t)2048 * 512 * 2;
constexpr size_t WS_WYB = WS_WYA + (size_t)1024 * 1024 * 2;
constexpr size_t WS_WO  = WS_WYB + (size_t)1024 * 1024 * 2;
constexpr size_t WS_WUP = WS_WO + (size_t)1024 * 1024 * 2;
constexpr size_t WS_WDN = WS_WUP + (size_t)4096 * 1024 * 2;
constexpr size_t WS_XN  = WS_WDN + (size_t)4096 * 1024 * 2;
constexpr size_t WS_QKV = WS_XN + (size_t)MPAD * 1024 * 2;
constexpr size_t WS_Z   = WS_QKV + (size_t)MPAD * 3072 * 2;
constexpr size_t WS_QD  = WS_Z + (size_t)MPAD * 1024 * 2;
constexpr size_t WS_KVD = WS_QD + (size_t)MPAD * 512 * 2;
constexpr size_t WS_SM  = WS_KVD + (size_t)MPAD * 512 * 2;
constexpr size_t WS_GATES = WS_SM + (size_t)MPAD * 128 * 4;
constexpr size_t WS_C   = WS_GATES + (size_t)MPAD * 2048 * 2;
constexpr size_t WS_KR  = WS_C + (size_t)MPAD * 512 * 2;
constexpr size_t WS_BETA = WS_KR + (size_t)MPAD * 64 * 2;
constexpr size_t WS_GLOG = WS_BETA + (size_t)MPAD * 8 * 4;
constexpr size_t WS_QP  = WS_GLOG + (size_t)MPAD * 8 * 4;
constexpr size_t WS_QP2 = WS_QP + (size_t)MPAD * 1536 * 2;
constexpr size_t WS_KN  = WS_QP2 + (size_t)MPAD * 1536 * 2;
constexpr size_t WS_V   = WS_KN + (size_t)MPAD * 1024 * 2;
constexpr size_t WS_YA  = WS_V + (size_t)MPAD * 1024 * 2;
constexpr size_t WS_YB  = WS_YA + (size_t)MPAD * 1024 * 2;
constexpr size_t WS_TF  = WS_YB + (size_t)MPAD * 1024 * 2;
constexpr size_t WS_T   = WS_TF + (size_t)MPAD * 1024 * 4;
constexpr size_t WS_X1  = WS_T + (size_t)MPAD * 1024 * 2;
constexpr size_t WS_XN2 = WS_X1 + (size_t)MPAD * 1024 * 4;
constexpr size_t WS_RX = WS_CTL + (256u << 10);
constexpr size_t WS_SQN = WS_CTL + (512u << 10);
constexpr size_t WS_SQR = WS_CTL + (1280u << 10);
constexpr size_t WS_SKN = WS_CTL + (2048u << 10);
constexpr size_t WS_H   = WS_XN2 + (size_t)MPAD * 1024 * 2;
constexpr size_t WS_GU0 = WS_H + (size_t)MPAD * 4096 * 2;
constexpr size_t WS_GW  = WS_GU0 + (size_t)2048 * 64 * 128 * 4;
constexpr size_t WS_GQG = WS_GW + (size_t)2048 * 64 * 128 * 2;
constexpr size_t WS_GKD = WS_GQG + (size_t)2048 * 64 * 128 * 2;
constexpr size_t WS_GAQK = WS_GKD + (size_t)2048 * 64 * 128 * 2;
constexpr size_t WS_GEND = WS_GAQK + (size_t)2048 * 64 * 64 * 2;
constexpr size_t WS_DML = WS_GEND + (size_t)2048 * 4 * 64;
constexpr size_t WS_DACC = WS_DML + (size_t)4096 * 8 * 2 * 4;
constexpr size_t WS_WKT = WS_DACC + (size_t)4096 * 8 * 512 * 4;
constexpr size_t WS_END = WS_WKT + (size_t)1024 * 512 * 2;

constexpr int LDS_BYTES = 163840;
constexpr int MISC_OFF = LDS_BYTES - 128;

#define GAS __attribute__((address_space(1)))
typedef unsigned short bf16;
typedef unsigned v4u __attribute__((ext_vector_type(4)));
typedef unsigned v2u __attribute__((ext_vector_type(2)));
typedef float f32x4 __attribute__((ext_vector_type(4)));
typedef float f32x16 __attribute__((ext_vector_type(16)));
typedef short bf16x8 __attribute__((ext_vector_type(8)));
#define LDS_WAIT() asm volatile("s_waitcnt lgkmcnt(0)" ::: "memory")
#define VM_WAIT() asm volatile("s_waitcnt vmcnt(0)" ::: "memory")
#define LBAR() asm volatile("s_waitcnt lgkmcnt(0)\n\ts_barrier" ::: "memory")
__device__ __forceinline__ float bf2f(unsigned b) { return __builtin_bit_cast(float, b << 16); }
typedef float f32x2_t __attribute__((ext_vector_type(2)));
typedef __bf16 bf16x2_t __attribute__((ext_vector_type(2)));
__device__ __forceinline__ unsigned pk2(float lo, float hi) { const f32x2_t v = {lo, hi}; const bf16x2_t b = __builtin_convertvector(v, bf16x2_t); return __builtin_bit_cast(unsigned, b); }
__device__ __forceinline__ unsigned f2bf(float f) { return pk2(f, 0.f) & 0xffffu; }
__device__ __forceinline__ unsigned f8pack(float a, float b, float c, float d) { int r = __builtin_amdgcn_cvt_pk_fp8_f32(a, b, 0, false); r = __builtin_amdgcn_cvt_pk_fp8_f32(c, d, r, true); return (unsigned)r; }
__device__ __forceinline__ float lo16(unsigned w) { return __builtin_bit_cast(float, w << 16); }
__device__ __forceinline__ float hi16(unsigned w) { return __builtin_bit_cast(float, w & 0xffff0000u); }
__device__ __forceinline__ float wave_sum(float v) {
#pragma unroll
    for (int o = 1; o < 64; o <<= 1) v += __shfl_xor(v, o);
    return v;
}
__device__ __forceinline__ float wave_max(float v) {
#pragma unroll
    for (int o = 1; o < 64; o <<= 1) v = fmaxf(v, __shfl_xor(v, o));
    return v;
}
__device__ __forceinline__ float sigmoidf_(float x) { return __builtin_amdgcn_rcpf(1.f + __expf(-x)); }
__device__ __forceinline__ float siluf_(float x) { return x * __builtin_amdgcn_rcpf(1.f + __expf(-x)); }

__constant__ float ROPE_INV[32] = {1.000000000e+00f,7.498942614e-01f,5.623413324e-01f,4.216965139e-01f,3.162277639e-01f,2.371373773e-01f,1.778279394e-01f,1.333521307e-01f,
    1.000000015e-01f,7.498941571e-02f,5.623413250e-02f,4.216965288e-02f,3.162277490e-02f,2.371373773e-02f,1.778279431e-02f,1.333521493e-02f,
    9.999999776e-03f,7.498941850e-03f,5.623413250e-03f,4.216964822e-03f,3.162277630e-03f,2.371373586e-03f,1.778279431e-03f,1.333521446e-03f,
    1.000000047e-03f,7.498942432e-04f,5.623413017e-04f,4.216965172e-04f,3.162277571e-04f,2.371373703e-04f,1.778279402e-04f,1.333521504e-04f};

struct Args { const float* in[27]; float* out; unsigned char* ws; int ph_lo, ph_hi; };
enum { I_XP = 0, I_XS, I_CACHE, I_SGDN, I_SCONV, I_PT, I_NMIX, I_WIN, I_CONVW, I_ALOG, I_DTB, I_GDNN, I_QAN, I_WUQ, I_KVAN, I_WUK, I_WUV,
       I_QNN, I_QNR, I_KNN, I_KNR, I_WYA, I_WYB, I_WO, I_NMLP, I_WUP, I_WDN };

__device__ __forceinline__ int src_col(int mode, int n) {
    if (mode == 0) {
        if (n < 4096) return n;
        if (n < 5184) return n + 16;
        if (n < 5200) return n - 5184 + 4096;
        if (n < 5376) return -1;
        return n - 5376 + 5200;
    }
    if (mode == 1) {
        if (n < 1024) return (n >> 7) * 192 + (n & 127);
        const int m = n - 1024; return (m >> 6) * 192 + 128 + (m & 63);
    }
    return n;
}
__device__ __forceinline__ void cvt_item(const float* W, int N, int K, bf16* WT, int row_off, int mode, LAS float* scr, int item, int nblk, int lane, const float* kscale = nullptr) {
    const int kb = item / nblk, nb = item % nblk, k0 = 64 * kb, n0 = 32 * nb;
    const int sc = src_col(mode, n0 + (lane & 31));
#pragma unroll
    for (int i = 0; i < 32; ++i) { const int kk = 2 * i + (lane >> 5); scr[kk * 33 + (lane & 31)] = sc >= 0 ? W[(size_t)(k0 + kk) * N + sc] * (kscale ? kscale[k0 + kk] : 1.f) : 0.f; }
    LDS_WAIT(); asm volatile("" ::: "memory");
    const int c = lane & 7;
#pragma unroll
    for (int j = 0; j < 4; ++j) { const int n = (lane >> 3) + 8 * j; const LAS float* s = scr + (8 * c) * 33 + n;
        v4u o; o.x = pk2(s[0 * 33], s[1 * 33]); o.y = pk2(s[2 * 33], s[3 * 33]); o.z = pk2(s[4 * 33], s[5 * 33]); o.w = pk2(s[6 * 33], s[7 * 33]);
        *(v4u*)(WT + (size_t)(row_off + n0 + n) * K + k0 + 8 * c) = o; }
    LDS_WAIT(); asm volatile("" ::: "memory");
}
__device__ __forceinline__ void rms_row_finish(const f32x4 (&v)[4], const float* gain, bf16* orow, int lane) {
    const f32x4* gr = (const f32x4*)gain + lane; float s = 0.f;
#pragma unroll
    for (int j = 0; j < 4; ++j) s += (v[j].x * v[j].x + v[j].y * v[j].y) + (v[j].z * v[j].z + v[j].w * v[j].w);
    const float r = 1.f / sqrtf(wave_sum(s) * (1.f / 1024.f) + EPS);
    unsigned long long* o8 = (unsigned long long*)orow + lane;
#pragma unroll
    for (int j = 0; j < 4; ++j) { const f32x4 g = gr[64 * j];
        o8[64 * j] = (unsigned long long)pk2(v[j].x * r * g.x, v[j].y * r * g.y) | ((unsigned long long)pk2(v[j].z * r * g.z, v[j].w * r * g.w) << 32); }
}
template <bool LATE> __device__ __forceinline__ void cvt_weights(const Args& A, LAS unsigned char* lds, int gw, int NGW, int wave, int lane) {
    LAS float* scr = (LAS float*)(lds + wave * 16384);
    unsigned char* ws = A.ws;
    constexpr int I0 = 16 * (NIN / 32), I1 = 8 * (1536 / 32), I2 = 8 * 32, I3 = 8 * 32, I4 = 16 * 32, I5 = I4, I6 = I4, I7 = 16 * 128, I8 = 64 * 32;
    if (!LATE) {
        for (int it = gw; it < I0 + I1 + I2 + I3; it += NGW) {
            int r = it;
            if (r < I0) { cvt_item(A.in[I_WIN], 7248, 1024, (bf16*)(ws + WS_WIN), 0, 0, scr, r, NIN / 32, lane); continue; } r -= I0;
            if (r < I1) { cvt_item(A.in[I_WUQ], 1536, 512, (bf16*)(ws + WS_WQ), 0, 1, scr, r, 1536 / 32, lane); continue; } r -= I1;
            if (r < I2) { cvt_item(A.in[I_WUK], 1024, 512, (bf16*)(ws + WS_WKV), 0, 2, scr, r, 32, lane); continue; } r -= I2;
            cvt_item(A.in[I_WUV], 1024, 512, (bf16*)(ws + WS_WKV), 1024, 2, scr, r, 32, lane);
        }
    } else {
        for (int it = gw; it < I4 + I5 + I6 + I7 + I8; it += NGW) {
            int r = it;
            if (r < I4) { cvt_item(A.in[I_WYA], 1024, 1024, (bf16*)(ws + WS_WYA), 0, 2, scr, r, 32, lane); continue; } r -= I4;
            if (r < I5) { cvt_item(A.in[I_WYB], 1024, 1024, (bf16*)(ws + WS_WYB), 0, 2, scr, r, 32, lane); continue; } r -= I5;
            if (r < I6) { cvt_item(A.in[I_WO], 1024, 1024, (bf16*)(ws + WS_WO), 0, 2, scr, r, 32, lane); continue; } r -= I6;
            if (r < I7) { cvt_item(A.in[I_WUP], 4096, 1024, (bf16*)(ws + WS_WUP), 0, 2, scr, r, 128, lane, A.in[I_NMLP]); continue; } r -= I7;
            cvt_item(A.in[I_WDN], 1024, 4096, (bf16*)(ws + WS_WDN), 0, 2, scr, r, 32, lane);
        }
    }
}
__device__ __forceinline__ void p0_prologue(const Args& A, LAS unsigned char* lds, int gw, int NGW, int wave, int lane) {
    unsigned char* ws = A.ws;
    cvt_weights<false>(A, lds, gw, NGW, wave, lane);
    bf16* XN = (bf16*)(ws + WS_XN);
#define XROW(m_) ((m_) < MP ? A.in[I_XP] + (size_t)(m_) * 1024 : A.in[I_XS] + (size_t)((m_) - MP) * 1024)
    f32x4 v[4], vn[4];
    if (gw < MR) {
#pragma unroll
        for (int j = 0; j < 4; ++j) v[j] = ((const f32x4*)XROW(gw) + lane)[64 * j]; }
    for (int m = gw; m < MPAD; m += NGW) {
        const int mn = m + NGW;
        if (mn < MR) {
#pragma unroll
            for (int j = 0; j < 4; ++j) vn[j] = ((const f32x4*)XROW(mn) + lane)[64 * j]; }
        if (m < MR) rms_row_finish(v, A.in[I_NMIX], XN + (size_t)m * 1024, lane);
        else { v4u z = {0u, 0u, 0u, 0u}; *((v4u*)(XN + (size_t)m * 1024) + lane) = z; *((v4u*)(XN + (size_t)m * 1024) + 64 + lane) = z; }
#pragma unroll
        for (int j = 0; j < 4; ++j) v[j] = vn[j];
    }
#undef XROW
}

struct EpiG1 {
    static constexpr bool PERM = true, AFTER_DRAIN = false;
    bf16 *QKV, *Z, *QD, *KVD, *GATES; float* SM;
    __device__ __forceinline__ void operator()(const pg8::f32x4 (&acc)[2][2][4][2], const pg8::Unit& u, int wr, int wc, int fr, int fq) const {
        const int row0 = u.pm * 256 + wr * 64 + fr, pn = u.pn, cl = wc * 32 + 8 * fq;
        if (pn == 20) {
#pragma unroll
            for (int ai = 0; ai < 2; ++ai)
#pragma unroll
                for (int m = 0; m < 4; ++m) { float* rowp = SM + (size_t)(row0 + ai * 128 + m * 16) * 128 + cl;
                    *(pg8::f32x4*)rowp = acc[ai][0][m][0]; *(pg8::f32x4*)(rowp + 4) = acc[ai][0][m][1]; }
            return;
        }
        bf16* base; int ld; bool sg = false;
        if (pn < 12) { base = QKV + pn * 256; ld = 3072; }
        else if (pn < 16) { base = Z + (pn - 12) * 256; ld = 1024; }
        else if (pn < 18) { base = QD + (pn - 16) * 256; ld = 512; }
        else if (pn < 20) { base = KVD + (pn - 18) * 256; ld = 512; }
        else { base = GATES + (pn - 21) * 256; ld = 2048; sg = true; }
#pragma unroll
        for (int ai = 0; ai < 2; ++ai)
#pragma unroll
            for (int m = 0; m < 4; ++m) { bf16* rowp = base + (size_t)(row0 + ai * 128 + m * 16) * ld + cl;
#pragma unroll
                for (int bj = 0; bj < 2; ++bj) { pg8::f32x4 v0 = acc[ai][bj][m][0], v1 = acc[ai][bj][m][1];
                    if (sg) { v0 = (pg8::f32x4){sigmoidf_(v0[0]), sigmoidf_(v0[1]), sigmoidf_(v0[2]), sigmoidf_(v0[3])}; v1 = (pg8::f32x4){sigmoidf_(v1[0]), sigmoidf_(v1[1]), sigmoidf_(v1[2]), sigmoidf_(v1[3])}; }
                    pg8::u32x4 w; w.x = pk2(v0[0], v0[1]); w.y = pk2(v0[2], v0[3]); w.z = pk2(v1[0], v1[1]); w.w = pk2(v1[2], v1[3]);
                    *(pg8::u32x4*)(rowp + bj * 128) = w; } }
    }
};

__device__ __forceinline__ void p2_rows(const Args& A, int gw, int NGW, int lane) {
    unsigned char* ws = A.ws;
    bf16* QD = (bf16*)(ws + WS_QD); const bf16* KVD = (const bf16*)(ws + WS_KVD); const float* SM = (const float*)(ws + WS_SM);
    bf16* C = (bf16*)(ws + WS_C); bf16* KR = (bf16*)(ws + WS_KR); float* BETA = (float*)(ws + WS_BETA); float* GLOG = (float*)(ws + WS_GLOG);
    v4u wq = {0u, 0u, 0u, 0u}, wk = wq, wqn = wq, wkn = wq; float xs = 0.f, xb = 0.f, xa = 0.f, xsn = 0.f, xbn = 0.f, xan = 0.f;
    if (gw < MR) { wq = *((const v4u*)(QD + (size_t)gw * 512) + lane); wk = *((const v4u*)(KVD + (size_t)gw * 512) + lane); xs = SM[(size_t)gw * 128 + lane];
        if (lane < 8) { xb = SM[(size_t)gw * 128 + 64 + lane]; xa = SM[(size_t)gw * 128 + 72 + lane]; } }
    for (int m = gw; m < MR; m += NGW) {
        const int mn = m + NGW;
        if (mn < MR) { wqn = *((const v4u*)(QD + (size_t)mn * 512) + lane); wkn = *((const v4u*)(KVD + (size_t)mn * 512) + lane); xsn = SM[(size_t)mn * 128 + lane];
            if (lane < 8) { xbn = SM[(size_t)mn * 128 + 64 + lane]; xan = SM[(size_t)mn * 128 + 72 + lane]; } }
        const int pos = m < MP ? (m & (SEQ - 1)) : PAST;
        float* lat = m < MP ? A.out + O_ROWSP + (size_t)m * LATW : A.out + O_ROWSS + (size_t)(m - MP) * LATW;
        {
            v4u w = wq;
            float v[8] = {lo16(w.x), hi16(w.x), lo16(w.y), hi16(w.y), lo16(w.z), hi16(w.z), lo16(w.w), hi16(w.w)};
            float s = 0.f;
#pragma unroll
            for (int i = 0; i < 8; ++i) s += v[i] * v[i];
            const float r = 1.f / sqrtf(wave_sum(s) * (1.f / 512.f) + EPS);
            const f32x4 g0 = *((const f32x4*)A.in[I_QAN] + 2 * lane), g1 = *((const f32x4*)A.in[I_QAN] + 2 * lane + 1);
            v4u o; o.x = pk2(v[0] * r * g0.x, v[1] * r * g0.y); o.y = pk2(v[2] * r * g0.z, v[3] * r * g0.w); o.z = pk2(v[4] * r * g1.x, v[5] * r * g1.y); o.w = pk2(v[6] * r * g1.z, v[7] * r * g1.w);
            *((v4u*)(QD + (size_t)m * 512) + lane) = o;
        }
        {
            v4u w = wk;
            float v[8] = {lo16(w.x), hi16(w.x), lo16(w.y), hi16(w.y), lo16(w.z), hi16(w.z), lo16(w.w), hi16(w.w)};
            float s = 0.f;
#pragma unroll
            for (int i = 0; i < 8; ++i) s += v[i] * v[i];
            const float r = 1.f / sqrtf(wave_sum(s) * (1.f / 512.f) + EPS);
            const f32x4 g0 = *((const f32x4*)A.in[I_KVAN] + 2 * lane), g1 = *((const f32x4*)A.in[I_KVAN] + 2 * lane + 1);
            f32x4 c0 = {v[0] * r * g0.x, v[1] * r * g0.y, v[2] * r * g0.z, v[3] * r * g0.w}, c1 = {v[4] * r * g1.x, v[5] * r * g1.y, v[6] * r * g1.z, v[7] * r * g1.w};
            *((f32x4*)lat + 2 * lane) = c0; *((f32x4*)lat + 2 * lane + 1) = c1;
            v4u o; o.x = pk2(c0.x, c0.y); o.y = pk2(c0.z, c0.w); o.z = pk2(c1.x, c1.y); o.w = pk2(c1.z, c1.w);
            *((v4u*)(C + (size_t)m * 512) + lane) = o;
        }
        {
            const float x = xs;
            const float r = 1.f / sqrtf(wave_sum(x * x) * (1.f / 64.f) + EPS);
            const float xr = x * r * A.in[I_KNR][lane];
            const float other = __shfl_xor(xr, 32);
            const float ang = (float)pos * ROPE_INV[lane & 31];
            const float cs = cosf(ang), sn = sinf(ang);
            const float o = lane < 32 ? xr * cs - other * sn : other * sn + xr * cs;
            lat[512 + lane] = o;
            KR[(size_t)m * 64 + lane] = (bf16)f2bf(o);
        }
        if (lane < 8) {
            const float b = xb, a = xa;
            BETA[(size_t)m * 8 + lane] = 1.f / (1.f + expf(-b));
            const float xx = a + A.in[I_DTB][lane];
            const float sp = fmaxf(xx, 0.f) + log1pf(expf(-fabsf(xx)));
            GLOG[(size_t)m * 8 + lane] = -expf(A.in[I_ALOG][lane]) * sp;
        }
        wq = wqn; wk = wkn; xs = xsn; xb = xbn; xa = xan;
    }
}
__device__ __forceinline__ void p2_conv_state(const Args& A, int gtid, int NGT) {
    const bf16* QKV = (const bf16*)(A.ws + WS_QKV);
    {
        const bf16* WKV = (const bf16*)(A.ws + WS_WKV); unsigned* WK8 = (unsigned*)(A.ws + WS_WKT);
        for (int c = gtid; c < 16384; c += NGT) { const int blk = c >> 6, l = c & 63, rt = blk >> 3, ks = blk & 7;
            const bf16* src = WKV + (size_t)(rt * 32 + (l & 31)) * 512 + 64 * ks + 32 * (l >> 5);
#pragma unroll
            for (int q = 0; q < 2; ++q) { const v4u w0 = *(const v4u*)(src + 16 * q), w1 = *(const v4u*)(src + 16 * q + 8);
                v4u o;
                o.x = f8pack(lo16(w0.x) * 64.f, hi16(w0.x) * 64.f, lo16(w0.y) * 64.f, hi16(w0.y) * 64.f); o.y = f8pack(lo16(w0.z) * 64.f, hi16(w0.z) * 64.f, lo16(w0.w) * 64.f, hi16(w0.w) * 64.f);
                o.z = f8pack(lo16(w1.x) * 64.f, hi16(w1.x) * 64.f, lo16(w1.y) * 64.f, hi16(w1.y) * 64.f); o.w = f8pack(lo16(w1.z) * 64.f, hi16(w1.z) * 64.f, lo16(w1.w) * 64.f, hi16(w1.w) * 64.f);
                *(v4u*)(WK8 + (size_t)c * 8 + 4 * q) = o; } }
    }
    for (int i = gtid; i < 8 * 3 * 3072; i += NGT) { const int c = i % 3072, r = (i / 3072) % 3, b = i / (3 * 3072);
        A.out[O_CSP + i] = bf2f(QKV[(size_t)(b * SEQ + SEQ - 3 + r) * 3072 + c]); }
    for (int i = gtid; i < 32 * 3 * 3072; i += NGT) { const int c = i % 3072, r = (i / 3072) % 3, j = i / (3 * 3072);
        A.out[O_CSS + i] = r < 2 ? A.in[I_SCONV][(size_t)(j * 3 + r + 1) * 3072 + c] : bf2f(QKV[(size_t)(MP + j) * 3072 + c]); }
}
__device__ __forceinline__ pg8::u32x4 pack8(const pg8::f32x4& v0, const pg8::f32x4& v1) {
    pg8::u32x4 w; w.x = pk2(v0[0], v0[1]); w.y = pk2(v0[2], v0[3]); w.z = pk2(v1[0], v1[1]); w.w = pk2(v1[2], v1[3]); return w;
}
template <int ACT> struct EpiStore {
    static constexpr bool PERM = true, AFTER_DRAIN = false;
    bf16* O0; int ld0; int split; bf16* O1; int ld1;
    __device__ __forceinline__ void operator()(const pg8::f32x4 (&acc)[2][2][4][2], const pg8::Unit& u, int wr, int wc, int fr, int fq) const {
        const int row0 = u.pm * 256 + wr * 64 + fr, cl = wc * 32 + 8 * fq;
        bf16* base; int ld;
        if (u.pn < split) { base = O0 + u.pn * 256; ld = ld0; } else { base = O1 + (u.pn - split) * 256; ld = ld1; }
#pragma unroll
        for (int ai = 0; ai < 2; ++ai)
#pragma unroll
            for (int m = 0; m < 4; ++m) { bf16* rowp = base + (size_t)(row0 + ai * 128 + m * 16) * ld + cl;
#pragma unroll
                for (int bj = 0; bj < 2; ++bj) { pg8::f32x4 v0 = acc[ai][bj][m][0], v1 = acc[ai][bj][m][1];
                    if (ACT == 1) {
#pragma unroll
                        for (int e = 0; e < 4; ++e) { const float a = fmaxf(v0[e], 0.f), b = fmaxf(v1[e], 0.f); v0[e] = a * a; v1[e] = b * b; } }
                    *(pg8::u32x4*)(rowp + bj * 128) = pack8(v0, v1); } }
    }
};
struct EpiUp {
    static constexpr bool PERM = true, AFTER_DRAIN = false;
    bf16* H; const float* RX;
    __device__ __forceinline__ void operator()(const pg8::f32x4 (&acc)[2][2][4][2], const pg8::Unit& u, int wr, int wc, int fr, int fq) const {
        const int row0 = u.pm * 256 + wr * 64 + fr, cl = u.pn * 256 + wc * 32 + 8 * fq;
#pragma unroll
        for (int ai = 0; ai < 2; ++ai)
#pragma unroll
            for (int m = 0; m < 4; ++m) { const int row = row0 + ai * 128 + m * 16; const float r = __builtin_amdgcn_rsqf(RX[row] * (1.f / 1024.f) + EPS);
                bf16* rowp = H + (size_t)row * 4096 + cl;
#pragma unroll
                for (int bj = 0; bj < 2; ++bj) { pg8::f32x4 v0 = acc[ai][bj][m][0], v1 = acc[ai][bj][m][1];
#pragma unroll
                    for (int e = 0; e < 4; ++e) { const float a = fmaxf(v0[e] * r, 0.f), b = fmaxf(v1[e] * r, 0.f); v0[e] = a * a; v1[e] = b * b; }
                    *(pg8::u32x4*)(rowp + bj * 128) = pack8(v0, v1); } }
    }
};
constexpr int EPI_S_OFF = 131072;
template <int KIND> struct EpiHeads {
    static constexpr bool PERM = true, AFTER_DRAIN = false;
    bf16* O0; int ld0; int split; bf16* O1; int ld1; float* SB; const float* gain; LAS float* S;
    __device__ __forceinline__ void operator()(const pg8::f32x4 (&acc)[2][2][4][2], const pg8::Unit& u, int wr, int wc, int fr, int fq) const {
        const int rl0 = wr * 64 + fr, row0 = u.pm * 256 + rl0, cl = wc * 32 + 8 * fq;
        bf16* base; int ld;
        if (u.pn < split) { base = O0 + u.pn * 256; ld = ld0; } else { base = O1 + (u.pn - split) * 256; ld = ld1; }
        if (KIND == 1 && u.pn >= 4) {
#pragma unroll
            for (int ai = 0; ai < 2; ++ai)
#pragma unroll
                for (int m = 0; m < 4; ++m) { bf16* rowp = base + (size_t)(row0 + ai * 128 + m * 16) * ld + cl;
#pragma unroll
                    for (int bj = 0; bj < 2; ++bj) *(pg8::u32x4*)(rowp + bj * 128) = pack8(acc[ai][bj][m][0], acc[ai][bj][m][1]); }
            return;
        }
        const bool rope = (KIND == 0) && (u.pn >= 4);
        if (wc == 0) {
#pragma unroll
            for (int ai = 0; ai < 2; ++ai)
#pragma unroll
                for (int m = 0; m < 4; ++m) S[(rl0 + ai * 128 + m * 16) * 4 + fq] = 0.f; }
        LBAR();
#pragma unroll
        for (int ai = 0; ai < 2; ++ai)
#pragma unroll
            for (int m = 0; m < 4; ++m)
#pragma unroll
                for (int bj = 0; bj < 2; ++bj) { const pg8::f32x4 v0 = acc[ai][bj][m][0], v1 = acc[ai][bj][m][1];
                    float s = (v0[0] * v0[0] + v0[1] * v0[1]) + (v0[2] * v0[2] + v0[3] * v0[3]) + (v1[0] * v1[0] + v1[1] * v1[1]) + (v1[2] * v1[2] + v1[3] * v1[3]);
                    s += __shfl_xor(s, 16); s += __shfl_xor(s, 32);
                    if (fq == 0) (void)__hip_atomic_fetch_add(S + (rl0 + ai * 128 + m * 16) * 4 + (rope ? 2 * bj + (wc >> 1) : bj), s, __ATOMIC_RELAXED, __HIP_MEMORY_SCOPE_WORKGROUP); }
        LBAR();
#pragma unroll
        for (int ai = 0; ai < 2; ++ai)
#pragma unroll
            for (int m = 0; m < 4; ++m) { const int rl = rl0 + ai * 128 + m * 16, row = row0 + ai * 128 + m * 16; bf16* rowp = base + (size_t)row * ld + cl;
#pragma unroll
                for (int bj = 0; bj < 2; ++bj) { pg8::f32x4 v0 = acc[ai][bj][m][0], v1 = acc[ai][bj][m][1];
                    if (!rope) { const float r = __builtin_amdgcn_rsqf(S[rl * 4 + bj] * (1.f / 128.f) + EPS); const f32x4 g0 = *(const f32x4*)(gain + cl), g1 = *(const f32x4*)(gain + cl + 4);
                        v0[0] *= r * g0.x; v0[1] *= r * g0.y; v0[2] *= r * g0.z; v0[3] *= r * g0.w; v1[0] *= r * g1.x; v1[1] *= r * g1.y; v1[2] *= r * g1.z; v1[3] *= r * g1.w; }
                    else if (fq == 0 && (wc & 1) == 0 && row < MR) SB[(size_t)row * 8 + 4 * (u.pn - 4) + 2 * bj + (wc >> 1)] = S[rl * 4 + 2 * bj + (wc >> 1)];
                    *(pg8::u32x4*)(rowp + bj * 128) = pack8(v0, v1); } }
    }
};
template <int STEP> struct EpiMerge {
    static constexpr bool PERM = true, AFTER_DRAIN = false;
    const bf16* GATES; float* TF; bf16* T;
    __device__ __forceinline__ void operator()(const pg8::f32x4 (&acc)[2][2][4][2], const pg8::Unit& u, int wr, int wc, int fr, int fq) const {
        const int row0 = u.pm * 256 + wr * 64 + fr, c0 = u.pn * 256 + wc * 32 + 8 * fq;
#pragma unroll
        for (int ai = 0; ai < 2; ++ai)
#pragma unroll
            for (int m = 0; m < 4; ++m) { const size_t row = (size_t)(row0 + ai * 128 + m * 16);
#pragma unroll
                for (int bj = 0; bj < 2; ++bj) { const int col = c0 + bj * 128;
                    const v4u gw = *(const v4u*)(GATES + row * 2048 + (STEP == 1 ? 0 : 1024) + col);
                    const float g[8] = {lo16(gw.x), hi16(gw.x), lo16(gw.y), hi16(gw.y), lo16(gw.z), hi16(gw.z), lo16(gw.w), hi16(gw.w)};
                    pg8::f32x4 v0 = acc[ai][bj][m][0], v1 = acc[ai][bj][m][1];
#pragma unroll
                    for (int e = 0; e < 4; ++e) { v0[e] *= g[e]; v1[e] *= g[4 + e]; }
                    bf16* tp = T + row * 1024 + col;
                    if (STEP == 1) *(pg8::u32x4*)tp = pack8(v0, v1);
                    else { const v4u pw = *(const v4u*)tp;
                        v0[0] += lo16(pw.x); v0[1] += hi16(pw.x); v0[2] += lo16(pw.y); v0[3] += hi16(pw.y); v1[0] += lo16(pw.z); v1[1] += hi16(pw.z); v1[2] += lo16(pw.w); v1[3] += hi16(pw.w);
                        *(pg8::u32x4*)tp = pack8(v0, v1); } } }
    }
};
template <int MODE> struct EpiRes {
    static constexpr bool PERM = true, AFTER_DRAIN = false;
    const float *XPp, *XSp; float* X1; float* out; bf16* XB; float* RX; LAS unsigned char* lds_epi;
    __device__ __forceinline__ void operator()(const pg8::f32x4 (&acc)[2][2][4][2], const pg8::Unit& u, int wr, int wc, int fr, int fq) const {
        const int row0 = u.pm * 256 + wr * 64 + fr, c0 = u.pn * 256 + wc * 32 + 8 * fq;
        float ss[2][4] = {{0.f, 0.f, 0.f, 0.f}, {0.f, 0.f, 0.f, 0.f}};
#pragma unroll
        for (int ai = 0; ai < 2; ++ai)
#pragma unroll
            for (int m = 0; m < 4; ++m) { const int row = row0 + ai * 128 + m * 16;
                if (row >= MR) continue;
#pragma unroll
                for (int bj = 0; bj < 2; ++bj) { const int col = c0 + bj * 128;
                    if (MODE == 0) {
                        const float* src = row < MP ? XPp + (size_t)row * 1024 + col : XSp + (size_t)(row - MP) * 1024 + col;
                        const pg8::f32x4 y0 = acc[ai][bj][m][0] + *(const pg8::f32x4*)src, y1 = acc[ai][bj][m][1] + *(const pg8::f32x4*)(src + 4);
                        *(pg8::u32x4*)(XB + (size_t)row * 1024 + col) = pack8(y0, y1);
                        ss[ai][m] += (y0[0] * y0[0] + y0[1] * y0[1]) + (y0[2] * y0[2] + y0[3] * y0[3]) + (y1[0] * y1[0] + y1[1] * y1[1]) + (y1[2] * y1[2] + y1[3] * y1[3]);
                    } else {
                        const v4u pw = *(const v4u*)(XB + (size_t)row * 1024 + col);
                        float* dst = row < MP ? out + O_YP + (size_t)row * 1024 + col : out + O_YS + (size_t)(row - MP) * 1024 + col;
                        pg8::f32x4 y0 = acc[ai][bj][m][0], y1 = acc[ai][bj][m][1];
                        y0[0] += lo16(pw.x); y0[1] += hi16(pw.x); y0[2] += lo16(pw.y); y0[3] += hi16(pw.y); y1[0] += lo16(pw.z); y1[1] += hi16(pw.z); y1[2] += lo16(pw.w); y1[3] += hi16(pw.w);
                        *(pg8::f32x4*)dst = y0; *(pg8::f32x4*)(dst + 4) = y1; } } }
        if (MODE == 0) {
            LAS float* S = (LAS float*)(lds_epi + EPI_S_OFF); const int rl0 = wr * 64 + fr;
            if (wc == 0 && fq == 0) {
#pragma unroll
                for (int ai = 0; ai < 2; ++ai)
#pragma unroll
                    for (int m = 0; m < 4; ++m) S[rl0 + ai * 128 + m * 16] = 0.f; }
            LBAR();
#pragma unroll
            for (int ai = 0; ai < 2; ++ai)
#pragma unroll
                for (int m = 0; m < 4; ++m) { float v = ss[ai][m]; v += __shfl_xor(v, 16); v += __shfl_xor(v, 32);
                    if (fq == 0) (void)__hip_atomic_fetch_add(S + rl0 + ai * 128 + m * 16, v, __ATOMIC_RELAXED, __HIP_MEMORY_SCOPE_WORKGROUP); }
            LBAR();
            const int t = threadIdx.x;
            if (t < 256 && u.pm * 256 + t < MR) atomicAdd(RX + u.pm * 256 + t, S[t]);
            LBAR();
        }
    }
};

#define MFMA32(a, b, c) __builtin_amdgcn_mfma_f32_32x32x16_bf16((a), (b), (c), 0, 0, 0)
__device__ __forceinline__ int crow(int r, int hi) { return (r & 3) + 8 * (r >> 2) + 4 * hi; }
__device__ __forceinline__ bf16x8 lds_ld8(LAS const unsigned char* p) { return *(LAS const bf16x8*)p; }
__device__ __forceinline__ bf16x8 gl_ld8(const bf16* p) { return *(const bf16x8*)p; }

constexpr int GA_QH = 0, GA_KH = 17408, GA_KBH = 34816, GA_VBT = 52224, GA_KBGT = 70656, GA_KDT = 89088, GA_LF = 107520, GA_TB = 123904, GA_GS = 133120, GA_BS = 133376, GA_T32 = 133632, GA_X32 = 141824;
__device__ __forceinline__ void gdn_a_unit(const Args& A, LAS unsigned char* lds, int unit, int tid, int lane, int wave) {
    unsigned char* ws = A.ws;
    const int b = unit >> 8, h = (unit >> 5) & 7, n = unit & 31;
    const int row0 = b * SEQ + n * 64;
#ifdef PROBE_K
    unsigned long long pt0 = 0, pdt = 0;
#define GPS(k) do { if ((k) == PROBE_K) pt0 = __builtin_amdgcn_s_memrealtime(); } while (0)
#define GPE(k) do { if ((k) == PROBE_K) pdt += __builtin_amdgcn_s_memrealtime() - pt0; } while (0)
#else
#define GPS(k) do {} while (0)
#define GPE(k) do {} while (0)
#endif
    GPS(74); GPS(70);
    const bf16* QKV = (const bf16*)(ws + WS_QKV);
    LAS float* Gs = (LAS float*)(lds + GA_GS); LAS float* Bs = (LAS float*)(lds + GA_BS);
    float Gend;
    {
        const int cg = tid & 15, rr = tid >> 4;
        v4u xw[3][2][4];
#pragma unroll
        for (int part = 0; part < 3; ++part)
#pragma unroll
            for (int ri = 0; ri < 2; ++ri)
#pragma unroll
                for (int tap = 0; tap < 4; ++tap) { const int tt = n * 64 + rr + 32 * ri - 3 + tap;
                    xw[part][ri][tap] = tt >= 0 ? *(const v4u*)(QKV + (size_t)(b * SEQ + tt) * 3072 + part * 1024 + h * 128 + 8 * cg) : (v4u){0u, 0u, 0u, 0u}; }
        float gx = ((const float*)(ws + WS_GLOG))[(size_t)(row0 + lane) * 8 + h];
        const float be0 = ((const float*)(ws + WS_BETA))[(size_t)(row0 + rr) * 8 + h], be1 = ((const float*)(ws + WS_BETA))[(size_t)(row0 + rr + 32) * 8 + h];
#pragma unroll
        for (int o = 1; o < 64; o <<= 1) { const float y = __shfl_up(gx, o); if (lane >= o) gx += y; }
        if (wave == 0) { Gs[lane] = gx; Bs[lane] = ((const float*)(ws + WS_BETA))[(size_t)(row0 + lane) * 8 + h]; }
        Gend = __shfl(gx, 63);
        const float Gr0 = __shfl(gx, rr), Gr1 = __shfl(gx, rr + 32);
        bf16* GQG = (bf16*)(ws + WS_GQG) + (size_t)unit * 8192;
#pragma unroll
        for (int part = 0; part < 3; ++part) {
            const int colb = part * 1024 + h * 128 + 8 * cg;
            float wgt[4][8];
#pragma unroll
            for (int tap = 0; tap < 4; ++tap) { const f32x4 w0 = *(const f32x4*)(A.in[I_CONVW] + tap * 3072 + colb), w1 = *(const f32x4*)(A.in[I_CONVW] + tap * 3072 + colb + 4);
                wgt[tap][0] = w0.x; wgt[tap][1] = w0.y; wgt[tap][2] = w0.z; wgt[tap][3] = w0.w; wgt[tap][4] = w1.x; wgt[tap][5] = w1.y; wgt[tap][6] = w1.z; wgt[tap][7] = w1.w; }
#pragma unroll
            for (int ri = 0; ri < 2; ++ri) {
                const int i = rr + 32 * ri;
                float y[8];
#pragma unroll
                for (int e = 0; e < 8; ++e) y[e] = 0.f;
#pragma unroll
                for (int tap = 0; tap < 4; ++tap) { const v4u w = xw[part][ri][tap];
                    const float x[8] = {lo16(w.x), hi16(w.x), lo16(w.y), hi16(w.y), lo16(w.z), hi16(w.z), lo16(w.w), hi16(w.w)};
#pragma unroll
                    for (int e = 0; e < 8; ++e) y[e] += wgt[tap][e] * x[e]; }
                float ss = 0.f;
#pragma unroll
                for (int e = 0; e < 8; ++e) { y[e] = siluf_(y[e]); ss += y[e] * y[e]; }
                ss += __shfl_xor(ss, 1); ss += __shfl_xor(ss, 2); ss += __shfl_xor(ss, 4); ss += __shfl_xor(ss, 8);
                const float Gi = ri ? Gr1 : Gr0;
                const float rs = 1.f / sqrtf(ss + EPS), beta = ri ? be1 : be0, eg = __expf(Gi), ed = __expf(Gend - Gi);
                if (part == 0) {
                    float q[8];
#pragma unroll
                    for (int e = 0; e < 8; ++e) q[e] = y[e] * rs * 0.08838834764831845f;
                    v4u o; o.x = pk2(q[0], q[1]); o.y = pk2(q[2], q[3]); o.z = pk2(q[4], q[5]); o.w = pk2(q[6], q[7]);
                    *(LAS v4u*)(lds + GA_QH + i * 272 + cg * 16) = o;
                    v4u g; g.x = pk2(q[0] * eg, q[1] * eg); g.y = pk2(q[2] * eg, q[3] * eg); g.z = pk2(q[4] * eg, q[5] * eg); g.w = pk2(q[6] * eg, q[7] * eg);
                    *(v4u*)(GQG + i * 128 + 8 * cg) = g;
                } else if (part == 1) {
                    float k[8];
#pragma unroll
                    for (int e = 0; e < 8; ++e) k[e] = y[e] * rs;
                    v4u o; o.x = pk2(k[0], k[1]); o.y = pk2(k[2], k[3]); o.z = pk2(k[4], k[5]); o.w = pk2(k[6], k[7]);
                    *(LAS v4u*)(lds + GA_KH + i * 272 + cg * 16) = o;
                    v4u kb; kb.x = pk2(k[0] * beta, k[1] * beta); kb.y = pk2(k[2] * beta, k[3] * beta); kb.z = pk2(k[4] * beta, k[5] * beta); kb.w = pk2(k[6] * beta, k[7] * beta);
                    *(LAS v4u*)(lds + GA_KBH + i * 272 + cg * 16) = kb;
#pragma unroll
                    for (int e = 0; e < 8; ++e) { *(LAS bf16*)(lds + GA_KBGT + (8 * cg + e) * 144 + i * 2) = (bf16)f2bf(k[e] * beta * eg);
                        *(LAS bf16*)(lds + GA_KDT + (8 * cg + e) * 144 + i * 2) = (bf16)f2bf(k[e] * ed); }
                } else {
#pragma unroll
                    for (int e = 0; e < 8; ++e) *(LAS bf16*)(lds + GA_VBT + (8 * cg + e) * 144 + i * 2) = (bf16)f2bf(y[e] * beta);
                }
            }
            __builtin_amdgcn_sched_barrier(0);
        }
    }
    __syncthreads();
    GPE(70); GPS(71);
    int l31 = lane & 31, hi = lane >> 5; asm volatile("" : "+v"(l31), "+v"(hi));
    {
        const int it = (wave >> 1) & 1, jt = wave & 1; const bool isL = wave < 4;
        f32x16 acc = {};
        if (it >= jt) {
            LAS const unsigned char* Ab = lds + (isL ? GA_KBH : GA_QH) + (32 * it + l31) * 272 + hi * 16;
            LAS const unsigned char* Bb = lds + GA_KH + (32 * jt + l31) * 272 + hi * 16;
#pragma unroll
            for (int ks = 0; ks < 8; ++ks) acc = MFMA32(lds_ld8(Ab + ks * 32), lds_ld8(Bb + ks * 32), acc);
        }
        const int j = 32 * jt + l31; const float Gj = Gs[j];
        bf16* AQ = (bf16*)(ws + WS_GAQK) + (size_t)unit * 4096;
#pragma unroll
        for (int r = 0; r < 16; ++r) { const int i = 32 * it + crow(r, hi);
            const float d = __expf(fminf(Gs[i] - Gj, 0.f));
            if (isL) ((LAS float*)(lds + GA_LF))[i * 64 + j] = (i > j) ? acc[r] * d : 0.f;
            else AQ[i * 64 + j] = (bf16)f2bf((i >= j) ? acc[r] * d : 0.f); }
    }
    __syncthreads();
    GPE(71); GPS(72);
    {
        LAS const float* Lf = (LAS const float*)(lds + GA_LF);
        LAS float* T32 = (LAS float*)(lds + GA_T32); LAS float* X32 = (LAS float*)(lds + GA_X32);
        if (wave == 0) {
            int lx = lane; asm volatile("" : "+v"(lx));
            const int hb = lx >> 5, c = lx & 31;
            LAS const float* Lb = Lf + (32 * hb) * 64 + 32 * hb;
            float T[32];
#pragma unroll
            for (int i = 0; i < 32; ++i) {
                float a0 = (i == c) ? 1.f : 0.f, a1 = 0.f;
#pragma unroll
                for (int j4 = 0; j4 < (i + 3) / 4; ++j4) { const f32x4 l4 = *(LAS const f32x4*)(Lb + i * 64 + 4 * j4);
                    if (4 * j4 + 0 < i) a0 -= l4.x * T[4 * j4 + 0];
                    if (4 * j4 + 1 < i) a1 -= l4.y * T[4 * j4 + 1];
                    if (4 * j4 + 2 < i) a0 -= l4.z * T[4 * j4 + 2];
                    if (4 * j4 + 3 < i) a1 -= l4.w * T[4 * j4 + 3]; }
                T[i] = a0 + a1;
                T32[hb * 1024 + i * 32 + c] = T[i];
                *(LAS bf16*)(lds + GA_TB + (32 * hb + i) * 144 + (32 * hb + c) * 2) = (bf16)f2bf(T[i]);
                if (hb == 0) *(LAS bf16*)(lds + GA_TB + i * 144 + (32 + c) * 2) = (bf16)0;
            }
        } else {
            bf16* GKD = (bf16*)(ws + WS_GKD) + (size_t)unit * 8192;
            int t0 = tid; asm volatile("" : "+v"(t0));
            for (int id = t0 - 64; id < 1024; id += 448) { const int row = id >> 3, ch = id & 7;
                *(v4u*)(GKD + row * 64 + ch * 8) = *(LAS const v4u*)(lds + GA_KDT + row * 144 + ch * 16); }
        }
        __syncthreads();
        int tidx = tid; asm volatile("" : "+v"(tidx));
        const int r = tidx >> 4, c2 = (tidx & 15) * 2;
        {
            float x0 = 0.f, x1 = 0.f;
#pragma unroll 8
            for (int k = 0; k < 32; ++k) { const float l = Lf[(32 + r) * 64 + k]; x0 += l * T32[k * 32 + c2]; x1 += l * T32[k * 32 + c2 + 1]; }
            X32[r * 32 + c2] = x0; X32[r * 32 + c2 + 1] = x1;
        }
        __syncthreads();
        {
            float x0 = 0.f, x1 = 0.f;
#pragma unroll 8
            for (int k = 0; k < 32; ++k) { const float t = T32[1024 + r * 32 + k]; x0 += t * X32[k * 32 + c2]; x1 += t * X32[k * 32 + c2 + 1]; }
            *(LAS unsigned*)(lds + GA_TB + (32 + r) * 144 + c2 * 2) = pk2(-x0, -x1);
        }
    }
    __syncthreads();
    GPE(72); GPS(73);
    {
        const int nt = wave; LAS const unsigned char* Bb = lds + (nt < 4 ? GA_VBT : GA_KBGT) + (32 * (nt & 3) + l31) * 144 + hi * 16;
        float* GU0 = (float*)(ws + WS_GU0) + (size_t)unit * 8192; bf16* GW = (bf16*)(ws + WS_GW) + (size_t)unit * 8192;
#pragma unroll
        for (int it = 0; it < 2; ++it) {
            f32x16 acc = {};
            LAS const unsigned char* Ab = lds + GA_TB + (32 * it + l31) * 144 + hi * 16;
#pragma unroll
            for (int ks = 0; ks < 4; ++ks) if (ks < 2 * (it + 1)) acc = MFMA32(lds_ld8(Ab + ks * 32), lds_ld8(Bb + ks * 32), acc);
            const int col = 32 * (nt & 3) + l31;
#pragma unroll
            for (int r = 0; r < 16; ++r) { const int i = 32 * it + crow(r, hi);
                if (nt < 4) GU0[i * 128 + col] = acc[r]; else GW[i * 128 + col] = (bf16)f2bf(acc[r]); }
        }
        if (tid == 0) ((float*)(ws + WS_GEND))[unit] = __expf(Gend);
    }
    __syncthreads();
    GPE(73); GPE(74);
#ifdef PROBE_K
    if (blockIdx.x == PROBE_B && PROBE_K >= 70 && PROBE_K < 80) { const unsigned long long te = __builtin_amdgcn_s_memrealtime(); while (__builtin_amdgcn_s_memrealtime() - te < (unsigned long long)PROBE_MULT * pdt) __builtin_amdgcn_s_sleep(8); }
#endif
}

constexpr int GB_ST = 0, GB_UT = 34816, GB_OF = 53248;
__device__ __forceinline__ void gdn_b_unit(const Args& A, LAS unsigned char* lds, int bh, int tid, int lane, int wave) {
    unsigned char* ws = A.ws;
    const int b = bh >> 3, h = bh & 7, l31 = lane & 31, hi = lane >> 5;
    const int it = wave >> 2, vt = wave & 3;
    for (int i = tid; i < 34816 / 16; i += 512) *(LAS v4u*)(lds + GB_ST + i * 16) = (v4u){0u, 0u, 0u, 0u};
    f32x16 Sacc[2] = {};
    __syncthreads();
    const bf16* Zb = (const bf16*)(ws + WS_Z); bf16* YA = (bf16*)(ws + WS_YA);
    LAS const unsigned char* Sb = lds + GB_ST + (32 * vt + l31) * 272 + hi * 16;
    LAS const unsigned char* Ub = lds + GB_UT + (32 * vt + l31) * 144 + hi * 16;
    const int di = tid >> 3, dc0 = (tid & 7) * 16;
    bf16x8 wA[8], qA[8], cA[4], kA[2][4]; float u0[16]; v4u zz[2]; float gend;
#define BL8(rs_, vo_, so_) __builtin_bit_cast(bf16x8, __builtin_amdgcn_raw_buffer_load_b128((rs_), (vo_), (so_), 0))
#define MKRS(p_, bytes_) __builtin_amdgcn_make_buffer_rsrc((void*)(p_), 0, (bytes_), 0x00020000)
    const unsigned voW = (unsigned)((32 * it + l31) * 128 + 8 * hi) * 2u, voA = (unsigned)((32 * it + l31) * 64 + 8 * hi) * 2u, voK = (unsigned)((64 * it + l31) * 64 + 8 * hi) * 2u;
    const unsigned voU = (unsigned)((32 * it + 4 * hi) * 128 + 32 * vt + l31) * 4u, voZ = (unsigned)(di * 1024 + h * 128 + dc0) * 2u;
#define GB_LD_W(n_) do { const int cu_ = bh * 32 + (n_); const __amdgpu_buffer_rsrc_t rW_ = MKRS((const bf16*)(ws + WS_GW) + (size_t)cu_ * 8192, 16384), rU_ = MKRS((const float*)(ws + WS_GU0) + (size_t)cu_ * 8192, 32768); \
        _Pragma("unroll") for (int ks = 0; ks < 8; ++ks) wA[ks] = BL8(rW_, voW, ks * 32); \
        _Pragma("unroll") for (int r = 0; r < 16; ++r) u0[r] = __builtin_bit_cast(float, __builtin_amdgcn_raw_buffer_load_b32(rU_, voU, ((r & 3) + 8 * (r >> 2)) * 512, 0)); } while (0)
#define GB_LD_Q(n_) do { const int cu_ = bh * 32 + (n_); const __amdgpu_buffer_rsrc_t rQ_ = MKRS((const bf16*)(ws + WS_GQG) + (size_t)cu_ * 8192, 16384), rA_ = MKRS((const bf16*)(ws + WS_GAQK) + (size_t)cu_ * 4096, 8192); \
        _Pragma("unroll") for (int ks = 0; ks < 8; ++ks) qA[ks] = BL8(rQ_, voW, ks * 32); \
        _Pragma("unroll") for (int ks = 0; ks < 4; ++ks) cA[ks] = BL8(rA_, voA, ks * 32); } while (0)
#define GB_LD_K(n_) do { const int cu_ = bh * 32 + (n_); const __amdgpu_buffer_rsrc_t rK_ = MKRS((const bf16*)(ws + WS_GKD) + (size_t)cu_ * 8192, 16384), rZ_ = MKRS(Zb + (size_t)(b * SEQ + 64 * (n_)) * 1024, 64 * 1024 * 2); \
        _Pragma("unroll") for (int ks = 0; ks < 4; ++ks) { kA[0][ks] = BL8(rK_, voK, ks * 32); kA[1][ks] = BL8(rK_, voK, 32 * 64 * 2 + ks * 32); } \
        zz[0] = __builtin_amdgcn_raw_buffer_load_b128(rZ_, voZ, 0, 0); zz[1] = __builtin_amdgcn_raw_buffer_load_b128(rZ_, voZ, 16, 0); \
        gend = ((const float*)(ws + WS_GEND))[cu_]; } while (0)
#ifdef PROBE_K
    unsigned long long pt0 = 0, pdt = 0;
#endif
    float gn[16];
#pragma unroll
    for (int e = 0; e < 16; ++e) gn[e] = A.in[I_GDNN][dc0 + e];
    GB_LD_W(0); GB_LD_Q(0);
#pragma unroll 1
    for (int n = 0; n < 32; ++n) {
        const int r0 = b * SEQ + 64 * n;
        GPS(80); GPS(84);
        GB_LD_K(n);
        {
            f32x16 acc = {};
#pragma unroll
            for (int ks = 0; ks < 8; ++ks) acc = MFMA32(wA[ks], lds_ld8(Sb + ks * 32), acc);
            float u[16];
#pragma unroll
            for (int r = 0; r < 16; ++r) u[r] = u0[r] - acc[r];
#pragma unroll
            for (int g = 0; g < 4; ++g) { v2u w; w.x = pk2(u[4 * g], u[4 * g + 1]); w.y = pk2(u[4 * g + 2], u[4 * g + 3]);
                *(LAS v2u*)(lds + GB_UT + (32 * vt + l31) * 144 + (32 * it + 8 * g + 4 * hi) * 2) = w; }
        }
        LBAR();
        GPE(80); GPS(81);
        GB_LD_W(n + 1 < 32 ? n + 1 : 31);
        {
            f32x16 acc = {};
#pragma unroll
            for (int ks = 0; ks < 8; ++ks) acc = MFMA32(qA[ks], lds_ld8(Sb + ks * 32), acc);
#pragma unroll
            for (int ks = 0; ks < 4; ++ks) if (ks < 2 * (it + 1)) acc = MFMA32(cA[ks], lds_ld8(Ub + ks * 32), acc);
#pragma unroll
            for (int r = 0; r < 16; ++r) ((LAS float*)(lds + GB_OF))[(32 * it + crow(r, hi)) * 132 + 32 * vt + l31] = acc[r];
        }
        LBAR();
        GPE(81); GPS(82);
        GB_LD_Q(n + 1 < 32 ? n + 1 : 31);
        {
#pragma unroll
            for (int t = 0; t < 2; ++t) { const int kt = 2 * (wave >> 2) + t;
                Sacc[t] = Sacc[t] * gend;
#pragma unroll
                for (int ks = 0; ks < 4; ++ks) Sacc[t] = MFMA32(kA[t][ks], lds_ld8(Ub + ks * 32), Sacc[t]);
#pragma unroll
                for (int g = 0; g < 4; ++g) { v2u w; w.x = pk2(Sacc[t][4 * g], Sacc[t][4 * g + 1]); w.y = pk2(Sacc[t][4 * g + 2], Sacc[t][4 * g + 3]);
                    *(LAS v2u*)(lds + GB_ST + (32 * vt + l31) * 272 + (32 * kt + 8 * g + 4 * hi) * 2) = w; }
            }
        }
        {
            LAS const float* orow = (LAS const float*)(lds + GB_OF) + di * 132 + dc0;
            float o[16]; float ss = 0.f;
#pragma unroll
            for (int q = 0; q < 4; ++q) { const f32x4 v = *(LAS const f32x4*)(orow + 4 * q); o[4 * q] = v.x; o[4 * q + 1] = v.y; o[4 * q + 2] = v.z; o[4 * q + 3] = v.w; }
#pragma unroll
            for (int e = 0; e < 16; ++e) ss += o[e] * o[e];
            ss += __shfl_xor(ss, 1); ss += __shfl_xor(ss, 2); ss += __shfl_xor(ss, 4);
            const float r = 1.f / sqrtf(ss * (1.f / 128.f) + EPS);
            const size_t off = (size_t)(r0 + di) * 1024 + h * 128 + dc0;
            const v4u z0 = zz[0], z1 = zz[1];
            const float z[16] = {lo16(z0.x), hi16(z0.x), lo16(z0.y), hi16(z0.y), lo16(z0.z), hi16(z0.z), lo16(z0.w), hi16(z0.w),
                                 lo16(z1.x), hi16(z1.x), lo16(z1.y), hi16(z1.y), lo16(z1.z), hi16(z1.z), lo16(z1.w), hi16(z1.w)};
            float y[16];
#pragma unroll
            for (int e = 0; e < 16; ++e) y[e] = o[e] * r * gn[e] * siluf_(z[e]);
            v4u o0, o1; o0.x = pk2(y[0], y[1]); o0.y = pk2(y[2], y[3]); o0.z = pk2(y[4], y[5]); o0.w = pk2(y[6], y[7]);
            o1.x = pk2(y[8], y[9]); o1.y = pk2(y[10], y[11]); o1.z = pk2(y[12], y[13]); o1.w = pk2(y[14], y[15]);
            *(v4u*)(YA + off) = o0; *(v4u*)(YA + off + 8) = o1;
        }
        GPE(82); GPS(83);
        LBAR();
        GPE(83); GPE(84);
    }
#undef GB_LD_W
#undef GB_LD_Q
#undef GB_LD_K
#undef BL8
#undef MKRS
#ifdef PROBE_K
    if (bh == 0 && tid == 0 && PROBE_K >= 80 && PROBE_K < 90) ((volatile LAS unsigned*)(lds + MISC_OFF))[16] = (unsigned)pdt;
#endif
    float* So = A.out + O_GSP + (size_t)bh * 16384;
#pragma unroll
    for (int t = 0; t < 2; ++t) { const int kt = 2 * (wave >> 2) + t;
#pragma unroll
        for (int r = 0; r < 16; ++r) So[(32 * kt + crow(r, hi)) * 128 + 32 * vt + l31] = Sacc[t][r]; }
    __syncthreads();
}

__device__ __forceinline__ void gdn_r_unit(const Args& A, LAS unsigned char* lds, int unit, int tid, int lane, int wave) {
    unsigned char* ws = A.ws;
    const int j = unit >> 3, h = unit & 7, row = MP + j;
    LAS float* qs = (LAS float*)lds; LAS float* ks = qs + 128; LAS float* vs = qs + 256; LAS float* red = qs + 384;
    LAS float* os = qs + 896;
    if (tid < 384) {
        const int part = tid >> 7, d = tid & 127, col = part * 1024 + h * 128 + d;
        const float* cw = A.in[I_CONVW]; const float* sc = A.in[I_SCONV] + (size_t)j * 3 * 3072;
        const float xn = bf2f(((const bf16*)(ws + WS_QKV))[(size_t)row * 3072 + col]);
        const float y = cw[col] * sc[col] + cw[3072 + col] * sc[3072 + col] + cw[2 * 3072 + col] * sc[2 * 3072 + col] + cw[3 * 3072 + col] * xn;
        qs[tid] = siluf_(y);
    }
    __syncthreads();
    const float rq = 1.f / sqrtf(wave_sum(qs[lane] * qs[lane] + qs[lane + 64] * qs[lane + 64]) + EPS) * 0.08838834764831845f;
    const float rk = 1.f / sqrtf(wave_sum(ks[lane] * ks[lane] + ks[lane + 64] * ks[lane + 64]) + EPS);
    const float beta = ((const float*)(ws + WS_BETA))[(size_t)row * 8 + h], eg = __expf(((const float*)(ws + WS_GLOG))[(size_t)row * 8 + h]);
    const int v = tid & 127, kq = tid >> 7;
    const float* S0 = A.in[I_SGDN] + (size_t)unit * 16384;
    float s[32]; float kv = 0.f;
#pragma unroll
    for (int i = 0; i < 32; ++i) { const int k = 32 * kq + i; s[i] = eg * S0[k * 128 + v]; kv += ks[k] * rk * s[i]; }
    red[kq * 128 + v] = kv;
    __syncthreads();
    const float u = beta * (vs[v] - (red[v] + red[128 + v] + red[256 + v] + red[384 + v]));
    __syncthreads();
    float* So = A.out + O_GSS + (size_t)unit * 16384; float po = 0.f;
#pragma unroll
    for (int i = 0; i < 32; ++i) { const int k = 32 * kq + i; s[i] += ks[k] * rk * u; So[k * 128 + v] = s[i]; po += qs[k] * rq * s[i]; }
    red[kq * 128 + v] = po;
    __syncthreads();
    if (tid < 128) os[tid] = red[tid] + red[128 + tid] + red[256 + tid] + red[384 + tid];
    __syncthreads();
    const float rn = 1.f / sqrtf(wave_sum(os[lane] * os[lane] + os[lane + 64] * os[lane + 64]) * (1.f / 128.f) + EPS);
    if (tid < 128) { const size_t off = (size_t)row * 1024 + h * 128 + tid;
        ((bf16*)(ws + WS_YA))[off] = (bf16)f2bf(os[tid] * rn * A.in[I_GDNN][tid] * siluf_(bf2f(((const bf16*)(ws + WS_Z))[off]))); }
    __syncthreads();
}

namespace att {
using s16x4 = __attribute__((ext_vector_type(4))) short;
using u32x4 = __attribute__((ext_vector_type(4))) unsigned;
constexpr int SHM_V = 16384, SHM_K = 16384, SHM_KR = 8192;
constexpr int OFF_V = 0, OFF_K = 2 * SHM_V, OFF_KR = OFF_K + 2 * SHM_K, OFF_WS = OFF_KR + 2 * SHM_KR, OFF_QR = OFF_WS + 2048;
constexpr float THR = 8.f;
#define KSWZ(row, colB) ((row) * 256 + ((colB) ^ (((row) & 7) << 4)))
#define KRSWZ(row, colB) ((row) * 128 + ((colB) ^ (((row) & 7) << 4)))
#define SBAR() __builtin_amdgcn_sched_barrier(0)
__device__ __forceinline__ unsigned cvtpk(float lo, float hi) { unsigned r; asm volatile("v_cvt_pk_bf16_f32 %0, %1, %2" : "=v"(r) : "v"(lo), "v"(hi)); return r; }
__device__ __forceinline__ void partialSM(f32x16& p0, f32x16& p1, float& m_reg, float& mn, float& alpha) {
    constexpr float C = MLA_SCALE * 1.4426950408889634f;
    float pmax = p0[0];
#pragma unroll
    for (int r = 1; r < 16; ++r) pmax = fmaxf(pmax, p0[r]);
#pragma unroll
    for (int r = 0; r < 16; ++r) pmax = fmaxf(pmax, p1[r]);
    { auto rr = __builtin_amdgcn_permlane32_swap(__float_as_uint(pmax), __float_as_uint(pmax), false, false);
      pmax = fmaxf(__uint_as_float(rr[0]), __uint_as_float(rr[1])); }
    if (__builtin_expect(__all(pmax - m_reg <= THR / MLA_SCALE), 1)) { mn = m_reg; alpha = 1.f; }
    else { mn = fmaxf(m_reg, pmax); alpha = __builtin_amdgcn_exp2f((m_reg - mn) * C); m_reg = mn; }
    const float mnC = -mn * C;
#pragma unroll
    for (int r = 0; r < 16; ++r) p0[r] = fmaf(p0[r], C, mnC);
#pragma unroll
    for (int r = 0; r < 16; ++r) p1[r] = fmaf(p1[r], C, mnC);
#pragma unroll
    for (int r = 0; r < 16; ++r) p0[r] = __builtin_amdgcn_exp2f(p0[r]);
}
__device__ __forceinline__ void finishSM(f32x16& p0, f32x16& p1, float alpha, float& l_reg, bf16x8& pa0, bf16x8& pa1, bf16x8& pa2, bf16x8& pa3) {
#pragma unroll
    for (int r = 0; r < 16; ++r) p1[r] = __builtin_amdgcn_exp2f(p1[r]);
    float ps = 0;
#pragma unroll
    for (int r = 0; r < 16; ++r) ps += p0[r];
#pragma unroll
    for (int r = 0; r < 16; ++r) ps += p1[r];
    { auto rr = __builtin_amdgcn_permlane32_swap(__float_as_uint(ps), __float_as_uint(ps), false, false);
      ps = __uint_as_float(rr[0]) + __uint_as_float(rr[1]); }
    l_reg = l_reg * alpha + ps;
#define PK4(P, BASE, OUT) do { unsigned a0 = cvtpk(P[BASE + 0], P[BASE + 1]), a1 = cvtpk(P[BASE + 2], P[BASE + 3]);   \
    unsigned b0 = cvtpk(P[BASE + 4], P[BASE + 5]), b1 = cvtpk(P[BASE + 6], P[BASE + 7]);                              \
    auto r0 = __builtin_amdgcn_permlane32_swap(a0, b0, false, false); auto r1 = __builtin_amdgcn_permlane32_swap(a1, b1, false, false); \
    u32x4 w = {r0[0], r1[0], r0[1], r1[1]}; OUT = *reinterpret_cast<bf16x8*>(&w); } while (0)
    PK4(p0, 0, pa0); PK4(p0, 8, pa1); PK4(p1, 0, pa2); PK4(p1, 8, pa3);
#undef PK4
}
__device__ __forceinline__ void qkt(f32x16& p0, f32x16& p1, LAS const unsigned char* Ks, LAS const unsigned char* KRs, const bf16x8* qr, LAS const unsigned char* qrl, int r32, int hi) {
    p0 = f32x16{}; p1 = f32x16{};
#pragma unroll
    for (int d0 = 0; d0 < 8; ++d0) { const int cb = (d0 * 16 + hi * 8) * 2;
        const bf16x8 b0 = *(LAS const bf16x8*)(Ks + KSWZ(r32, cb)), b1 = *(LAS const bf16x8*)(Ks + KSWZ(32 + r32, cb));
        p0 = MFMA32(b0, qr[d0], p0); p1 = MFMA32(b1, qr[d0], p1); if (d0 == 3 || d0 == 7) SBAR(); }
#pragma unroll
    for (int d0 = 0; d0 < 4; ++d0) { const int cb = (d0 * 16 + hi * 8) * 2;
        const bf16x8 b0 = *(LAS const bf16x8*)(KRs + KRSWZ(r32, cb)), b1 = *(LAS const bf16x8*)(KRs + KRSWZ(32 + r32, cb));
        const bf16x8 qq = *(LAS const bf16x8*)(qrl + d0 * 1024);
        p0 = MFMA32(b0, qq, p0); p1 = MFMA32(b1, qq, p1); }
}
__device__ __forceinline__ void cmask(f32x16& p0, f32x16& p1, int key0, int qpos, int hi) {
#pragma unroll
    for (int r = 0; r < 16; ++r) { const int k = key0 + crow(r, hi); if (k > qpos) p0[r] = -1e30f; if (k + 32 > qpos) p1[r] = -1e30f; }
}
__device__ __forceinline__ int v_st(int k, int c) { const int kk = (k & ~0xC) | ((k & 4) << 1) | ((k & 8) >> 1); return ((kk >> 3) * 4 + (c >> 5)) * 512 + ((kk & 7) * 32 + (c & 31)) * 2; }
__device__ __forceinline__ int v_rd_base(int lane) { return ((lane & 3) << 3) | (((lane >> 2) & 3) << 6) | (((lane >> 4) & 1) << 5) | (((lane >> 5) & 1) << 8); }
constexpr int v_rd_off(int d0, int ks, int half) { return d0 * 512 + ks * 4096 + half * 2048; }
template <int OFF> __device__ __forceinline__ s16x4 tr_read(int vb) {
    s16x4 r; asm volatile("ds_read_b64_tr_b16 %0, %1 offset:%2" : "=&v"(r) : "v"(vb), "i"(OFF) : "memory"); return r;
}
template <int D0> __device__ __forceinline__ void pv_one(f32x16& od, int vb, bf16x8 pa0, bf16x8 pa1, bf16x8 pa2, bf16x8 pa3) {
    const s16x4 l0 = tr_read<v_rd_off(D0, 0, 0)>(vb), h0 = tr_read<v_rd_off(D0, 0, 1)>(vb), l1 = tr_read<v_rd_off(D0, 1, 0)>(vb), h1 = tr_read<v_rd_off(D0, 1, 1)>(vb);
    const s16x4 l2 = tr_read<v_rd_off(D0, 2, 0)>(vb), h2 = tr_read<v_rd_off(D0, 2, 1)>(vb), l3 = tr_read<v_rd_off(D0, 3, 0)>(vb), h3 = tr_read<v_rd_off(D0, 3, 1)>(vb);
    asm volatile("s_waitcnt lgkmcnt(0)" ::: "memory"); SBAR();
#define PKV(L, H) (bf16x8){L[0], L[1], L[2], L[3], H[0], H[1], H[2], H[3]}
    od = MFMA32(pa0, PKV(l0, h0), od); od = MFMA32(pa1, PKV(l1, h1), od); od = MFMA32(pa2, PKV(l2, h2), od); od = MFMA32(pa3, PKV(l3, h3), od);
#undef PKV
}
__device__ __forceinline__ void pv_d0(f32x16* o, int vb, bf16x8 pa0, bf16x8 pa1, bf16x8 pa2, bf16x8 pa3) {
    pv_one<0>(o[0], vb, pa0, pa1, pa2, pa3); pv_one<1>(o[1], vb, pa0, pa1, pa2, pa3); pv_one<2>(o[2], vb, pa0, pa1, pa2, pa3); pv_one<3>(o[3], vb, pa0, pa1, pa2, pa3);
}
__device__ __forceinline__ void attn_block(const bf16* __restrict__ Qn, const bf16* __restrict__ Qr, const float* __restrict__ sqn, const float* __restrict__ sqr,
                                           const bf16* __restrict__ Kh, const float* __restrict__ skn, const bf16* __restrict__ KRb, const bf16* __restrict__ Vh,
                                           const float* __restrict__ gqn, const float* __restrict__ gqr, const float* __restrict__ gkn,
                                           bf16* __restrict__ Ob, int q0, LAS unsigned char* lds) {
    const int tid = threadIdx.x, wid = __builtin_amdgcn_readfirstlane(tid >> 6), lane = tid & 63, r32 = lane & 31, hi = lane >> 5; const int r32_o = r32, hi_o = hi;
    LAS unsigned char* V_lds = lds + OFF_V; LAS unsigned char* K_lds = lds + OFF_K; LAS unsigned char* KR_lds = lds + OFF_KR;
    LAS float* wsf = (LAS float*)(lds + OFF_WS) + wid * 64; LAS float* li_l = wsf; LAS float* al_l = wsf + 32;
    float m_reg = -1e30f, l_reg = 0; f32x16 o[4] = {}; bf16x8 qr[8];
    LAS unsigned char* qrl = lds + OFF_QR + wid * 4096 + lane * 16;
    const int qpos = q0 + wid * 32 + r32;
    {
        int hi = hi_o, r32 = r32_o; asm volatile("" : "+v"(hi), "+v"(r32));
        const char* Qw = (const char*)Qn + (size_t)wid * (32 * 1536 * 2); const char* Qx = (const char*)Qr + (size_t)wid * (32 * 1536 * 2);
        const unsigned qoff = (unsigned)(r32 * 1536 + hi * 8) * 2u;
        const float rr = __builtin_amdgcn_rsqf(sqr[(size_t)(wid * 32 + r32) * 8] * (1.f / 64.f) + EPS);
#pragma unroll
        for (int d0 = 0; d0 < 8; ++d0) qr[d0] = *(const bf16x8*)(Qw + qoff + d0 * 32);
#pragma unroll
        for (int d0 = 0; d0 < 2; ++d0) {
            const v4u w1 = *(const v4u*)(Qx + qoff + d0 * 32), w2 = *(const v4u*)(Qx + qoff + (d0 + 2) * 32);
            const float x1[8] = {lo16(w1.x), hi16(w1.x), lo16(w1.y), hi16(w1.y), lo16(w1.z), hi16(w1.z), lo16(w1.w), hi16(w1.w)};
            const float x2[8] = {lo16(w2.x), hi16(w2.x), lo16(w2.y), hi16(w2.y), lo16(w2.z), hi16(w2.z), lo16(w2.w), hi16(w2.w)};
            float o1[8], o2[8];
#pragma unroll
            for (int j = 0; j < 8; ++j) { const int e = 16 * d0 + 8 * hi + j; const float a = x1[j] * rr * gqr[e], b = x2[j] * rr * gqr[e + 32];
                const float rev = (float)qpos * ROPE_INV[e] * 0.15915494309189535f; const float fr_ = rev - floorf(rev);
                const float cs = __builtin_amdgcn_cosf(fr_), sn = __builtin_amdgcn_sinf(fr_);
                o1[j] = a * cs - b * sn; o2[j] = a * sn + b * cs; }
            v4u p1, p2; p1.x = pk2(o1[0], o1[1]); p1.y = pk2(o1[2], o1[3]); p1.z = pk2(o1[4], o1[5]); p1.w = pk2(o1[6], o1[7]);
            p2.x = pk2(o2[0], o2[1]); p2.y = pk2(o2[2], o2[3]); p2.z = pk2(o2[4], o2[5]); p2.w = pk2(o2[6], o2[7]);
            *(LAS v4u*)(qrl + d0 * 1024) = p1; *(LAS v4u*)(qrl + (d0 + 2) * 1024) = p2; }
    }
    const int sr = tid >> 4, sc = (tid & 15) * 8, vst0 = v_st(sr, sc), vst1 = v_st(32 + sr, sc);
    const int krr = tid >> 3, krc = (tid & 7) * 8;
    const unsigned voff = (unsigned)(sr * 1024 + sc) * 2u, voffr = (unsigned)(krr * 64 + krc) * 2u;
    const int vb0 = (int)(uintptr_t)V_lds + v_rd_base(lane);
    bf16x8 vs0, vs1, ks0, ks1, krs;
#define KSCALE(x_, r_) do { const v4u w_ = __builtin_bit_cast(v4u, x_); const float s_ = __builtin_amdgcn_rsqf((r_) * (1.f / 128.f) + EPS); v4u o_; \
    int sc_ = sc; asm volatile("" : "+v"(sc_)); const f32x4 ga_ = *(const f32x4*)(gkn + sc_), gb_ = *(const f32x4*)(gkn + sc_ + 4);     \
    o_.x = pk2(lo16(w_.x) * s_ * ga_.x, hi16(w_.x) * s_ * ga_.y); o_.y = pk2(lo16(w_.y) * s_ * ga_.z, hi16(w_.y) * s_ * ga_.w); \
    o_.z = pk2(lo16(w_.z) * s_ * gb_.x, hi16(w_.z) * s_ * gb_.y); o_.w = pk2(lo16(w_.w) * s_ * gb_.z, hi16(w_.w) * s_ * gb_.w); x_ = __builtin_bit_cast(bf16x8, o_); } while (0)
#define SLOAD(k0) do { do { const char* kb_ = (const char*)Kh + (size_t)(k0) * 2048; const char* vb_ = (const char*)Vh + (size_t)(k0) * 2048; const char* rb_ = (const char*)KRb + (size_t)(k0) * 128; \
    vs0 = *(const bf16x8*)(vb_ + voff); vs1 = *(const bf16x8*)(vb_ + 65536 + voff); ks0 = *(const bf16x8*)(kb_ + voff); ks1 = *(const bf16x8*)(kb_ + 65536 + voff); \
    krs = *(const bf16x8*)(rb_ + voffr); } while (0); } while (0)
#define SWRITE(b) do { *(LAS bf16x8*)(V_lds + (b) * SHM_V + vst0) = vs0; *(LAS bf16x8*)(V_lds + (b) * SHM_V + vst1) = vs1; const int kc = sc * 2; \
    *(LAS bf16x8*)(K_lds + (b) * SHM_K + KSWZ(sr, kc)) = ks0; *(LAS bf16x8*)(K_lds + (b) * SHM_K + KSWZ(32 + sr, kc)) = ks1; \
    *(LAS bf16x8*)(KR_lds + (b) * SHM_KR + KRSWZ(krr, krc * 2)) = krs; } while (0)
#define SWAIT() asm volatile("s_waitcnt vmcnt(0)" ::: "memory")
#define RESC(a) do { if (__any((a) < 1.f)) { if (hi == 0) al_l[r32] = (a); asm volatile("s_waitcnt lgkmcnt(0)" ::: "memory"); \
    _Pragma("unroll") for (int d = 0; d < 4; ++d) _Pragma("unroll") for (int r = 0; r < 16; ++r) o[d][r] *= al_l[crow(r, hi)]; } } while (0)
    f32x16 p0, p1; float mn, al; bf16x8 pa0, pa1, pa2, pa3;
    const int NT = (q0 + 256) / 64, NM = q0 / 64;
    SLOAD(0); SWAIT(); SWRITE(0); SLOAD(64); __syncthreads();
#pragma unroll 1
    for (int j = 0; j < NT; ++j) {
        const int bf = j & 1;
        const bool act = 64 * j <= q0 + wid * 32 + 31;
        if (act) {
            SBAR(); qkt(p0, p1, K_lds + bf * SHM_K, KR_lds + bf * SHM_KR, qr, qrl, r32, hi); if (j >= NM) cmask(p0, p1, 64 * j, qpos, hi);
            partialSM(p0, p1, m_reg, mn, al); RESC(al);
            finishSM(p0, p1, al, l_reg, pa0, pa1, pa2, pa3); SBAR();
        }
        if (j + 1 < NT) { SWAIT(); SWRITE(bf ^ 1); }
        if (j + 2 < NT) SLOAD((j + 2) * 64);
        SBAR();
        if (act) pv_d0(o, vb0 + bf * SHM_V, pa0, pa1, pa2, pa3);
        __syncthreads();
    }
    if (hi == 0) li_l[r32] = l_reg; asm volatile("s_waitcnt lgkmcnt(0)" ::: "memory");
    char* Ow = (char*)Ob + (size_t)wid * (32 * 1024 * 2);
    unsigned lofs = (unsigned)(4 * hi * 1024 + r32) * 2u; asm volatile("" : "+v"(lofs));
#pragma unroll
    for (int r = 0; r < 16; ++r) { const float rl = __builtin_amdgcn_rcpf(li_l[crow(r, hi)]);
#pragma unroll
        for (int d0 = 0; d0 < 4; ++d0) *(bf16*)(Ow + lofs + (unsigned)(((r & 3) + 8 * (r >> 2)) * 1024 + d0 * 32) * 2u) = (bf16)f2bf(o[d0][r] * rl); }
    __syncthreads();
#undef SLOAD
#undef KSCALE
#undef SWRITE
#undef SWAIT
#undef RESC
}
}

constexpr int DP_C8 = 0, C8S = 528, DP_KR = 67584, DP_P8 = 86016, P8S = 144, DP_QK = 87168, DP_QR = 91264;
__device__ __forceinline__ float dec_qn(const Args& A, int j, int h, int d) {
    const int row = MP + j;
    return bf2f(((const bf16*)(A.ws + WS_QP))[(size_t)row * 1536 + h * 128 + d]);
}
__device__ __forceinline__ float dec_qr(const Args& A, int j, int h, int e) {
    const int row = MP + j, e1 = e & 31;
    const bf16* q = (const bf16*)(A.ws + WS_QP) + (size_t)row * 1536 + 1024 + h * 64;
    const float rs = __builtin_amdgcn_rsqf(((const float*)(A.ws + WS_SQR))[(size_t)row * 8 + h] * (1.f / 64.f) + EPS);
    const float a = bf2f(q[e1]) * rs * A.in[I_QNR][e1], b = bf2f(q[e1 + 32]) * rs * A.in[I_QNR][e1 + 32];
    const float ang = (float)PAST * ROPE_INV[e1]; const float cs = cosf(ang), sn = sinf(ang);
    return e < 32 ? a * cs - b * sn : a * sn + b * cs;
}
__device__ __forceinline__ void dec_tables(const Args& A, LAS unsigned char* lds, int j, int tid_) {
    int tid = tid_; asm volatile("" : "+v"(tid));
#pragma unroll
    for (int q = 0; q < 2; ++q) { const int idx = tid + 512 * q, h = idx >> 7, d = idx & 127; ((LAS float*)(lds + DP_QK))[idx] = dec_qn(A, j, h, d) * A.in[I_KNN][d]; }
    { const int h = tid >> 6, e = tid & 63; ((LAS float*)(lds + DP_QR))[tid] = dec_qr(A, j, h, e); }
}
__device__ __forceinline__ void dec_combine(const Args& A, LAS unsigned char* lds, int unit, int tid, int lane, int wave) {
    unsigned char* ws = A.ws;
    const int j = unit >> 3, h = unit & 7, row = MP + j;
    const bf16* Krow = (const bf16*)(ws + WS_KN) + (size_t)row * 1024 + h * 128;
    const bf16* KRrow = (const bf16*)(ws + WS_KR) + (size_t)row * 64;
    const float snew = wave_sum(dec_qn(A, j, h, lane) * bf2f(Krow[lane]) + dec_qn(A, j, h, lane + 64) * bf2f(Krow[lane + 64])
                                + dec_qr(A, j, h, lane) * bf2f(KRrow[lane])) * MLA_SCALE;
    const float* ML = (const float*)(ws + WS_DML) + ((size_t)j * NPAGE * 8 + h) * 2;
    const float m0 = ML[(size_t)lane * 16], m1 = ML[(size_t)(lane + 64) * 16], l0 = ML[(size_t)lane * 16 + 1], l1 = ML[(size_t)(lane + 64) * 16 + 1];
    const float M = fmaxf(wave_max(fmaxf(m0, m1)), snew);
    const float wn = __expf(snew - M);
    const float den = wave_sum(__expf(m0 - M) * l0 + __expf(m1 - M) * l1) + wn;
    const float* DA = (const float*)(ws + WS_DACC) + ((size_t)j * NPAGE * 8 + h) * 512 + tid;
    float num = wn * bf2f(((const bf16*)(ws + WS_C))[(size_t)row * 512 + tid]);
#pragma unroll 16
    for (int p = 0; p < NPAGE; ++p) num += __expf(ML[(size_t)p * 16] - M) * DA[(size_t)p * 4096];
    LAS float* lat = (LAS float*)lds; LAS float* red = lat + 512;
    lat[tid] = num / den;
    __syncthreads();
    const int d = tid & 127, qt = tid >> 7;
    const float* Wv = A.in[I_WUV] + (size_t)(qt * 128) * 1024 + h * 128 + d;
    float part = 0.f;
#pragma unroll 32
    for (int c = 0; c < 128; ++c) part += lat[qt * 128 + c] * Wv[(size_t)c * 1024];
    red[tid] = part;
    __syncthreads();
    if (tid < 128) ((bf16*)(ws + WS_YB))[(size_t)row * 1024 + h * 128 + tid] = (bf16)f2bf(red[tid] + red[128 + tid] + red[256 + tid] + red[384 + tid]);
    __syncthreads();
}
__device__ __forceinline__ f32x16 skinny_partial(const bf16* A, const bf16* Bt, int K, int n0, int wave, int lane) {
    const int l31 = lane & 31, hi = lane >> 5, kw = K >> 3, k0 = wave * kw;
    const bf16* ap = A + (size_t)l31 * K + k0 + 8 * hi; const bf16* bp = Bt + (size_t)(n0 + l31) * K + k0 + 8 * hi;
    f32x16 acc = {};
#pragma unroll 8
    for (int ks = 0; ks < (kw >> 4); ++ks) acc = MFMA32(gl_ld8(ap + 16 * ks), gl_ld8(bp + 16 * ks), acc);
    return acc;
}
__device__ __forceinline__ void skinny_put(LAS float* red, const f32x16& acc, int wave, int lane) {
    const int l31 = lane & 31, hi = lane >> 5;
#pragma unroll
    for (int r = 0; r < 16; ++r) red[(wave * 32 + crow(r, hi)) * 32 + l31] = acc[r];
}
__device__ __forceinline__ void skinny_get(LAS const float* red, int tid, float& v0, float& v1) {
    v0 = 0.f; v1 = 0.f;
#pragma unroll
    for (int w = 0; w < 8; ++w) { v0 += red[w * 1024 + tid * 2]; v1 += red[w * 1024 + tid * 2 + 1]; }
}
template <int MODE> __device__ __forceinline__ void skinny_tile(const Args& A, LAS unsigned char* lds, int tile, int tid, int lane, int wave) {
    unsigned char* ws = A.ws; const int n0 = tile * 32;
    LAS float* red = (LAS float*)lds; LAS float* red2 = red + 8192;
    if (MODE == 0) {
        skinny_put(red, skinny_partial((const bf16*)(ws + WS_YA) + (size_t)MP * 1024, (const bf16*)(ws + WS_WYA), 1024, n0, wave, lane), wave, lane);
        skinny_put(red2, skinny_partial((const bf16*)(ws + WS_YB) + (size_t)MP * 1024, (const bf16*)(ws + WS_WYB), 1024, n0, wave, lane), wave, lane);
    } else if (MODE == 1) skinny_put(red, skinny_partial((const bf16*)(ws + WS_T) + (size_t)MP * 1024, (const bf16*)(ws + WS_WO), 1024, n0, wave, lane), wave, lane);
    else if (MODE == 2) skinny_put(red, skinny_partial((const bf16*)(ws + WS_XN2) + (size_t)MP * 1024, (const bf16*)(ws + WS_WUP), 1024, n0, wave, lane), wave, lane);
    else skinny_put(red, skinny_partial((const bf16*)(ws + WS_H) + (size_t)MP * 4096, (const bf16*)(ws + WS_WDN), 4096, n0, wave, lane), wave, lane);
    __syncthreads();
    float v0, v1; skinny_get(red, tid, v0, v1);
    const int row = tid >> 4, col = n0 + 2 * (tid & 15); const size_t grow = (size_t)(MP + row);
    if (MODE == 0) {
        float u0, u1; skinny_get(red2, tid, u0, u1);
        const bf16* g = (const bf16*)(ws + WS_GATES) + grow * 2048 + col;
        const float t0 = bf2f(g[0]) * v0 + bf2f(g[1024]) * u0, t1 = bf2f(g[1]) * v1 + bf2f(g[1025]) * u1;
        *(unsigned*)((bf16*)(ws + WS_T) + grow * 1024 + col) = pk2(t0, t1);
    } else if (MODE == 1) {
        const float* x = A.in[I_XS] + (size_t)row * 1024 + col;
        const float y0 = x[0] + v0, y1 = x[1] + v1;
        *(unsigned*)((bf16*)(ws + WS_XN2) + grow * 1024 + col) = pk2(y0, y1);
        float ss = y0 * y0 + y1 * y1; ss += __shfl_xor(ss, 1); ss += __shfl_xor(ss, 2); ss += __shfl_xor(ss, 4); ss += __shfl_xor(ss, 8);
        if ((tid & 15) == 0) atomicAdd((float*)(ws + WS_RX) + grow, ss);
    } else if (MODE == 2) {
        const float rr = __builtin_amdgcn_rsqf(((const float*)(ws + WS_RX))[grow] * (1.f / 1024.f) + EPS);
        const float a = fmaxf(v0 * rr, 0.f), b = fmaxf(v1 * rr, 0.f);
        *(unsigned*)((bf16*)(ws + WS_H) + grow * 4096 + col) = pk2(a * a, b * b);
    } else {
        const unsigned xw = *(const unsigned*)((const bf16*)(ws + WS_XN2) + grow * 1024 + col); float* o = A.out + O_YS + (size_t)row * 1024 + col;
        o[0] = lo16(xw) + v0; o[1] = hi16(xw) + v1;
    }
    __syncthreads();
}
typedef int v8i __attribute__((ext_vector_type(8)));
#define MFMA8(a_, b_, c_) __builtin_amdgcn_mfma_scale_f32_32x32x64_f8f6f4((a_), (b_), (c_), 0, 0, 0, 0x7F7F7F7F, 0, 0x7F7F7F7F)
struct DecPk { v4u p[36]; };
__device__ __forceinline__ void dec_cvt_group(const f32x4& a, const f32x4& b, bool rope, v4u& o) {
    if (rope) { o.x = pk2(a.x, a.y); o.y = pk2(a.z, a.w); o.z = pk2(b.x, b.y); o.w = pk2(b.z, b.w); }
    else { o.x = f8pack(a.x, a.y, a.z, a.w); o.y = f8pack(b.x, b.y, b.z, b.w); o.z = 0u; o.w = 0u; }
}
__device__ __forceinline__ void dec_put_group(LAS unsigned char* lds, int row, int g, const v4u& o) {
    if (g < 64) *(LAS v2u*)(lds + DP_C8 + row * C8S + g * 8) = (v2u){o.x, o.y}; else *(LAS v4u*)(lds + DP_KR + row * 144 + (g - 64) * 16) = o;
}
__device__ __forceinline__ void dec_load_sync(const Args& A, LAS unsigned char* lds, int unit, int tid) {
    const int phys = ((const int*)A.in[I_PT])[unit];
    const float* src = A.in[I_CACHE] + (size_t)phys * PAGE * LATW;
#pragma unroll 1
    for (int q0 = 0; q0 < 18; q0 += 6) {
        f32x4 va[6], vb[6];
#pragma unroll
        for (int q = 0; q < 6; ++q) { const int id = (q0 + q) * 512 + tid, row = id / 72, g = id % 72; const float* p = src + (size_t)row * LATW + 8 * g; va[q] = *(const f32x4*)p; vb[q] = *(const f32x4*)(p + 4); }
#pragma unroll
        for (int q = 0; q < 6; ++q) { const int id = (q0 + q) * 512 + tid, row = id / 72, g = id % 72; v4u o; dec_cvt_group(va[q], vb[q], g >= 64, o); dec_put_group(lds, row, g, o); }
    }
    __syncthreads();
}
__device__ __forceinline__ void dec_prefetch(const Args& A, int unit, int lt, DecPk& pk) {
    const int phys = __builtin_amdgcn_readfirstlane(((const int*)A.in[I_PT])[unit]);
    const char* src = (const char*)(A.in[I_CACHE] + (size_t)phys * PAGE * LATW);
    const unsigned lo = (unsigned)lt * 32u;
#pragma unroll
    for (int q0 = 0; q0 < 36; q0 += 12) {
        f32x4 va[12], vb[12];
#pragma unroll
        for (int q = 0; q < 12; ++q) { const char* p = src + (size_t)(q0 + q) * 8192 + lo; va[q] = __builtin_nontemporal_load((const f32x4*)p); vb[q] = __builtin_nontemporal_load((const f32x4*)(p + 16)); }
#pragma unroll
        for (int q = 0; q < 12; ++q) { const int id = (q0 + q) * 256 + lt; dec_cvt_group(va[q], vb[q], (id % 72) >= 64, pk.p[q0 + q]); }
    }
}
__device__ __forceinline__ void dec_store(LAS unsigned char* lds, int lt, const DecPk& pk) {
    int ltx = lt; asm volatile("" : "+v"(ltx));
#pragma unroll
    for (int q = 0; q < 36; ++q) { const int id = q * 256 + ltx, row = id / 72, g = id - row * 72; dec_put_group(lds, row, g, pk.p[q]); }
}
constexpr int RD = 8;
__device__ __forceinline__ v8i dec_ld_a(const __amdgpu_buffer_rsrc_t rs, unsigned voff, int so) {
    const v4u x = __builtin_amdgcn_raw_buffer_load_b128(rs, voff, so, 0), y = __builtin_amdgcn_raw_buffer_load_b128(rs, voff, so + 16, 0);
    return (v8i){(int)x.x, (int)x.y, (int)x.z, (int)x.w, (int)y.x, (int)y.y, (int)y.z, (int)y.w};
}
__device__ __forceinline__ v8i dec_ld_b(LAS const unsigned char* p) { const v4u x = *(LAS const v4u*)p, y = *(LAS const v4u*)(p + 16); return (v8i){(int)x.x, (int)x.y, (int)x.z, (int)x.w, (int)y.x, (int)y.y, (int)y.z, (int)y.w}; }
__device__ __forceinline__ void dec_ring_fill(const Args& A, int mw, int lane, v8i (&a)[RD]) {
    const __amdgpu_buffer_rsrc_t rs = __builtin_amdgcn_make_buffer_rsrc((void*)(A.ws + WS_WKT), 0, 1024 * 512, 0x00020000);
    const unsigned voff = (unsigned)lane * 32u; const int so = 8 * mw * 8 * 2048;
#pragma unroll
    for (int d = 0; d < RD; ++d) a[d] = dec_ld_a(rs, voff, so + d * 2048);
}
__device__ __forceinline__ void dec_mfma(const Args& A, LAS unsigned char* lds, int unit, int mw, int lane, v8i (&a)[RD]) {
    const int l31_ = lane & 31, hi_ = lane >> 5;
    const __amdgpu_buffer_rsrc_t rs = __builtin_amdgcn_make_buffer_rsrc((void*)(A.ws + WS_WKT), 0, 1024 * 512, 0x00020000);
    const unsigned voff = (unsigned)lane * 32u; const int so = 8 * mw * 8 * 2048;
    LAS const unsigned char* Bb = lds + DP_C8 + l31_ * C8S + hi_ * 32;
    float ssq[4] = {0.f, 0.f, 0.f, 0.f}, dot[4] = {0.f, 0.f, 0.f, 0.f};
    v8i bc0 = dec_ld_b(Bb), bc1 = dec_ld_b(Bb + 32 * C8S), bc2 = dec_ld_b(Bb + 64 * C8S), bc3 = dec_ld_b(Bb + 96 * C8S), bd0, bd1, bd2, bd3;
#pragma unroll 1
    for (int jb = 0; jb < 8; ++jb) {
        f32x16 acc[4];
#pragma unroll
        for (int nt = 0; nt < 4; ++nt) acc[nt] = f32x16{};
        const int nb = so + ((jb + 1) & 7) * 8 * 2048;
#pragma unroll
        for (int d = 0; d < RD; d += 2) {
            {   LAS const unsigned char* Bx = Bb + (d + 1) * 64;
                bd0 = dec_ld_b(Bx); bd1 = dec_ld_b(Bx + 32 * C8S); bd2 = dec_ld_b(Bx + 64 * C8S); bd3 = dec_ld_b(Bx + 96 * C8S);
                __builtin_amdgcn_sched_barrier(0);
                acc[0] = MFMA8(a[d], bc0, acc[0]); acc[1] = MFMA8(a[d], bc1, acc[1]); acc[2] = MFMA8(a[d], bc2, acc[2]); acc[3] = MFMA8(a[d], bc3, acc[3]);
                a[d] = dec_ld_a(rs, voff, nb + d * 2048);
                __builtin_amdgcn_sched_barrier(0); }
            {   LAS const unsigned char* Bx = Bb + ((d + 2) & 7) * 64;
                bc0 = dec_ld_b(Bx); bc1 = dec_ld_b(Bx + 32 * C8S); bc2 = dec_ld_b(Bx + 64 * C8S); bc3 = dec_ld_b(Bx + 96 * C8S);
                __builtin_amdgcn_sched_barrier(0);
                acc[0] = MFMA8(a[d + 1], bd0, acc[0]); acc[1] = MFMA8(a[d + 1], bd1, acc[1]); acc[2] = MFMA8(a[d + 1], bd2, acc[2]); acc[3] = MFMA8(a[d + 1], bd3, acc[3]);
                a[d + 1] = dec_ld_a(rs, voff, nb + (d + 1) * 2048);
                __builtin_amdgcn_sched_barrier(0); }
        }
        const int e4 = jb & 3, h = 2 * mw + (jb >> 2);
        int l31 = l31_, hi = hi_; asm volatile("" : "+v"(l31), "+v"(hi));
        LAS const float* QK = (LAS const float*)(lds + DP_QK) + h * 128 + 32 * e4 + 4 * hi;
#pragma unroll
        for (int g = 0; g < 4; ++g) { const f32x4 qv = *(LAS const f32x4*)(QK + 8 * g);
#pragma unroll
            for (int nt = 0; nt < 4; ++nt) {
                const float x0 = acc[nt][4 * g], x1 = acc[nt][4 * g + 1], x2 = acc[nt][4 * g + 2], x3 = acc[nt][4 * g + 3];
                ssq[nt] += x0 * x0 + x1 * x1 + x2 * x2 + x3 * x3; dot[nt] += x0 * qv.x + x1 * qv.y + x2 * qv.z + x3 * qv.w; } }
        if (e4 == 3) {
#pragma unroll
            for (int nt = 0; nt < 4; ++nt) { ssq[nt] += __shfl_xor(ssq[nt], 32); dot[nt] += __shfl_xor(dot[nt], 32); }
            constexpr float C1 = 1.f / 64.f, C2 = 1.f / (4096.f * 128.f);
            const float sn0 = dot[0] * C1 * __builtin_amdgcn_rsqf(ssq[0] * C2 + EPS), sn1 = dot[1] * C1 * __builtin_amdgcn_rsqf(ssq[1] * C2 + EPS);
            const float sn2 = dot[2] * C1 * __builtin_amdgcn_rsqf(ssq[2] * C2 + EPS), sn3 = dot[3] * C1 * __builtin_amdgcn_rsqf(ssq[3] * C2 + EPS);
            const float snA = hi ? sn2 : sn0, snB = hi ? sn3 : sn1;
            float s[2];
            LAS const float* QR = (LAS const float*)(lds + DP_QR) + h * 64;
#pragma unroll
            for (int u = 0; u < 2; ++u) { const int key = 32 * (2 * hi + u) + l31; float sr = 0.f;
#pragma unroll
                for (int c = 0; c < 8; ++c) { const v4u w = *(LAS const v4u*)(lds + DP_KR + key * 144 + c * 16); const f32x4 q0 = *(LAS const f32x4*)(QR + 8 * c), q1 = *(LAS const f32x4*)(QR + 8 * c + 4);
                    sr += lo16(w.x) * q0.x + hi16(w.x) * q0.y + lo16(w.y) * q0.z + hi16(w.y) * q0.w + lo16(w.z) * q1.x + hi16(w.z) * q1.y + lo16(w.w) * q1.z + hi16(w.w) * q1.w; }
                s[u] = ((u ? snB : snA) + sr) * MLA_SCALE; }
            const float mx = wave_max(fmaxf(s[0], s[1]));
            const float p0 = __expf(s[0] - mx), p1 = __expf(s[1] - mx);
            const float lsum = wave_sum(p0 + p1);
            const unsigned pw = f8pack(p0, p1, 0.f, 0.f);
            *(LAS unsigned char*)(lds + DP_P8 + h * P8S + 32 * (2 * hi) + l31) = (unsigned char)(pw & 0xffu);
            *(LAS unsigned char*)(lds + DP_P8 + h * P8S + 32 * (2 * hi + 1) + l31) = (unsigned char)((pw >> 8) & 0xffu);
            if (l31 + hi == 0) { float* ml = (float*)(A.ws + WS_DML) + ((size_t)unit * 8 + h) * 2; ml[0] = mx; ml[1] = lsum; }
#pragma unroll
            for (int nt = 0; nt < 4; ++nt) { ssq[nt] = 0.f; dot[nt] = 0.f; }
        }
    }
}
__device__ __forceinline__ void dec_pv(const Args& A, LAS unsigned char* lds, int unit, int lane, int wave) {
    int l31 = lane & 31, hi = lane >> 5; asm volatile("" : "+v"(l31), "+v"(hi));
    float* DA = (float*)(A.ws + WS_DACC) + (size_t)unit * 8 * 512;
#pragma unroll 1
    for (int t = 0; t < 2; ++t) { const int cb = 64 * wave + 32 * t + l31;
        f32x16 acc2 = {};
#pragma unroll 1
        for (int ks = 0; ks < 2; ++ks) {
            v8i a = {0, 0, 0, 0, 0, 0, 0, 0};
            if (l31 < 8) a = dec_ld_b(lds + DP_P8 + l31 * P8S + 64 * ks + 32 * hi);
            LAS const unsigned char* cp = lds + DP_C8 + (64 * ks + 32 * hi) * C8S + cb;
            v8i bb;
#pragma unroll
            for (int w = 0; w < 8; ++w) { const unsigned b0 = cp[(4 * w) * C8S], b1 = cp[(4 * w + 1) * C8S], b2 = cp[(4 * w + 2) * C8S], b3 = cp[(4 * w + 3) * C8S];
                bb[w] = (int)(b0 | (b1 << 8) | (b2 << 16) | (b3 << 24)); }
            acc2 = MFMA8(a, bb, acc2);
        }
#pragma unroll
        for (int r = 0; r < 4; ++r) DA[(size_t)(r + 4 * hi) * 512 + cb] = acc2[r];
    }
}
constexpr int NG4 = 640, NG2 = 512, NG1 = 512;
template <bool MF> __device__ __forceinline__ void dec_loop(const Args& A, LAS unsigned char* lds, volatile LAS unsigned* MISC, unsigned* qc, int g, int tid, int lane, int wave) {
    constexpr int NGRP = NG4 + NG2 + NG1; static_assert(4 * NG4 + 2 * NG2 + NG1 == 4096, "page count");
#define GFIRST(g_) ((g_) < NG4 ? 4 * (g_) : (g_) < NG4 + NG2 ? 4 * NG4 + 2 * ((g_) - NG4) : 4 * NG4 + 2 * NG2 + ((g_) - NG4 - NG2))
#define GCOUNT(g_) ((g_) < NG4 ? 4 : (g_) < NG4 + NG2 ? 2 : 1)
#define DPULL() ({ __syncthreads(); if (tid == 0) MISC[0] = atomicAdd(qc, 1u); __syncthreads(); (int)MISC[0]; })
    int jcur = -1;
#ifdef PROBE_K
#ifndef PROBE_B
#define PROBE_B 0
#endif
    unsigned long long pt0 = 0, pdt = 0;
#define DPS(k) do { if ((k) == PROBE_K) pt0 = __builtin_amdgcn_s_memrealtime(); } while (0)
#define DPE(k) do { if ((k) == PROBE_K) pdt += __builtin_amdgcn_s_memrealtime() - pt0; } while (0)
#else
#define DPS(k) do {} while (0)
#define DPE(k) do {} while (0)
#endif
    v8i a[RD];
    if (MF) dec_ring_fill(A, wave, lane, a);
#pragma unroll 1
    while (g < NGRP) {
        const int gn = DPULL();
        const int j = GFIRST(g) >> 7, PG = GCOUNT(g), u0 = GFIRST(g);
        if (j != jcur) { dec_tables(A, lds, j, tid); jcur = j; __syncthreads(); }
#pragma unroll 1
        for (int p = 0; p < PG; ++p) {
            const int unit = u0 + p, np = (p + 1 < PG) ? unit + 1 : (gn < NGRP ? GFIRST(gn) : -1);
            DecPk pk;
            DPS(64); DPS(60); DPS(61);
#ifdef PROBE_K
            const unsigned long long ck0 = __builtin_readcyclecounter();
#endif
            if (MF) { dec_mfma(A, lds, unit, wave, lane, a); DPE(60);
#ifdef PROBE_K
                if (PROBE_K == 66) pdt += (__builtin_readcyclecounter() - ck0) / 24;
#endif
            }
            else if (np >= 0) { dec_prefetch(A, np, tid - 256, pk); DPE(61); }
            LBAR();
            DPS(62);
            dec_pv(A, lds, unit, lane, wave);
            LBAR();
            DPE(62); DPS(63);
            if (MF) { if (np >= 0) dec_ring_fill(A, wave, lane, a); }
            else if (np >= 0) dec_store(lds, tid - 256, pk);
            LBAR();
            DPE(63); DPE(64);
#ifdef PROBE_K
            if (PROBE_K == 67) pdt = ((volatile LAS unsigned*)(lds + MISC_OFF))[20];
#endif
#ifdef PROBE_K
            if (PROBE_K == 65) pdt += 1000;
#endif
        }
        g = gn;
    }
#ifdef PROBE_K
    if (blockIdx.x == PROBE_B && PROBE_K >= 60) { const unsigned long long te = __builtin_amdgcn_s_memrealtime(); while (__builtin_amdgcn_s_memrealtime() - te < (unsigned long long)PROBE_MULT * pdt) __builtin_amdgcn_s_sleep(8); }
#endif
}
__device__ __forceinline__ void dec_run(const Args& A, LAS unsigned char* lds, volatile LAS unsigned* MISC, unsigned* qc, int tid, int lane, int wave) {
    const int g = DPULL();
    if (g >= NG4 + NG2 + NG1) return;
    dec_load_sync(A, lds, GFIRST(g), tid);
    if (wave < 4) dec_loop<true>(A, lds, MISC, qc, g, tid, lane, wave);
    else dec_loop<false>(A, lds, MISC, qc, g, tid, lane, wave);
#undef DPULL
#undef GFIRST
#undef GCOUNT
}
#ifndef MK_SINGLE
#define MK_SINGLE 1
#endif
constexpr int N_PHASES = 12;
__global__ void __launch_bounds__(512, 2) mk_fwd(Args args) {
    extern __shared__ __attribute__((aligned(16))) unsigned char lds_raw[];
    LAS unsigned char* lds = (LAS unsigned char*)lds_raw;
    const int tid = threadIdx.x, lane = tid & 63, wave = __builtin_amdgcn_readfirstlane(tid >> 6);
    const int G = gridDim.x, bid = blockIdx.x;
    const int gw = bid * 8 + wave, NGW = G * 8, gtid = bid * 512 + tid, NGT = G * 512;
    volatile LAS unsigned* MISC = (volatile LAS unsigned*)(lds + MISC_OFF);
    if (tid < 32) MISC[tid] = 0u;
    __syncthreads();
    unsigned char* ws = args.ws;
#if MK_SINGLE
    XcdBarrier bar = xcd_barrier_post((unsigned*)(ws + WS_CTL) + 4096, MISC + 8);
#define GRID_BAR() xcd_barrier(bar)
#else
#define GRID_BAR() do {} while (0)
#endif
    const int lo = args.ph_lo, hi = args.ph_hi;
#ifdef PROBE_K
#ifndef PROBE_B
#define PROBE_B 0
#endif
    unsigned long long pt0 = 0, pdt = 0;
#define PSTART(k) do { if ((k) == PROBE_K) pt0 = __builtin_amdgcn_s_memrealtime(); } while (0)
#define PEND(k) do { if ((k) == PROBE_K) pdt += __builtin_amdgcn_s_memrealtime() - pt0; } while (0)
#else
#define PSTART(k) do {} while (0)
#define PEND(k) do {} while (0)
#endif
#ifndef PHASE_MASK
#define PHASE_MASK 0xFFFF
#endif
#define IN(k) (((PHASE_MASK >> (k)) & 1) && lo <= (k) && (k) < hi)
#define SEAM(k) do { if (IN(k) && IN((k) + 1)) GRID_BAR(); } while (0)

    PSTART(0);
    if (IN(0)) {
        p0_prologue(args, lds, gw, NGW, wave, lane);
        for (int i = gtid; i < 32 * 2 * 3072; i += NGT) { const int c = i % 3072, r = (i / 3072) % 2, j = i / (2 * 3072);
            args.out[O_CSS + (size_t)(j * 3 + r) * 3072 + c] = args.in[I_SCONV][(size_t)(j * 3 + r + 1) * 3072 + c]; }
        __syncthreads();
    }
    SEAM(0);
    PEND(0);
    PSTART(1);
    if (IN(1)) {
        pg8::Gemm g{(const pg8::bf16_t*)(ws + WS_XN), (const pg8::bf16_t*)(ws + WS_WIN), MPAD, NIN, 1024};
        pg8::StaticOrder S; S.init(MPAD, NIN, G, bid);
        EpiG1 E{(bf16*)(ws + WS_QKV), (bf16*)(ws + WS_Z), (bf16*)(ws + WS_QD), (bf16*)(ws + WS_KVD), (bf16*)(ws + WS_GATES), (float*)(ws + WS_SM)};
        pg8::gemm_phase<EpiG1, pg8::StaticOrder, true, true>(lds, g, S, E);
        { const int nfull = (MPAD / 256) * (NIN / 256) - ((MPAD / 256) * (NIN / 256) / G) * G;
          if (bid >= nfull) cvt_weights<true>(args, lds, (bid - nfull) * 8 + wave, (G - nfull) * 8, wave, lane); }
    }
    SEAM(1);
    PEND(1);
    PSTART(2);
    if (IN(2)) {
        p2_rows(args, gw, NGW, lane);
        p2_conv_state(args, gtid, NGT);
    }
    SEAM(2);
    PEND(2);
    PSTART(3);
    if (IN(3)) {
        { pg8::Gemm g{(const pg8::bf16_t*)(ws + WS_QD), (const pg8::bf16_t*)(ws + WS_WQ), MPAD, 1536, 512};
          pg8::StaticOrder S; S.init(MPAD, 1536, G, bid);
          EpiHeads<0> E{(bf16*)(ws + WS_QP), 1536, 6, (bf16*)(ws + WS_QP), 1536, (float*)(ws + WS_SQR), args.in[I_QNN], (LAS float*)(lds + EPI_S_OFF)};
          pg8::gemm_phase<EpiHeads<0>, pg8::StaticOrder, true, true>(lds, g, S, E); }
        { pg8::Gemm g{(const pg8::bf16_t*)(ws + WS_C), (const pg8::bf16_t*)(ws + WS_WKV), MPAD, 2048, 512};
          pg8::StaticOrder S; S.init(MPAD, 2048, G, G - 1 - bid);
          EpiHeads<1> E{(bf16*)(ws + WS_KN), 1024, 4, (bf16*)(ws + WS_V), 1024, (float*)(ws + WS_SQR), args.in[I_KNN], (LAS float*)(lds + EPI_S_OFF)};
          pg8::gemm_phase<EpiHeads<1>, pg8::StaticOrder, true, true>(lds, g, S, E); }
        PSTART(31);
        for (int u = bid; u < 2048; u += G) gdn_a_unit(args, lds, u, tid, lane, wave);
        PEND(31); PSTART(32);
        for (int u = bid; u < 256; u += G) gdn_r_unit(args, lds, u, tid, lane, wave);
        PEND(32);
    }
    SEAM(3);
    PEND(3);
    PSTART(5);
    if (IN(5)) {
        unsigned* qctr = (unsigned*)(ws + WS_CTL) + 64;
#define PULL(k) ({ __syncthreads(); if (tid == 0) MISC[0] = atomicAdd(qctr + 64 * (k), 1u); __syncthreads(); (int)MISC[0]; })
        PSTART(50);
        for (int it = PULL(0); it < 64; it = PULL(0)) gdn_b_unit(args, lds, it, tid, lane, wave);
        PEND(50); PSTART(51);
        for (int u = PULL(1); u < 256; u = PULL(1)) {
            const int bh = u >> 2, pr = u & 3, b = bh >> 3, h = bh & 7;
#pragma unroll 1
            for (int s2 = 0; s2 < 2; ++s2) { const int qb = s2 ? pr : 7 - pr;
                att::attn_block((const bf16*)(ws + WS_QP) + (size_t)(b * SEQ + 256 * qb) * 1536 + h * 128, (const bf16*)(ws + WS_QP) + (size_t)(b * SEQ + 256 * qb) * 1536 + 1024 + h * 64,
                                (const float*)(ws + WS_SQN) + (size_t)(b * SEQ + 256 * qb) * 8 + h, (const float*)(ws + WS_SQR) + (size_t)(b * SEQ + 256 * qb) * 8 + h,
                                (const bf16*)(ws + WS_KN) + (size_t)(b * SEQ) * 1024 + h * 128, (const float*)(ws + WS_SKN) + (size_t)(b * SEQ) * 8 + h,
                                (const bf16*)(ws + WS_KR) + (size_t)(b * SEQ) * 64, (const bf16*)(ws + WS_V) + (size_t)(b * SEQ) * 1024 + h * 128,
                                args.in[I_QNN], args.in[I_QNR], args.in[I_KNN],
                                (bf16*)(ws + WS_YB) + (size_t)(b * SEQ + 256 * qb) * 1024 + h * 128, 256 * qb, lds); }
        }
        PEND(51); PSTART(52);
        dec_run(args, lds, MISC, qctr + 128, tid, lane, wave);
        PEND(52); PSTART(53);
#undef PULL
    }
    SEAM(5);
    PEND(5); PEND(53);
    PSTART(6);
    if (IN(6)) { for (int u = bid; u < 256; u += G) dec_combine(args, lds, u, tid, lane, wave); }
    SEAM(6);
    PEND(6);
    PSTART(7);
    if (IN(7)) {
        for (int t = bid; t < 32; t += G) skinny_tile<0>(args, lds, t, tid, lane, wave);
        pg8::StaticOrder S; S.init(MP, 1024, G, bid);
        { pg8::Gemm g{(const pg8::bf16_t*)(ws + WS_YA), (const pg8::bf16_t*)(ws + WS_WYA), MP, 1024, 1024};
          EpiMerge<1> E{(const bf16*)(ws + WS_GATES), (float*)(ws + WS_TF), (bf16*)(ws + WS_T)};
          pg8::gemm_phase<EpiMerge<1>, pg8::StaticOrder, true, true>(lds, g, S, E); }
        { pg8::Gemm g{(const pg8::bf16_t*)(ws + WS_YB), (const pg8::bf16_t*)(ws + WS_WYB), MP, 1024, 1024};
          EpiMerge<2> E{(const bf16*)(ws + WS_GATES), (float*)(ws + WS_TF), (bf16*)(ws + WS_T)};
          pg8::gemm_phase<EpiMerge<2>, pg8::StaticOrder, true, true>(lds, g, S, E); }
    }
    SEAM(7);
    PEND(7);
    PSTART(8);
    if (IN(8)) {
        for (int t = bid; t < 32; t += G) skinny_tile<1>(args, lds, t, tid, lane, wave);
        pg8::Gemm g{(const pg8::bf16_t*)(ws + WS_T), (const pg8::bf16_t*)(ws + WS_WO), MP, 1024, 1024};
        pg8::StaticOrder S; S.init(MP, 1024, G, bid);
        EpiRes<0> E{args.in[I_XP], args.in[I_XS], (float*)(ws + WS_X1), args.out, (bf16*)(ws + WS_XN2), (float*)(ws + WS_RX), lds};
        pg8::gemm_phase<EpiRes<0>, pg8::StaticOrder, true, true>(lds, g, S, E);
    }
    SEAM(8);
    PEND(8);
    PSTART(10);
    if (IN(10)) {
        for (int t = bid; t < 128; t += G) skinny_tile<2>(args, lds, t, tid, lane, wave);
        pg8::Gemm g{(const pg8::bf16_t*)(ws + WS_XN2), (const pg8::bf16_t*)(ws + WS_WUP), MP, 4096, 1024};
        pg8::StaticOrder S; S.init(MP, 4096, G, bid);
        EpiUp E{(bf16*)(ws + WS_H), (const float*)(ws + WS_RX)};
        pg8::gemm_phase<EpiUp, pg8::StaticOrder, true, true>(lds, g, S, E);
    }
    SEAM(10);
    PEND(10);
    PSTART(11);
    if (IN(11)) {
        for (int t = bid; t < 32; t += G) skinny_tile<3>(args, lds, t, tid, lane, wave);
        pg8::Gemm g{(const pg8::bf16_t*)(ws + WS_H), (const pg8::bf16_t*)(ws + WS_WDN), MP, 1024, 4096};
        pg8::StaticOrder S; S.init(MP, 1024, G, bid);
        EpiRes<1> E{args.in[I_XP], args.in[I_XS], (float*)(ws + WS_X1), args.out, (bf16*)(ws + WS_XN2), (float*)(ws + WS_RX), lds};
        pg8::gemm_phase<EpiRes<1>, pg8::StaticOrder, true, true>(lds, g, S, E);
    }
    PEND(11);
#ifdef PROBE_K
    if (PROBE_K >= 80 && PROBE_K < 90) { __syncthreads(); pdt = MISC[16]; }
    if (bid == PROBE_B || (PROBE_K >= 80 && PROBE_K < 90)) { const unsigned long long te = __builtin_amdgcn_s_memrealtime(); while (__builtin_amdgcn_s_memrealtime() - te < (unsigned long long)PROBE_MULT * pdt) __builtin_amdgcn_s_sleep(8); }
#endif
#undef IN
#undef SEAM
}

extern "C" void kernel_launch(void* const* d_in, const int* in_sizes, int n_in, void* d_out, int out_size, void* d_ws, size_t ws_size, hipStream_t stream) {
    static int grid = 0;
    if (grid == 0) {
        if (n_in != 27 || ws_size < WS_END) { fprintf(stderr, "kernel_launch: unexpected n_in %d or ws_size %zu (need %zu)\n", n_in, ws_size, (size_t)WS_END); grid = -1; return; }
        int dev = 0, cus = 0, per_cu = 0;
        if (hipGetDevice(&dev) != hipSuccess || hipDeviceGetAttribute(&cus, hipDeviceAttributeMultiprocessorCount, dev) != hipSuccess) { grid = -1; return; }
        if (hipFuncSetAttribute((const void*)mk_fwd, hipFuncAttributeMaxDynamicSharedMemorySize, LDS_BYTES) != hipSuccess) { fprintf(stderr, "kernel_launch: hipFuncSetAttribute failed\n"); grid = -1; return; }
        if (hipOccupancyMaxActiveBlocksPerMultiprocessor(&per_cu, (const void*)mk_fwd, 512, LDS_BYTES) != hipSuccess || per_cu < 1) fprintf(stderr, "kernel_launch: occupancy query says %d\n", per_cu);
        (void)hipGetLastError();
        grid = cus;
    }
    if (grid < 0) return;
    (void)hipMemsetAsync((char*)d_ws + WS_CTL, 0, CTL_BYTES, stream);
    Args a{};
    for (int i = 0; i < 27; ++i) a.in[i] = (const float*)d_in[i];
    a.out = (float*)d_out; a.ws = (unsigned char*)d_ws;
#if MK_SINGLE
    a.ph_lo = 0; a.ph_hi = N_PHASES;
    hipLaunchKernelGGL(mk_fwd, dim3(grid), dim3(512), LDS_BYTES, stream, a);
#else
    for (int p = 0; p < N_PHASES; ++p) { a.ph_lo = p; a.ph_hi = p + 1; hipLaunchKernelGGL(mk_fwd, dim3(grid), dim3(512), LDS_BYTES, stream, a); }
#endif
    const hipError_t le = hipPeekAtLastError();
    if (le != hipSuccess) fprintf(stderr, "kernel_launch: launch failed: %s\n", hipGetErrorName(le));
}
```
